# Optimizing an MI355X kernel written in HIP

```python
import math
import jax
import jax.numpy as jnp
from jax import lax
import numpy as np

D_MODEL = 1024
BATCH = 2
SEQ = 16384
DEPTH = 4

N_HEADS = 4
HEAD_DIM = D_MODEL // N_HEADS
BLOCK = 128
D_FF = 2816
N_EXPERTS = 8
TOP_K = 2
D_FF_EXPERT = D_FF // 4
PLE_DIM = 256
N_A = DEPTH // 2
N_B = DEPTH - N_A
N_DENSE = (DEPTH + 1) // 2
N_MOE = DEPTH // 2
DEEPNORM_ALPHA = (2.0 * DEPTH) ** 0.25
DEEPNORM_BETA = (8.0 * DEPTH) ** -0.25
FORGET_BIAS_INIT = 2.0
LN_EPS = 1e-5

kernel_name = "yoco_stickbreak_fox_moe_deepnorm"


def layer_norm(x, g, b):
    xf = x.astype(jnp.float32)
    mu = jnp.mean(xf, axis=-1, keepdims=True)
    var = jnp.mean(jnp.square(xf - mu), axis=-1, keepdims=True)
    y = (xf - mu) * lax.rsqrt(var + LN_EPS) * g.astype(jnp.float32) + b.astype(jnp.float32)
    return y.astype(x.dtype)


def split_heads(t):
    b, s, _ = t.shape
    return t.reshape(b, s, N_HEADS, HEAD_DIM).transpose(0, 2, 1, 3)


def merge_heads(o):
    b, h, s, dh = o.shape
    return o.transpose(0, 2, 1, 3).reshape(b, s, h * dh)


def stick_breaking_attention(q, k, v):
    b, h, s_len, _ = q.shape
    nb = s_len // BLOCK
    scale = 1.0 / math.sqrt(HEAD_DIM)
    r = jnp.arange(BLOCK)
    tri_in = (r[:, None] > r[None, :]).astype(jnp.float32)
    outs = []
    for bi in range(nb):
        lo, hi = bi * BLOCK, (bi + 1) * BLOCK
        nk = bi + 1
        z = jnp.einsum('bhqd,bhkd->bhqk', q[:, :, lo:hi], k[:, :, :hi]).astype(jnp.float32) * scale
        mask = jnp.arange(hi)[None, :] < (lo + r)[:, None]
        log_1m = jnp.where(mask, -jax.nn.softplus(z), 0.0)
        lb = log_1m.reshape(b, h, BLOCK, nk, BLOCK)
        tail_in = jnp.einsum('bhqnj,js->bhqns', lb, tri_in)
        rb = jnp.arange(nk)
        tri_x = (rb[:, None] > rb[None, :]).astype(jnp.float32)
        tail_x = jnp.einsum('bhqm,mn->bhqn', jnp.sum(lb, axis=-1), tri_x)
        tail = (tail_in + tail_x[..., None]).reshape(b, h, BLOCK, hi)
        a = jnp.where(mask, jnp.exp(jax.nn.log_sigmoid(z) + tail), 0.0)
        outs.append(jnp.einsum('bhqk,bhkd->bhqd', a.astype(v.dtype), v[:, :, :hi]))
    return merge_heads(jnp.concatenate(outs, axis=2))


def forgetting_attention(q, k, v, c):
    s_len = q.shape[2]
    nb = s_len // BLOCK
    scale = 1.0 / math.sqrt(HEAD_DIM)
    r = jnp.arange(BLOCK)
    outs = []
    for bi in range(nb):
        lo, hi = bi * BLOCK, (bi + 1) * BLOCK
        z = jnp.einsum('bhqd,bhkd->bhqk', q[:, :, lo:hi], k[:, :, :hi]).astype(jnp.float32) * scale
        z = z + c[:, :, lo:hi, None] - c[:, :, None, :hi]
        mask = jnp.arange(hi)[None, :] <= (lo + r)[:, None]
        w = jax.nn.softmax(jnp.where(mask, z, -jnp.inf), axis=-1)
        outs.append(jnp.einsum('bhqk,bhkd->bhqd', w.astype(v.dtype), v[:, :, :hi]))
    return merge_heads(jnp.concatenate(outs, axis=2))


def swiglu(x, w_gu, w_down):
    g, u = jnp.split(x @ w_gu, 2, axis=-1)
    return (jax.nn.silu(g) * u) @ w_down


def moe_swiglu(x, w_router, w_gu, w_down):
    logits = jnp.einsum('bsd,de->bse', x, w_router).astype(jnp.float32)
    top_val, top_idx = lax.top_k(logits, TOP_K)
    gates = jax.nn.softmax(top_val, axis=-1)
    gate_full = jnp.einsum('bsk,bske->bse', gates,
                           jax.nn.one_hot(top_idx, N_EXPERTS, dtype=jnp.float32))
    gate_full = gate_full.astype(x.dtype)
    out = jnp.zeros_like(x)
    for e in range(N_EXPERTS):
        out = out + gate_full[..., e:e + 1] * swiglu(x, w_gu[e], w_down[e])
    return out


def setup_inputs(seed: int = 0) -> dict:
    key = jax.random.key(seed)
    ks = jax.random.split(key, 20)
    d = D_MODEL
    f32 = jnp.float32
    sd = d ** -0.5
    beta = DEEPNORM_BETA
    nrm = lambda k, shape: jax.random.normal(k, shape, f32)

    x = nrm(ks[0], (BATCH, SEQ, d))
    p = nrm(ks[1], (DEPTH, BATCH, SEQ, PLE_DIM))
    qkv_col_scale = jnp.concatenate([jnp.ones((2 * d,), f32), jnp.full((d,), beta, f32)])
    a_w_qkv = nrm(ks[2], (N_A, d, 3 * d)) * sd * qkv_col_scale
    a_w_o = nrm(ks[3], (N_A, d, d)) * sd * beta
    kvf_col_scale = jnp.concatenate([jnp.ones((d,), f32), jnp.full((d,), beta, f32),
                                     jnp.ones((N_HEADS,), f32)])
    kvf_w = nrm(ks[4], (d, 2 * d + N_HEADS)) * sd * kvf_col_scale
    kvf_b_f = FORGET_BIAS_INIT + 0.1 * nrm(ks[5], (N_HEADS,))
    b_w_q = nrm(ks[6], (N_B, d, d)) * sd
    b_w_o = nrm(ks[7], (N_B, d, d)) * sd * beta
    ffn_w_gu = nrm(ks[8], (N_DENSE, d, 2 * D_FF)) * sd
    ffn_w_down = nrm(ks[9], (N_DENSE, D_FF, d)) * (D_FF ** -0.5) * beta
    moe_w_router = nrm(ks[10], (N_MOE, d, N_EXPERTS)) * sd
    moe_w_gu = nrm(ks[11], (N_MOE, N_EXPERTS, d, 2 * D_FF_EXPERT)) * sd
    moe_w_down = nrm(ks[12], (N_MOE, N_EXPERTS, D_FF_EXPERT, d)) * (D_FF_EXPERT ** -0.5) * beta
    ple_w_proj = nrm(ks[13], (DEPTH, PLE_DIM, d)) * (PLE_DIM ** -0.5) * beta
    ple_w_gate = nrm(ks[14], (DEPTH, d, d)) * sd
    ln_g = 1.0 + 0.02 * nrm(ks[15], (DEPTH, 2, d))
    ln_b = 0.02 * nrm(ks[16], (DEPTH, 2, d))
    return {"x": x, "p": p, "a_w_qkv": a_w_qkv, "a_w_o": a_w_o,
            "kvf_w": kvf_w, "kvf_b_f": kvf_b_f, "b_w_q": b_w_q, "b_w_o": b_w_o,
            "ffn_w_gu": ffn_w_gu, "ffn_w_down": ffn_w_down,
            "moe_w_router": moe_w_router, "moe_w_gu": moe_w_gu, "moe_w_down": moe_w_down,
            "ple_w_proj": ple_w_proj, "ple_w_gate": ple_w_gate,
            "ln_g": ln_g, "ln_b": ln_b}


def reference(x, p, a_w_qkv, a_w_o, kvf_w, kvf_b_f, b_w_q, b_w_o,
              ffn_w_gu, ffn_w_down, moe_w_router, moe_w_gu, moe_w_down,
              ple_w_proj, ple_w_gate, ln_g, ln_b):
    d = D_MODEL
    k_sh = v_sh = c_sh = None
    for i in range(DEPTH):
        if i < N_A:
            q, k, v = jnp.split(x @ a_w_qkv[i], 3, axis=-1)
            mix = stick_breaking_attention(split_heads(q), split_heads(k), split_heads(v))
            mix = mix @ a_w_o[i]
        else:
            if i == N_A:
                kvf = x @ kvf_w
                k_sh = split_heads(kvf[..., :d])
                v_sh = split_heads(kvf[..., d:2 * d])
                log_f = jax.nn.log_sigmoid(kvf[..., 2 * d:].astype(jnp.float32)
                                           + kvf_b_f.astype(jnp.float32))
                c_sh = jnp.cumsum(log_f.transpose(0, 2, 1), axis=-1)
            j = i - N_A
            q = split_heads(x @ b_w_q[j])
            mix = forgetting_attention(q, k_sh, v_sh, c_sh) @ b_w_o[j]
        x = layer_norm(DEEPNORM_ALPHA * x + mix, ln_g[i, 0], ln_b[i, 0])
        if i % 2 == 0:
            ff = swiglu(x, ffn_w_gu[i // 2], ffn_w_down[i // 2])
        else:
            ff = moe_swiglu(x, moe_w_router[i // 2], moe_w_gu[i // 2], moe_w_down[i // 2])
        x = layer_norm(DEEPNORM_ALPHA * x + ff, ln_g[i, 1], ln_b[i, 1])
        x = x + (p[i] @ ple_w_proj[i]) * jax.nn.sigmoid(x @ ple_w_gate[i])
    return x
```

```cpp
#include <hip/hip_runtime.h>
#include <cstdio>
#include <cstdint>

#ifndef MK_DEBUG
#define MK_DEBUG 0
#endif

#define LAS __attribute__((address_space(3)))
#define GAS __attribute__((address_space(1)))
typedef unsigned short bf16_t;
typedef short bf16x8 __attribute__((ext_vector_type(8)));
typedef short bf16x4 __attribute__((ext_vector_type(4)));
typedef float f32x4 __attribute__((ext_vector_type(4)));
typedef float f32x2 __attribute__((ext_vector_type(2)));
typedef unsigned u32x4 __attribute__((ext_vector_type(4)));
typedef unsigned u32x2 __attribute__((ext_vector_type(2)));
typedef int i32x4 __attribute__((ext_vector_type(4)));

constexpr int DM = 1024, NBATCH = 2, SEQ = 16384, T = NBATCH * SEQ, NH = 4, HD = 256, DFF = 2816, NE = 8, DFE = 704, PLE = 256, DEPTH = 4;
constexpr float ALPHA = 1.6817928305074292f;
constexpr float LN_EPS = 1e-5f;
constexpr int NWAVES = 8, NTHREADS = 512;
enum { IN_X = 0, IN_P, IN_AQKV, IN_AO, IN_KVF, IN_KVFB, IN_BQ, IN_BO, IN_FGU, IN_FDN, IN_MR, IN_MGU, IN_MDN, IN_PP, IN_PG, IN_LNG, IN_LNB, N_IN };

constexpr size_t MiB = 1u << 20;
constexpr size_t WS_CTL = 0, CTL_ZERO_BYTES = 1 * MiB;
constexpr size_t WS_MISC = 1 * MiB;
constexpr size_t WS_WLIVE = 8 * MiB;
constexpr size_t WS_PB = 77 * MiB;
constexpr size_t WS_XB1 = 93 * MiB, WS_XB0 = 157 * MiB;
constexpr size_t WS_WDEAD = 221 * MiB;
constexpr size_t WS_QA = 294 * MiB, WS_KS = 358 * MiB, WS_VS = 422 * MiB, WS_END = 486 * MiB;
constexpr size_t MS_REC = 0;
constexpr size_t MS_HIST = 512 * 1024;
constexpr size_t MS_ELIST = 576 * 1024;
constexpr int ELIST_CAP = 2 * T + NE * 256;
constexpr size_t MS_PLIST = MS_ELIST + (size_t)ELIST_CAP * 16;
constexpr int NPAIR = 28, PLIST_CAP = T + NPAIR * 256;
constexpr size_t MS_TAB = 2 * MiB;
constexpr size_t MS_CL = 2 * MiB + 64 * 1024;
constexpr size_t MS_TOT = MS_CL + (size_t)8 * SEQ * 4;
constexpr size_t MS_SNAP = 3 * MiB;
constexpr size_t MS_EGATE = 4 * MiB + 512 * 1024;
constexpr size_t MS_GATE = 4 * MiB;
static_assert(MS_PLIST + (size_t)PLIST_CAP * 4 <= MS_TAB && MS_TOT + 8 * 256 * 4 <= MS_SNAP, "misc map");
enum { TB_ECUM = 0  , TB_EOFF = 16  , TB_NRT = 32, TB_RT2P = 64  , TB_WORDS = 320 };
constexpr int CW_TMO = 0, CW_CODE = 1, CW_DBG = 64  , CW_KN2 = 192  , CW_BAR = 4096;

constexpr size_t WSZ_QKV = (size_t)3072 * 1024, WSZ_SQ = (size_t)1024 * 1024, WSZ_GU = (size_t)5632 * 1024, WSZ_DN = (size_t)1024 * 2816,
                 WSZ_MGU = (size_t)NE * 1536 * 1024, WSZ_MDN = (size_t)1024 * 5632, WSZ_PP = (size_t)1024 * 256;
constexpr size_t WD_QKV0 = 0, WD_O0 = WD_QKV0 + WSZ_QKV, WD_QKV1 = WD_O0 + WSZ_SQ, WD_O1 = WD_QKV1 + WSZ_QKV, WD_GU0 = WD_O1 + WSZ_SQ, WD_DN0 = WD_GU0 + WSZ_GU,
                 WD_MGU0 = WD_DN0 + WSZ_DN, WD_MDN0 = WD_MGU0 + WSZ_MGU, WD_PP0 = WD_MDN0 + WSZ_MDN, WD_PG0 = WD_PP0 + WSZ_PP, WD_PP1 = WD_PG0 + WSZ_SQ, WD_PG1 = WD_PP1 + WSZ_PP, WD_END = WD_PG1 + WSZ_SQ;
constexpr size_t WL_QKV2 = 0, WL_O2 = WL_QKV2 + WSZ_QKV, WL_Q3 = WL_O2 + WSZ_SQ, WL_O3 = WL_Q3 + WSZ_SQ, WL_GU1 = WL_O3 + WSZ_SQ, WL_DN1 = WL_GU1 + WSZ_GU,
                 WL_MGU1 = WL_DN1 + WSZ_DN, WL_MDN1 = WL_MGU1 + WSZ_MGU, WL_PP2 = WL_MDN1 + WSZ_MDN, WL_PG2 = WL_PP2 + WSZ_PP, WL_PP3 = WL_PG2 + WSZ_SQ, WL_PG3 = WL_PP3 + WSZ_PP, WL_END = WL_PG3 + WSZ_SQ;
static_assert(WD_END * 2 <= 73 * MiB && WL_END * 2 <= 69 * MiB, "weight regions");
static_assert((size_t)T * DFF * 2 <= WS_END - WS_QA && WS_XB0 + (size_t)T * DFF * 2 <= WS_KS && WS_WDEAD + (size_t)(T + NPAIR * 256) * 1408 * 2 <= WS_KS, "h overlays");

constexpr int RING_BYTES = 131072;
constexpr int LDS_CTL = 135168;
constexpr int LDS_TAB = LDS_CTL + 128;
constexpr int LDS_FLAGS = LDS_TAB + TB_WORDS * 4;
constexpr int LDS_BYTES = 147456;
static_assert(LDS_FLAGS + 64 <= LDS_BYTES, "LDS map");

#define RLX_AGENT __ATOMIC_RELAXED, __HIP_MEMORY_SCOPE_AGENT
__device__ __forceinline__ unsigned f2bf(float f) { unsigned u = __builtin_bit_cast(unsigned, f); return (u + 0x7fffu + ((u >> 16) & 1u)) >> 16; }
__device__ __forceinline__ unsigned pk2(float lo, float hi) { return f2bf(lo) | (f2bf(hi) << 16); }
__device__ __forceinline__ float bf2f(unsigned short b) { return __builtin_bit_cast(float, (unsigned)b << 16); }
typedef __bf16 bf16v2_t __attribute__((ext_vector_type(2)));
__device__ __forceinline__ unsigned cvt_pk_bf16(float lo, float hi) { bf16v2_t v; v[0] = (__bf16)lo; v[1] = (__bf16)hi; return __builtin_bit_cast(unsigned, v); }
__device__ __forceinline__ float shx(float v, int m, int lane) { return __builtin_bit_cast(float, __builtin_amdgcn_ds_bpermute((lane ^ m) << 2, __builtin_bit_cast(int, v))); }
__device__ __forceinline__ int shxi(int v, int m, int lane) { return __builtin_amdgcn_ds_bpermute((lane ^ m) << 2, v); }
__device__ __forceinline__ float shup(float v, int o, int lane) { return __builtin_bit_cast(float, __builtin_amdgcn_ds_bpermute(((lane - o) & 63) << 2, __builtin_bit_cast(int, v))); }
__device__ __forceinline__ float wave_sum(float v, int lane) {
#pragma unroll
    for (int o = 1; o < 64; o <<= 1) v += shx(v, o, lane);
    return v;
}
__device__ __forceinline__ float fast_exp(float x) { return __builtin_amdgcn_exp2f(x * 1.4426950408889634f); }
__device__ __forceinline__ float fast_log(float x) { return __builtin_amdgcn_logf(x) * 0.6931471805599453f; }
__device__ __forceinline__ float softplus_f(float z) { return fmaxf(z, 0.f) + fast_log(1.f + fast_exp(-fabsf(z))); }
__device__ __forceinline__ float sigmoid_f(float z) { return __builtin_amdgcn_rcpf(1.f + fast_exp(-z)); }

typedef const GAS float* fptr_t;
__device__ __forceinline__ const GAS float* in_sel(int idx) { const __attribute__((address_space(4))) fptr_t* ka = (const __attribute__((address_space(4))) fptr_t*)__builtin_amdgcn_kernarg_segment_ptr(); return ka[idx]; }

template <class Tp> __device__ __forceinline__ GAS Tp* launder_ptr(GAS Tp* p) { unsigned lo = (unsigned)(unsigned long long)p, hi = (unsigned)((unsigned long long)p >> 32); asm volatile("" : "+v"(lo), "+v"(hi));
    lo = __builtin_amdgcn_readfirstlane(lo); hi = __builtin_amdgcn_readfirstlane(hi); return (GAS Tp*)(((unsigned long long)hi << 32) | lo); }
__device__ __forceinline__ int launder_int(int v) { asm volatile("" : "+v"(v)); return __builtin_amdgcn_readfirstlane(v); }

#define XB_TMO      128
#define XB_XCNT(j)  (256  + 64 * (j))
#define XB_XSUB(j)  (1280 + 64 * (j))
#define XB_XGEN(j)  (2304 + 64 * (j))
#define XB_TOP      3328
#define XB_TOPGEN   3392
#define XCD_BAR_WORDS 3456
#define XB_SPIN_CAP (1u << 18)
__device__ __forceinline__ unsigned xb_ld(GAS unsigned* p)              { return __hip_atomic_load(p, __ATOMIC_RELAXED, __HIP_MEMORY_SCOPE_AGENT); }
__device__ __forceinline__ unsigned xb_add(GAS unsigned* p, unsigned v) { return __hip_atomic_fetch_add(p, v, __ATOMIC_RELAXED, __HIP_MEMORY_SCOPE_AGENT); }
__device__ __forceinline__ unsigned xb_xcc_id() { return (unsigned)__builtin_amdgcn_s_getreg((3 << 11) | 20) & 0xFu; }
#define XB_SPIN(cond, bar) do { unsigned _sp = 0; while (cond) { __builtin_amdgcn_s_sleep(1); \
    if ((++_sp & 255u) == 0u) { if (xb_ld(&(bar)[XB_TMO])) break; if (_sp > XB_SPIN_CAP) { (void)xb_add(&(bar)[XB_TMO], 1u); break; } } } } while (0)
struct XcdBarrier { GAS unsigned* bar; unsigned x; volatile LAS unsigned* st; };
__device__ __forceinline__ XcdBarrier xcd_barrier_post(GAS unsigned* bar, volatile LAS unsigned* st) {
    XcdBarrier b; b.bar = bar; b.x = xb_xcc_id(); b.st = st;
    if (threadIdx.x == 0) (void)xb_add(&bar[XB_XCNT(b.x)], 1u);
    return b;
}
__device__ __forceinline__ void xcd_barrier_complete(GAS unsigned* bar, unsigned x, unsigned& nloc, unsigned& nx) {
    const unsigned G = gridDim.x * gridDim.y * gridDim.z;
    unsigned sum, cnt, mine, sp = 0u;
    for (;;) {
        sum = 0u; cnt = 0u; mine = 0u;
#pragma unroll
        for (unsigned j = 0; j < 16; ++j) { const unsigned c = xb_ld(&bar[XB_XCNT(j)]); sum += c; cnt += (c > 0u) ? 1u : 0u; mine = (j == x) ? c : mine; }
        if (sum == G) break;
        __builtin_amdgcn_s_sleep(1);
        if ((++sp & 255u) == 0u) { if (xb_ld(&bar[XB_TMO])) break; if (sp > XB_SPIN_CAP) { (void)xb_add(&bar[XB_TMO], 1u); break; } }
    }
    nloc = mine > 0u ? mine : 1u; nx = cnt > 0u ? cnt : 1u;
}
__device__ __forceinline__ void xcd_barrier(const XcdBarrier& b) {
    asm volatile("s_waitcnt vmcnt(0)" ::: "memory");
    __syncthreads();
    if (threadIdx.x == 0) {
        GAS unsigned* bar = b.bar;
        __builtin_amdgcn_s_waitcnt(0);
        unsigned nloc = b.st[0], nx = b.st[1];
        if (nloc == 0u) { xcd_barrier_complete(bar, b.x, nloc, nx); b.st[0] = nloc; b.st[1] = nx; }
        const unsigned old = xb_add(&bar[XB_XSUB(b.x)], 1u);
        const unsigned gen = old / nloc;
        if (old + 1u == (gen + 1u) * nloc) {
            __builtin_amdgcn_fence(__ATOMIC_RELEASE, "agent");
            asm volatile("s_waitcnt vmcnt(0)" ::: "memory");
            const unsigned og = xb_add(&bar[XB_TOP], 1u);
            const unsigned tg = og / nx;
            if (og + 1u == (tg + 1u) * nx) xb_add(&bar[XB_TOPGEN], 1u);
            else XB_SPIN(xb_ld(&bar[XB_TOPGEN]) == tg, bar);
            __builtin_amdgcn_fence(__ATOMIC_ACQUIRE, "agent");
            xb_add(&bar[XB_XGEN(b.x)], 1u);
            asm volatile("s_waitcnt vmcnt(0)" ::: "memory");
        } else {
            XB_SPIN(xb_ld(&bar[XB_XGEN(b.x)]) == gen, bar);
            __builtin_amdgcn_fence(__ATOMIC_ACQUIRE, "agent");
            asm volatile("s_waitcnt vmcnt(0)" ::: "memory");
        }
    }
    __syncthreads();
}

namespace g8 {
constexpr int BM = 256, BK = 64, HALF = 128, HTB = HALF * BK * 2, STAGE_BYTES = 8 * HTB, NXCD = 8, WGM = 8;
__host__ __device__ __forceinline__ int lds_byte(int r, int c) { const int st = (r >> 4) * 2 + (c >> 5), rr = r & 15, cc = c & 31, ob = rr * 64 + cc * 2; return st * 1024 + (ob ^ (((ob >> 9) & 1) << 5)); }
__host__ __device__ __forceinline__ void stage_rc(int b, int& R, int& C) { const int st = b / 1024, sb = b % 1024, swz = sb ^ (((sb >> 9) & 1) << 5); R = (st >> 1) * 16 + swz / 64; C = (st & 1) * 32 + (swz % 64) / 2; }
__host__ __device__ __forceinline__ int perm32(int rho) { const int n = rho >> 4, i = rho & 15; return 8 * (i >> 2) + 4 * n + (i & 3); }
struct Unit { int pm, pn, x0, x1; };
__device__ __forceinline__ bool static_order(int i, int G, int c, int nM, int nN, int& pm, int& pn) {
    const int nwg = nM * nN; const long L = (long)i * G + c; if (L >= nwg) return false;
    int wgid = (int)L; { const int q = nwg / NXCD, r = nwg % NXCD, xcd = wgid % NXCD, off = wgid / NXCD; wgid = (xcd < r ? xcd * (q + 1) : r * (q + 1) + (xcd - r) * q) + off; }
    const int nig = WGM * nN, gid = wgid / nig, fm = gid * WGM, gsz = (nM - fm) < WGM ? (nM - fm) : WGM;
    pm = fm + ((wgid % nig) % gsz); pn = (wgid % nig) / gsz; return true;
}

template <class Prob, class Epi, bool ALIGN_EPI = true>
__device__ __forceinline__ void gemm_phase(LAS unsigned char* lds, const Prob& P, const Epi& E, int wave_id) {
    int tid_; asm volatile("v_mbcnt_lo_u32_b32 %0, -1, 0\n\tv_mbcnt_hi_u32_b32 %0, -1, %0" : "=v"(tid_)); tid_ += wave_id * 64;
    const int tid = tid_, wid = __builtin_amdgcn_readfirstlane(tid >> 6), lane = tid & 63, wr = wid >> 2, wc = wid & 3, fr = lane & 15, fq = lane >> 4;
    const int nt = P.nt;
    unsigned voffA[2], voffB[2]; int Rr0 = 0; unsigned voffC = 0;
#pragma unroll
    for (int i = 0; i < 2; ++i) { int R, C; stage_rc(tid * 16 + i * 8192, R, C); const int Rb = Epi::PERM ? ((R & ~31) + perm32(R & 31)) : R;
        voffA[i] = (unsigned)(R * P.lda + C) * 2u; voffB[i] = (unsigned)(Rb * P.ldb + C) * 2u; if (i == 0) { Rr0 = R; voffC = (unsigned)C * 2u; } }
    const size_t kstep = (size_t)(BK * 2);
    const size_t hstepA = (size_t)HALF * P.lda * 2, hstepB = (size_t)HALF * P.ldb * 2;
    const unsigned ldsw = (unsigned)wid * 1024u;
    const int aoff = lds_byte(wr * 64 + fr, fq * 8), boff = lds_byte(wc * 32 + fr, fq * 8);
#define G8_SA(b, h) (((b) * 2 + (h)) * HTB)
#define G8_SB(b, h) ((4 + (b) * 2 + (h)) * HTB)
#define G8_STAGE(bufoff, gbase, voff) do { _Pragma("unroll") for (int _i = 0; _i < 2; ++_i) \
        __builtin_amdgcn_global_load_lds((const GAS unsigned*)((const GAS char*)(gbase) + (voff)[_i]), (LAS unsigned*)(lds + (bufoff) + ldsw + _i * 8192), 16, 0, 0); } while (0)
#define G8_STAGE_A(bufoff, h, kb, NX) do { if constexpr (Prob::GATHER) { const unsigned pk_ = (NX) ? gAn[h] : gAc[h]; const unsigned vo_[2] = {(pk_ & 0xffffu) * (unsigned)(P.lda * 2) + voffC, (pk_ >> 16) * (unsigned)(P.lda * 2) + voffC}; \
        G8_STAGE(bufoff, P.a_base() + (kb), vo_); } \
        else { G8_STAGE(bufoff, ((NX) ? nA : cA) + (h) * hstepA + (kb), voffA); } } while (0)
#define G8_LDA(dst, b, h) do { _Pragma("unroll") for (int m = 0; m < 4; ++m) _Pragma("unroll") for (int k = 0; k < 2; ++k) dst[m][k] = *(const LAS bf16x8*)(lds + G8_SA(b, h) + aoff + m * 2048 + k * 1024); } while (0)
#define G8_LDB(dst, b, h) do { _Pragma("unroll") for (int n = 0; n < 2; ++n) _Pragma("unroll") for (int k = 0; k < 2; ++k) dst[n][k] = *(const LAS bf16x8*)(lds + G8_SB(b, h) + boff + n * 2048 + k * 1024); } while (0)
#define G8_MMA(ai, bj, At, Bt) do { __builtin_amdgcn_s_setprio(1); _Pragma("unroll") for (int m = 0; m < 4; ++m) _Pragma("unroll") for (int n = 0; n < 2; ++n) _Pragma("unroll") for (int k = 0; k < 2; ++k) \
        acc[ai][bj][m][n] = __builtin_amdgcn_mfma_f32_16x16x32_bf16(Bt[n][k], At[m][k], acc[ai][bj][m][n], 0, 0, 0); __builtin_amdgcn_s_setprio(0); } while (0)
#define G8_WAIT_V(n) asm volatile("s_waitcnt vmcnt(" #n ")" ::: "memory")
#define G8_WAIT_L(n) asm volatile("s_waitcnt lgkmcnt(" #n ")" ::: "memory")
#define G8_BAR __builtin_amdgcn_s_barrier()
#define G8_SCHED __builtin_amdgcn_sched_barrier(0)
    Unit cur, nxt; int ui = 0;
    if (!P.next(0, cur)) return;
    f32x4 acc[2][2][4][2];
#pragma unroll
    for (int a = 0; a < 2; ++a)
#pragma unroll
        for (int b = 0; b < 2; ++b)
#pragma unroll
            for (int m = 0; m < 4; ++m)
#pragma unroll
                for (int n = 0; n < 2; ++n) acc[a][b][m][n] = (f32x4){0.f, 0.f, 0.f, 0.f};
    bf16x8 At[4][2], B0[2][2], B1[2][2];
    unsigned gAc[2], gAn[2];
    const GAS char* cA = nullptr; const GAS char* nA = nullptr;
    if constexpr (Prob::GATHER) { P.gather(cur, Rr0, gAc); } else { cA = P.a_tile(cur); }
    {
        const GAS char* b0 = P.b_ptr(cur, 0); const GAS char* b1 = P.b_ptr(cur, 1);
        G8_STAGE(G8_SB(0, 0), b0, voffB); G8_STAGE(G8_SB(0, 1), b0 + hstepB, voffB); G8_STAGE_A(G8_SA(0, 0), 0, 0, false); G8_STAGE_A(G8_SA(0, 1), 1, 0, false);
        if (wr == 1) G8_BAR;
        G8_WAIT_V(2); G8_BAR;
        G8_STAGE(G8_SB(1, 0), b1, voffB); G8_STAGE_A(G8_SA(1, 0), 0, kstep, false); G8_STAGE(G8_SB(1, 1), b1 + hstepB, voffB);
        G8_WAIT_V(6); G8_BAR;
    }
    for (;;) {
        const bool has_next = P.next(ui + 1, nxt);
        if (!has_next) nxt = cur;
        if constexpr (Prob::GATHER) { if (has_next) P.gather(nxt, Rr0, gAn); else { gAn[0] = gAc[0]; gAn[1] = gAc[1]; } }
        else { nA = P.a_tile(nxt); }
        for (int t = 0; t < nt; t += 2) {
            const bool last = (t == nt - 2);
            const size_t a1k = (size_t)(t + 1) * kstep;
            const size_t a2k = last ? 0 : (size_t)(t + 2) * kstep, a3k = last ? kstep : (size_t)(t + 3) * kstep;
            const GAS char* b2 = last ? P.b_ptr(nxt, 0) : P.b_ptr(cur, t + 2); const GAS char* b3 = last ? P.b_ptr(nxt, 1) : P.b_ptr(cur, t + 3);
            G8_LDB(B0, 0, 0); G8_LDB(B1, 0, 1); G8_SCHED; G8_LDA(At, 0, 0); G8_STAGE_A(G8_SA(1, 1), 1, a1k, false);
            G8_WAIT_V(8); G8_WAIT_L(0); G8_BAR; G8_MMA(0, 0, At, B0); G8_MMA(0, 1, At, B1); G8_BAR; G8_SCHED;
            G8_LDA(At, 0, 1); G8_STAGE(G8_SB(0, 0), b2, voffB); G8_STAGE(G8_SB(0, 1), b2 + hstepB, voffB);
            if (last) { G8_STAGE_A(G8_SA(0, 0), 0, a2k, true); } else { G8_STAGE_A(G8_SA(0, 0), 0, a2k, false); }
            G8_WAIT_V(8); G8_WAIT_L(0); G8_BAR; G8_MMA(1, 0, At, B0); G8_MMA(1, 1, At, B1); G8_BAR; G8_SCHED;
            G8_LDB(B0, 1, 0); G8_LDB(B1, 1, 1); G8_SCHED; G8_LDA(At, 1, 0);
            if (last) { G8_STAGE_A(G8_SA(0, 1), 1, a2k, true); } else { G8_STAGE_A(G8_SA(0, 1), 1, a2k, false); }
            G8_WAIT_V(8); G8_WAIT_L(0); G8_BAR; G8_MMA(0, 0, At, B0); G8_MMA(0, 1, At, B1); G8_BAR; G8_SCHED;
            G8_LDA(At, 1, 1); G8_STAGE(G8_SB(1, 0), b3, voffB); G8_STAGE(G8_SB(1, 1), b3 + hstepB, voffB);
            if (last) { G8_STAGE_A(G8_SA(1, 0), 0, a3k, true); } else { G8_STAGE_A(G8_SA(1, 0), 0, a3k, false); }
            G8_WAIT_V(8); G8_WAIT_L(0); G8_BAR; G8_MMA(1, 0, At, B0); G8_MMA(1, 1, At, B1); G8_BAR; G8_SCHED;
        }
        if constexpr (ALIGN_EPI) { if (wr == 0) G8_BAR; }
        { int l2_; asm volatile("v_mbcnt_lo_u32_b32 %0, -1, 0\n\tv_mbcnt_hi_u32_b32 %0, -1, %0" : "=v"(l2_)); E(acc, cur, wr, wc, l2_ & 15, l2_ >> 4); }
        if (!has_next) break;
#pragma unroll
        for (int a = 0; a < 2; ++a)
#pragma unroll
            for (int b = 0; b < 2; ++b)
#pragma unroll
                for (int m = 0; m < 4; ++m)
#pragma unroll
                    for (int n = 0; n < 2; ++n) acc[a][b][m][n] = (f32x4){0.f, 0.f, 0.f, 0.f};
        cur = nxt; ++ui;
        if constexpr (Prob::GATHER) { gAc[0] = gAn[0]; gAc[1] = gAn[1]; }
        else { cA = nA; }
        if constexpr (ALIGN_EPI) { if (wr == 1) G8_BAR; }
    }
    G8_WAIT_V(0);
    if constexpr (!ALIGN_EPI) { if (wr == 0) G8_BAR; }
    G8_BAR;
#undef G8_SA
#undef G8_SB
#undef G8_STAGE
#undef G8_STAGE_A
#undef G8_LDA
#undef G8_LDB
#undef G8_MMA
#undef G8_WAIT_V
#undef G8_WAIT_L
#undef G8_BAR
#undef G8_SCHED
}

struct ProbPlain {
    static constexpr bool GATHER = false;
    const GAS bf16_t* A; const GAS bf16_t* Bt; int lda, ldb, nt, nM, nN, G, c;
    __device__ __forceinline__ bool next(int i, Unit& u) const { u.x0 = 0; u.x1 = 0; return static_order(i, G, c, nM, nN, u.pm, u.pn); }
    __device__ __forceinline__ const GAS char* a_tile(const Unit& u) const { return (const GAS char*)A + (size_t)u.pm * BM * lda * 2; }
    __device__ __forceinline__ const GAS char* a_base() const { return (const GAS char*)A; }
    __device__ __forceinline__ void gather(const Unit&, int, unsigned (&)[2]) const {}
    __device__ __forceinline__ const GAS char* b_ptr(const Unit& u, int t) const { return (const GAS char*)Bt + ((size_t)u.pn * BM * ldb + (size_t)t * BK) * 2; }
};
struct ProbMoeGU {
    static constexpr bool GATHER = true;
    const GAS bf16_t* A; const GAS bf16_t* Bt; const GAS i32x4* elist; const LAS int* tab; int lda, ldb, nt, G, c;
    __device__ __forceinline__ bool next(int i, Unit& u) const {
        const int total = tab[TB_ECUM + NE]; const long L = (long)i * G + c; if (L >= total) return false;
        int wgid = (int)L; { const int q = total / NXCD, r = total % NXCD, xcd = wgid % NXCD, off = wgid / NXCD; wgid = (xcd < r ? xcd * (q + 1) : r * (q + 1) + (xcd - r) * q) + off; }
        int e = 0;
#pragma unroll
        for (int k = 1; k < NE; ++k) e += (wgid >= tab[TB_ECUM + k]) ? 1 : 0;
        const int loc = wgid - tab[TB_ECUM + e], nM = (tab[TB_ECUM + e + 1] - tab[TB_ECUM + e]) / 6;
        const int nig = WGM * 6, gid = loc / nig, fm = gid * WGM, gsz = (nM - fm) < WGM ? (nM - fm) : WGM;
        u.pm = fm + ((loc % nig) % gsz); u.pn = (loc % nig) / gsz; u.x0 = e; u.x1 = tab[TB_EOFF + e] + 256 * u.pm; return true;
    }
    __device__ __forceinline__ const GAS char* a_tile(const Unit&) const { return (const GAS char*)A; }
    __device__ __forceinline__ const GAS char* a_base() const { return (const GAS char*)A; }
    __device__ __forceinline__ void gather(const Unit& u, int R0, unsigned (&g)[2]) const {
#pragma unroll
        for (int h = 0; h < 2; ++h) { const int t0 = elist[u.x1 + h * HALF + R0].x, t1 = elist[u.x1 + h * HALF + R0 + 64].x; g[h] = (unsigned)t0 | ((unsigned)t1 << 16); }
    }
    __device__ __forceinline__ const GAS char* b_ptr(const Unit& u, int t) const { return (const GAS char*)Bt + ((size_t)(u.x0 * 1536 + u.pn * BM) * ldb + (size_t)t * BK) * 2; }
};
struct ProbMoeDown {
    static constexpr bool GATHER = false;
    const GAS bf16_t* A; const GAS bf16_t* Bt; const LAS int* tab; int lda, ldb, nt, G, c;
    __device__ __forceinline__ bool next(int i, Unit& u) const {
        const int nM = tab[TB_NRT]; if (!static_order(i, G, c, nM, 4, u.pm, u.pn)) return false;
        const int p = tab[TB_RT2P + u.pm]; u.x0 = (p & 0xff) * DFE; u.x1 = ((p >> 8) & 0xff) * DFE; return true;
    }
    __device__ __forceinline__ const GAS char* a_tile(const Unit& u) const { return (const GAS char*)A + (size_t)u.pm * BM * lda * 2; }
    __device__ __forceinline__ const GAS char* a_base() const { return (const GAS char*)A; }
    __device__ __forceinline__ void gather(const Unit&, int, unsigned (&)[2]) const {}
    __device__ __forceinline__ const GAS char* b_ptr(const Unit& u, int t) const { const int ko = (t < 11) ? (u.x0 + t * BK) : (u.x1 + (t - 11) * BK); return (const GAS char*)Bt + ((size_t)u.pn * BM * ldb + (size_t)ko) * 2; }
};

#define G8_ROWLOOP _Pragma("unroll") for (int ai = 0; ai < 2; ++ai) _Pragma("unroll") for (int m = 0; m < 4; ++m)
struct EpiBf16Split {
    static constexpr bool PERM = true;
    GAS bf16_t* O; int ldc; int split_cols; size_t split_stride;
    __device__ __forceinline__ void operator()(const f32x4 (&acc)[2][2][4][2], const Unit& u, int wr, int wc, int fr, int fq) const {
        const int row0 = u.pm * BM + wr * 64 + fr; int colt = u.pn * BM; GAS bf16_t* base = O;
        if (split_cols) { const int t = colt / split_cols; base += (size_t)t * split_stride; colt -= t * split_cols; }
        const int col0 = colt + wc * 32 + 8 * fq;
        G8_ROWLOOP { GAS bf16_t* rowp = base + (size_t)(row0 + ai * HALF + m * 16) * ldc + col0;
#pragma unroll
            for (int bj = 0; bj < 2; ++bj) { const f32x4 v0 = acc[ai][bj][m][0], v1 = acc[ai][bj][m][1];
                u32x4 w; w.x = cvt_pk_bf16(v0[0], v0[1]); w.y = cvt_pk_bf16(v0[2], v0[3]); w.z = cvt_pk_bf16(v1[0], v1[1]); w.w = cvt_pk_bf16(v1[2], v1[3]);
                *(GAS u32x4*)(rowp + bj * HALF) = w; } }
    }
};
struct EpiResid {
    static constexpr bool PERM = false;
    const GAS float* rin; GAS float* out;
    __device__ __forceinline__ void operator()(const f32x4 (&acc)[2][2][4][2], const Unit& u, int wr, int wc, int fr, int fq) const {
        const int row0 = u.pm * BM + wr * 64 + fr, col0 = u.pn * BM + wc * 32 + 4 * fq;
        G8_ROWLOOP { const size_t off = (size_t)(row0 + ai * HALF + m * 16) * DM + col0;
#pragma unroll
            for (int bj = 0; bj < 2; ++bj)
#pragma unroll
                for (int n = 0; n < 2; ++n) { const f32x4 r = *(const GAS f32x4*)(rin + off + bj * HALF + n * 16); *(GAS f32x4*)(out + off + bj * HALF + n * 16) = r * ALPHA + acc[ai][bj][m][n]; }
            asm volatile("" ::: "memory"); }
    }
};
struct EpiSwiglu {
    static constexpr bool PERM = true;
    GAS bf16_t* H; int ldh;
    __device__ __forceinline__ void operator()(const f32x4 (&acc)[2][2][4][2], const Unit& u, int wr, int wc, int fr, int fq) const {
        const int row0 = u.pm * BM + wr * 64 + fr, col0 = u.pn * HALF + wc * 32 + 8 * fq;
        G8_ROWLOOP { u32x4 w; unsigned ww[4];
#pragma unroll
            for (int n = 0; n < 2; ++n) { const f32x4 g = acc[ai][0][m][n], uu = acc[ai][1][m][n]; float hv[4];
#pragma unroll
                for (int i = 0; i < 4; ++i) hv[i] = g[i] * sigmoid_f(g[i]) * uu[i];
                ww[2 * n] = cvt_pk_bf16(hv[0], hv[1]); ww[2 * n + 1] = cvt_pk_bf16(hv[2], hv[3]); }
            w.x = ww[0]; w.y = ww[1]; w.z = ww[2]; w.w = ww[3];
            *(GAS u32x4*)(H + (size_t)(row0 + ai * HALF + m * 16) * ldh + col0) = w; }
    }
};
struct EpiGate {
    static constexpr bool PERM = true;
    GAS bf16_t* O;
    __device__ __forceinline__ void operator()(const f32x4 (&acc)[2][2][4][2], const Unit& u, int wr, int wc, int fr, int fq) const {
        const int row0 = u.pm * BM + wr * 64 + fr, col0 = u.pn * BM + wc * 32 + 8 * fq;
        G8_ROWLOOP { GAS bf16_t* rowp = O + (size_t)(row0 + ai * HALF + m * 16) * DM + col0;
#pragma unroll
            for (int bj = 0; bj < 2; ++bj) { const f32x4 v0 = acc[ai][bj][m][0], v1 = acc[ai][bj][m][1];
                u32x4 w; w.x = cvt_pk_bf16(sigmoid_f(v0[0]), sigmoid_f(v0[1])); w.y = cvt_pk_bf16(sigmoid_f(v0[2]), sigmoid_f(v0[3]));
                w.z = cvt_pk_bf16(sigmoid_f(v1[0]), sigmoid_f(v1[1])); w.w = cvt_pk_bf16(sigmoid_f(v1[2]), sigmoid_f(v1[3]));
                *(GAS u32x4*)(rowp + bj * HALF) = w; } }
    }
};
struct EpiPle {
    static constexpr bool PERM = true;
    GAS float* res; GAS bf16_t* XG;
    __device__ __forceinline__ void operator()(const f32x4 (&acc)[2][2][4][2], const Unit& u, int wr, int wc, int fr, int fq) const {
        const int row0 = u.pm * BM + wr * 64 + fr, col0 = u.pn * BM + wc * 32 + 8 * fq;
        G8_ROWLOOP { const size_t off = (size_t)(row0 + ai * HALF + m * 16) * DM + col0;
#pragma unroll
            for (int bj = 0; bj < 2; ++bj)
#pragma unroll
                for (int n = 0; n < 2; ++n) { const u32x2 gw = *(const GAS u32x2*)(XG + off + bj * HALF + 4 * n); const f32x4 r = *(const GAS f32x4*)(res + off + bj * HALF + 4 * n); const f32x4 a = acc[ai][bj][m][n]; f32x4 o;
                    o[0] = r[0] + a[0] * __builtin_bit_cast(float, gw.x << 16); o[1] = r[1] + a[1] * __builtin_bit_cast(float, gw.x & 0xffff0000u);
                    o[2] = r[2] + a[2] * __builtin_bit_cast(float, gw.y << 16); o[3] = r[3] + a[3] * __builtin_bit_cast(float, gw.y & 0xffff0000u);
                    *(GAS f32x4*)(res + off + bj * HALF + 4 * n) = o; u32x2 w; w.x = cvt_pk_bf16(o[0], o[1]); w.y = cvt_pk_bf16(o[2], o[3]); *(GAS u32x2*)(XG + off + bj * HALF + 4 * n) = w;
                    asm volatile("" ::: "memory"); } }
    }
};
struct EpiMoeGU {
    static constexpr bool PERM = true;
    GAS bf16_t* HS; const GAS i32x4* elist; const GAS float* egate;
    __device__ __forceinline__ void operator()(const f32x4 (&acc)[2][2][4][2], const Unit& u, int wr, int wc, int fr, int fq) const {
        const int j0 = u.pn * HALF + wc * 32 + 8 * fq; const bool colok = j0 < DFE;
        G8_ROWLOOP { const int sl = u.x1 + ai * HALF + wr * 64 + m * 16 + fr; const i32x4 en = elist[sl]; const float gate = egate[sl];
            if (colok && en.y >= 0) { u32x4 w; unsigned ww[4];
#pragma unroll
                for (int n = 0; n < 2; ++n) { const f32x4 g = acc[ai][0][m][n], uu = acc[ai][1][m][n]; float hv[4];
#pragma unroll
                    for (int i = 0; i < 4; ++i) hv[i] = gate * g[i] * sigmoid_f(g[i]) * uu[i];
                    ww[2 * n] = cvt_pk_bf16(hv[0], hv[1]); ww[2 * n + 1] = cvt_pk_bf16(hv[2], hv[3]); }
                w.x = ww[0]; w.y = ww[1]; w.z = ww[2]; w.w = ww[3];
                *(GAS u32x4*)(HS + (size_t)en.y + j0) = w; } }
    }
};
struct EpiMoeDown {
    static constexpr bool PERM = false;
    GAS float* res; const GAS int* plist;
    __device__ __forceinline__ void operator()(const f32x4 (&acc)[2][2][4][2], const Unit& u, int wr, int wc, int fr, int fq) const {
        const int col0 = u.pn * BM + wc * 32 + 4 * fq;
        G8_ROWLOOP { const int tok = plist[u.pm * BM + ai * HALF + wr * 64 + m * 16 + fr];
            if (tok >= 0) { const size_t off = (size_t)tok * DM + col0;
#pragma unroll
                for (int bj = 0; bj < 2; ++bj)
#pragma unroll
                    for (int n = 0; n < 2; ++n) { const f32x4 r = *(const GAS f32x4*)(res + off + bj * HALF + n * 16); *(GAS f32x4*)(res + off + bj * HALF + n * 16) = r * ALPHA + acc[ai][bj][m][n]; } }
            asm volatile("" ::: "memory"); }
    }
};
}

struct Frame {
    LAS unsigned char* lds; GAS unsigned* ctl; GAS unsigned char* ws; GAS float* res;
    int wave, vcu, G;
    __device__ __forceinline__ int lane_id() const { int l; asm volatile("v_mbcnt_lo_u32_b32 %0, -1, 0\n\tv_mbcnt_hi_u32_b32 %0, -1, %0" : "=v"(l)); return l; }
    __device__ __forceinline__ int tid_id() const { return wave * 64 + lane_id(); }
};
__device__ __forceinline__ GAS bf16_t* xb_ptr(const Frame& F, int which) { return (GAS bf16_t*)(F.ws + (which ? WS_XB1 : WS_XB0)); }

struct Job { int in_idx, Ns, nkb, n0, nblk, ldd, drow0, dk0, split, item0; float scale; long long src_off, dst_off; };
constexpr int NJOBS = 55;
struct JobTable { Job j[NJOBS]; int total; int njobs; };
constexpr JobTable make_jobs() {
    JobTable t{}; int n = 0, items = 0;
    auto add = [&](int in_idx, long long src_off, int Ns, int K, int n0, int ncols, long long dst_byte, int ldd, int drow0, int dk0, int split, float scale) {
        Job& j = t.j[n++]; j.in_idx = in_idx; j.src_off = src_off; j.Ns = Ns; j.nkb = K / 64; j.n0 = n0; j.nblk = ncols / 32; j.dst_off = dst_byte; j.ldd = ldd; j.drow0 = drow0; j.dk0 = dk0; j.split = split; j.scale = scale;
        j.item0 = items; items += j.nkb * j.nblk; };
    const long long WD = (long long)WS_WDEAD, WL = (long long)WS_WLIVE;
    const float QS = 0.0625f;
    for (int i = 0; i < 2; ++i) { const long long q = WD + 2 * (long long)(i ? WD_QKV1 : WD_QKV0), o = WD + 2 * (long long)(i ? WD_O1 : WD_O0);
        add(IN_AQKV, (long long)i * 1024 * 3072, 3072, 1024, 0, 1024, q, 1024, 0, 0, 0, QS);
        add(IN_AQKV, (long long)i * 1024 * 3072, 3072, 1024, 1024, 2048, q, 1024, 1024, 0, 0, 1.f);
        add(IN_AO, (long long)i * 1024 * 1024, 1024, 1024, 0, 1024, o, 1024, 0, 0, 0, 1.f); }
    add(IN_BQ, 0, 1024, 1024, 0, 1024, WL + 2 * (long long)WL_QKV2, 1024, 0, 0, 0, QS);
    add(IN_KVF, 0, 2052, 1024, 0, 2048, WL + 2 * (long long)WL_QKV2, 1024, 1024, 0, 0, 1.f);
    add(IN_BQ, (long long)1024 * 1024, 1024, 1024, 0, 1024, WL + 2 * (long long)WL_Q3, 1024, 0, 0, 0, QS);
    add(IN_BO, 0, 1024, 1024, 0, 1024, WL + 2 * (long long)WL_O2, 1024, 0, 0, 0, 1.f);
    add(IN_BO, (long long)1024 * 1024, 1024, 1024, 0, 1024, WL + 2 * (long long)WL_O3, 1024, 0, 0, 0, 1.f);
    for (int i = 0; i < 2; ++i) { const long long gu = i ? WL + 2 * (long long)WL_GU1 : WD + 2 * (long long)WD_GU0, dn = i ? WL + 2 * (long long)WL_DN1 : WD + 2 * (long long)WD_DN0;
        add(IN_FGU, (long long)i * 1024 * 5632, 5632, 1024, 0, 5632, gu, 1024, 0, 0, DFF, 1.f);
        add(IN_FDN, (long long)i * 2816 * 1024, 1024, 2816, 0, 1024, dn, 2816, 0, 0, 0, 1.f); }
    for (int i = 0; i < 2; ++i) for (int e = 0; e < NE; ++e) { const long long gu = i ? WL + 2 * (long long)WL_MGU1 : WD + 2 * (long long)WD_MGU0, dn = i ? WL + 2 * (long long)WL_MDN1 : WD + 2 * (long long)WD_MDN0;
        add(IN_MGU, (long long)(i * NE + e) * 1024 * 1408, 1408, 1024, 0, 1408, gu, 1024, e * 1536, 0, DFE, 1.f);
        add(IN_MDN, (long long)(i * NE + e) * 704 * 1024, 1024, 704, 0, 1024, dn, 5632, 0, e * DFE, 0, 1.f); }
    for (int i = 0; i < 4; ++i) { const long long pp = i == 0 ? WD + 2 * (long long)WD_PP0 : i == 1 ? WD + 2 * (long long)WD_PP1 : i == 2 ? WL + 2 * (long long)WL_PP2 : WL + 2 * (long long)WL_PP3;
        const long long pg = i == 0 ? WD + 2 * (long long)WD_PG0 : i == 1 ? WD + 2 * (long long)WD_PG1 : i == 2 ? WL + 2 * (long long)WL_PG2 : WL + 2 * (long long)WL_PG3;
        add(IN_PP, (long long)i * 256 * 1024, 1024, 256, 0, 1024, pp, 256, 0, 0, 0, 1.f);
        add(IN_PG, (long long)i * 1024 * 1024, 1024, 1024, 0, 1024, pg, 1024, 0, 0, 0, 1.f); }
    t.total = items; t.njobs = n; return t;
}
__device__ const JobTable g_jobs = make_jobs();
static_assert(make_jobs().njobs == NJOBS, "job count");

__device__ __forceinline__ void conv_item(const Frame& F, const Job& J, int it, LAS float* scr) {
    const int lane = F.lane_id(); const int kb = it / J.nblk, nb = it % J.nblk, k0 = 64 * kb, ncol = J.n0 + 32 * nb;
    const GAS float* W = in_sel(J.in_idx) + J.src_off;
#pragma unroll 8
    for (int i = 0; i < 32; ++i) { const int kk = 2 * i + (lane >> 5); scr[kk * 33 + (lane & 31)] = W[(size_t)(k0 + kk) * J.Ns + ncol + (lane & 31)] * J.scale; }
    asm volatile("s_waitcnt lgkmcnt(0)" ::: "memory");
    int drow;
    if (J.split) { const int ty = ncol / J.split, jj = ncol % J.split; drow = J.drow0 + 256 * (jj >> 7) + 128 * ty + (jj & 127); } else drow = J.drow0 + (ncol - J.n0);
    GAS bf16_t* WT = (GAS bf16_t*)(F.ws + J.dst_off);
    const int c = lane & 7;
#pragma unroll
    for (int j = 0; j < 4; ++j) { const int n = (lane >> 3) + 8 * j; const LAS float* s = scr + (8 * c) * 33 + n;
        u32x4 o; o.x = pk2(s[0 * 33], s[1 * 33]); o.y = pk2(s[2 * 33], s[3 * 33]); o.z = pk2(s[4 * 33], s[5 * 33]); o.w = pk2(s[6 * 33], s[7 * 33]);
        *(GAS u32x4*)(WT + (size_t)(drow + n) * J.ldd + J.dk0 + k0 + 8 * c) = o; }
    asm volatile("s_waitcnt lgkmcnt(0)" ::: "memory");
}
__device__ __forceinline__ void prologue_phase(Frame& F) {
    LAS float* scr = (LAS float*)(F.lds + F.wave * 16384);
    const int gw = F.vcu * NWAVES + F.wave, NGW = F.G * NWAVES;
    const int total = g_jobs.total;
    for (int it = gw; it < total; it += NGW) {
        int jn = 0;
        for (int k = 1; k < NJOBS; ++k) jn += (it >= g_jobs.j[k].item0) ? 1 : 0;
        jn = __builtin_amdgcn_readfirstlane(jn);
        conv_item(F, g_jobs.j[jn], it - g_jobs.j[jn].item0, scr);
    }
    { const size_t gt = (size_t)blockIdx.x * NTHREADS + F.tid_id(), gs = (size_t)F.G * NTHREADS;
      for (size_t i = gt; i < (size_t)2 * NE * 2 * 64 * 128; i += gs) {
          const int ch = (int)(i & 127), row = (int)((i >> 7) & 63), gu = (int)((i >> 13) & 1), e = (int)((i >> 14) & 7), li = (int)(i >> 17);
          GAS bf16_t* base = (GAS bf16_t*)(F.ws + (li ? WS_WLIVE + 2 * WL_MGU1 : WS_WDEAD + 2 * WD_MGU0));
          *(GAS u32x4*)(base + (size_t)(e * 1536 + 1280 + 128 * gu + 64 + row) * 1024 + ch * 8) = (u32x4){0u, 0u, 0u, 0u}; } }
    GAS bf16_t* xb = xb_ptr(F, 0);
    for (int m = gw; m < T; m += NGW) { const int ln = F.lane_id(); const GAS f32x4* xr = (const GAS f32x4*)(in_sel(IN_X) + (size_t)m * DM) + ln; GAS u32x2* o8 = (GAS u32x2*)(xb + (size_t)m * DM) + ln;
#pragma unroll
        for (int j = 0; j < 4; ++j) { const f32x4 v = xr[64 * j]; u32x2 o; o.x = pk2(v[0], v[1]); o.y = pk2(v[2], v[3]); o8[64 * j] = o; } }
}

template <bool ROUTER, bool CVT_P>
__device__ __forceinline__ void ln_phase(Frame& F, int L, int which, GAS bf16_t* xo) {
    int tid_ = F.tid_id(); asm volatile("" : "+v"(tid_));
    const int lane = tid_ & 63, w = __builtin_amdgcn_readfirstlane(tid_ >> 6);
    const GAS f32x4* gp = (const GAS f32x4*)(in_sel(IN_LNG) + (size_t)(L * 2 + which) * DM) + lane; const GAS f32x4* bp = (const GAS f32x4*)(in_sel(IN_LNB) + (size_t)(L * 2 + which) * DM) + lane;
    f32x4 gg[4], bb[4];
#pragma unroll
    for (int j = 0; j < 4; ++j) { gg[j] = gp[64 * j]; bb[j] = bp[64 * j]; }
    LAS f32x4* wrl = (LAS f32x4*)(F.lds + 1024);
    if constexpr (ROUTER) { const GAS float* Wr = in_sel(IN_MR) + (size_t)(L >> 1) * DM * NE;
        __syncthreads();
        for (int jc = w; jc < 16; jc += NWAVES) { const int k = 4 * lane + 256 * (jc >> 2) + (jc & 3);
            wrl[(jc * 2 + 0) * 64 + lane] = *(const GAS f32x4*)(Wr + (size_t)k * NE); wrl[(jc * 2 + 1) * 64 + lane] = *(const GAS f32x4*)(Wr + (size_t)k * NE + 4); }
        __syncthreads(); }
    LAS int* hist = (LAS int*)F.lds;
    for (int ch = blockIdx.x; ch < T / 128; ch += F.G) {
        if constexpr (ROUTER) { __syncthreads(); if (tid_ < 40) hist[tid_] = 0; __syncthreads(); }
        for (int k = 0; k < 16; ++k) {
            const int row = 128 * ch + 16 * w + k;
            GAS f32x4* xr = (GAS f32x4*)(F.res + (size_t)row * DM) + lane;
            f32x4 v[4]; float s = 0.f;
#pragma unroll
            for (int j = 0; j < 4; ++j) { v[j] = xr[64 * j]; s += (v[j][0] + v[j][1]) + (v[j][2] + v[j][3]); }
            const float mean = wave_sum(s, lane) * (1.f / DM); float s2 = 0.f;
#pragma unroll
            for (int j = 0; j < 4; ++j) { v[j] = v[j] - mean; s2 += (v[j][0] * v[j][0] + v[j][1] * v[j][1]) + (v[j][2] * v[j][2] + v[j][3] * v[j][3]); }
            const float rstd = 1.f / sqrtf(wave_sum(s2, lane) * (1.f / DM) + LN_EPS);
            GAS u32x2* o8 = (GAS u32x2*)(xo + (size_t)row * DM) + lane;
#pragma unroll
            for (int j = 0; j < 4; ++j) { v[j] = v[j] * rstd * gg[j] + bb[j]; xr[64 * j] = v[j]; u32x2 o; o.x = pk2(v[j][0], v[j][1]); o.y = pk2(v[j][2], v[j][3]); o8[64 * j] = o; }
            if constexpr (CVT_P) { const f32x4 pv = *((const GAS f32x4*)(in_sel(IN_P) + ((size_t)L * T + row) * PLE) + lane); u32x2 o; o.x = pk2(pv[0], pv[1]); o.y = pk2(pv[2], pv[3]);
                *((GAS u32x2*)((GAS bf16_t*)(F.ws + WS_PB) + (size_t)row * PLE) + lane) = o; }
            if constexpr (ROUTER) {
                float lg[NE];
#pragma unroll
                for (int e = 0; e < NE; ++e) lg[e] = 0.f;
#pragma unroll
                for (int j = 0; j < 4; ++j)
#pragma unroll
                    for (int c = 0; c < 4; ++c) { const float xv = v[j][c]; const f32x4 w0 = wrl[((j * 4 + c) * 2 + 0) * 64 + lane], w1 = wrl[((j * 4 + c) * 2 + 1) * 64 + lane];
#pragma unroll
                        for (int e = 0; e < 4; ++e) { lg[e] += xv * w0[e]; lg[4 + e] += xv * w1[e]; } }
#pragma unroll
                for (int e = 0; e < NE; ++e) lg[e] = wave_sum(lg[e], lane);
                int i1 = 0; float v1 = lg[0];
#pragma unroll
                for (int e = 1; e < NE; ++e) if (lg[e] > v1) { v1 = lg[e]; i1 = e; }
                int i2 = -1; float v2 = -3.0e38f;
#pragma unroll
                for (int e = 0; e < NE; ++e) if (e != i1 && lg[e] > v2) { v2 = lg[e]; i2 = e; }
                const float ex = fast_exp(v2 - v1), g1 = __builtin_amdgcn_rcpf(1.f + ex), g2 = 1.f - g1;
                const int ea = i1 < i2 ? i1 : i2, eb = i1 < i2 ? i2 : i1, pid = ea * (15 - ea) / 2 + eb - ea - 1;
                if (lane == 0) { GAS int* rp = (GAS int*)(F.ws + WS_MISC + MS_REC) + (size_t)row * 4; GAS float* gp = (GAS float*)(F.ws + WS_MISC + MS_GATE);
                    rp[0] = i1 | (i2 << 8) | (pid << 16); rp[1] = 0; rp[2] = 0; rp[3] = row; gp[row] = g1; gp[T + row] = g2;
                    __hip_atomic_fetch_add(hist + i1, 1, __ATOMIC_RELAXED, __HIP_MEMORY_SCOPE_WORKGROUP); __hip_atomic_fetch_add(hist + i2, 1, __ATOMIC_RELAXED, __HIP_MEMORY_SCOPE_WORKGROUP);
                    __hip_atomic_fetch_add(hist + 8 + pid, 1, __ATOMIC_RELAXED, __HIP_MEMORY_SCOPE_WORKGROUP); }
            }
        }
        if constexpr (ROUTER) { __syncthreads(); if (tid_ < 40) ((GAS int*)(F.ws + WS_MISC + MS_HIST))[ch * 40 + tid_] = hist[tid_]; }
    }
}

__device__ __forceinline__ int pad256(int v) { return (v + 255) & ~255; }
__device__ __forceinline__ void moe_lists_phase(Frame& F) {
    LAS int* pre = (LAS int*)F.lds; LAS int* tot = pre + 40; LAS int* eoff = tot + 40; LAS int* poff = eoff + 16; LAS int* recs = poff + 32; LAS int* tabl = recs + 128;
    const GAS int* hist = (const GAS int*)(F.ws + WS_MISC + MS_HIST);
    const GAS i32x4* rec = (const GAS i32x4*)(F.ws + WS_MISC + MS_REC);
    GAS i32x4* elist = (GAS i32x4*)(F.ws + WS_MISC + MS_ELIST); GAS int* plist = (GAS int*)(F.ws + WS_MISC + MS_PLIST);
    int tid_ = F.tid_id(); asm volatile("" : "+v"(tid_));
    const int lane = tid_ & 63, w = F.wave, tid = tid_;
    bool first = true;
    for (int ch = blockIdx.x; ch < T / 128; ch += F.G) {
        __syncthreads();
        for (int col = w; col < 36; col += NWAVES) { int sp = 0, st = 0;
#pragma unroll
            for (int k = 0; k < 4; ++k) { const int c2 = lane + 64 * k; const int v = hist[c2 * 40 + col]; st += v; sp += (c2 < ch) ? v : 0; }
#pragma unroll
            for (int o = 1; o < 64; o <<= 1) { sp += shxi(sp, o, lane); st += shxi(st, o, lane); }
            if (lane == 0) { pre[col] = sp; tot[col] = st; } }
        __syncthreads();
        if (tid == 0) {
            int acc = 0, ucum = 0;
            for (int e = 0; e < NE; ++e) { eoff[e] = acc; tabl[TB_EOFF + e] = acc; tabl[TB_ECUM + e] = ucum; const int p = pad256(tot[e]); acc += p; ucum += 6 * (p >> 8); }
            eoff[NE] = acc; tabl[TB_EOFF + NE] = acc; tabl[TB_ECUM + NE] = ucum;
            int pacc = 0, pid = 0;
            for (int a = 0; a < NE - 1; ++a) for (int b = a + 1; b < NE; ++b) { poff[pid] = pacc; pacc += pad256(tot[8 + pid]); ++pid; }
            poff[NPAIR] = pacc; tabl[TB_NRT] = pacc >> 8;
        }
        __syncthreads();
        if (tid < 192) { const int r8 = tid << 8; int p = 0;
            for (int k = 1; k < NPAIR; ++k) p += (r8 >= poff[k]) ? 1 : 0;
            int a = 0, rem = p; while (rem >= NE - 1 - a) { rem -= NE - 1 - a; ++a; }
            tabl[TB_RT2P + tid] = a | ((a + 1 + rem) << 8); }
        __syncthreads();
        if (ch == 0) { for (int i = tid; i < TB_WORDS; i += NTHREADS) ((GAS int*)(F.ws + WS_MISC + MS_TAB))[i] = tabl[i]; }
        if (tid < 128) recs[tid] = rec[128 * ch + tid].x;
        __syncthreads();
        if (tid < 128) {
            const int token = 128 * ch + tid; const i32x4 r = rec[token]; const int e1 = r.x & 0xff, e2 = (r.x >> 8) & 0xff, pid = (r.x >> 16) & 0xff;
            int r1 = 0, r2 = 0, rp = 0;
            for (int j = 0; j < tid; ++j) { const int o = recs[j]; const int o1 = o & 0xff, o2 = (o >> 8) & 0xff, op = (o >> 16) & 0xff;
                r1 += ((o1 == e1) | (o2 == e1)) ? 1 : 0; r2 += ((o1 == e2) | (o2 == e2)) ? 1 : 0; rp += (op == pid) ? 1 : 0; }
            const int pslot = poff[pid] + pre[8 + pid] + rp; plist[pslot] = token;
            i32x4 en; en.x = token; en.w = 0;
            const GAS float* gp = (const GAS float*)(F.ws + WS_MISC + MS_GATE);
            GAS float* eg = (GAS float*)(F.ws + WS_MISC + MS_EGATE); en.z = 0;
            { const int sl = eoff[e1] + pre[e1] + r1; en.y = pslot * 1408 + (e1 < e2 ? 0 : DFE); elist[sl] = en; eg[sl] = gp[token]; }
            { const int sl = eoff[e2] + pre[e2] + r2; en.y = pslot * 1408 + (e2 < e1 ? 0 : DFE); elist[sl] = en; eg[sl] = gp[T + token]; }
        }
        if (first) {
            first = false; const int gt = blockIdx.x * NTHREADS + tid, gs = F.G * NTHREADS;
            for (int e = 0; e < NE; ++e) for (int i = eoff[e] + tot[e] + gt; i < eoff[e + 1]; i += gs) elist[i] = (i32x4){0, -1, 0, 0};
            for (int p = 0; p < NPAIR; ++p) for (int i = poff[p] + tot[8 + p] + gt; i < poff[p + 1]; i += gs) plist[i] = -1;
        }
    }
    __syncthreads();
}
__device__ __forceinline__ void load_tab(Frame& F) {
    __syncthreads();
    for (int i = F.tid_id(); i < TB_WORDS; i += NTHREADS) ((LAS int*)(F.lds + LDS_TAB))[i] = ((const GAS int*)(F.ws + WS_MISC + MS_TAB))[i];
    __syncthreads();
}

__device__ __forceinline__ void forget_phase(Frame& F) {
    int tid_ = F.tid_id(); asm volatile("" : "+v"(tid_));
    const int lane = tid_ & 63, w = __builtin_amdgcn_readfirstlane(tid_ >> 6);
    const GAS float* Wf = in_sel(IN_KVF);
    f32x4 wf[16];
#pragma unroll
    for (int j = 0; j < 4; ++j)
#pragma unroll
        for (int c = 0; c < 4; ++c) { const int k = 4 * lane + 256 * j + c; wf[j * 4 + c] = *(const GAS f32x4*)(Wf + (size_t)k * 2052 + 2048); }
    const f32x4 bias = *(const GAS f32x4*)in_sel(IN_KVFB);
    LAS float* lf = (LAS float*)F.lds;
    GAS float* cl = (GAS float*)(F.ws + WS_MISC + MS_CL); GAS float* tt = (GAS float*)(F.ws + WS_MISC + MS_TOT);
    for (int ch = blockIdx.x; ch < T / 128; ch += F.G) {
        __syncthreads();
        for (int k = 0; k < 16; ++k) {
            const int row = 128 * ch + 16 * w + k; const GAS f32x4* xr = (const GAS f32x4*)(F.res + (size_t)row * DM) + lane;
            f32x4 a = (f32x4){0.f, 0.f, 0.f, 0.f};
#pragma unroll
            for (int j = 0; j < 4; ++j) { const f32x4 v = xr[64 * j];
#pragma unroll
                for (int c = 0; c < 4; ++c) a += wf[j * 4 + c] * v[c]; }
#pragma unroll
            for (int hh = 0; hh < 4; ++hh) a[hh] = wave_sum(a[hh], lane);
            if (lane == 0) { f32x4 o;
#pragma unroll
                for (int hh = 0; hh < 4; ++hh) { const float z = a[hh] + bias[hh]; o[hh] = -(fmaxf(-z, 0.f) + log1pf(__expf(-fabsf(z)))); }
                *(LAS f32x4*)(lf + (16 * w + k) * 4) = o; }
        }
        __syncthreads();
        { const int tile = w >> 2, hh = w & 3; float x = lf[(tile * 64 + lane) * 4 + hh];
#pragma unroll
          for (int o = 1; o < 64; o <<= 1) { const float y = shup(x, o, lane); if (lane >= o) x += y; }
          const int row = 128 * ch + tile * 64 + lane, b = row / SEQ, s = row % SEQ;
          cl[(size_t)(b * NH + hh) * SEQ + s] = x; if (lane == 63) tt[(b * NH + hh) * 256 + (s >> 6)] = x; }
    }
    __syncthreads();
}
__device__ __forceinline__ void knorm_phase(Frame& F, const GAS bf16_t* KS) {
    const int lane = F.lane_id(), w = F.wave;
    for (int ch = blockIdx.x; ch < T / 128; ch += F.G) {
        float mx = 0.f;
        for (int k = 0; k < 16; ++k) { const int row = 128 * ch + 16 * w + k; const GAS u32x4* kr = (const GAS u32x4*)(KS + (size_t)row * DM) + 2 * lane; const u32x4 a = kr[0], b = kr[1];
            const unsigned u[8] = {a.x, a.y, a.z, a.w, b.x, b.y, b.z, b.w}; float s = 0.f;
#pragma unroll
            for (int i = 0; i < 8; ++i) { const float lo = __builtin_bit_cast(float, u[i] << 16), hi = __builtin_bit_cast(float, u[i] & 0xffff0000u); s += lo * lo + hi * hi; }
            s += shx(s, 1, lane); s += shx(s, 2, lane); s += shx(s, 4, lane); s += shx(s, 8, lane);
            mx = fmaxf(mx, s); }
        if ((lane & 15) == 0) { const int b = (128 * ch) / SEQ; (void)__hip_atomic_fetch_max(F.ctl + CW_KN2 + b * NH + (lane >> 4), __builtin_bit_cast(unsigned, mx), RLX_AGENT); }
    }
}

constexpr int AT_KB0 = 0, AT_VB0 = 32768, AT_KB1 = 66048, AT_VB1 = 98816, AT_VPANEL = 2080;
constexpr float SB_STOP = -24.f, FOX_STOP = -30.f;
typedef short s16x4 __attribute__((ext_vector_type(4)));
#define AT_TR4(r0, r1, r2, r3, addr, o0, o1, o2, o3) asm volatile("ds_read_b64_tr_b16 %0, %4 offset:%5\n\tds_read_b64_tr_b16 %1, %4 offset:%6\n\tds_read_b64_tr_b16 %2, %4 offset:%7\n\tds_read_b64_tr_b16 %3, %4 offset:%8" \
    : "=&v"(r0), "=&v"(r1), "=&v"(r2), "=&v"(r3) : "v"(addr), "i"(o0), "i"(o1), "i"(o2), "i"(o3) : "memory")
#define AT_WAIT4(r0, r1, r2, r3) asm volatile("s_waitcnt lgkmcnt(0)" : "+v"(r0), "+v"(r1), "+v"(r2), "+v"(r3) :: "memory")

template <bool FOX>
__device__ __forceinline__ void attn_phase(Frame& F, const GAS bf16_t* Q, const GAS bf16_t* Kb, const GAS bf16_t* Vb, GAS bf16_t* O) {
    LAS unsigned char* lds = F.lds;
    volatile LAS unsigned* flags = (volatile LAS unsigned*)(lds + LDS_FLAGS);
    int tid_ = F.tid_id(); asm volatile("" : "+v"(tid_));
    const int tid = tid_, w = __builtin_amdgcn_readfirstlane(tid >> 6), lane = tid & 63, fr = lane & 15, fq = lane >> 4;
    const int srow0 = tid >> 5, schunk = tid & 31;
    const unsigned kst = (unsigned)(srow0 * 512 + ((schunk ^ (srow0 & 15)) * 16));
    const unsigned vst = (unsigned)((schunk >> 1) * AT_VPANEL + srow0 * 32 + (schunk & 1) * 16);
    const unsigned vrd = (unsigned)((4 * fq + ((lane & 15) >> 2)) * 32 + 8 * (lane & 3));
    const GAS float* cl = (const GAS float*)(F.ws + WS_MISC + MS_CL); const GAS float* tt = (const GAS float*)(F.ws + WS_MISC + MS_TOT);
    for (int id = blockIdx.x; id < 8 * 128; id += F.G) {
        const int bh = id & 7, qt = id >> 3, b = bh >> 2, h = bh & 3, t0 = qt * 128;
        const size_t rowbase = (size_t)b * SEQ;
        const int tq = t0 + 16 * w + fr;
        bf16x8 qf[8];
        { const GAS bf16_t* qp = Q + (rowbase + tq) * DM + h * HD + 8 * fq;
#pragma unroll
          for (int s = 0; s < 8; ++s) qf[s] = *(const GAS bf16x8*)(qp + 32 * s); }
        f32x4 o[16];
#pragma unroll
        for (int d = 0; d < 16; ++d) o[d] = (f32x4){0.f, 0.f, 0.f, 0.f};
        float R = 0.f;
        float mrun = -1.0e30f, lsum = 0.f, cq = 0.f, qn = 0.f, KN = 0.f, gacc = 0.f;
        if constexpr (FOX) {
            float s2 = 0.f;
#pragma unroll
            for (int s = 0; s < 8; ++s)
#pragma unroll
                for (int j = 0; j < 8; ++j) { const float x = bf2f((unsigned short)qf[s][j]); s2 += x * x; }
            s2 += shx(s2, 16, lane); s2 += shx(s2, 32, lane); qn = sqrtf(s2);
            KN = sqrtf(__builtin_bit_cast(float, __hip_atomic_load(F.ctl + CW_KN2 + bh, RLX_AGENT))) * 1.002f;
            cq = cl[(size_t)bh * SEQ + tq] + ((tq >= t0 + 64) ? tt[bh * 256 + 2 * qt] : 0.f);
        }
        int kt = 2 * qt + 1, it = 0;
        u32x4 kr[4], vr[4];
        { const GAS bf16_t* kp = Kb + (rowbase + (size_t)64 * kt + srow0) * DM + h * HD + schunk * 8; const GAS bf16_t* vp = Vb + (rowbase + (size_t)64 * kt + srow0) * DM + h * HD + schunk * 8;
#pragma unroll
          for (int j = 0; j < 4; ++j) { kr[j] = *(const GAS u32x4*)(kp + (size_t)16 * j * DM); vr[j] = *(const GAS u32x4*)(vp + (size_t)16 * j * DM); } }
        for (;;) {
            const int kbuf = (it & 1) ? AT_KB1 : AT_KB0, vbuf = (it & 1) ? AT_VB1 : AT_VB0;
#pragma unroll
            for (int j = 0; j < 4; ++j) { *(LAS u32x4*)(lds + kbuf + kst + j * 8192) = kr[j]; *(LAS u32x4*)(lds + vbuf + vst + j * 512) = vr[j]; }
            __syncthreads();
            if (it >= 2) { unsigned any = 0u; const int par = (it - 1) & 1;
#pragma unroll
                for (int k = 0; k < 8; ++k) any |= flags[par * 8 + k];
                if (any == 0u) break; }
            const int kmin = 64 * kt, wmax = t0 + 16 * w + 15, wmin = t0 + 16 * w;
            f32x4 ckv[4]; float ttv = 0.f;
            if constexpr (FOX) {
#pragma unroll
                for (int blk = 0; blk < 4; ++blk) ckv[blk] = *(const GAS f32x4*)(cl + (size_t)bh * SEQ + kmin + 16 * blk + 4 * fq);
                ttv = tt[bh * 256 + (kt > 2 * qt ? 2 * qt : kt)];
                asm volatile("" ::: "memory"); }
            if (kt > 0) { const GAS bf16_t* kp = Kb + (rowbase + (size_t)64 * (kt - 1) + srow0) * DM + h * HD + schunk * 8; const GAS bf16_t* vp = Vb + (rowbase + (size_t)64 * (kt - 1) + srow0) * DM + h * HD + schunk * 8;
#pragma unroll
                for (int j = 0; j < 4; ++j) { kr[j] = *(const GAS u32x4*)(kp + (size_t)16 * j * DM); vr[j] = *(const GAS u32x4*)(vp + (size_t)16 * j * DM); } }
            const bool part = FOX ? (kmin <= wmax) : (kmin < wmax);
            if (part) {
                const bool need_mask = (kmin + 63 >= wmin);
                f32x4 s[4];
#pragma unroll
                for (int blk = 0; blk < 4; ++blk) { s[blk] = (f32x4){0.f, 0.f, 0.f, 0.f};
#pragma unroll
                    for (int st = 0; st < 8; ++st) { const bf16x8 kf = *(const LAS bf16x8*)(lds + kbuf + (16 * blk + fr) * 512 + (((4 * st + fq) ^ fr) * 16));
                        s[blk] = __builtin_amdgcn_mfma_f32_16x16x32_bf16(kf, qf[st], s[blk], 0, 0, 0); } }
                float pv[4][4];
                if constexpr (!FOX) {
                    float lm[4][4], w4[4], Tt[4], Ex[4];
#pragma unroll
                    for (int blk = 0; blk < 4; ++blk) { w4[blk] = 0.f;
#pragma unroll
                        for (int i = 0; i < 4; ++i) { const float z = s[blk][i]; const float sp = softplus_f(z); const bool valid = !need_mask || (kmin + 16 * blk + 4 * fq + i < tq);
                            lm[blk][i] = valid ? -sp : 0.f; pv[blk][i] = valid ? (z - sp) : -1.0e30f; w4[blk] += lm[blk][i]; } }
#pragma unroll
                    for (int blk = 0; blk < 4; ++blk) { const float a = shx(w4[blk], 16, lane), bq = shx(w4[blk], 32, lane), c = shx(a, 32, lane);
                        Tt[blk] = (w4[blk] + a) + (bq + c); Ex[blk] = (fq == 0) ? (a + bq + c) : (fq == 1) ? (bq + c) : (fq == 2) ? a : 0.f; }
                    float bs = 0.f;
#pragma unroll
                    for (int blk = 3; blk >= 0; --blk) { float tail = R + bs + Ex[blk];
#pragma unroll
                        for (int i = 3; i >= 0; --i) { const float e = pv[blk][i] + tail; pv[blk][i] = (e > -80.f) ? fast_exp(e) : 0.f; tail += lm[blk][i]; }
                        bs += Tt[blk]; }
                    R += bs;
                } else {
                    float base;
                    if (kt == 2 * qt + 1) base = ttv; else if (kt == 2 * qt) base = 0.f; else { gacc += ttv; base = -gacc; }
                    float mx = -1.0e30f;
#pragma unroll
                    for (int blk = 0; blk < 4; ++blk) { const f32x4 ck = ckv[blk];
#pragma unroll
                        for (int i = 0; i < 4; ++i) { const bool valid = !need_mask || (kmin + 16 * blk + 4 * fq + i <= tq); const float lg = valid ? (s[blk][i] + cq - (ck[i] + base)) : -1.0e30f; pv[blk][i] = lg; mx = fmaxf(mx, lg); } }
                    mx = fmaxf(mx, shx(mx, 16, lane)); mx = fmaxf(mx, shx(mx, 32, lane));
                    const float mnew = fmaxf(mrun, mx), al = fast_exp(mrun - mnew); float ps = 0.f;
#pragma unroll
                    for (int blk = 0; blk < 4; ++blk)
#pragma unroll
                        for (int i = 0; i < 4; ++i) { const float e = pv[blk][i] - mnew; const float p = (e > -80.f) ? fast_exp(e) : 0.f; pv[blk][i] = p; ps += p; }
                    lsum = lsum * al + ps;
                    if (__any(mnew > mrun)) {
#pragma unroll
                        for (int d = 0; d < 16; ++d) o[d] = o[d] * al; }
                    mrun = mnew;
                }
                bf16x8 pf[2];
#pragma unroll
                for (int c = 0; c < 2; ++c) { u32x4 pw; pw.x = cvt_pk_bf16(pv[2 * c][0], pv[2 * c][1]); pw.y = cvt_pk_bf16(pv[2 * c][2], pv[2 * c][3]); pw.z = cvt_pk_bf16(pv[2 * c + 1][0], pv[2 * c + 1][1]); pw.w = cvt_pk_bf16(pv[2 * c + 1][2], pv[2 * c + 1][3]);
                    pf[c] = __builtin_bit_cast(bf16x8, pw); }
                const unsigned va = (unsigned)(size_t)(lds + vbuf) + vrd;
                s16x4 c0, c1, c2, c3, n0, n1, n2, n3;
                AT_TR4(c0, c1, c2, c3, va, 0, 512, 1024, 1536);
                n0 = c0; n1 = c1; n2 = c2; n3 = c3;
#define AT_PV(db) do { AT_WAIT4(c0, c1, c2, c3); \
                    if ((db) < 15) { AT_TR4(n0, n1, n2, n3, va, ((db) + 1) * AT_VPANEL, ((db) + 1) * AT_VPANEL + 512, ((db) + 1) * AT_VPANEL + 1024, ((db) + 1) * AT_VPANEL + 1536); } \
                    { const bf16x8 v0 = __builtin_shufflevector(c0, c1, 0, 1, 2, 3, 4, 5, 6, 7), v1 = __builtin_shufflevector(c2, c3, 0, 1, 2, 3, 4, 5, 6, 7); \
                      o[db] = __builtin_amdgcn_mfma_f32_16x16x32_bf16(v0, pf[0], o[db], 0, 0, 0); o[db] = __builtin_amdgcn_mfma_f32_16x16x32_bf16(v1, pf[1], o[db], 0, 0, 0); } \
                    c0 = n0; c1 = n1; c2 = n2; c3 = n3; } while (0)
                AT_PV(0); AT_PV(1); AT_PV(2); AT_PV(3); AT_PV(4); AT_PV(5); AT_PV(6); AT_PV(7); AT_PV(8); AT_PV(9); AT_PV(10); AT_PV(11); AT_PV(12); AT_PV(13); AT_PV(14); AT_PV(15);
#undef AT_PV
            } else if constexpr (FOX) { if (kt < 2 * qt) gacc += ttv; }
            { bool cont;
              if constexpr (!FOX) cont = (R >= SB_STOP);
              else cont = (qn * KN + cq + ((kt <= 2 * qt) ? gacc : 0.f) - mrun >= FOX_STOP) || (kt > 2 * qt);
              const bool anyc = __any(cont);
              if (lane == 0) flags[(it & 1) * 8 + w] = anyc ? 1u : 0u; }
            if (kt == 0) break;
            --kt; ++it;
        }
        float inv = 1.f;
        if constexpr (FOX) { float lt = lsum; lt += shx(lt, 16, lane); lt += shx(lt, 32, lane); inv = 1.f / lt; }
        { GAS bf16_t* op = O + (rowbase + tq) * DM + h * HD + 4 * fq;
#pragma unroll
          for (int db = 0; db < 16; ++db) { u32x2 ow; ow.x = cvt_pk_bf16(o[db][0] * inv, o[db][1] * inv); ow.y = cvt_pk_bf16(o[db][2] * inv, o[db][3] * inv); *(GAS u32x2*)(op + 16 * db) = ow; } }
        __syncthreads();
    }
}

constexpr int NPH = 41;
__host__ __device__ inline bool phase_nonempty(int k) { if (k == 0) return true; const int L = (k - 1) / 10, s = (k - 1) % 10; if (s == 1) return L == 2; if (s == 5) return (L & 1) != 0; return true; }
struct Args { const float* in[N_IN]; float* out; unsigned char* ws; int ph_lo, ph_hi, sub, pad; };

__global__ void __launch_bounds__(NTHREADS, 2) mk_fwd(Args args) {
    extern __shared__ __attribute__((aligned(16))) unsigned char lds_raw[];
    Frame F;
    F.lds = (LAS unsigned char*)lds_raw;
    F.wave = __builtin_amdgcn_readfirstlane((int)threadIdx.x >> 6);
    F.G = gridDim.x; { const int bx = blockIdx.x; F.vcu = (F.G % 8 == 0) ? (bx % 8) * (F.G / 8) + bx / 8 : bx; }
    F.ws = (GAS unsigned char*)args.ws; F.ctl = (GAS unsigned*)F.ws; F.res = (GAS float*)args.out;
    for (int u = (int)threadIdx.x; u < (LDS_BYTES - LDS_CTL) / 4; u += NTHREADS) ((LAS unsigned*)(F.lds + LDS_CTL))[u] = 0u;
    __syncthreads();
    const int lo = args.ph_lo, hi = args.ph_hi;
    XcdBarrier bar; bar.bar = F.ctl + CW_BAR; bar.x = 0; bar.st = nullptr;
    if (hi - lo > 1) bar = xcd_barrier_post(F.ctl + CW_BAR, (volatile LAS unsigned*)(F.lds + LDS_CTL) + 8);
#ifndef SITE_MASK
#define SITE_MASK 0xFFFFF
#endif
#define SITE(n) ((SITE_MASK >> (n)) & 1)
#define IN(k) (lo <= (k) && (k) < hi)
#define SEAM(k) do { if ((k) + 1 < hi) xcd_barrier(bar); } while (0)
    const int c = (int)blockIdx.x;
#define WSB(name) GAS unsigned char* name = launder_ptr(F.ws)
#define XBP(ws_, which) ((GAS bf16_t*)((ws_) + ((which) ? WS_XB1 : WS_XB0)))

    if (SITE(0) && IN(0)) { prologue_phase(F); SEAM(0); }

    for (int L = 0; L < DEPTH; ++L) {
        const int pb = 1 + 10 * L;
        {
            F.wave = launder_int(F.wave); F.ws = launder_ptr(F.ws); F.res = launder_ptr(F.res); F.ctl = (GAS unsigned*)F.ws; F.G = launder_int(F.G); }
        if (SITE(1) && IN(pb + 0)) {
            WSB(ws);
            const GAS bf16_t* Wqkv = (const GAS bf16_t*)(ws + (L < 2 ? WS_WDEAD : WS_WLIVE)) + (L == 0 ? WD_QKV0 : L == 1 ? WD_QKV1 : L == 2 ? WL_QKV2 : WL_Q3);
            g8::ProbPlain P{XBP(ws, L & 1), Wqkv, 1024, 1024, 16, T / 256, (L == 3) ? 4 : 12, F.G, c};
            g8::EpiBf16Split E{(GAS bf16_t*)(ws + WS_QA), 1024, (L == 3) ? 0 : 1024, (size_t)(WS_KS - WS_QA) / 2};
            g8::gemm_phase<g8::ProbPlain, g8::EpiBf16Split>(F.lds, P, E, F.wave);
            if (SITE(2) && L == 2) forget_phase(F);
            SEAM(pb + 0);
        }
        if (SITE(3) && IN(pb + 1) && L == 2) { WSB(ws); knorm_phase(F, (const GAS bf16_t*)(ws + WS_KS)); SEAM(pb + 1); }
        if (IN(pb + 2)) {
            WSB(ws); GAS bf16_t* QA = (GAS bf16_t*)(ws + WS_QA); const GAS bf16_t* KS = (const GAS bf16_t*)(ws + WS_KS); const GAS bf16_t* VS = (const GAS bf16_t*)(ws + WS_VS);
            if (L < 2) { if (SITE(4)) attn_phase<false>(F, QA, KS, VS, QA); } else { if (SITE(5)) attn_phase<true>(F, QA, KS, VS, QA); }
            SEAM(pb + 2);
        }
        if (SITE(6) && IN(pb + 3)) {
            WSB(ws);
            const GAS bf16_t* Wo = (const GAS bf16_t*)(ws + (L < 2 ? WS_WDEAD : WS_WLIVE)) + (L == 0 ? WD_O0 : L == 1 ? WD_O1 : L == 2 ? WL_O2 : WL_O3);
            g8::ProbPlain P{(const GAS bf16_t*)(ws + WS_QA), Wo, 1024, 1024, 16, T / 256, 4, F.G, c};
            g8::EpiResid E{L == 0 ? in_sel(IN_X) : (const GAS float*)F.res, F.res};
            g8::gemm_phase<g8::ProbPlain, g8::EpiResid>(F.lds, P, E, F.wave);
            SEAM(pb + 3);
        }
        if (IN(pb + 4)) { WSB(ws); GAS bf16_t* xln1 = XBP(ws, (L + 1) & 1); if (L & 1) { if (SITE(7)) ln_phase<true, true>(F, L, 0, xln1); } else { if (SITE(8)) ln_phase<false, true>(F, L, 0, xln1); } SEAM(pb + 4); }
        if (SITE(9) && IN(pb + 5) && (L & 1)) { moe_lists_phase(F); SEAM(pb + 5); }
        if (IN(pb + 6)) {
            WSB(ws); const GAS bf16_t* xln1 = XBP(ws, (L + 1) & 1);
            if (L & 1) { if (SITE(10)) { load_tab(F);
                const GAS bf16_t* Wmgu = (const GAS bf16_t*)(ws + (L == 1 ? WS_WDEAD : WS_WLIVE)) + (L == 1 ? WD_MGU0 : WL_MGU1); const GAS i32x4* elist = (const GAS i32x4*)(ws + WS_MISC + MS_ELIST);
                g8::ProbMoeGU P{xln1, Wmgu, elist, (const LAS int*)(F.lds + LDS_TAB), 1024, 1024, 16, F.G, c}; g8::EpiMoeGU E{(GAS bf16_t*)(ws + (L == 1 ? WS_QA : WS_WDEAD)), elist, (const GAS float*)(ws + WS_MISC + MS_EGATE)};
                g8::gemm_phase<g8::ProbMoeGU, g8::EpiMoeGU>(F.lds, P, E, F.wave); } }
            else if (SITE(11)) { const GAS bf16_t* Wgu = (const GAS bf16_t*)(ws + (L == 0 ? WS_WDEAD : WS_WLIVE)) + (L == 0 ? WD_GU0 : WL_GU1);
                g8::ProbPlain P{xln1, Wgu, 1024, 1024, 16, T / 256, 22, F.G, c}; g8::EpiSwiglu E{(GAS bf16_t*)(ws + (L == 0 ? WS_QA : WS_XB0)), DFF};
                g8::gemm_phase<g8::ProbPlain, g8::EpiSwiglu>(F.lds, P, E, F.wave); }
            SEAM(pb + 6);
        }
        if (IN(pb + 7)) {
            WSB(ws);
            if (L & 1) { if (SITE(12)) { load_tab(F);
                const GAS bf16_t* Wmdn = (const GAS bf16_t*)(ws + (L == 1 ? WS_WDEAD : WS_WLIVE)) + (L == 1 ? WD_MDN0 : WL_MDN1);
                g8::ProbMoeDown P{(const GAS bf16_t*)(ws + (L == 1 ? WS_QA : WS_WDEAD)), Wmdn, (const LAS int*)(F.lds + LDS_TAB), 1408, 5632, 22, F.G, c}; g8::EpiMoeDown E{F.res, (const GAS int*)(ws + WS_MISC + MS_PLIST)};
                g8::gemm_phase<g8::ProbMoeDown, g8::EpiMoeDown>(F.lds, P, E, F.wave); } }
            else if (SITE(13)) { const GAS bf16_t* Wdn = (const GAS bf16_t*)(ws + (L == 0 ? WS_WDEAD : WS_WLIVE)) + (L == 0 ? WD_DN0 : WL_DN1);
                g8::ProbPlain P{(const GAS bf16_t*)(ws + (L == 0 ? WS_QA : WS_XB0)), Wdn, DFF, DFF, 44, T / 256, 4, F.G, c}; g8::EpiResid E{F.res, F.res};
                g8::gemm_phase<g8::ProbPlain, g8::EpiResid>(F.lds, P, E, F.wave); }
            SEAM(pb + 7);
        }
        if (SITE(14) && IN(pb + 8)) { WSB(ws); ln_phase<false, false>(F, L, 1, XBP(ws, L & 1)); SEAM(pb + 8); }
        if (IN(pb + 9)) {
            if (SITE(15) && args.sub != 2) { WSB(ws); const GAS bf16_t* Wpg = (const GAS bf16_t*)(ws + (L < 2 ? WS_WDEAD : WS_WLIVE)) + (L == 0 ? WD_PG0 : L == 1 ? WD_PG1 : L == 2 ? WL_PG2 : WL_PG3);
                g8::ProbPlain P{XBP(ws, L & 1), Wpg, 1024, 1024, 16, T / 256, 4, F.G, c}; g8::EpiGate E{XBP(ws, (L + 1) & 1)}; g8::gemm_phase<g8::ProbPlain, g8::EpiGate>(F.lds, P, E, F.wave); }
            if (SITE(16) && args.sub != 1) { WSB(ws); const GAS bf16_t* Wpp = (const GAS bf16_t*)(ws + (L < 2 ? WS_WDEAD : WS_WLIVE)) + (L == 0 ? WD_PP0 : L == 1 ? WD_PP1 : L == 2 ? WL_PP2 : WL_PP3);
                g8::ProbPlain P{(const GAS bf16_t*)(ws + WS_PB), Wpp, PLE, PLE, 4, T / 256, 4, F.G, c}; g8::EpiPle E{F.res, XBP(ws, (L + 1) & 1)}; g8::gemm_phase<g8::ProbPlain, g8::EpiPle>(F.lds, P, E, F.wave); }
            if (pb + 9 < NPH - 1) SEAM(pb + 9);
        }
    }
#undef WSB
#undef XBP
#undef IN
#undef SEAM
}

#if MK_DEBUG
constexpr int NSAMP = 64;
#ifndef DBG_SHOW_A
#define DBG_SHOW_A -1
#define DBG_SHOW_B 75
#endif
#ifndef DBG_HYP
#define DBG_HYP 6
#endif
#ifndef DBG_FOCUS
#define DBG_FOCUS 99
#endif
__device__ __forceinline__ float wave_sum(float v) {
#pragma unroll
    for (int o = 1; o < 64; o <<= 1) v += __shfl_xor(v, o);
    return v;
}
__device__ __forceinline__ int samp_row(int k) { const int fixed[8] = {0, 1, 127, 128, SEQ - 1, SEQ, SEQ + 129, T - 1}; return k < 8 ? fixed[k] : (int)(((long long)k * 40503 + 977) % T); }
__device__ __forceinline__ void dbg_report(unsigned* ctl, int slot, float err_over_tol) { if (!(err_over_tol >= 0.f)) err_over_tol = 1.0e30f; atomicMax(ctl + CW_DBG + slot, __builtin_bit_cast(unsigned, err_over_tol)); }
__device__ __forceinline__ float dbg_dot(const bf16_t* a, int K, const float* W, size_t ldw, int n, int lane) { float s = 0.f; for (int k = lane; k < K; k += 64) s += bf2f(a[k]) * W[(size_t)k * ldw + n]; return wave_sum(s); }
__global__ void dbg_snapshot(const float* src, float* snap) { const int k = blockIdx.x, r = samp_row(k); for (int i = threadIdx.x; i < DM; i += blockDim.x) snap[(size_t)k * DM + i] = src[(size_t)r * DM + i]; }
struct DbgArgs { const float* in[N_IN]; float* res; unsigned char* ws; int phase; int pad; };
__global__ void __launch_bounds__(64) dbg_check(DbgArgs a) {
    const int k = blockIdx.x, lane = threadIdx.x, r = samp_row(k), ph = a.phase, L = (ph - 1) / 10, s = (ph - 1) % 10;
    unsigned* ctl = (unsigned*)(a.ws + WS_CTL); const float* snap = (const float*)(a.ws + WS_MISC + MS_SNAP) + (size_t)k * DM;
    const bf16_t* XBin = (const bf16_t*)(a.ws + ((L & 1) ? WS_XB1 : WS_XB0)); const bf16_t* XBl1 = (const bf16_t*)(a.ws + (((L + 1) & 1) ? WS_XB1 : WS_XB0));
    const bf16_t* QA = (const bf16_t*)(a.ws + WS_QA); const bf16_t* KS = (const bf16_t*)(a.ws + WS_KS); const bf16_t* VS = (const bf16_t*)(a.ws + WS_VS);
    if (ph == 0) {
        float e = 0.f; for (int i = lane; i < DM; i += 64) e = fmaxf(e, fabsf(bf2f(((const bf16_t*)(a.ws + WS_XB0))[(size_t)r * DM + i]) - a.in[IN_X][(size_t)r * DM + i]));
        e = fmaxf(e, __shfl_xor(e, 1)); dbg_report(ctl, ph, e / 0.05f); return; }
    if (s == 0) {
        const int NC = (L == 3) ? 1024 : 3072;
        for (int rep = 0; rep < 6; ++rep) { const int n = (k * 977 + rep * 517 + 131) % NC; const float* W; size_t ldw; int col; float sc = 1.f;
            if (L < 2) { W = a.in[IN_AQKV] + (size_t)L * 1024 * 3072; ldw = 3072; col = n; if (n < 1024) sc = 0.0625f; }
            else if (n < 1024) { W = a.in[IN_BQ] + (size_t)(L - 2) * 1024 * 1024; ldw = 1024; col = n; sc = 0.0625f; }
            else { W = a.in[IN_KVF]; ldw = 2052; col = n - 1024; }
            const float ex = dbg_dot(XBin + (size_t)r * DM, 1024, W, ldw, col, lane) * sc;
            const bf16_t* O = n < 1024 ? QA : n < 2048 ? KS : VS; const float got = bf2f(O[(size_t)r * DM + (n & 1023)]);
            dbg_report(ctl, ph, fabsf(got - ex) / (0.02f * fabsf(ex) + 0.02f)); }
        if (L == 2) {
            const int b = r / SEQ, sq = r % SEQ, hh = k & 3; float acc = 0.f;
            for (int j = (sq & ~63); j <= sq; ++j) { const float* xr = a.res + ((size_t)b * SEQ + j) * DM; float d = 0.f; for (int q = lane; q < DM; q += 64) d += xr[q] * a.in[IN_KVF][(size_t)q * 2052 + 2048 + hh];
                d = wave_sum(d) + a.in[IN_KVFB][hh]; acc += -(fmaxf(-d, 0.f) + log1pf(expf(-fabsf(d)))); }
            const float got = ((const float*)(a.ws + WS_MISC + MS_CL))[(size_t)(b * NH + hh) * SEQ + sq];
            dbg_report(ctl, ph, fabsf(got - acc) / (0.002f * fabsf(acc) + 0.002f)); }
        return; }
    if (s == 2) {
        const int hh = k & 3, b = r / SEQ, sq = r % SEQ; const size_t rb = (size_t)b * SEQ;
        float q4[4], o4[4] = {0.f, 0.f, 0.f, 0.f};
        for (int i = 0; i < 4; ++i) q4[i] = snap[hh * HD + 4 * lane + i];
        if (L < 2) { float Rr = 0.f;
            for (int t = sq - 1; t >= 0; --t) { const bf16_t* kp = KS + (rb + t) * DM + hh * HD + 4 * lane; float z = 0.f; for (int i = 0; i < 4; ++i) z += q4[i] * bf2f(kp[i]); z = wave_sum(z);
                const float sp = fmaxf(z, 0.f) + log1pf(expf(-fabsf(z))); const float aw = expf(z - sp + Rr); Rr -= sp;
                const bf16_t* vp = VS + (rb + t) * DM + hh * HD + 4 * lane; for (int i = 0; i < 4; ++i) o4[i] += aw * bf2f(vp[i]); }
        } else { const float* cl = (const float*)(a.ws + WS_MISC + MS_CL) + (size_t)(b * NH + hh) * SEQ; const float* tt = (const float*)(a.ws + WS_MISC + MS_TOT) + (b * NH + hh) * 256;
            float mx = -1.0e30f, den = 0.f;
            for (int pass = 0; pass < 2; ++pass) { double cacc = 0.0;
                for (int t = sq; t >= 0; --t) { const bf16_t* kp = KS + (rb + t) * DM + hh * HD + 4 * lane; float z = 0.f; for (int i = 0; i < 4; ++i) z += q4[i] * bf2f(kp[i]); z = wave_sum(z);
                    const float lg = z + (float)cacc;
                    if (pass == 0) mx = fmaxf(mx, lg); else { const float p = expf(lg - mx); den += p; const bf16_t* vp = VS + (rb + t) * DM + hh * HD + 4 * lane; for (int i = 0; i < 4; ++i) o4[i] += p * bf2f(vp[i]); }
                    const float lf = (t & 63) ? (cl[t] - cl[t - 1]) : cl[t]; cacc += (double)lf; } }
            for (int i = 0; i < 4; ++i) o4[i] /= den; (void)tt; }
        float em = 0.f, mg = 0.f; for (int i = 0; i < 4; ++i) { const float got = bf2f(QA[(size_t)r * DM + hh * HD + 4 * lane + i]); em = fmaxf(em, fabsf(got - o4[i])); mg = fmaxf(mg, fabsf(o4[i])); }
        for (int o = 1; o < 64; o <<= 1) { em = fmaxf(em, __shfl_xor(em, o)); mg = fmaxf(mg, __shfl_xor(mg, o)); }
        dbg_report(ctl, ph, em / (0.03f * mg + 0.003f)); return; }
    if (s == 3 || (s == 7 && !(L & 1))) {
        const bf16_t* A; const float* W; int K;
        if (s == 3) { A = QA + (size_t)r * DM; K = 1024; W = (L < 2) ? a.in[IN_AO] + (size_t)L * 1024 * 1024 : a.in[IN_BO] + (size_t)(L - 2) * 1024 * 1024; }
        else { A = (const bf16_t*)(a.ws + (L == 0 ? WS_QA : WS_XB0)) + (size_t)r * DFF; K = DFF; W = a.in[IN_FDN] + (size_t)(L >> 1) * DFF * 1024; }
        for (int rep = 0; rep < 6; ++rep) { const int n = (k * 733 + rep * 171 + 29) % 1024; const float ex = ALPHA * snap[n] + dbg_dot(A, K, W, 1024, n, lane); const float got = a.res[(size_t)r * DM + n];
            dbg_report(ctl, ph, fabsf(got - ex) / (0.01f * fabsf(ex) + 0.02f)); }
        return; }
    if (s == 4 || s == 8) {
        const int which = (s == 8); const float* g = a.in[IN_LNG] + (size_t)(L * 2 + which) * DM; const float* bb = a.in[IN_LNB] + (size_t)(L * 2 + which) * DM;
        float sm = 0.f; for (int i = lane; i < DM; i += 64) sm += snap[i]; const float mean = wave_sum(sm) / DM; float sv = 0.f; for (int i = lane; i < DM; i += 64) { const float d = snap[i] - mean; sv += d * d; }
        const float rstd = 1.f / sqrtf(wave_sum(sv) / DM + LN_EPS); const bf16_t* xo = which ? XBin : XBl1; float e = 0.f;
        for (int i = lane; i < DM; i += 64) { const float ex = (snap[i] - mean) * rstd * g[i] + bb[i]; e = fmaxf(e, fabsf(a.res[(size_t)r * DM + i] - ex) / 1e-3f); e = fmaxf(e, fabsf(bf2f(xo[(size_t)r * DM + i]) - ex) / (0.01f * fabsf(ex) + 0.01f)); }
        for (int o = 1; o < 64; o <<= 1) e = fmaxf(e, __shfl_xor(e, o));
        dbg_report(ctl, ph, e);
        if (s == 4 && (L & 1)) {
            const float* Wr = a.in[IN_MR] + (size_t)(L >> 1) * DM * NE; float lgs[NE];
            for (int e8 = 0; e8 < NE; ++e8) { float d = 0.f; for (int q = lane; q < DM; q += 64) d += a.res[(size_t)r * DM + q] * Wr[(size_t)q * NE + e8]; lgs[e8] = wave_sum(d); }
            int i1 = 0; for (int e8 = 1; e8 < NE; ++e8) if (lgs[e8] > lgs[i1]) i1 = e8; int i2 = -1; for (int e8 = 0; e8 < NE; ++e8) if (e8 != i1 && (i2 < 0 || lgs[e8] > lgs[i2])) i2 = e8;
            float third = -1.0e30f; for (int e8 = 0; e8 < NE; ++e8) if (e8 != i1 && e8 != i2) third = fmaxf(third, lgs[e8]);
            const float ex2 = expf(lgs[i2] - lgs[i1]), g1 = 1.f / (1.f + ex2), g2 = ex2 * g1;
            const i32x4 rr = ((const i32x4*)(a.ws + WS_MISC + MS_REC))[r]; const int q1 = rr.x & 0xff, q2 = (rr.x >> 8) & 0xff; const float h1 = ((const float*)(a.ws + WS_MISC + MS_GATE))[r], h2 = ((const float*)(a.ws + WS_MISC + MS_GATE))[T + r];
            if (lgs[i2] - third > 1e-3f && lgs[i1] - lgs[i2] > 1e-3f) { float bad = 0.f; if (q1 != i1 || q2 != i2) bad = 10.f; else if (fabsf(h1 - g1) > 1e-3f || fabsf(h2 - g2) > 1e-3f) bad = 5.f; dbg_report(ctl, ph, bad);
                if (L == 1 && k == 8 && lane == 0) { const float hv2[2] = {h1, h2};
                    for (int q = 0; q < 2; ++q) { const float h = hv2[q]; const unsigned bits = __builtin_bit_cast(unsigned, h); unsigned cat;
                        if (!(h == h)) cat = (bits == 0xffffffffu) ? 1u : (bits >> 31) ? 2u : 3u; else if (fabsf(h) > 3.0e38f) cat = 4u; else if (h < 0.f) cat = 5u; else if (h < 1e-30f) cat = (bits == 0u) ? 6u : 7u; else if (h > 1.f) cat = 8u; else cat = 9u;
                        (void)cat; }
                    { const unsigned bits = __builtin_bit_cast(unsigned, h1); ctl[CW_DBG + 70] = (rr.w == r) ? 9u : ((rr.w == 0) ? 3u : 1u); ctl[CW_DBG + 71] = (__builtin_bit_cast(unsigned, h2) >> 20) & 63u; (void)bits; } }
                if (L == 1) { if (lane == 0 && fabsf(h1 + h2 - 1.f) < 1e-3f) atomicAdd(ctl + CW_DBG + 46, 1u); if (lane == 0 && fabsf(h1 - g1) < 1e-3f) atomicAdd(ctl + CW_DBG + 47, 1u);
                if (lane == 0 && fabsf(h1 - g2) < 1e-3f && fabsf(h2 - g1) < 1e-3f) atomicAdd(ctl + CW_DBG + 45, 1u); if (lane == 0 && !(h1 == h1)) atomicAdd(ctl + CW_DBG + 44, 1u); } } }
        if (s == 4) { float e2 = 0.f; for (int i = lane; i < PLE; i += 64) e2 = fmaxf(e2, fabsf(bf2f(((const bf16_t*)(a.ws + WS_PB))[(size_t)r * PLE + i]) - a.in[IN_P][((size_t)L * T + r) * PLE + i]) / 0.05f);
            for (int o = 1; o < 64; o <<= 1) e2 = fmaxf(e2, __shfl_xor(e2, o)); dbg_report(ctl, ph, e2); }
        return; }
    if (s == 6 && !(L & 1)) {
        const float* W = a.in[IN_FGU] + (size_t)(L >> 1) * 1024 * 5632; const bf16_t* H = (const bf16_t*)(a.ws + (L == 0 ? WS_QA : WS_XB0));
        for (int rep = 0; rep < 6; ++rep) { const int j = (k * 389 + rep * 997 + 7) % DFF; const float g = dbg_dot(XBl1 + (size_t)r * DM, 1024, W, 5632, j, lane), u = dbg_dot(XBl1 + (size_t)r * DM, 1024, W, 5632, DFF + j, lane);
            const float ex = g / (1.f + expf(-g)) * u; const float got = bf2f(H[(size_t)r * DFF + j]); dbg_report(ctl, ph, fabsf(got - ex) / (0.03f * fabsf(ex) + 0.03f)); }
        return; }
    if (s == 6 && (L & 1)) {
        const int* tabg = (const int*)(a.ws + WS_MISC + MS_TAB); const i32x4* elist = (const i32x4*)(a.ws + WS_MISC + MS_ELIST); const i32x4* rec = (const i32x4*)(a.ws + WS_MISC + MS_REC);
        const int total = tabg[TB_EOFF + NE]; const int idx = (int)(((long long)k * 7919 + 13) % total); const i32x4 en = elist[idx];
        int e = 0; for (int q = 1; q < NE; ++q) e += (idx >= tabg[TB_EOFF + q]) ? 1 : 0;
        if (lane == 0) atomicAdd(ctl + CW_DBG + 55, 1u);
        if (en.y < 0) { if (lane == 0) atomicAdd(ctl + CW_DBG + 57, 1u); return; }
        const int tok = en.x; const i32x4 rr = rec[tok]; const int e1 = rr.x & 0xff, e2 = (rr.x >> 8) & 0xff;
        float bad = 0.f; if (e != e1 && e != e2) bad = 10.f;
        const float gate = ((const float*)(a.ws + WS_MISC + MS_EGATE))[idx]; const float gexp = (e == e1) ? ((const float*)(a.ws + WS_MISC + MS_GATE))[tok] : ((const float*)(a.ws + WS_MISC + MS_GATE))[T + tok]; if (fabsf(gate - gexp) > 1e-6f) bad = 20.f;
        if (lane == 0 && gate > 0.01f && gate < 0.999f) atomicAdd(ctl + CW_DBG + 60, 1u);
        if (lane == 0 && ((const int*)(a.ws + WS_MISC + MS_PLIST))[en.y / 1408] == tok) atomicAdd(ctl + CW_DBG + 59, 1u);
        const int half = (en.y % 1408) / DFE; if (half != ((e == (e1 < e2 ? e1 : e2)) ? 0 : 1)) bad = 30.f;
        dbg_report(ctl, ph, bad); if (lane == 0 && L == 1) { if (bad == 10.f) atomicAdd(ctl + CW_DBG + 72, 1u); if (bad == 20.f) atomicAdd(ctl + CW_DBG + 73, 1u); if (bad == 30.f) atomicAdd(ctl + CW_DBG + 74, 1u); }
        const float* Wg = a.in[IN_MGU] + (size_t)((L >> 1) * NE + e) * 1024 * 1408; const bf16_t* HS = (const bf16_t*)(a.ws + (L == 1 ? WS_QA : WS_WDEAD));
        for (int rep = 0; rep < 6; ++rep) { const int j = (k * 389 + rep * 131 + 5) % DFE; const float g = dbg_dot(XBl1 + (size_t)tok * DM, 1024, Wg, 1408, j, lane), u = dbg_dot(XBl1 + (size_t)tok * DM, 1024, Wg, 1408, DFE + j, lane);
            const float ex = gate * g / (1.f + expf(-g)) * u; const float got = bf2f(HS[(size_t)en.y + j]); const float er = fabsf(got - ex) / (0.03f * fabsf(ex) + 0.03f);
            dbg_report(ctl, ph, er); if (L == 1 && rep == 0 && lane == 0 && er <= 1.f) atomicAdd(ctl + CW_DBG + 56, 1u); if (L == 1 && rep == 0 && lane == 0 && fabsf(got) < 1e-6f) atomicAdd(ctl + CW_DBG + 75, 1u); }
        return; }
    if (s == 7 && (L & 1)) {
        __shared__ float hid[2][DFE]; __shared__ float lgs[NE];
        const float* Wr = a.in[IN_MR] + (size_t)(L >> 1) * DM * NE;
        for (int e = 0; e < NE; ++e) { float d = 0.f; for (int q = lane; q < DM; q += 64) d += snap[q] * Wr[(size_t)q * NE + e]; d = wave_sum(d); if (lane == 0) lgs[e] = d; }
        __syncthreads();
        int i1 = 0; for (int e = 1; e < NE; ++e) if (lgs[e] > lgs[i1]) i1 = e; int i2 = -1; for (int e = 0; e < NE; ++e) if (e != i1 && (i2 < 0 || lgs[e] > lgs[i2])) i2 = e;
        const float ex2 = expf(lgs[i2] - lgs[i1]), g1 = 1.f / (1.f + ex2), g2 = ex2 * g1; const int es[2] = {i1, i2}; const float gs[2] = {g1, g2};
        float third = -1.0e30f; for (int e = 0; e < NE; ++e) if (e != i1 && e != i2) third = fmaxf(third, lgs[e]);
        if (lgs[i2] - third < 1e-3f) return;
        for (int q = 0; q < 2; ++q) { const float* Wg = a.in[IN_MGU] + (size_t)((L >> 1) * NE + es[q]) * 1024 * 1408;
            for (int j = 0; j < DFE; ++j) { const float g = dbg_dot(XBl1 + (size_t)r * DM, 1024, Wg, 1408, j, lane), u = dbg_dot(XBl1 + (size_t)r * DM, 1024, Wg, 1408, DFE + j, lane);
                if (lane == 0) hid[q][j] = bf2f((unsigned short)f2bf(g / (1.f + expf(-g)) * u)); } }
        __syncthreads();
        for (int rep = 0; rep < 2; ++rep) { const int n = (lane * 16 + k + rep * 5) % 1024; float ac[2] = {0.f, 0.f};
            for (int q = 0; q < 2; ++q) { const float* Wdn = a.in[IN_MDN] + (size_t)((L >> 1) * NE + es[q]) * DFE * 1024; for (int j = 0; j < DFE; ++j) ac[q] += hid[q][j] * Wdn[(size_t)j * 1024 + n]; }
            const float base = ALPHA * snap[n]; const float got = a.res[(size_t)r * DM + n];
            const int* plist = (const int*)(a.ws + WS_MISC + MS_PLIST); const int* tabg = (const int*)(a.ws + WS_MISC + MS_TAB); const int nslot = tabg[TB_NRT] * 256; int ps = -1;
            for (int i = lane; i < nslot; i += 64) if (plist[i] == r) ps = i;
            for (int o = 1; o < 64; o <<= 1) ps = max(ps, __shfl_xor(ps, o));
            float ah = 0.f; float exact0 = fabsf(got - base);
            if (ps >= 0) { const bf16_t* HS = (const bf16_t*)(a.ws + (L == 1 ? WS_QA : WS_WDEAD)) + (size_t)ps * 1408; const int pp = tabg[TB_RT2P + (ps >> 8)]; const int ea = pp & 0xff, eb = (pp >> 8) & 0xff;
                const float* Wa = a.in[IN_MDN] + (size_t)((L >> 1) * NE + ea) * DFE * 1024; const float* Wb = a.in[IN_MDN] + (size_t)((L >> 1) * NE + eb) * DFE * 1024;
                for (int j = 0; j < DFE; ++j) ah += bf2f(HS[j]) * Wa[(size_t)j * 1024 + n] + bf2f(HS[DFE + j]) * Wb[(size_t)j * 1024 + n]; }
            const float hy[6] = {base + gs[0] * ac[0] + gs[1] * ac[1], base, base + ah, base + gs[1] * ac[1], base + ac[0] + ac[1], base + gs[1] * ac[0] + gs[0] * ac[1]};
            for (int hq = 0; hq < 6; ++hq) { float e = fabsf(got - hy[hq]) / (0.01f * fabsf(hy[hq]) + 0.02f);
                for (int o = 1; o < 64; o <<= 1) e = fmaxf(e, __shfl_xor(e, o));
                if (hq == 0) dbg_report(ctl, ph, e);
                if (ph == DBG_FOCUS && rep == 0 && lane == 0 && e <= 1.0f) atomicAdd(ctl + CW_DBG + 56 + hq, 1u); }
            for (int o = 1; o < 64; o <<= 1) exact0 = fmaxf(exact0, __shfl_xor(exact0, o));
            float ahm = fabsf(ah); for (int o = 1; o < 64; o <<= 1) ahm = fmaxf(ahm, __shfl_xor(ahm, o));
            if (ph == DBG_FOCUS && rep == 0 && lane == 0 && ahm > 0.05f) atomicAdd(ctl + CW_DBG + 61, 1u);
            if (ph == DBG_FOCUS && rep == 0 && lane == 0 && exact0 < 1e-5f) atomicAdd(ctl + CW_DBG + 62, 1u);
            if (ph == DBG_FOCUS && rep == 0 && lane == 0 && ps < 0) atomicAdd(ctl + CW_DBG + 63, 1u); }
        if (ph == DBG_FOCUS && lane == 0) atomicAdd(ctl + CW_DBG + 55, 1u);
        return; }
    if (s == 9 && a.pad == 1) {
        const float* Wg = a.in[IN_PG] + (size_t)L * 1024 * 1024;
        for (int rep = 0; rep < 6; ++rep) { const int n = (k * 613 + rep * 211 + 3) % 1024; const float gl = dbg_dot(XBin + (size_t)r * DM, 1024, Wg, 1024, n, lane); const float sg = 1.f / (1.f + expf(-gl));
            dbg_report(ctl, 41 + L, fabsf(bf2f(XBl1[(size_t)r * DM + n]) - sg) / 0.02f); }
        return; }
    if (s == 9) {
        const float* Wg = a.in[IN_PG] + (size_t)L * 1024 * 1024; const float* Wp = a.in[IN_PP] + (size_t)L * PLE * 1024; const bf16_t* pbp = (const bf16_t*)(a.ws + WS_PB) + (size_t)r * PLE;
        for (int rep = 0; rep < 6; ++rep) { const int n = (k * 613 + rep * 211 + 3) % 1024; const float gl = dbg_dot(XBin + (size_t)r * DM, 1024, Wg, 1024, n, lane), pj = dbg_dot(pbp, PLE, Wp, 1024, n, lane);
            const float sg = 1.f / (1.f + expf(-gl)); const float ex = snap[n] + pj * sg; const float got = a.res[(size_t)r * DM + n], gb = bf2f(XBl1[(size_t)r * DM + n]);
            dbg_report(ctl, ph, fabsf(got - ex) / (0.01f * fabsf(ex) + 0.01f)); dbg_report(ctl, ph, fabsf(gb - ex) / (0.02f * fabsf(ex) + 0.02f));
            if (ph == DBG_FOCUS) {
                dbg_report(ctl, 48 + 1, fabsf(got - ex) / (0.01f * fabsf(ex) + 0.01f));
                dbg_report(ctl, 48 + 2, fabsf(got - (snap[n] + pj)) / 0.02f);
                dbg_report(ctl, 48 + 3, fabsf(got - (snap[n] + sg)) / 0.02f);
                dbg_report(ctl, 48 + 4, fabsf(got - snap[n]) / 0.02f);
                dbg_report(ctl, 48 + 5, fabsf(gb - got) / (0.02f * fabsf(got) + 0.02f));
                dbg_report(ctl, 48 + 6, fabsf(got - (snap[n] + pj * 0.5f)) / 0.02f);
            } }
        return; }
}
__global__ void dbg_snap_q(const bf16_t* Q, float* snap) { const int k = blockIdx.x, r = samp_row(k); for (int i = threadIdx.x; i < DM; i += blockDim.x) snap[(size_t)k * DM + i] = bf2f(Q[(size_t)r * DM + i]); }
__global__ void dbg_poison(float* out, const unsigned* ctl, size_t n) {
    int code = 0; for (int kk = 0; kk < NPH; ++kk) { if (kk > 0 && (kk - 1) % 10 == 9 && __builtin_bit_cast(float, ctl[CW_DBG + 41 + (kk - 1) / 10]) > 1.0f) { code = 42 + (kk - 1) / 10; break; }
        if (__builtin_bit_cast(float, ctl[CW_DBG + kk]) > 1.0f) { code = kk + 1; break; } }
    if (ctl[CW_TMO] || ctl[CW_BAR + XB_TMO]) code = 60;
    if (code == 0) return;
    float V = exp2f((float)code);
    if (DBG_SHOW_A >= 0) { const unsigned n0 = ctl[CW_DBG + DBG_SHOW_A], nh = ctl[CW_DBG + DBG_SHOW_B]; V = exp2f(64.f + (float)(n0 > 60u ? 60u : n0)) * (1.f + (float)(nh > 63u ? 63u : nh) / 128.f); }
    else if (code == DBG_FOCUS + 1) {
        const unsigned n0 = ctl[CW_DBG + 63], nh = ctl[CW_DBG + 61];
        V = exp2f(64.f + (float)(n0 > 60u ? 60u : n0)) * (1.f + (float)(nh > 63u ? 63u : nh) / 128.f); }
    for (size_t i = (size_t)blockIdx.x * blockDim.x + threadIdx.x; i < n; i += (size_t)gridDim.x * blockDim.x) out[i] = V;
}
#endif

extern "C" void kernel_launch(void* const* d_in, const int* in_sizes, int n_in, void* d_out, int out_size, void* d_ws, size_t ws_size, hipStream_t stream) {
    static int grid = 0;
    if (grid == 0) {
        if (n_in != N_IN || out_size != T * DM || ws_size < WS_END) { fprintf(stderr, "kernel_launch: unexpected problem (n_in %d, out %d, ws %zu < %zu)\n", n_in, out_size, ws_size, (size_t)WS_END); grid = -1; return; }
        int dev = 0, cus = 0, per_cu = 0;
        if (hipGetDevice(&dev) != hipSuccess || hipDeviceGetAttribute(&cus, hipDeviceAttributeMultiprocessorCount, dev) != hipSuccess) { grid = -1; return; }
        if (hipFuncSetAttribute((const void*)mk_fwd, hipFuncAttributeMaxDynamicSharedMemorySize, LDS_BYTES) != hipSuccess) { fprintf(stderr, "kernel_launch: hipFuncSetAttribute failed\n"); grid = -1; return; }
        if (hipOccupancyMaxActiveBlocksPerMultiprocessor(&per_cu, (const void*)mk_fwd, NTHREADS, LDS_BYTES) != hipSuccess || per_cu < 1) { fprintf(stderr, "kernel_launch: occupancy query says %d blocks per CU\n", per_cu); }
        (void)hipGetLastError();
        grid = cus;
    }
    if (grid < 0) return;
    (void)hipMemsetAsync((char*)d_ws + WS_CTL, 0, CTL_ZERO_BYTES, stream);
    Args a{};
    for (int i = 0; i < N_IN; ++i) a.in[i] = (const float*)d_in[i];
    a.out = (float*)d_out; a.ws = (unsigned char*)d_ws;
#if !MK_DEBUG
    a.ph_lo = 0; a.ph_hi = NPH;
    hipLaunchKernelGGL(mk_fwd, dim3(grid), dim3(NTHREADS), LDS_BYTES, stream, a);
#else
    DbgArgs da{}; for (int i = 0; i < N_IN; ++i) da.in[i] = (const float*)d_in[i]; da.res = (float*)d_out; da.ws = (unsigned char*)d_ws;
    float* snap = (float*)((char*)d_ws + WS_MISC + MS_SNAP);
    for (int k = 0; k < NPH; ++k) {
        if (!phase_nonempty(k)) continue;
        const int L = (k - 1) / 10, s = (k - 1) % 10;
        if (k > 0) {
            if (s == 2) hipLaunchKernelGGL(dbg_snap_q, dim3(NSAMP), dim3(256), 0, stream, (const bf16_t*)((char*)d_ws + WS_QA), snap);
            if (s == 3) hipLaunchKernelGGL(dbg_snapshot, dim3(NSAMP), dim3(256), 0, stream, L == 0 ? (const float*)d_in[IN_X] : (const float*)d_out, snap);
            if (s == 4 || s == 7 || s == 8 || s == 9) hipLaunchKernelGGL(dbg_snapshot, dim3(NSAMP), dim3(256), 0, stream, (const float*)d_out, snap);
        }
        a.ph_lo = k; a.ph_hi = k + 1; a.sub = 0;
        if (k > 0 && s == 9) { a.sub = 1; hipLaunchKernelGGL(mk_fwd, dim3(grid), dim3(NTHREADS), LDS_BYTES, stream, a); da.phase = k; da.pad = 1; hipLaunchKernelGGL(dbg_check, dim3(NSAMP), dim3(64), 0, stream, da); da.pad = 0; a.sub = 2; }
        hipLaunchKernelGGL(mk_fwd, dim3(grid), dim3(NTHREADS), LDS_BYTES, stream, a);
        if (k == 0 || s == 0 || s == 2 || s == 3 || s == 4 || s == 6 || s == 7 || s == 8 || s == 9) { da.phase = k; hipLaunchKernelGGL(dbg_check, dim3(NSAMP), dim3(64), 0, stream, da); }
    }
    hipLaunchKernelGGL(dbg_poison, dim3(1024), dim3(256), 0, stream, (float*)d_out, (const unsigned*)d_ws, (size_t)T * DM);
#endif
}
```

```cpp
#include <hip/hip_runtime.h>
#include <cstdio>
#include <cstdint>

#ifndef MK_DEBUG
#define MK_DEBUG 0
#endif

#define LAS __attribute__((address_space(3)))
#define GAS __attribute__((address_space(1)))
typedef unsigned short bf16_t;
typedef short bf16x8 __attribute__((ext_vector_type(8)));
typedef short bf16x4 __attribute__((ext_vector_type(4)));
typedef float f32x4 __attribute__((ext_vector_type(4)));
typedef float f32x2 __attribute__((ext_vector_type(2)));
typedef unsigned u32x4 __attribute__((ext_vector_type(4)));
typedef unsigned u32x2 __attribute__((ext_vector_type(2)));
typedef int i32x4 __attribute__((ext_vector_type(4)));

constexpr int DM = 1024, NBATCH = 2, SEQ = 16384, T = NBATCH * SEQ, NH = 4, HD = 256, DFF = 2816, NE = 8, DFE = 704, PLE = 256, DEPTH = 4;
constexpr float ALPHA = 1.6817928305074292f;
constexpr float LN_EPS = 1e-5f;
constexpr int NWAVES = 8, NTHREADS = 512;
enum { IN_X = 0, IN_P, IN_AQKV, IN_AO, IN_KVF, IN_KVFB, IN_BQ, IN_BO, IN_FGU, IN_FDN, IN_MR, IN_MGU, IN_MDN, IN_PP, IN_PG, IN_LNG, IN_LNB, N_IN };

constexpr size_t MiB = 1u << 20;
constexpr size_t WS_CTL = 0, CTL_ZERO_BYTES = 1 * MiB;
constexpr size_t WS_MISC = 1 * MiB;
constexpr size_t WS_WLIVE = 8 * MiB;
constexpr size_t WS_PB = 77 * MiB;
constexpr size_t WS_XB1 = 93 * MiB, WS_XB0 = 157 * MiB;
constexpr size_t WS_WDEAD = 221 * MiB;
constexpr size_t WS_QA = 294 * MiB, WS_KS = 358 * MiB, WS_VS = 422 * MiB, WS_END = 486 * MiB;
constexpr size_t MS_REC = 0;
constexpr size_t MS_HIST = 512 * 1024;
constexpr size_t MS_ELIST = 576 * 1024;
constexpr int ELIST_CAP = 2 * T + NE * 256;
constexpr size_t MS_PLIST = MS_ELIST + (size_t)ELIST_CAP * 16;
constexpr int NPAIR = 28, PLIST_CAP = T + NPAIR * 256;
constexpr size_t MS_TAB = 2 * MiB;
constexpr size_t MS_CL = 2 * MiB + 64 * 1024;
constexpr size_t MS_TOT = MS_CL + (size_t)8 * SEQ * 4;
constexpr size_t MS_SNAP = 3 * MiB;
constexpr size_t MS_EGATE = 4 * MiB + 512 * 1024;
constexpr size_t MS_GATE = 4 * MiB;
static_assert(MS_PLIST + (size_t)PLIST_CAP * 4 <= MS_TAB && MS_TOT + 8 * 256 * 4 <= MS_SNAP, "misc map");
enum { TB_ECUM = 0  , TB_EOFF = 16  , TB_NRT = 32, TB_RT2P = 64  , TB_WORDS = 320 };
constexpr int CW_TMO = 0, CW_CODE = 1, CW_DBG = 64  , CW_KN2 = 192  , CW_BAR = 4096;

constexpr size_t WSZ_QKV = (size_t)3072 * 1024, WSZ_SQ = (size_t)1024 * 1024, WSZ_GU = (size_t)5632 * 1024, WSZ_DN = (size_t)1024 * 2816,
                 WSZ_MGU = (size_t)NE * 1536 * 1024, WSZ_MDN = (size_t)1024 * 5632, WSZ_PP = (size_t)1024 * 256;
constexpr size_t WD_QKV0 = 0, WD_O0 = WD_QKV0 + WSZ_QKV, WD_QKV1 = WD_O0 + WSZ_SQ, WD_O1 = WD_QKV1 + WSZ_QKV, WD_GU0 = WD_O1 + WSZ_SQ, WD_DN0 = WD_GU0 + WSZ_GU,
                 WD_MGU0 = WD_DN0 + WSZ_DN, WD_MDN0 = WD_MGU0 + WSZ_MGU, WD_PP0 = WD_MDN0 + WSZ_MDN, WD_PG0 = WD_PP0 + WSZ_PP, WD_PP1 = WD_PG0 + WSZ_SQ, WD_PG1 = WD_PP1 + WSZ_PP, WD_END = WD_PG1 + WSZ_SQ;
constexpr size_t WL_QKV2 = 0, WL_O2 = WL_QKV2 + WSZ_QKV, WL_Q3 = WL_O2 + WSZ_SQ, WL_O3 = WL_Q3 + WSZ_SQ, WL_GU1 = WL_O3 + WSZ_SQ, WL_DN1 = WL_GU1 + WSZ_GU,
                 WL_MGU1 = WL_DN1 + WSZ_DN, WL_MDN1 = WL_MGU1 + WSZ_MGU, WL_PP2 = WL_MDN1 + WSZ_MDN, WL_PG2 = WL_PP2 + WSZ_PP, WL_PP3 = WL_PG2 + WSZ_SQ, WL_PG3 = WL_PP3 + WSZ_PP, WL_END = WL_PG3 + WSZ_SQ;
static_assert(WD_END * 2 <= 73 * MiB && WL_END * 2 <= 69 * MiB, "weight regions");
static_assert((size_t)T * DFF * 2 <= WS_END - WS_QA && WS_XB0 + (size_t)T * DFF * 2 <= WS_KS && WS_WDEAD + (size_t)(T + NPAIR * 256) * 1408 * 2 <= WS_KS, "h overlays");

constexpr int RING_BYTES = 131072;
constexpr int LDS_CTL = 135168;
constexpr int LDS_TAB = LDS_CTL + 128;
constexpr int LDS_FLAGS = LDS_TAB + TB_WORDS * 4;
constexpr int LDS_BYTES = 147456;
static_assert(LDS_FLAGS + 64 <= LDS_BYTES, "LDS map");

#define RLX_AGENT __ATOMIC_RELAXED, __HIP_MEMORY_SCOPE_AGENT
__device__ __forceinline__ unsigned f2bf(float f) { unsigned u = __builtin_bit_cast(unsigned, f); return (u + 0x7fffu + ((u >> 16) & 1u)) >> 16; }
__device__ __forceinline__ unsigned pk2(float lo, float hi) { return f2bf(lo) | (f2bf(hi) << 16); }
__device__ __forceinline__ float bf2f(unsigned short b) { return __builtin_bit_cast(float, (unsigned)b << 16); }
typedef __bf16 bf16v2_t __attribute__((ext_vector_type(2)));
__device__ __forceinline__ unsigned cvt_pk_bf16(float lo, float hi) { bf16v2_t v; v[0] = (__bf16)lo; v[1] = (__bf16)hi; return __builtin_bit_cast(unsigned, v); }
__device__ __forceinline__ float shx(float v, int m, int lane) { return __builtin_bit_cast(float, __builtin_amdgcn_ds_bpermute((lane ^ m) << 2, __builtin_bit_cast(int, v))); }
__device__ __forceinline__ int shxi(int v, int m, int lane) { return __builtin_amdgcn_ds_bpermute((lane ^ m) << 2, v); }
__device__ __forceinline__ float shup(float v, int o, int lane) { return __builtin_bit_cast(float, __builtin_amdgcn_ds_bpermute(((lane - o) & 63) << 2, __builtin_bit_cast(int, v))); }
__device__ __forceinline__ float wave_sum(float v, int lane) {
#pragma unroll
    for (int o = 1; o < 64; o <<= 1) v += shx(v, o, lane);
    return v;
}
template <int CTRL> __device__ __forceinline__ float dpp_mov(float v) { return __builtin_bit_cast(float, __builtin_amdgcn_update_dpp(0, __builtin_bit_cast(int, v), CTRL, 0xF, 0xF, true)); }
__device__ __forceinline__ float wave_sum_dpp(float v) {
    v += dpp_mov<0xB1>(v); v += dpp_mov<0x4E>(v); v += dpp_mov<0x141>(v); v += dpp_mov<0x140>(v);
    const int b = __builtin_bit_cast(int, v);
    return (__builtin_bit_cast(float, __builtin_amdgcn_readlane(b, 0)) + __builtin_bit_cast(float, __builtin_amdgcn_readlane(b, 16))) + (__builtin_bit_cast(float, __builtin_amdgcn_readlane(b, 32)) + __builtin_bit_cast(float, __builtin_amdgcn_readlane(b, 48)));
}
__device__ __forceinline__ float fast_exp(float x) { return __builtin_amdgcn_exp2f(x * 1.4426950408889634f); }
__device__ __forceinline__ float fast_log(float x) { return __builtin_amdgcn_logf(x) * 0.6931471805599453f; }
__device__ __forceinline__ float softplus_f(float z) { return fmaxf(z, 0.f) + fast_log(1.f + fast_exp(-fabsf(z))); }
__device__ __forceinline__ float sigmoid_f(float z) { return __builtin_amdgcn_rcpf(1.f + fast_exp(-z)); }

typedef const GAS float* fptr_t;
__device__ __forceinline__ const GAS float* in_sel(int idx) { const __attribute__((address_space(4))) fptr_t* ka = (const __attribute__((address_space(4))) fptr_t*)__builtin_amdgcn_kernarg_segment_ptr(); return ka[idx]; }

template <class Tp> __device__ __forceinline__ GAS Tp* launder_ptr(GAS Tp* p) { unsigned lo = (unsigned)(unsigned long long)p, hi = (unsigned)((unsigned long long)p >> 32); asm volatile("" : "+v"(lo), "+v"(hi));
    lo = __builtin_amdgcn_readfirstlane(lo); hi = __builtin_amdgcn_readfirstlane(hi); return (GAS Tp*)(((unsigned long long)hi << 32) | lo); }
__device__ __forceinline__ int launder_int(int v) { asm volatile("" : "+v"(v)); return __builtin_amdgcn_readfirstlane(v); }

#define XB_TMO      128
#define XB_XCNT(j)  (256  + 64 * (j))
#define XB_XSUB(j)  (1280 + 64 * (j))
#define XB_XGEN(j)  (2304 + 64 * (j))
#define XB_TOP      3328
#define XB_TOPGEN   3392
#define XCD_BAR_WORDS 3456
#define XB_SPIN_CAP (1u << 18)
__device__ __forceinline__ unsigned xb_ld(GAS unsigned* p)              { return __hip_atomic_load(p, __ATOMIC_RELAXED, __HIP_MEMORY_SCOPE_AGENT); }
__device__ __forceinline__ unsigned xb_add(GAS unsigned* p, unsigned v) { return __hip_atomic_fetch_add(p, v, __ATOMIC_RELAXED, __HIP_MEMORY_SCOPE_AGENT); }
__device__ __forceinline__ unsigned xb_xcc_id() { return (unsigned)__builtin_amdgcn_s_getreg((3 << 11) | 20) & 0xFu; }
#define XB_SPIN(cond, bar) do { unsigned _sp = 0; while (cond) { __builtin_amdgcn_s_sleep(1); \
    if ((++_sp & 255u) == 0u) { if (xb_ld(&(bar)[XB_TMO])) break; if (_sp > XB_SPIN_CAP) { (void)xb_add(&(bar)[XB_TMO], 1u); break; } } } } while (0)
struct XcdBarrier { GAS unsigned* bar; unsigned x; volatile LAS unsigned* st; };
__device__ __forceinline__ XcdBarrier xcd_barrier_post(GAS unsigned* bar, volatile LAS unsigned* st) {
    XcdBarrier b; b.bar = bar; b.x = xb_xcc_id(); b.st = st;
    if (threadIdx.x == 0) (void)xb_add(&bar[XB_XCNT(b.x)], 1u);
    return b;
}
__device__ __forceinline__ void xcd_barrier_complete(GAS unsigned* bar, unsigned x, unsigned& nloc, unsigned& nx) {
    const unsigned G = gridDim.x * gridDim.y * gridDim.z;
    unsigned sum, cnt, mine, sp = 0u;
    for (;;) {
        sum = 0u; cnt = 0u; mine = 0u;
#pragma unroll
        for (unsigned j = 0; j < 16; ++j) { const unsigned c = xb_ld(&bar[XB_XCNT(j)]); sum += c; cnt += (c > 0u) ? 1u : 0u; mine = (j == x) ? c : mine; }
        if (sum == G) break;
        __builtin_amdgcn_s_sleep(1);
        if ((++sp & 255u) == 0u) { if (xb_ld(&bar[XB_TMO])) break; if (sp > XB_SPIN_CAP) { (void)xb_add(&bar[XB_TMO], 1u); break; } }
    }
    nloc = mine > 0u ? mine : 1u; nx = cnt > 0u ? cnt : 1u;
}
__device__ __forceinline__ void xcd_barrier(const XcdBarrier& b) {
    asm volatile("s_waitcnt vmcnt(0)" ::: "memory");
    __syncthreads();
    if (threadIdx.x == 0) {
        GAS unsigned* bar = b.bar;
        __builtin_amdgcn_s_waitcnt(0);
        unsigned nloc = b.st[0], nx = b.st[1];
        if (nloc == 0u) { xcd_barrier_complete(bar, b.x, nloc, nx); b.st[0] = nloc; b.st[1] = nx; }
        const unsigned old = xb_add(&bar[XB_XSUB(b.x)], 1u);
        const unsigned gen = old / nloc;
        if (old + 1u == (gen + 1u) * nloc) {
            __builtin_amdgcn_fence(__ATOMIC_RELEASE, "agent");
            asm volatile("s_waitcnt vmcnt(0)" ::: "memory");
            const unsigned og = xb_add(&bar[XB_TOP], 1u);
            const unsigned tg = og / nx;
            if (og + 1u == (tg + 1u) * nx) xb_add(&bar[XB_TOPGEN], 1u);
            else XB_SPIN(xb_ld(&bar[XB_TOPGEN]) == tg, bar);
            __builtin_amdgcn_fence(__ATOMIC_ACQUIRE, "agent");
            xb_add(&bar[XB_XGEN(b.x)], 1u);
            asm volatile("s_waitcnt vmcnt(0)" ::: "memory");
        } else {
            XB_SPIN(xb_ld(&bar[XB_XGEN(b.x)]) == gen, bar);
            __builtin_amdgcn_fence(__ATOMIC_ACQUIRE, "agent");
            asm volatile("s_waitcnt vmcnt(0)" ::: "memory");
        }
    }
    __syncthreads();
}

namespace g8 {
constexpr int BM = 256, BK = 64, HALF = 128, HTB = HALF * BK * 2, STAGE_BYTES = 8 * HTB, NXCD = 8, WGM = 8;
__host__ __device__ __forceinline__ int lds_byte(int r, int c) { const int st = (r >> 4) * 2 + (c >> 5), rr = r & 15, cc = c & 31, ob = rr * 64 + cc * 2; return st * 1024 + (ob ^ (((ob >> 9) & 1) << 5)); }
__host__ __device__ __forceinline__ void stage_rc(int b, int& R, int& C) { const int st = b / 1024, sb = b % 1024, swz = sb ^ (((sb >> 9) & 1) << 5); R = (st >> 1) * 16 + swz / 64; C = (st & 1) * 32 + (swz % 64) / 2; }
__host__ __device__ __forceinline__ int perm32(int rho) { const int n = rho >> 4, i = rho & 15; return 8 * (i >> 2) + 4 * n + (i & 3); }
struct Unit { int pm, pn, x0, x1; };
__device__ __forceinline__ bool static_order(int i, int G, int c, int nM, int nN, int& pm, int& pn) {
    const int nwg = nM * nN; const long L = (long)i * G + c; if (L >= nwg) return false;
    int wgid = (int)L; { const int q = nwg / NXCD, r = nwg % NXCD, xcd = wgid % NXCD, off = wgid / NXCD; wgid = (xcd < r ? xcd * (q + 1) : r * (q + 1) + (xcd - r) * q) + off; }
    const int nig = WGM * nN, gid = wgid / nig, fm = gid * WGM, gsz = (nM - fm) < WGM ? (nM - fm) : WGM;
    pm = fm + ((wgid % nig) % gsz); pn = (wgid % nig) / gsz; return true;
}

template <class Prob, class Epi, bool ALIGN_EPI = true>
__device__ __forceinline__ void gemm_phase(LAS unsigned char* lds, const Prob& P, const Epi& E, int wave_id) {
    int tid_; asm volatile("v_mbcnt_lo_u32_b32 %0, -1, 0\n\tv_mbcnt_hi_u32_b32 %0, -1, %0" : "=v"(tid_)); tid_ += wave_id * 64;
    const int tid = tid_, wid = __builtin_amdgcn_readfirstlane(tid >> 6), lane = tid & 63, wr = wid >> 2, wc = wid & 3, fr = lane & 15, fq = lane >> 4;
    const int nt = P.nt;
    unsigned voffA[2], voffB[2]; int Rr0 = 0; unsigned voffC = 0;
#pragma unroll
    for (int i = 0; i < 2; ++i) { int R, C; stage_rc(tid * 16 + i * 8192, R, C); const int Rb = Epi::PERM ? ((R & ~31) + perm32(R & 31)) : R;
        voffA[i] = (unsigned)(R * P.lda + C) * 2u; voffB[i] = (unsigned)(Rb * P.ldb + C) * 2u; if (i == 0) { Rr0 = R; voffC = (unsigned)C * 2u; } }
    const size_t kstep = (size_t)(BK * 2);
    const size_t hstepA = (size_t)HALF * P.lda * 2, hstepB = (size_t)HALF * P.ldb * 2;
    const unsigned ldsw = (unsigned)wid * 1024u;
    const int aoff = lds_byte(wr * 64 + fr, fq * 8), boff = lds_byte(wc * 32 + fr, fq * 8);
#define G8_SA(b, h) (((b) * 2 + (h)) * HTB)
#define G8_SB(b, h) ((4 + (b) * 2 + (h)) * HTB)
#define G8_STAGE(bufoff, gbase, voff) do { _Pragma("unroll") for (int _i = 0; _i < 2; ++_i) \
        __builtin_amdgcn_global_load_lds((const GAS unsigned*)((const GAS char*)(gbase) + (voff)[_i]), (LAS unsigned*)(lds + (bufoff) + ldsw + _i * 8192), 16, 0, 0); } while (0)
#define G8_STAGE_A(bufoff, h, kb, NX) do { if constexpr (Prob::GATHER) { const unsigned pk_ = (NX) ? gAn[h] : gAc[h]; const unsigned vo_[2] = {(pk_ & 0xffffu) * (unsigned)(P.lda * 2) + voffC, (pk_ >> 16) * (unsigned)(P.lda * 2) + voffC}; \
        G8_STAGE(bufoff, P.a_base() + (kb), vo_); } \
        else { G8_STAGE(bufoff, ((NX) ? nA : cA) + (h) * hstepA + (kb), voffA); } } while (0)
#define G8_LDA(dst, b, h) do { _Pragma("unroll") for (int m = 0; m < 4; ++m) _Pragma("unroll") for (int k = 0; k < 2; ++k) dst[m][k] = *(const LAS bf16x8*)(lds + G8_SA(b, h) + aoff + m * 2048 + k * 1024); } while (0)
#define G8_LDB(dst, b, h) do { _Pragma("unroll") for (int n = 0; n < 2; ++n) _Pragma("unroll") for (int k = 0; k < 2; ++k) dst[n][k] = *(const LAS bf16x8*)(lds + G8_SB(b, h) + boff + n * 2048 + k * 1024); } while (0)
#define G8_MMA(ai, bj, At, Bt) do { __builtin_amdgcn_s_setprio(1); _Pragma("unroll") for (int m = 0; m < 4; ++m) _Pragma("unroll") for (int n = 0; n < 2; ++n) _Pragma("unroll") for (int k = 0; k < 2; ++k) \
        acc[ai][bj][m][n] = __builtin_amdgcn_mfma_f32_16x16x32_bf16(Bt[n][k], At[m][k], acc[ai][bj][m][n], 0, 0, 0); __builtin_amdgcn_s_setprio(0); } while (0)
#define G8_WAIT_V(n) asm volatile("s_waitcnt vmcnt(" #n ")" ::: "memory")
#define G8_WAIT_L(n) asm volatile("s_waitcnt lgkmcnt(" #n ")" ::: "memory")
#define G8_BAR __builtin_amdgcn_s_barrier()
#define G8_SCHED __builtin_amdgcn_sched_barrier(0)
    Unit cur, nxt; int ui = 0;
    if (!P.next(0, cur)) return;
    f32x4 acc[2][2][4][2];
#pragma unroll
    for (int a = 0; a < 2; ++a)
#pragma unroll
        for (int b = 0; b < 2; ++b)
#pragma unroll
            for (int m = 0; m < 4; ++m)
#pragma unroll
                for (int n = 0; n < 2; ++n) acc[a][b][m][n] = (f32x4){0.f, 0.f, 0.f, 0.f};
    bf16x8 At[4][2], B0[2][2], B1[2][2];
    unsigned gAc[2], gAn[2];
    const GAS char* cA = nullptr; const GAS char* nA = nullptr;
    if constexpr (Prob::GATHER) { P.gather(cur, Rr0, gAc); } else { cA = P.a_tile(cur); }
    {
        const GAS char* b0 = P.b_ptr(cur, 0); const GAS char* b1 = P.b_ptr(cur, 1);
        G8_STAGE(G8_SB(0, 0), b0, voffB); G8_STAGE(G8_SB(0, 1), b0 + hstepB, voffB); G8_STAGE_A(G8_SA(0, 0), 0, 0, false); G8_STAGE_A(G8_SA(0, 1), 1, 0, false);
        if (wr == 1) G8_BAR;
        G8_WAIT_V(2); G8_BAR;
        G8_STAGE(G8_SB(1, 0), b1, voffB); G8_STAGE_A(G8_SA(1, 0), 0, kstep, false); G8_STAGE(G8_SB(1, 1), b1 + hstepB, voffB);
        G8_WAIT_V(6); G8_BAR;
    }
    for (;;) {
        const bool has_next = P.next(ui + 1, nxt);
        if (!has_next) nxt = cur;
        if constexpr (Prob::GATHER) { if (has_next) P.gather(nxt, Rr0, gAn); else { gAn[0] = gAc[0]; gAn[1] = gAc[1]; } }
        else { nA = P.a_tile(nxt); }
        for (int t = 0; t < nt; t += 2) {
            const bool last = (t == nt - 2);
            const size_t a1k = (size_t)(t + 1) * kstep;
            const size_t a2k = last ? 0 : (size_t)(t + 2) * kstep, a3k = last ? kstep : (size_t)(t + 3) * kstep;
            const GAS char* b2 = last ? P.b_ptr(nxt, 0) : P.b_ptr(cur, t + 2); const GAS char* b3 = last ? P.b_ptr(nxt, 1) : P.b_ptr(cur, t + 3);
            G8_LDB(B0, 0, 0); G8_LDB(B1, 0, 1); G8_SCHED; G8_LDA(At, 0, 0); G8_STAGE_A(G8_SA(1, 1), 1, a1k, false);
            G8_WAIT_V(8); G8_WAIT_L(0); G8_BAR; G8_MMA(0, 0, At, B0); G8_MMA(0, 1, At, B1); G8_BAR; G8_SCHED;
            G8_LDA(At, 0, 1); G8_STAGE(G8_SB(0, 0), b2, voffB); G8_STAGE(G8_SB(0, 1), b2 + hstepB, voffB);
            if (last) { G8_STAGE_A(G8_SA(0, 0), 0, a2k, true); } else { G8_STAGE_A(G8_SA(0, 0), 0, a2k, false); }
            G8_WAIT_V(8); G8_WAIT_L(0); G8_BAR; G8_MMA(1, 0, At, B0); G8_MMA(1, 1, At, B1); G8_BAR; G8_SCHED;
            G8_LDB(B0, 1, 0); G8_LDB(B1, 1, 1); G8_SCHED; G8_LDA(At, 1, 0);
            if (last) { G8_STAGE_A(G8_SA(0, 1), 1, a2k, true); } else { G8_STAGE_A(G8_SA(0, 1), 1, a2k, false); }
            G8_WAIT_V(8); G8_WAIT_L(0); G8_BAR; G8_MMA(0, 0, At, B0); G8_MMA(0, 1, At, B1); G8_BAR; G8_SCHED;
            G8_LDA(At, 1, 1); G8_STAGE(G8_SB(1, 0), b3, voffB); G8_STAGE(G8_SB(1, 1), b3 + hstepB, voffB);
            if (last) { G8_STAGE_A(G8_SA(1, 0), 0, a3k, true); } else { G8_STAGE_A(G8_SA(1, 0), 0, a3k, false); }
            G8_WAIT_V(8); G8_WAIT_L(0); G8_BAR; G8_MMA(1, 0, At, B0); G8_MMA(1, 1, At, B1); G8_BAR; G8_SCHED;
        }
        if constexpr (ALIGN_EPI) { if (wr == 0) G8_BAR; }
        { int l2_; asm volatile("v_mbcnt_lo_u32_b32 %0, -1, 0\n\tv_mbcnt_hi_u32_b32 %0, -1, %0" : "=v"(l2_)); E(acc, cur, wr, wc, l2_ & 15, l2_ >> 4); }
        if (!has_next) break;
#pragma unroll
        for (int a = 0; a < 2; ++a)
#pragma unroll
            for (int b = 0; b < 2; ++b)
#pragma unroll
                for (int m = 0; m < 4; ++m)
#pragma unroll
                    for (int n = 0; n < 2; ++n) acc[a][b][m][n] = (f32x4){0.f, 0.f, 0.f, 0.f};
        cur = nxt; ++ui;
        if constexpr (Prob::GATHER) { gAc[0] = gAn[0]; gAc[1] = gAn[1]; }
        else { cA = nA; }
        if constexpr (ALIGN_EPI) { if (wr == 1) G8_BAR; }
    }
    G8_WAIT_V(0);
    if constexpr (!ALIGN_EPI) { if (wr == 0) G8_BAR; }
    G8_BAR;
#undef G8_SA
#undef G8_SB
#undef G8_STAGE
#undef G8_STAGE_A
#undef G8_LDA
#undef G8_LDB
#undef G8_MMA
#undef G8_WAIT_V
#undef G8_WAIT_L
#undef G8_BAR
#undef G8_SCHED
}

struct ProbPlain {
    static constexpr bool GATHER = false;
    const GAS bf16_t* A; const GAS bf16_t* Bt; int lda, ldb, nt, nM, nN, G, c;
    __device__ __forceinline__ bool next(int i, Unit& u) const { u.x0 = 0; u.x1 = 0; return static_order(i, G, c, nM, nN, u.pm, u.pn); }
    __device__ __forceinline__ const GAS char* a_tile(const Unit& u) const { return (const GAS char*)A + (size_t)u.pm * BM * lda * 2; }
    __device__ __forceinline__ const GAS char* a_base() const { return (const GAS char*)A; }
    __device__ __forceinline__ void gather(const Unit&, int, unsigned (&)[2]) const {}
    __device__ __forceinline__ const GAS char* b_ptr(const Unit& u, int t) const { return (const GAS char*)Bt + ((size_t)u.pn * BM * ldb + (size_t)t * BK) * 2; }
};
struct ProbMoeGU {
    static constexpr bool GATHER = true;
    const GAS bf16_t* A; const GAS bf16_t* Bt; const GAS i32x4* elist; const LAS int* tab; int lda, ldb, nt, G, c;
    __device__ __forceinline__ bool next(int i, Unit& u) const {
        const int total = tab[TB_ECUM + NE]; const long L = (long)i * G + c; if (L >= total) return false;
        int wgid = (int)L; { const int q = total / NXCD, r = total % NXCD, xcd = wgid % NXCD, off = wgid / NXCD; wgid = (xcd < r ? xcd * (q + 1) : r * (q + 1) + (xcd - r) * q) + off; }
        int e = 0;
#pragma unroll
        for (int k = 1; k < NE; ++k) e += (wgid >= tab[TB_ECUM + k]) ? 1 : 0;
        const int loc = wgid - tab[TB_ECUM + e], nM = (tab[TB_ECUM + e + 1] - tab[TB_ECUM + e]) / 6;
        const int nig = WGM * 6, gid = loc / nig, fm = gid * WGM, gsz = (nM - fm) < WGM ? (nM - fm) : WGM;
        u.pm = fm + ((loc % nig) % gsz); u.pn = (loc % nig) / gsz; u.x0 = e; u.x1 = tab[TB_EOFF + e] + 256 * u.pm; return true;
    }
    __device__ __forceinline__ const GAS char* a_tile(const Unit&) const { return (const GAS char*)A; }
    __device__ __forceinline__ const GAS char* a_base() const { return (const GAS char*)A; }
    __device__ __forceinline__ void gather(const Unit& u, int R0, unsigned (&g)[2]) const {
#pragma unroll
        for (int h = 0; h < 2; ++h) { const int t0 = elist[u.x1 + h * HALF + R0].x, t1 = elist[u.x1 + h * HALF + R0 + 64].x; g[h] = (unsigned)t0 | ((unsigned)t1 << 16); }
    }
    __device__ __forceinline__ const GAS char* b_ptr(const Unit& u, int t) const { return (const GAS char*)Bt + ((size_t)(u.x0 * 1536 + u.pn * BM) * ldb + (size_t)t * BK) * 2; }
};
struct ProbMoeDown {
    static constexpr bool GATHER = false;
    const GAS bf16_t* A; const GAS bf16_t* Bt; const LAS int* tab; int lda, ldb, nt, G, c;
    __device__ __forceinline__ bool next(int i, Unit& u) const {
        const int nM = tab[TB_NRT]; if (!static_order(i, G, c, nM, 4, u.pm, u.pn)) return false;
        const int p = tab[TB_RT2P + u.pm]; u.x0 = (p & 0xff) * DFE; u.x1 = ((p >> 8) & 0xff) * DFE; return true;
    }
    __device__ __forceinline__ const GAS char* a_tile(const Unit& u) const { return (const GAS char*)A + (size_t)u.pm * BM * lda * 2; }
    __device__ __forceinline__ const GAS char* a_base() const { return (const GAS char*)A; }
    __device__ __forceinline__ void gather(const Unit&, int, unsigned (&)[2]) const {}
    __device__ __forceinline__ const GAS char* b_ptr(const Unit& u, int t) const { const int ko = (t < 11) ? (u.x0 + t * BK) : (u.x1 + (t - 11) * BK); return (const GAS char*)Bt + ((size_t)u.pn * BM * ldb + (size_t)ko) * 2; }
};

#define G8_ROWLOOP _Pragma("unroll") for (int ai = 0; ai < 2; ++ai) _Pragma("unroll") for (int m = 0; m < 4; ++m)
struct EpiBf16Split {
    static constexpr bool PERM = true;
    GAS bf16_t* O; int ldc; int split_cols; size_t split_stride;
    __device__ __forceinline__ void operator()(const f32x4 (&acc)[2][2][4][2], const Unit& u, int wr, int wc, int fr, int fq) const {
        const int row0 = u.pm * BM + wr * 64 + fr; int colt = u.pn * BM; GAS bf16_t* base = O;
        if (split_cols) { const int t = colt / split_cols; base += (size_t)t * split_stride; colt -= t * split_cols; }
        const int col0 = colt + wc * 32 + 8 * fq;
        G8_ROWLOOP { GAS bf16_t* rowp = base + (size_t)(row0 + ai * HALF + m * 16) * ldc + col0;
#pragma unroll
            for (int bj = 0; bj < 2; ++bj) { const f32x4 v0 = acc[ai][bj][m][0], v1 = acc[ai][bj][m][1];
                u32x4 w; w.x = cvt_pk_bf16(v0[0], v0[1]); w.y = cvt_pk_bf16(v0[2], v0[3]); w.z = cvt_pk_bf16(v1[0], v1[1]); w.w = cvt_pk_bf16(v1[2], v1[3]);
                *(GAS u32x4*)(rowp + bj * HALF) = w; } }
    }
};
struct EpiResid {
    static constexpr bool PERM = false;
    const GAS float* rin; GAS float* out;
    __device__ __forceinline__ void operator()(const f32x4 (&acc)[2][2][4][2], const Unit& u, int wr, int wc, int fr, int fq) const {
        const int row0 = u.pm * BM + wr * 64 + fr, col0 = u.pn * BM + wc * 32 + 4 * fq;
        G8_ROWLOOP { const size_t off = (size_t)(row0 + ai * HALF + m * 16) * DM + col0;
#pragma unroll
            for (int bj = 0; bj < 2; ++bj)
#pragma unroll
                for (int n = 0; n < 2; ++n) { const f32x4 r = *(const GAS f32x4*)(rin + off + bj * HALF + n * 16); *(GAS f32x4*)(out + off + bj * HALF + n * 16) = r * ALPHA + acc[ai][bj][m][n]; }
            asm volatile("" ::: "memory"); }
    }
};
struct EpiSwiglu {
    static constexpr bool PERM = true;
    GAS bf16_t* H; int ldh;
    __device__ __forceinline__ void operator()(const f32x4 (&acc)[2][2][4][2], const Unit& u, int wr, int wc, int fr, int fq) const {
        const int row0 = u.pm * BM + wr * 64 + fr, col0 = u.pn * HALF + wc * 32 + 8 * fq;
        G8_ROWLOOP { u32x4 w; unsigned ww[4];
#pragma unroll
            for (int n = 0; n < 2; ++n) { const f32x4 g = acc[ai][0][m][n], uu = acc[ai][1][m][n]; float hv[4];
#pragma unroll
                for (int i = 0; i < 4; ++i) hv[i] = g[i] * sigmoid_f(g[i]) * uu[i];
                ww[2 * n] = cvt_pk_bf16(hv[0], hv[1]); ww[2 * n + 1] = cvt_pk_bf16(hv[2], hv[3]); }
            w.x = ww[0]; w.y = ww[1]; w.z = ww[2]; w.w = ww[3];
            *(GAS u32x4*)(H + (size_t)(row0 + ai * HALF + m * 16) * ldh + col0) = w; }
    }
};
struct EpiGate {
    static constexpr bool PERM = true;
    GAS bf16_t* O;
    __device__ __forceinline__ void operator()(const f32x4 (&acc)[2][2][4][2], const Unit& u, int wr, int wc, int fr, int fq) const {
        const int row0 = u.pm * BM + wr * 64 + fr, col0 = u.pn * BM + wc * 32 + 8 * fq;
        G8_ROWLOOP { GAS bf16_t* rowp = O + (size_t)(row0 + ai * HALF + m * 16) * DM + col0;
#pragma unroll
            for (int bj = 0; bj < 2; ++bj) { const f32x4 v0 = acc[ai][bj][m][0], v1 = acc[ai][bj][m][1];
                u32x4 w; w.x = cvt_pk_bf16(sigmoid_f(v0[0]), sigmoid_f(v0[1])); w.y = cvt_pk_bf16(sigmoid_f(v0[2]), sigmoid_f(v0[3]));
                w.z = cvt_pk_bf16(sigmoid_f(v1[0]), sigmoid_f(v1[1])); w.w = cvt_pk_bf16(sigmoid_f(v1[2]), sigmoid_f(v1[3]));
                *(GAS u32x4*)(rowp + bj * HALF) = w; } }
    }
};
struct EpiPle {
    static constexpr bool PERM = true;
    GAS float* res; GAS bf16_t* XG;
    __device__ __forceinline__ void operator()(const f32x4 (&acc)[2][2][4][2], const Unit& u, int wr, int wc, int fr, int fq) const {
        const int row0 = u.pm * BM + wr * 64 + fr, col0 = u.pn * BM + wc * 32 + 8 * fq;
        G8_ROWLOOP { const size_t off = (size_t)(row0 + ai * HALF + m * 16) * DM + col0;
#pragma unroll
            for (int bj = 0; bj < 2; ++bj)
#pragma unroll
                for (int n = 0; n < 2; ++n) { const u32x2 gw = *(const GAS u32x2*)(XG + off + bj * HALF + 4 * n); const f32x4 r = *(const GAS f32x4*)(res + off + bj * HALF + 4 * n); const f32x4 a = acc[ai][bj][m][n]; f32x4 o;
                    o[0] = r[0] + a[0] * __builtin_bit_cast(float, gw.x << 16); o[1] = r[1] + a[1] * __builtin_bit_cast(float, gw.x & 0xffff0000u);
                    o[2] = r[2] + a[2] * __builtin_bit_cast(float, gw.y << 16); o[3] = r[3] + a[3] * __builtin_bit_cast(float, gw.y & 0xffff0000u);
                    *(GAS f32x4*)(res + off + bj * HALF + 4 * n) = o; u32x2 w; w.x = cvt_pk_bf16(o[0], o[1]); w.y = cvt_pk_bf16(o[2], o[3]); *(GAS u32x2*)(XG + off + bj * HALF + 4 * n) = w;
                    asm volatile("" ::: "memory"); } }
    }
};
struct EpiMoeGU {
    static constexpr bool PERM = true;
    GAS bf16_t* HS; const GAS i32x4* elist; const GAS float* egate;
    __device__ __forceinline__ void operator()(const f32x4 (&acc)[2][2][4][2], const Unit& u, int wr, int wc, int fr, int fq) const {
        const int j0 = u.pn * HALF + wc * 32 + 8 * fq; const bool colok = j0 < DFE;
        G8_ROWLOOP { const int sl = u.x1 + ai * HALF + wr * 64 + m * 16 + fr; const i32x4 en = elist[sl]; const float gate = egate[sl];
            if (colok && en.y >= 0) { u32x4 w; unsigned ww[4];
#pragma unroll
                for (int n = 0; n < 2; ++n) { const f32x4 g = acc[ai][0][m][n], uu = acc[ai][1][m][n]; float hv[4];
#pragma unroll
                    for (int i = 0; i < 4; ++i) hv[i] = gate * g[i] * sigmoid_f(g[i]) * uu[i];
                    ww[2 * n] = cvt_pk_bf16(hv[0], hv[1]); ww[2 * n + 1] = cvt_pk_bf16(hv[2], hv[3]); }
                w.x = ww[0]; w.y = ww[1]; w.z = ww[2]; w.w = ww[3];
                *(GAS u32x4*)(HS + (size_t)en.y + j0) = w; } }
    }
};
struct EpiMoeDown {
    static constexpr bool PERM = false;
    GAS float* res; const GAS int* plist;
    __device__ __forceinline__ void operator()(const f32x4 (&acc)[2][2][4][2], const Unit& u, int wr, int wc, int fr, int fq) const {
        const int col0 = u.pn * BM + wc * 32 + 4 * fq;
        G8_ROWLOOP { const int tok = plist[u.pm * BM + ai * HALF + wr * 64 + m * 16 + fr];
            if (tok >= 0) { const size_t off = (size_t)tok * DM + col0;
#pragma unroll
                for (int bj = 0; bj < 2; ++bj)
#pragma unroll
                    for (int n = 0; n < 2; ++n) { const f32x4 r = *(const GAS f32x4*)(res + off + bj * HALF + n * 16); *(GAS f32x4*)(res + off + bj * HALF + n * 16) = r * ALPHA + acc[ai][bj][m][n]; } }
            asm volatile("" ::: "memory"); }
    }
};
}

struct Frame {
    LAS unsigned char* lds; GAS unsigned* ctl; GAS unsigned char* ws; GAS float* res;
    int wave, vcu, G;
    __device__ __forceinline__ int lane_id() const { int l; asm volatile("v_mbcnt_lo_u32_b32 %0, -1, 0\n\tv_mbcnt_hi_u32_b32 %0, -1, %0" : "=v"(l)); return l; }
    __device__ __forceinline__ int tid_id() const { return wave * 64 + lane_id(); }
};
__device__ __forceinline__ GAS bf16_t* xb_ptr(const Frame& F, int which) { return (GAS bf16_t*)(F.ws + (which ? WS_XB1 : WS_XB0)); }

struct Job { int in_idx, Ns, nkb, n0, nblk, ldd, drow0, dk0, split, item0; float scale; long long src_off, dst_off; };
constexpr int NJOBS = 55;
struct JobTable { Job j[NJOBS]; int total; int njobs; };
constexpr JobTable make_jobs() {
    JobTable t{}; int n = 0, items = 0;
    auto add = [&](int in_idx, long long src_off, int Ns, int K, int n0, int ncols, long long dst_byte, int ldd, int drow0, int dk0, int split, float scale) {
        Job& j = t.j[n++]; j.in_idx = in_idx; j.src_off = src_off; j.Ns = Ns; j.nkb = K / 64; j.n0 = n0; j.nblk = ncols / 32; j.dst_off = dst_byte; j.ldd = ldd; j.drow0 = drow0; j.dk0 = dk0; j.split = split; j.scale = scale;
        j.item0 = items; items += j.nkb * j.nblk; };
    const long long WD = (long long)WS_WDEAD, WL = (long long)WS_WLIVE;
    const float QS = 0.0625f;
    for (int i = 0; i < 2; ++i) { const long long q = WD + 2 * (long long)(i ? WD_QKV1 : WD_QKV0), o = WD + 2 * (long long)(i ? WD_O1 : WD_O0);
        add(IN_AQKV, (long long)i * 1024 * 3072, 3072, 1024, 0, 1024, q, 1024, 0, 0, 0, QS);
        add(IN_AQKV, (long long)i * 1024 * 3072, 3072, 1024, 1024, 2048, q, 1024, 1024, 0, 0, 1.f);
        add(IN_AO, (long long)i * 1024 * 1024, 1024, 1024, 0, 1024, o, 1024, 0, 0, 0, 1.f); }
    add(IN_BQ, 0, 1024, 1024, 0, 1024, WL + 2 * (long long)WL_QKV2, 1024, 0, 0, 0, QS);
    add(IN_KVF, 0, 2052, 1024, 0, 2048, WL + 2 * (long long)WL_QKV2, 1024, 1024, 0, 0, 1.f);
    add(IN_BQ, (long long)1024 * 1024, 1024, 1024, 0, 1024, WL + 2 * (long long)WL_Q3, 1024, 0, 0, 0, QS);
    add(IN_BO, 0, 1024, 1024, 0, 1024, WL + 2 * (long long)WL_O2, 1024, 0, 0, 0, 1.f);
    add(IN_BO, (long long)1024 * 1024, 1024, 1024, 0, 1024, WL + 2 * (long long)WL_O3, 1024, 0, 0, 0, 1.f);
    for (int i = 0; i < 2; ++i) { const long long gu = i ? WL + 2 * (long long)WL_GU1 : WD + 2 * (long long)WD_GU0, dn = i ? WL + 2 * (long long)WL_DN1 : WD + 2 * (long long)WD_DN0;
        add(IN_FGU, (long long)i * 1024 * 5632, 5632, 1024, 0, 5632, gu, 1024, 0, 0, DFF, 1.f);
        add(IN_FDN, (long long)i * 2816 * 1024, 1024, 2816, 0, 1024, dn, 2816, 0, 0, 0, 1.f); }
    for (int i = 0; i < 2; ++i) for (int e = 0; e < NE; ++e) { const long long gu = i ? WL + 2 * (long long)WL_MGU1 : WD + 2 * (long long)WD_MGU0, dn = i ? WL + 2 * (long long)WL_MDN1 : WD + 2 * (long long)WD_MDN0;
        add(IN_MGU, (long long)(i * NE + e) * 1024 * 1408, 1408, 1024, 0, 1408, gu, 1024, e * 1536, 0, DFE, 1.f);
        add(IN_MDN, (long long)(i * NE + e) * 704 * 1024, 1024, 704, 0, 1024, dn, 5632, 0, e * DFE, 0, 1.f); }
    for (int i = 0; i < 4; ++i) { const long long pp = i == 0 ? WD + 2 * (long long)WD_PP0 : i == 1 ? WD + 2 * (long long)WD_PP1 : i == 2 ? WL + 2 * (long long)WL_PP2 : WL + 2 * (long long)WL_PP3;
        const long long pg = i == 0 ? WD + 2 * (long long)WD_PG0 : i == 1 ? WD + 2 * (long long)WD_PG1 : i == 2 ? WL + 2 * (long long)WL_PG2 : WL + 2 * (long long)WL_PG3;
        add(IN_PP, (long long)i * 256 * 1024, 1024, 256, 0, 1024, pp, 256, 0, 0, 0, 1.f);
        add(IN_PG, (long long)i * 1024 * 1024, 1024, 1024, 0, 1024, pg, 1024, 0, 0, 0, 1.f); }
    t.total = items; t.njobs = n; return t;
}
__device__ const JobTable g_jobs = make_jobs();
static_assert(make_jobs().njobs == NJOBS, "job count");

__device__ __forceinline__ void conv_item(const Frame& F, const Job& J, int it, LAS float* scr) {
    const int lane = F.lane_id(); const int kb = it / J.nblk, nb = it % J.nblk, k0 = 64 * kb, ncol = J.n0 + 32 * nb;
    const GAS float* W = in_sel(J.in_idx) + J.src_off;
    { f32x4 wv[8];
#pragma unroll
      for (int i = 0; i < 8; ++i) wv[i] = *(const GAS f32x4*)(W + (size_t)(k0 + (lane >> 3) + 8 * i) * J.Ns + ncol + (lane & 7) * 4);
#pragma unroll
      for (int i = 0; i < 8; ++i) { LAS float* d = scr + ((lane >> 3) + 8 * i) * 33 + (lane & 7) * 4; d[0] = wv[i][0] * J.scale; d[1] = wv[i][1] * J.scale; d[2] = wv[i][2] * J.scale; d[3] = wv[i][3] * J.scale; } }
    asm volatile("s_waitcnt lgkmcnt(0)" ::: "memory");
    int drow;
    if (J.split) { const int ty = ncol / J.split, jj = ncol % J.split; drow = J.drow0 + 256 * (jj >> 7) + 128 * ty + (jj & 127); } else drow = J.drow0 + (ncol - J.n0);
    GAS bf16_t* WT = (GAS bf16_t*)(F.ws + J.dst_off);
    const int c = lane & 7;
#pragma unroll
    for (int j = 0; j < 4; ++j) { const int n = (lane >> 3) + 8 * j; const LAS float* s = scr + (8 * c) * 33 + n;
        u32x4 o; o.x = pk2(s[0 * 33], s[1 * 33]); o.y = pk2(s[2 * 33], s[3 * 33]); o.z = pk2(s[4 * 33], s[5 * 33]); o.w = pk2(s[6 * 33], s[7 * 33]);
        *(GAS u32x4*)(WT + (size_t)(drow + n) * J.ldd + J.dk0 + k0 + 8 * c) = o; }
    asm volatile("s_waitcnt lgkmcnt(0)" ::: "memory");
}
__device__ __forceinline__ void prologue_phase(Frame& F) {
    LAS float* scr = (LAS float*)(F.lds + F.wave * 16384);
    const int gw = F.vcu * NWAVES + F.wave, NGW = F.G * NWAVES;
    const int total = g_jobs.total;
    for (int it = gw; it < total; it += NGW) {
        int jn = 0;
        for (int k = 1; k < NJOBS; ++k) jn += (it >= g_jobs.j[k].item0) ? 1 : 0;
        jn = __builtin_amdgcn_readfirstlane(jn);
        conv_item(F, g_jobs.j[jn], it - g_jobs.j[jn].item0, scr);
    }
    { const size_t gt = (size_t)blockIdx.x * NTHREADS + F.tid_id(), gs = (size_t)F.G * NTHREADS;
      for (size_t i = gt; i < (size_t)2 * NE * 2 * 64 * 128; i += gs) {
          const int ch = (int)(i & 127), row = (int)((i >> 7) & 63), gu = (int)((i >> 13) & 1), e = (int)((i >> 14) & 7), li = (int)(i >> 17);
          GAS bf16_t* base = (GAS bf16_t*)(F.ws + (li ? WS_WLIVE + 2 * WL_MGU1 : WS_WDEAD + 2 * WD_MGU0));
          *(GAS u32x4*)(base + (size_t)(e * 1536 + 1280 + 128 * gu + 64 + row) * 1024 + ch * 8) = (u32x4){0u, 0u, 0u, 0u}; } }
    GAS bf16_t* xb = xb_ptr(F, 0);
    { const int ln = F.lane_id();
      for (int m = gw; m < T; m += 2 * NGW) {
          const GAS f32x4* xa = (const GAS f32x4*)(in_sel(IN_X) + (size_t)m * DM) + ln; const GAS f32x4* xc = (const GAS f32x4*)(in_sel(IN_X) + (size_t)(m + NGW) * DM) + ln;
          GAS u32x2* oa = (GAS u32x2*)(xb + (size_t)m * DM) + ln; GAS u32x2* oc = (GAS u32x2*)(xb + (size_t)(m + NGW) * DM) + ln;
          f32x4 va[4], vc[4];
#pragma unroll
          for (int j = 0; j < 4; ++j) { va[j] = xa[64 * j]; vc[j] = xc[64 * j]; }
#pragma unroll
          for (int j = 0; j < 4; ++j) { u32x2 o; o.x = cvt_pk_bf16(va[j][0], va[j][1]); o.y = cvt_pk_bf16(va[j][2], va[j][3]); oa[64 * j] = o; o.x = cvt_pk_bf16(vc[j][0], vc[j][1]); o.y = cvt_pk_bf16(vc[j][2], vc[j][3]); oc[64 * j] = o; } } }
}

template <bool ROUTER, bool CVT_P>
__device__ __forceinline__ void ln_phase(Frame& F, int L, int which, GAS bf16_t* xo) {
    int tid_ = F.tid_id(); asm volatile("" : "+v"(tid_));
    const int lane = tid_ & 63, w = __builtin_amdgcn_readfirstlane(tid_ >> 6);
    const GAS f32x4* gp = (const GAS f32x4*)(in_sel(IN_LNG) + (size_t)(L * 2 + which) * DM) + lane; const GAS f32x4* bp = (const GAS f32x4*)(in_sel(IN_LNB) + (size_t)(L * 2 + which) * DM) + lane;
    f32x4 gg[4], bb[4];
#pragma unroll
    for (int j = 0; j < 4; ++j) { gg[j] = gp[64 * j]; bb[j] = bp[64 * j]; }
    LAS f32x4* wrl = (LAS f32x4*)(F.lds + 1024);
    if constexpr (ROUTER) { const GAS float* Wr = in_sel(IN_MR) + (size_t)(L >> 1) * DM * NE;
        __syncthreads();
        for (int jc = w; jc < 16; jc += NWAVES) { const int k = 4 * lane + 256 * (jc >> 2) + (jc & 3);
            wrl[(jc * 2 + 0) * 64 + lane] = *(const GAS f32x4*)(Wr + (size_t)k * NE); wrl[(jc * 2 + 1) * 64 + lane] = *(const GAS f32x4*)(Wr + (size_t)k * NE + 4); }
        __syncthreads(); }
    LAS int* hist = (LAS int*)F.lds;
    for (int ch = blockIdx.x; ch < T / 128; ch += F.G) {
        if constexpr (ROUTER) { __syncthreads(); if (tid_ < 40) hist[tid_] = 0; __syncthreads(); }
        f32x4 nx[4], n2[4], n3[4], npv = (f32x4){0.f, 0.f, 0.f, 0.f}, np2 = npv, np3 = npv;
        { const GAS f32x4* x0 = (const GAS f32x4*)(F.res + (size_t)(128 * ch + 16 * w) * DM) + lane;
#pragma unroll
          for (int j = 0; j < 4; ++j) { nx[j] = x0[64 * j]; n2[j] = x0[256 + 64 * j]; n3[j] = x0[512 + 64 * j]; }
          if constexpr (CVT_P) { const GAS f32x4* p0 = (const GAS f32x4*)(in_sel(IN_P) + ((size_t)L * T + 128 * ch + 16 * w) * PLE) + lane; npv = p0[0]; np2 = p0[64]; np3 = p0[128]; } }
        for (int k = 0; k < 16; ++k) {
            const int row = 128 * ch + 16 * w + k;
            GAS f32x4* xr = (GAS f32x4*)(F.res + (size_t)row * DM) + lane;
            f32x4 v[4]; float s = 0.f; const f32x4 pv = npv;
#pragma unroll
            for (int j = 0; j < 4; ++j) { v[j] = nx[j]; nx[j] = n2[j]; n2[j] = n3[j]; s += (v[j][0] + v[j][1]) + (v[j][2] + v[j][3]); }
            npv = np2; np2 = np3;
            if (k < 13) {
#pragma unroll
                for (int j = 0; j < 4; ++j) n3[j] = xr[768 + 64 * j];
                if constexpr (CVT_P) np3 = *((const GAS f32x4*)(in_sel(IN_P) + ((size_t)L * T + row + 3) * PLE) + lane); }
            const float mean = wave_sum_dpp(s) * (1.f / DM); float s2 = 0.f;
#pragma unroll
            for (int j = 0; j < 4; ++j) { v[j] = v[j] - mean; s2 += (v[j][0] * v[j][0] + v[j][1] * v[j][1]) + (v[j][2] * v[j][2] + v[j][3] * v[j][3]); }
            const float rstd = 1.f / sqrtf(wave_sum_dpp(s2) * (1.f / DM) + LN_EPS);
            GAS u32x2* o8 = (GAS u32x2*)(xo + (size_t)row * DM) + lane;
#pragma unroll
            for (int j = 0; j < 4; ++j) { v[j] = v[j] * rstd * gg[j] + bb[j]; xr[64 * j] = v[j]; u32x2 o; o.x = cvt_pk_bf16(v[j][0], v[j][1]); o.y = cvt_pk_bf16(v[j][2], v[j][3]); o8[64 * j] = o; }
            if constexpr (CVT_P) { u32x2 o; o.x = cvt_pk_bf16(pv[0], pv[1]); o.y = cvt_pk_bf16(pv[2], pv[3]);
                *((GAS u32x2*)((GAS bf16_t*)(F.ws + WS_PB) + (size_t)row * PLE) + lane) = o; }
            if constexpr (ROUTER) {
                float lg[NE];
#pragma unroll
                for (int e = 0; e < NE; ++e) lg[e] = 0.f;
#pragma unroll
                for (int j = 0; j < 4; ++j)
#pragma unroll
                    for (int c = 0; c < 4; ++c) { const float xv = v[j][c]; const f32x4 w0 = wrl[((j * 4 + c) * 2 + 0) * 64 + lane], w1 = wrl[((j * 4 + c) * 2 + 1) * 64 + lane];
#pragma unroll
                        for (int e = 0; e < 4; ++e) { lg[e] += xv * w0[e]; lg[4 + e] += xv * w1[e]; } }
#pragma unroll
                for (int e = 0; e < NE; ++e) lg[e] = wave_sum_dpp(lg[e]);
                int i1 = 0; float v1 = lg[0];
#pragma unroll
                for (int e = 1; e < NE; ++e) if (lg[e] > v1) { v1 = lg[e]; i1 = e; }
                int i2 = -1; float v2 = -3.0e38f;
#pragma unroll
                for (int e = 0; e < NE; ++e) if (e != i1 && lg[e] > v2) { v2 = lg[e]; i2 = e; }
                const float ex = fast_exp(v2 - v1), g1 = __builtin_amdgcn_rcpf(1.f + ex), g2 = 1.f - g1;
                const int ea = i1 < i2 ? i1 : i2, eb = i1 < i2 ? i2 : i1, pid = ea * (15 - ea) / 2 + eb - ea - 1;
                if (lane == 0) { GAS int* rp = (GAS int*)(F.ws + WS_MISC + MS_REC) + (size_t)row * 4; GAS float* gp = (GAS float*)(F.ws + WS_MISC + MS_GATE);
                    rp[0] = i1 | (i2 << 8) | (pid << 16); rp[1] = 0; rp[2] = 0; rp[3] = row; gp[row] = g1; gp[T + row] = g2;
                    __hip_atomic_fetch_add(hist + i1, 1, __ATOMIC_RELAXED, __HIP_MEMORY_SCOPE_WORKGROUP); __hip_atomic_fetch_add(hist + i2, 1, __ATOMIC_RELAXED, __HIP_MEMORY_SCOPE_WORKGROUP);
                    __hip_atomic_fetch_add(hist + 8 + pid, 1, __ATOMIC_RELAXED, __HIP_MEMORY_SCOPE_WORKGROUP); }
            }
        }
        if constexpr (ROUTER) { __syncthreads(); if (tid_ < 40) ((GAS int*)(F.ws + WS_MISC + MS_HIST))[ch * 40 + tid_] = hist[tid_]; }
    }
}

__device__ __forceinline__ int pad256(int v) { return (v + 255) & ~255; }
__device__ __forceinline__ void moe_lists_phase(Frame& F) {
    LAS int* pre = (LAS int*)F.lds; LAS int* tot = pre + 40; LAS int* eoff = tot + 40; LAS int* poff = eoff + 16; LAS int* recs = poff + 32; LAS int* tabl = recs + 128;
    const GAS int* hist = (const GAS int*)(F.ws + WS_MISC + MS_HIST);
    const GAS i32x4* rec = (const GAS i32x4*)(F.ws + WS_MISC + MS_REC);
    GAS i32x4* elist = (GAS i32x4*)(F.ws + WS_MISC + MS_ELIST); GAS int* plist = (GAS int*)(F.ws + WS_MISC + MS_PLIST);
    int tid_ = F.tid_id(); asm volatile("" : "+v"(tid_));
    const int lane = tid_ & 63, w = F.wave, tid = tid_;
    bool first = true;
    for (int ch = blockIdx.x; ch < T / 128; ch += F.G) {
        __syncthreads();
        for (int col = w; col < 36; col += NWAVES) { int sp = 0, st = 0;
#pragma unroll
            for (int k = 0; k < 4; ++k) { const int c2 = lane + 64 * k; const int v = hist[c2 * 40 + col]; st += v; sp += (c2 < ch) ? v : 0; }
#pragma unroll
            for (int o = 1; o < 64; o <<= 1) { sp += shxi(sp, o, lane); st += shxi(st, o, lane); }
            if (lane == 0) { pre[col] = sp; tot[col] = st; } }
        __syncthreads();
        if (tid == 0) {
            int acc = 0, ucum = 0;
            for (int e = 0; e < NE; ++e) { eoff[e] = acc; tabl[TB_EOFF + e] = acc; tabl[TB_ECUM + e] = ucum; const int p = pad256(tot[e]); acc += p; ucum += 6 * (p >> 8); }
            eoff[NE] = acc; tabl[TB_EOFF + NE] = acc; tabl[TB_ECUM + NE] = ucum;
            int pacc = 0, pid = 0;
            for (int a = 0; a < NE - 1; ++a) for (int b = a + 1; b < NE; ++b) { poff[pid] = pacc; pacc += pad256(tot[8 + pid]); ++pid; }
            poff[NPAIR] = pacc; tabl[TB_NRT] = pacc >> 8;
        }
        __syncthreads();
        if (tid < 192) { const int r8 = tid << 8; int p = 0;
            for (int k = 1; k < NPAIR; ++k) p += (r8 >= poff[k]) ? 1 : 0;
            int a = 0, rem = p; while (rem >= NE - 1 - a) { rem -= NE - 1 - a; ++a; }
            tabl[TB_RT2P + tid] = a | ((a + 1 + rem) << 8); }
        __syncthreads();
        if (ch == 0) { for (int i = tid; i < TB_WORDS; i += NTHREADS) ((GAS int*)(F.ws + WS_MISC + MS_TAB))[i] = tabl[i]; }
        if (tid < 128) recs[tid] = rec[128 * ch + tid].x;
        __syncthreads();
        if (tid < 128) {
            const int token = 128 * ch + tid; const i32x4 r = rec[token]; const int e1 = r.x & 0xff, e2 = (r.x >> 8) & 0xff, pid = (r.x >> 16) & 0xff;
            int r1 = 0, r2 = 0, rp = 0;
            for (int j = 0; j < tid; ++j) { const int o = recs[j]; const int o1 = o & 0xff, o2 = (o >> 8) & 0xff, op = (o >> 16) & 0xff;
                r1 += ((o1 == e1) | (o2 == e1)) ? 1 : 0; r2 += ((o1 == e2) | (o2 == e2)) ? 1 : 0; rp += (op == pid) ? 1 : 0; }
            const int pslot = poff[pid] + pre[8 + pid] + rp; plist[pslot] = token;
            i32x4 en; en.x = token; en.w = 0;
            const GAS float* gp = (const GAS float*)(F.ws + WS_MISC + MS_GATE);
            GAS float* eg = (GAS float*)(F.ws + WS_MISC + MS_EGATE); en.z = 0;
            { const int sl = eoff[e1] + pre[e1] + r1; en.y = pslot * 1408 + (e1 < e2 ? 0 : DFE); elist[sl] = en; eg[sl] = gp[token]; }
            { const int sl = eoff[e2] + pre[e2] + r2; en.y = pslot * 1408 + (e2 < e1 ? 0 : DFE); elist[sl] = en; eg[sl] = gp[T + token]; }
        }
        if (first) {
            first = false; const int gt = blockIdx.x * NTHREADS + tid, gs = F.G * NTHREADS;
            for (int e = 0; e < NE; ++e) for (int i = eoff[e] + tot[e] + gt; i < eoff[e + 1]; i += gs) elist[i] = (i32x4){0, -1, 0, 0};
            for (int p = 0; p < NPAIR; ++p) for (int i = poff[p] + tot[8 + p] + gt; i < poff[p + 1]; i += gs) plist[i] = -1;
        }
    }
    __syncthreads();
}
__device__ __forceinline__ void load_tab(Frame& F) {
    __syncthreads();
    for (int i = F.tid_id(); i < TB_WORDS; i += NTHREADS) ((LAS int*)(F.lds + LDS_TAB))[i] = ((const GAS int*)(F.ws + WS_MISC + MS_TAB))[i];
    __syncthreads();
}

__device__ __forceinline__ void forget_phase(Frame& F) {
    int tid_ = F.tid_id(); asm volatile("" : "+v"(tid_));
    const int lane = tid_ & 63, w = __builtin_amdgcn_readfirstlane(tid_ >> 6);
    const GAS float* Wf = in_sel(IN_KVF);
    f32x4 wf[16];
#pragma unroll
    for (int j = 0; j < 4; ++j)
#pragma unroll
        for (int c = 0; c < 4; ++c) { const int k = 4 * lane + 256 * j + c; wf[j * 4 + c] = *(const GAS f32x4*)(Wf + (size_t)k * 2052 + 2048); }
    const f32x4 bias = *(const GAS f32x4*)in_sel(IN_KVFB);
    LAS float* lf = (LAS float*)F.lds;
    GAS float* cl = (GAS float*)(F.ws + WS_MISC + MS_CL); GAS float* tt = (GAS float*)(F.ws + WS_MISC + MS_TOT);
    for (int ch = blockIdx.x; ch < T / 128; ch += F.G) {
        __syncthreads();
        for (int k = 0; k < 16; ++k) {
            const int row = 128 * ch + 16 * w + k; const GAS f32x4* xr = (const GAS f32x4*)(F.res + (size_t)row * DM) + lane;
            f32x4 a = (f32x4){0.f, 0.f, 0.f, 0.f};
#pragma unroll
            for (int j = 0; j < 4; ++j) { const f32x4 v = xr[64 * j];
#pragma unroll
                for (int c = 0; c < 4; ++c) a += wf[j * 4 + c] * v[c]; }
#pragma unroll
            for (int hh = 0; hh < 4; ++hh) a[hh] = wave_sum_dpp(a[hh]);
            if (lane == 0) { f32x4 o;
#pragma unroll
                for (int hh = 0; hh < 4; ++hh) { const float z = a[hh] + bias[hh]; o[hh] = -(fmaxf(-z, 0.f) + log1pf(__expf(-fabsf(z)))); }
                *(LAS f32x4*)(lf + (16 * w + k) * 4) = o; }
        }
        __syncthreads();
        { const int tile = w >> 2, hh = w & 3; float x = lf[(tile * 64 + lane) * 4 + hh];
#pragma unroll
          for (int o = 1; o < 64; o <<= 1) { const float y = shup(x, o, lane); if (lane >= o) x += y; }
          const int row = 128 * ch + tile * 64 + lane, b = row / SEQ, s = row % SEQ;
          cl[(size_t)(b * NH + hh) * SEQ + s] = x; if (lane == 63) tt[(b * NH + hh) * 256 + (s >> 6)] = x; }
    }
    __syncthreads();
}
__device__ __forceinline__ void knorm_phase(Frame& F, const GAS bf16_t* KS) {
    const int lane = F.lane_id(), w = F.wave;
    for (int ch = blockIdx.x; ch < T / 128; ch += F.G) {
        float mx = 0.f;
        for (int k = 0; k < 16; ++k) { const int row = 128 * ch + 16 * w + k; const GAS u32x4* kr = (const GAS u32x4*)(KS + (size_t)row * DM) + 2 * lane; const u32x4 a = kr[0], b = kr[1];
            const unsigned u[8] = {a.x, a.y, a.z, a.w, b.x, b.y, b.z, b.w}; float s = 0.f;
#pragma unroll
            for (int i = 0; i < 8; ++i) { const float lo = __builtin_bit_cast(float, u[i] << 16), hi = __builtin_bit_cast(float, u[i] & 0xffff0000u); s += lo * lo + hi * hi; }
            s += shx(s, 1, lane); s += shx(s, 2, lane); s += shx(s, 4, lane); s += shx(s, 8, lane);
            mx = fmaxf(mx, s); }
        if ((lane & 15) == 0) { const int b = (128 * ch) / SEQ; (void)__hip_atomic_fetch_max(F.ctl + CW_KN2 + b * NH + (lane >> 4), __builtin_bit_cast(unsigned, mx), RLX_AGENT); }
    }
}

constexpr int AT_KB0 = 0, AT_VB0 = 32768, AT_KB1 = 66048, AT_VB1 = 98816, AT_VPANEL = 2080;
constexpr float SB_STOP = -24.f, FOX_STOP = -30.f;
typedef short s16x4 __attribute__((ext_vector_type(4)));
#define AT_TR4(r0, r1, r2, r3, addr, o0, o1, o2, o3) asm volatile("ds_read_b64_tr_b16 %0, %4 offset:%5\n\tds_read_b64_tr_b16 %1, %4 offset:%6\n\tds_read_b64_tr_b16 %2, %4 offset:%7\n\tds_read_b64_tr_b16 %3, %4 offset:%8" \
    : "=&v"(r0), "=&v"(r1), "=&v"(r2), "=&v"(r3) : "v"(addr), "i"(o0), "i"(o1), "i"(o2), "i"(o3) : "memory")
#define AT_WAIT4(r0, r1, r2, r3) asm volatile("s_waitcnt lgkmcnt(0)" : "+v"(r0), "+v"(r1), "+v"(r2), "+v"(r3) :: "memory")

template <bool FOX>
__device__ __forceinline__ void attn_phase(Frame& F, const GAS bf16_t* Q, const GAS bf16_t* Kb, const GAS bf16_t* Vb, GAS bf16_t* O) {
    LAS unsigned char* lds = F.lds;
    volatile LAS unsigned* flags = (volatile LAS unsigned*)(lds + LDS_FLAGS);
    int tid_ = F.tid_id(); asm volatile("" : "+v"(tid_));
    const int tid = tid_, w = __builtin_amdgcn_readfirstlane(tid >> 6), lane = tid & 63, fr = lane & 15, fq = lane >> 4;
    const int srow0 = tid >> 5, schunk = tid & 31;
    const unsigned kst = (unsigned)(srow0 * 512 + ((schunk ^ (srow0 & 15)) * 16));
    const unsigned vst = (unsigned)((schunk >> 1) * AT_VPANEL + srow0 * 32 + (schunk & 1) * 16);
    const unsigned vrd = (unsigned)((4 * fq + ((lane & 15) >> 2)) * 32 + 8 * (lane & 3));
    const GAS float* cl = (const GAS float*)(F.ws + WS_MISC + MS_CL); const GAS float* tt = (const GAS float*)(F.ws + WS_MISC + MS_TOT);
    for (int id = blockIdx.x; id < 8 * 128; id += F.G) {
        const int bh = id & 7, qt = id >> 3, b = bh >> 2, h = bh & 3, t0 = qt * 128;
        const size_t rowbase = (size_t)b * SEQ;
        const int tq = t0 + 16 * w + fr;
        bf16x8 qf[8];
        { const GAS bf16_t* qp = Q + (rowbase + tq) * DM + h * HD + 8 * fq;
#pragma unroll
          for (int s = 0; s < 8; ++s) qf[s] = *(const GAS bf16x8*)(qp + 32 * s); }
        f32x4 o[16];
#pragma unroll
        for (int d = 0; d < 16; ++d) o[d] = (f32x4){0.f, 0.f, 0.f, 0.f};
        float R = 0.f;
        float mrun = -1.0e30f, lsum = 0.f, cq = 0.f, qn = 0.f, KN = 0.f, gacc = 0.f;
        if constexpr (FOX) {
            float s2 = 0.f;
#pragma unroll
            for (int s = 0; s < 8; ++s)
#pragma unroll
                for (int j = 0; j < 8; ++j) { const float x = bf2f((unsigned short)qf[s][j]); s2 += x * x; }
            s2 += shx(s2, 16, lane); s2 += shx(s2, 32, lane); qn = sqrtf(s2);
            KN = sqrtf(__builtin_bit_cast(float, __hip_atomic_load(F.ctl + CW_KN2 + bh, RLX_AGENT))) * 1.002f;
            cq = cl[(size_t)bh * SEQ + tq] + ((tq >= t0 + 64) ? tt[bh * 256 + 2 * qt] : 0.f);
        }
        int kt = 2 * qt + 1, it = 0;
        u32x4 kr[4], vr[4];
        { const GAS bf16_t* kp = Kb + (rowbase + (size_t)64 * kt + srow0) * DM + h * HD + schunk * 8; const GAS bf16_t* vp = Vb + (rowbase + (size_t)64 * kt + srow0) * DM + h * HD + schunk * 8;
#pragma unroll
          for (int j = 0; j < 4; ++j) { kr[j] = *(const GAS u32x4*)(kp + (size_t)16 * j * DM); vr[j] = *(const GAS u32x4*)(vp + (size_t)16 * j * DM); } }
        for (;;) {
            const int kbuf = (it & 1) ? AT_KB1 : AT_KB0, vbuf = (it & 1) ? AT_VB1 : AT_VB0;
#pragma unroll
            for (int j = 0; j < 4; ++j) { *(LAS u32x4*)(lds + kbuf + kst + j * 8192) = kr[j]; *(LAS u32x4*)(lds + vbuf + vst + j * 512) = vr[j]; }
            __syncthreads();
            if (it >= 2) { unsigned any = 0u; const int par = (it - 1) & 1;
#pragma unroll
                for (int k = 0; k < 8; ++k) any |= flags[par * 8 + k];
                if (any == 0u) break; }
            const int kmin = 64 * kt, wmax = t0 + 16 * w + 15, wmin = t0 + 16 * w;
            f32x4 ckv[4]; float ttv = 0.f;
            if constexpr (FOX) {
#pragma unroll
                for (int blk = 0; blk < 4; ++blk) ckv[blk] = *(const GAS f32x4*)(cl + (size_t)bh * SEQ + kmin + 16 * blk + 4 * fq);
                ttv = tt[bh * 256 + (kt > 2 * qt ? 2 * qt : kt)];
                asm volatile("" ::: "memory"); }
            if (kt > 0) { const GAS bf16_t* kp = Kb + (rowbase + (size_t)64 * (kt - 1) + srow0) * DM + h * HD + schunk * 8; const GAS bf16_t* vp = Vb + (rowbase + (size_t)64 * (kt - 1) + srow0) * DM + h * HD + schunk * 8;
#pragma unroll
                for (int j = 0; j < 4; ++j) { kr[j] = *(const GAS u32x4*)(kp + (size_t)16 * j * DM); vr[j] = *(const GAS u32x4*)(vp + (size_t)16 * j * DM); } }
            const bool part = FOX ? (kmin <= wmax) : (kmin < wmax);
            if (part) {
                const bool need_mask = (kmin + 63 >= wmin);
                f32x4 s[4];
#pragma unroll
                for (int blk = 0; blk < 4; ++blk) { s[blk] = (f32x4){0.f, 0.f, 0.f, 0.f};
#pragma unroll
                    for (int st = 0; st < 8; ++st) { const bf16x8 kf = *(const LAS bf16x8*)(lds + kbuf + (16 * blk + fr) * 512 + (((4 * st + fq) ^ fr) * 16));
                        s[blk] = __builtin_amdgcn_mfma_f32_16x16x32_bf16(kf, qf[st], s[blk], 0, 0, 0); } }
                float pv[4][4];
                if constexpr (!FOX) {
                    float lm[4][4], w4[4], Tt[4], Ex[4];
#pragma unroll
                    for (int blk = 0; blk < 4; ++blk) { w4[blk] = 0.f;
#pragma unroll
                        for (int i = 0; i < 4; ++i) { const float z = s[blk][i]; const float sp = softplus_f(z); const bool valid = !need_mask || (kmin + 16 * blk + 4 * fq + i < tq);
                            lm[blk][i] = valid ? -sp : 0.f; pv[blk][i] = valid ? (z - sp) : -1.0e30f; w4[blk] += lm[blk][i]; } }
#pragma unroll
                    for (int blk = 0; blk < 4; ++blk) { const float a = shx(w4[blk], 16, lane), bq = shx(w4[blk], 32, lane), c = shx(a, 32, lane);
                        Tt[blk] = (w4[blk] + a) + (bq + c); Ex[blk] = (fq == 0) ? (a + bq + c) : (fq == 1) ? (bq + c) : (fq == 2) ? a : 0.f; }
                    float bs = 0.f;
#pragma unroll
                    for (int blk = 3; blk >= 0; --blk) { float tail = R + bs + Ex[blk];
#pragma unroll
                        for (int i = 3; i >= 0; --i) { const float e = pv[blk][i] + tail; pv[blk][i] = (e > -80.f) ? fast_exp(e) : 0.f; tail += lm[blk][i]; }
                        bs += Tt[blk]; }
                    R += bs;
                } else {
                    float base;
                    if (kt == 2 * qt + 1) base = ttv; else if (kt == 2 * qt) base = 0.f; else { gacc += ttv; base = -gacc; }
                    float mx = -1.0e30f;
#pragma unroll
                    for (int blk = 0; blk < 4; ++blk) { const f32x4 ck = ckv[blk];
#pragma unroll
                        for (int i = 0; i < 4; ++i) { const bool valid = !need_mask || (kmin + 16 * blk + 4 * fq + i <= tq); const float lg = valid ? (s[blk][i] + cq - (ck[i] + base)) : -1.0e30f; pv[blk][i] = lg; mx = fmaxf(mx, lg); } }
                    mx = fmaxf(mx, shx(mx, 16, lane)); mx = fmaxf(mx, shx(mx, 32, lane));
                    const float mnew = fmaxf(mrun, mx), al = fast_exp(mrun - mnew); float ps = 0.f;
#pragma unroll
                    for (int blk = 0; blk < 4; ++blk)
#pragma unroll
                        for (int i = 0; i < 4; ++i) { const float e = pv[blk][i] - mnew; const float p = (e > -80.f) ? fast_exp(e) : 0.f; pv[blk][i] = p; ps += p; }
                    lsum = lsum * al + ps;
                    if (__any(mnew > mrun)) {
#pragma unroll
                        for (int d = 0; d < 16; ++d) o[d] = o[d] * al; }
                    mrun = mnew;
                }
                bf16x8 pf[2];
#pragma unroll
                for (int c = 0; c < 2; ++c) { u32x4 pw; pw.x = cvt_pk_bf16(pv[2 * c][0], pv[2 * c][1]); pw.y = cvt_pk_bf16(pv[2 * c][2], pv[2 * c][3]); pw.z = cvt_pk_bf16(pv[2 * c + 1][0], pv[2 * c + 1][1]); pw.w = cvt_pk_bf16(pv[2 * c + 1][2], pv[2 * c + 1][3]);
                    pf[c] = __builtin_bit_cast(bf16x8, pw); }
                const unsigned va = (unsigned)(size_t)(lds + vbuf) + vrd;
                s16x4 c0, c1, c2, c3, n0, n1, n2, n3;
                AT_TR4(c0, c1, c2, c3, va, 0, 512, 1024, 1536);
                n0 = c0; n1 = c1; n2 = c2; n3 = c3;
#define AT_PV(db) do { AT_WAIT4(c0, c1, c2, c3); \
                    if ((db) < 15) { AT_TR4(n0, n1, n2, n3, va, ((db) + 1) * AT_VPANEL, ((db) + 1) * AT_VPANEL + 512, ((db) + 1) * AT_VPANEL + 1024, ((db) + 1) * AT_VPANEL + 1536); } \
                    { const bf16x8 v0 = __builtin_shufflevector(c0, c1, 0, 1, 2, 3, 4, 5, 6, 7), v1 = __builtin_shufflevector(c2, c3, 0, 1, 2, 3, 4, 5, 6, 7); \
                      o[db] = __builtin_amdgcn_mfma_f32_16x16x32_bf16(v0, pf[0], o[db], 0, 0, 0); o[db] = __builtin_amdgcn_mfma_f32_16x16x32_bf16(v1, pf[1], o[db], 0, 0, 0); } \
                    c0 = n0; c1 = n1; c2 = n2; c3 = n3; } while (0)
                AT_PV(0); AT_PV(1); AT_PV(2); AT_PV(3); AT_PV(4); AT_PV(5); AT_PV(6); AT_PV(7); AT_PV(8); AT_PV(9); AT_PV(10); AT_PV(11); AT_PV(12); AT_PV(13); AT_PV(14); AT_PV(15);
#undef AT_PV
            } else if constexpr (FOX) { if (kt < 2 * qt) gacc += ttv; }
            { bool cont;
              if constexpr (!FOX) cont = (R >= SB_STOP);
              else cont = (qn * KN + cq + ((kt <= 2 * qt) ? gacc : 0.f) - mrun >= FOX_STOP) || (kt > 2 * qt);
              const bool anyc = __any(cont);
              if (lane == 0) flags[(it & 1) * 8 + w] = anyc ? 1u : 0u; }
            if (kt == 0) break;
            --kt; ++it;
        }
        float inv = 1.f;
        if constexpr (FOX) { float lt = lsum; lt += shx(lt, 16, lane); lt += shx(lt, 32, lane); inv = 1.f / lt; }
        { GAS bf16_t* op = O + (rowbase + tq) * DM + h * HD + 4 * fq;
#pragma unroll
          for (int db = 0; db < 16; ++db) { u32x2 ow; ow.x = cvt_pk_bf16(o[db][0] * inv, o[db][1] * inv); ow.y = cvt_pk_bf16(o[db][2] * inv, o[db][3] * inv); *(GAS u32x2*)(op + 16 * db) = ow; } }
        __syncthreads();
    }
}

constexpr int NPH = 41;
__host__ __device__ inline bool phase_nonempty(int k) { if (k == 0) return true; const int L = (k - 1) / 10, s = (k - 1) % 10; if (s == 1) return L == 2; if (s == 5) return (L & 1) != 0; return true; }
struct Args { const float* in[N_IN]; float* out; unsigned char* ws; int ph_lo, ph_hi, sub, pad; };

__global__ void __launch_bounds__(NTHREADS, 2) mk_fwd(Args args) {
    extern __shared__ __attribute__((aligned(16))) unsigned char lds_raw[];
    Frame F;
    F.lds = (LAS unsigned char*)lds_raw;
    F.wave = __builtin_amdgcn_readfirstlane((int)threadIdx.x >> 6);
    F.G = gridDim.x; { const int bx = blockIdx.x; F.vcu = (F.G % 8 == 0) ? (bx % 8) * (F.G / 8) + bx / 8 : bx; }
    F.ws = (GAS unsigned char*)args.ws; F.ctl = (GAS unsigned*)F.ws; F.res = (GAS float*)args.out;
    for (int u = (int)threadIdx.x; u < (LDS_BYTES - LDS_CTL) / 4; u += NTHREADS) ((LAS unsigned*)(F.lds + LDS_CTL))[u] = 0u;
    __syncthreads();
    const int lo = args.ph_lo, hi = args.ph_hi;
    XcdBarrier bar; bar.bar = F.ctl + CW_BAR; bar.x = 0; bar.st = nullptr;
    if (hi - lo > 1) bar = xcd_barrier_post(F.ctl + CW_BAR, (volatile LAS unsigned*)(F.lds + LDS_CTL) + 8);
#ifndef DUP_MASK
#define DUP_MASK 0
#endif
#define DUP(n) (1 + ((DUP_MASK >> (n)) & 1))
#ifndef SITE_MASK
#define SITE_MASK 0xFFFFF
#endif
#define SITE(n) ((SITE_MASK >> (n)) & 1)
#define IN(k) (lo <= (k) && (k) < hi)
#define SEAM(k) do { if ((k) + 1 < hi) xcd_barrier(bar); } while (0)
    const int c = (int)blockIdx.x;
#define WSB(name) GAS unsigned char* name = launder_ptr(F.ws)
#define XBP(ws_, which) ((GAS bf16_t*)((ws_) + ((which) ? WS_XB1 : WS_XB0)))

    if (SITE(0) && IN(0)) { for (int rep_ = 0; rep_ < DUP(0); ++rep_) prologue_phase(F); SEAM(0); }

    for (int L = 0; L < DEPTH; ++L) {
        const int pb = 1 + 10 * L;
        {
            F.wave = launder_int(F.wave); F.ws = launder_ptr(F.ws); F.res = launder_ptr(F.res); F.ctl = (GAS unsigned*)F.ws; F.G = launder_int(F.G); }
        for (int repa_ = 0; repa_ < DUP(20); ++repa_) {
        if (SITE(1) && IN(pb + 0)) {
            WSB(ws);
            const GAS bf16_t* Wqkv = (const GAS bf16_t*)(ws + (L < 2 ? WS_WDEAD : WS_WLIVE)) + (L == 0 ? WD_QKV0 : L == 1 ? WD_QKV1 : L == 2 ? WL_QKV2 : WL_Q3);
            g8::ProbPlain P{XBP(ws, L & 1), Wqkv, 1024, 1024, 16, T / 256, (L == 3) ? 4 : 12, F.G, c};
            g8::EpiBf16Split E{(GAS bf16_t*)(ws + WS_QA), 1024, (L == 3) ? 0 : 1024, (size_t)(WS_KS - WS_QA) / 2};
            for (int rep_ = 0; rep_ < DUP(1); ++rep_) g8::gemm_phase<g8::ProbPlain, g8::EpiBf16Split>(F.lds, P, E, F.wave);
            if (SITE(2) && L == 2) forget_phase(F);
            SEAM(pb + 0);
        }
        if (SITE(3) && IN(pb + 1) && L == 2) { WSB(ws); knorm_phase(F, (const GAS bf16_t*)(ws + WS_KS)); SEAM(pb + 1); }
        if (IN(pb + 2)) {
            WSB(ws); GAS bf16_t* QA = (GAS bf16_t*)(ws + WS_QA); const GAS bf16_t* KS = (const GAS bf16_t*)(ws + WS_KS); const GAS bf16_t* VS = (const GAS bf16_t*)(ws + WS_VS);
            if (L < 2) { if (SITE(4)) attn_phase<false>(F, QA, KS, VS, QA); } else { if (SITE(5)) attn_phase<true>(F, QA, KS, VS, QA); }
            SEAM(pb + 2);
        }
        }
        if (SITE(6) && IN(pb + 3)) {
            WSB(ws);
            const GAS bf16_t* Wo = (const GAS bf16_t*)(ws + (L < 2 ? WS_WDEAD : WS_WLIVE)) + (L == 0 ? WD_O0 : L == 1 ? WD_O1 : L == 2 ? WL_O2 : WL_O3);
            g8::ProbPlain P{(const GAS bf16_t*)(ws + WS_QA), Wo, 1024, 1024, 16, T / 256, 4, F.G, c};
            g8::EpiResid E{L == 0 ? in_sel(IN_X) : (const GAS float*)F.res, F.res};
            g8::gemm_phase<g8::ProbPlain, g8::EpiResid>(F.lds, P, E, F.wave);
            SEAM(pb + 3);
        }
        if (IN(pb + 4)) { WSB(ws); GAS bf16_t* xln1 = XBP(ws, (L + 1) & 1); if (L & 1) { if (SITE(7)) ln_phase<true, true>(F, L, 0, xln1); } else { if (SITE(8)) ln_phase<false, true>(F, L, 0, xln1); } SEAM(pb + 4); }
        if (SITE(9) && IN(pb + 5) && (L & 1)) { moe_lists_phase(F); SEAM(pb + 5); }
        if (IN(pb + 6)) {
            WSB(ws); const GAS bf16_t* xln1 = XBP(ws, (L + 1) & 1);
            if (L & 1) { if (SITE(10)) { load_tab(F);
                const GAS bf16_t* Wmgu = (const GAS bf16_t*)(ws + (L == 1 ? WS_WDEAD : WS_WLIVE)) + (L == 1 ? WD_MGU0 : WL_MGU1); const GAS i32x4* elist = (const GAS i32x4*)(ws + WS_MISC + MS_ELIST);
                g8::ProbMoeGU P{xln1, Wmgu, elist, (const LAS int*)(F.lds + LDS_TAB), 1024, 1024, 16, F.G, c}; g8::EpiMoeGU E{(GAS bf16_t*)(ws + (L == 1 ? WS_QA : WS_WDEAD)), elist, (const GAS float*)(ws + WS_MISC + MS_EGATE)};
                for (int rep_ = 0; rep_ < DUP(10); ++rep_) g8::gemm_phase<g8::ProbMoeGU, g8::EpiMoeGU>(F.lds, P, E, F.wave); } }
            else if (SITE(11)) { const GAS bf16_t* Wgu = (const GAS bf16_t*)(ws + (L == 0 ? WS_WDEAD : WS_WLIVE)) + (L == 0 ? WD_GU0 : WL_GU1);
                g8::ProbPlain P{xln1, Wgu, 1024, 1024, 16, T / 256, 22, F.G, c}; g8::EpiSwiglu E{(GAS bf16_t*)(ws + (L == 0 ? WS_QA : WS_XB0)), DFF};
                for (int rep_ = 0; rep_ < DUP(11); ++rep_) g8::gemm_phase<g8::ProbPlain, g8::EpiSwiglu>(F.lds, P, E, F.wave); }
            SEAM(pb + 6);
        }
        if (IN(pb + 7)) {
            WSB(ws);
            if (L & 1) { if (SITE(12)) { load_tab(F);
                const GAS bf16_t* Wmdn = (const GAS bf16_t*)(ws + (L == 1 ? WS_WDEAD : WS_WLIVE)) + (L == 1 ? WD_MDN0 : WL_MDN1);
                g8::ProbMoeDown P{(const GAS bf16_t*)(ws + (L == 1 ? WS_QA : WS_WDEAD)), Wmdn, (const LAS int*)(F.lds + LDS_TAB), 1408, 5632, 22, F.G, c}; g8::EpiMoeDown E{F.res, (const GAS int*)(ws + WS_MISC + MS_PLIST)};
                g8::gemm_phase<g8::ProbMoeDown, g8::EpiMoeDown>(F.lds, P, E, F.wave); } }
            else if (SITE(13)) { const GAS bf16_t* Wdn = (const GAS bf16_t*)(ws + (L == 0 ? WS_WDEAD : WS_WLIVE)) + (L == 0 ? WD_DN0 : WL_DN1);
                g8::ProbPlain P{(const GAS bf16_t*)(ws + (L == 0 ? WS_QA : WS_XB0)), Wdn, DFF, DFF, 44, T / 256, 4, F.G, c}; g8::EpiResid E{F.res, F.res};
                g8::gemm_phase<g8::ProbPlain, g8::EpiResid>(F.lds, P, E, F.wave); }
            SEAM(pb + 7);
        }
        if (SITE(14) && IN(pb + 8)) { WSB(ws); ln_phase<false, false>(F, L, 1, XBP(ws, L & 1)); SEAM(pb + 8); }
        if (IN(pb + 9)) {
            if (SITE(15) && args.sub != 2) { WSB(ws); const GAS bf16_t* Wpg = (const GAS bf16_t*)(ws + (L < 2 ? WS_WDEAD : WS_WLIVE)) + (L == 0 ? WD_PG0 : L == 1 ? WD_PG1 : L == 2 ? WL_PG2 : WL_PG3);
                g8::ProbPlain P{XBP(ws, L & 1), Wpg, 1024, 1024, 16, T / 256, 4, F.G, c}; g8::EpiGate E{XBP(ws, (L + 1) & 1)}; for (int rep_ = 0; rep_ < DUP(15); ++rep_) g8::gemm_phase<g8::ProbPlain, g8::EpiGate>(F.lds, P, E, F.wave); }
            if (SITE(16) && args.sub != 1) { WSB(ws); const GAS bf16_t* Wpp = (const GAS bf16_t*)(ws + (L < 2 ? WS_WDEAD : WS_WLIVE)) + (L == 0 ? WD_PP0 : L == 1 ? WD_PP1 : L == 2 ? WL_PP2 : WL_PP3);
                g8::ProbPlain P{(const GAS bf16_t*)(ws + WS_PB), Wpp, PLE, PLE, 4, T / 256, 4, F.G, c}; g8::EpiPle E{F.res, XBP(ws, (L + 1) & 1)}; g8::gemm_phase<g8::ProbPlain, g8::EpiPle>(F.lds, P, E, F.wave); }
            if (pb + 9 < NPH - 1) SEAM(pb + 9);
        }
    }
#undef WSB
#undef XBP
#undef IN
#undef SEAM
}

#if MK_DEBUG
constexpr int NSAMP = 64;
#ifndef DBG_SHOW_A
#define DBG_SHOW_A -1
#define DBG_SHOW_B 75
#endif
#ifndef DBG_HYP
#define DBG_HYP 6
#endif
#ifndef DBG_FOCUS
#define DBG_FOCUS 99
#endif
__device__ __forceinline__ float wave_sum(float v) {
#pragma unroll
    for (int o = 1; o < 64; o <<= 1) v += __shfl_xor(v, o);
    return v;
}
__device__ __forceinline__ int samp_row(int k) { const int fixed[8] = {0, 1, 127, 128, SEQ - 1, SEQ, SEQ + 129, T - 1}; return k < 8 ? fixed[k] : (int)(((long long)k * 40503 + 977) % T); }
__device__ __forceinline__ void dbg_report(unsigned* ctl, int slot, float err_over_tol) { if (!(err_over_tol >= 0.f)) err_over_tol = 1.0e30f; atomicMax(ctl + CW_DBG + slot, __builtin_bit_cast(unsigned, err_over_tol)); }
__device__ __forceinline__ float dbg_dot(const bf16_t* a, int K, const float* W, size_t ldw, int n, int lane) { float s = 0.f; for (int k = lane; k < K; k += 64) s += bf2f(a[k]) * W[(size_t)k * ldw + n]; return wave_sum(s); }
__global__ void dbg_snapshot(const float* src, float* snap) { const int k = blockIdx.x, r = samp_row(k); for (int i = threadIdx.x; i < DM; i += blockDim.x) snap[(size_t)k * DM + i] = src[(size_t)r * DM + i]; }
struct DbgArgs { const float* in[N_IN]; float* res; unsigned char* ws; int phase; int pad; };
__global__ void __launch_bounds__(64) dbg_check(DbgArgs a) {
    const int k = blockIdx.x, lane = threadIdx.x, r = samp_row(k), ph = a.phase, L = (ph - 1) / 10, s = (ph - 1) % 10;
    unsigned* ctl = (unsigned*)(a.ws + WS_CTL); const float* snap = (const float*)(a.ws + WS_MISC + MS_SNAP) + (size_t)k * DM;
    const bf16_t* XBin = (const bf16_t*)(a.ws + ((L & 1) ? WS_XB1 : WS_XB0)); const bf16_t* XBl1 = (const bf16_t*)(a.ws + (((L + 1) & 1) ? WS_XB1 : WS_XB0));
    const bf16_t* QA = (const bf16_t*)(a.ws + WS_QA); const bf16_t* KS = (const bf16_t*)(a.ws + WS_KS); const bf16_t* VS = (const bf16_t*)(a.ws + WS_VS);
    if (ph == 0) {
        float e = 0.f; for (int i = lane; i < DM; i += 64) e = fmaxf(e, fabsf(bf2f(((const bf16_t*)(a.ws + WS_XB0))[(size_t)r * DM + i]) - a.in[IN_X][(size_t)r * DM + i]));
        e = fmaxf(e, __shfl_xor(e, 1)); dbg_report(ctl, ph, e / 0.05f); return; }
    if (s == 0) {
        const int NC = (L == 3) ? 1024 : 3072;
        for (int rep = 0; rep < 6; ++rep) { const int n = (k * 977 + rep * 517 + 131) % NC; const float* W; size_t ldw; int col; float sc = 1.f;
            if (L < 2) { W = a.in[IN_AQKV] + (size_t)L * 1024 * 3072; ldw = 3072; col = n; if (n < 1024) sc = 0.0625f; }
            else if (n < 1024) { W = a.in[IN_BQ] + (size_t)(L - 2) * 1024 * 1024; ldw = 1024; col = n; sc = 0.0625f; }
            else { W = a.in[IN_KVF]; ldw = 2052; col = n - 1024; }
            const float ex = dbg_dot(XBin + (size_t)r * DM, 1024, W, ldw, col, lane) * sc;
            const bf16_t* O = n < 1024 ? QA : n < 2048 ? KS : VS; const float got = bf2f(O[(size_t)r * DM + (n & 1023)]);
            dbg_report(ctl, ph, fabsf(got - ex) / (0.02f * fabsf(ex) + 0.02f)); }
        if (L == 2) {
            const int b = r / SEQ, sq = r % SEQ, hh = k & 3; float acc = 0.f;
            for (int j = (sq & ~63); j <= sq; ++j) { const float* xr = a.res + ((size_t)b * SEQ + j) * DM; float d = 0.f; for (int q = lane; q < DM; q += 64) d += xr[q] * a.in[IN_KVF][(size_t)q * 2052 + 2048 + hh];
                d = wave_sum(d) + a.in[IN_KVFB][hh]; acc += -(fmaxf(-d, 0.f) + log1pf(expf(-fabsf(d)))); }
            const float got = ((const float*)(a.ws + WS_MISC + MS_CL))[(size_t)(b * NH + hh) * SEQ + sq];
            dbg_report(ctl, ph, fabsf(got - acc) / (0.002f * fabsf(acc) + 0.002f)); }
        return; }
    if (s == 2) {
        const int hh = k & 3, b = r / SEQ, sq = r % SEQ; const size_t rb = (size_t)b * SEQ;
        float q4[4], o4[4] = {0.f, 0.f, 0.f, 0.f};
        for (int i = 0; i < 4; ++i) q4[i] = snap[hh * HD + 4 * lane + i];
        if (L < 2) { float Rr = 0.f;
            for (int t = sq - 1; t >= 0; --t) { const bf16_t* kp = KS + (rb + t) * DM + hh * HD + 4 * lane; float z = 0.f; for (int i = 0; i < 4; ++i) z += q4[i] * bf2f(kp[i]); z = wave_sum(z);
                const float sp = fmaxf(z, 0.f) + log1pf(expf(-fabsf(z))); const float aw = expf(z - sp + Rr); Rr -= sp;
                const bf16_t* vp = VS + (rb + t) * DM + hh * HD + 4 * lane; for (int i = 0; i < 4; ++i) o4[i] += aw * bf2f(vp[i]); }
        } else { const float* cl = (const float*)(a.ws + WS_MISC + MS_CL) + (size_t)(b * NH + hh) * SEQ; const float* tt = (const float*)(a.ws + WS_MISC + MS_TOT) + (b * NH + hh) * 256;
            float mx = -1.0e30f, den = 0.f;
            for (int pass = 0; pass < 2; ++pass) { double cacc = 0.0;
                for (int t = sq; t >= 0; --t) { const bf16_t* kp = KS + (rb + t) * DM + hh * HD + 4 * lane; float z = 0.f; for (int i = 0; i < 4; ++i) z += q4[i] * bf2f(kp[i]); z = wave_sum(z);
                    const float lg = z + (float)cacc;
                    if (pass == 0) mx = fmaxf(mx, lg); else { const float p = expf(lg - mx); den += p; const bf16_t* vp = VS + (rb + t) * DM + hh * HD + 4 * lane; for (int i = 0; i < 4; ++i) o4[i] += p * bf2f(vp[i]); }
                    const float lf = (t & 63) ? (cl[t] - cl[t - 1]) : cl[t]; cacc += (double)lf; } }
            for (int i = 0; i < 4; ++i) o4[i] /= den; (void)tt; }
        float em = 0.f, mg = 0.f; for (int i = 0; i < 4; ++i) { const float got = bf2f(QA[(size_t)r * DM + hh * HD + 4 * lane + i]); em = fmaxf(em, fabsf(got - o4[i])); mg = fmaxf(mg, fabsf(o4[i])); }
        for (int o = 1; o < 64; o <<= 1) { em = fmaxf(em, __shfl_xor(em, o)); mg = fmaxf(mg, __shfl_xor(mg, o)); }
        dbg_report(ctl, ph, em / (0.03f * mg + 0.003f)); return; }
    if (s == 3 || (s == 7 && !(L & 1))) {
        const bf16_t* A; const float* W; int K;
        if (s == 3) { A = QA + (size_t)r * DM; K = 1024; W = (L < 2) ? a.in[IN_AO] + (size_t)L * 1024 * 1024 : a.in[IN_BO] + (size_t)(L - 2) * 1024 * 1024; }
        else { A = (const bf16_t*)(a.ws + (L == 0 ? WS_QA : WS_XB0)) + (size_t)r * DFF; K = DFF; W = a.in[IN_FDN] + (size_t)(L >> 1) * DFF * 1024; }
        for (int rep = 0; rep < 6; ++rep) { const int n = (k * 733 + rep * 171 + 29) % 1024; const float ex = ALPHA * snap[n] + dbg_dot(A, K, W, 1024, n, lane); const float got = a.res[(size_t)r * DM + n];
            dbg_report(ctl, ph, fabsf(got - ex) / (0.01f * fabsf(ex) + 0.02f)); }
        return; }
    if (s == 4 || s == 8) {
        const int which = (s == 8); const float* g = a.in[IN_LNG] + (size_t)(L * 2 + which) * DM; const float* bb = a.in[IN_LNB] + (size_t)(L * 2 + which) * DM;
        float sm = 0.f; for (int i = lane; i < DM; i += 64) sm += snap[i]; const float mean = wave_sum(sm) / DM; float sv = 0.f; for (int i = lane; i < DM; i += 64) { const float d = snap[i] - mean; sv += d * d; }
        const float rstd = 1.f / sqrtf(wave_sum(sv) / DM + LN_EPS); const bf16_t* xo = which ? XBin : XBl1; float e = 0.f;
        for (int i = lane; i < DM; i += 64) { const float ex = (snap[i] - mean) * rstd * g[i] + bb[i]; e = fmaxf(e, fabsf(a.res[(size_t)r * DM + i] - ex) / 1e-3f); e = fmaxf(e, fabsf(bf2f(xo[(size_t)r * DM + i]) - ex) / (0.01f * fabsf(ex) + 0.01f)); }
        for (int o = 1; o < 64; o <<= 1) e = fmaxf(e, __shfl_xor(e, o));
        dbg_report(ctl, ph, e);
        if (s == 4 && (L & 1)) {
            const float* Wr = a.in[IN_MR] + (size_t)(L >> 1) * DM * NE; float lgs[NE];
            for (int e8 = 0; e8 < NE; ++e8) { float d = 0.f; for (int q = lane; q < DM; q += 64) d += a.res[(size_t)r * DM + q] * Wr[(size_t)q * NE + e8]; lgs[e8] = wave_sum(d); }
            int i1 = 0; for (int e8 = 1; e8 < NE; ++e8) if (lgs[e8] > lgs[i1]) i1 = e8; int i2 = -1; for (int e8 = 0; e8 < NE; ++e8) if (e8 != i1 && (i2 < 0 || lgs[e8] > lgs[i2])) i2 = e8;
            float third = -1.0e30f; for (int e8 = 0; e8 < NE; ++e8) if (e8 != i1 && e8 != i2) third = fmaxf(third, lgs[e8]);
            const float ex2 = expf(lgs[i2] - lgs[i1]), g1 = 1.f / (1.f + ex2), g2 = ex2 * g1;
            const i32x4 rr = ((const i32x4*)(a.ws + WS_MISC + MS_REC))[r]; const int q1 = rr.x & 0xff, q2 = (rr.x >> 8) & 0xff; const float h1 = ((const float*)(a.ws + WS_MISC + MS_GATE))[r], h2 = ((const float*)(a.ws + WS_MISC + MS_GATE))[T + r];
            if (lgs[i2] - third > 1e-3f && lgs[i1] - lgs[i2] > 1e-3f) { float bad = 0.f; if (q1 != i1 || q2 != i2) bad = 10.f; else if (fabsf(h1 - g1) > 1e-3f || fabsf(h2 - g2) > 1e-3f) bad = 5.f; dbg_report(ctl, ph, bad);
                if (L == 1 && k == 8 && lane == 0) { const float hv2[2] = {h1, h2};
                    for (int q = 0; q < 2; ++q) { const float h = hv2[q]; const unsigned bits = __builtin_bit_cast(unsigned, h); unsigned cat;
                        if (!(h == h)) cat = (bits == 0xffffffffu) ? 1u : (bits >> 31) ? 2u : 3u; else if (fabsf(h) > 3.0e38f) cat = 4u; else if (h < 0.f) cat = 5u; else if (h < 1e-30f) cat = (bits == 0u) ? 6u : 7u; else if (h > 1.f) cat = 8u; else cat = 9u;
                        (void)cat; }
                    { const unsigned bits = __builtin_bit_cast(unsigned, h1); ctl[CW_DBG + 70] = (rr.w == r) ? 9u : ((rr.w == 0) ? 3u : 1u); ctl[CW_DBG + 71] = (__builtin_bit_cast(unsigned, h2) >> 20) & 63u; (void)bits; } }
                if (L == 1) { if (lane == 0 && fabsf(h1 + h2 - 1.f) < 1e-3f) atomicAdd(ctl + CW_DBG + 46, 1u); if (lane == 0 && fabsf(h1 - g1) < 1e-3f) atomicAdd(ctl + CW_DBG + 47, 1u);
                if (lane == 0 && fabsf(h1 - g2) < 1e-3f && fabsf(h2 - g1) < 1e-3f) atomicAdd(ctl + CW_DBG + 45, 1u); if (lane == 0 && !(h1 == h1)) atomicAdd(ctl + CW_DBG + 44, 1u); } } }
        if (s == 4) { float e2 = 0.f; for (int i = lane; i < PLE; i += 64) e2 = fmaxf(e2, fabsf(bf2f(((const bf16_t*)(a.ws + WS_PB))[(size_t)r * PLE + i]) - a.in[IN_P][((size_t)L * T + r) * PLE + i]) / 0.05f);
            for (int o = 1; o < 64; o <<= 1) e2 = fmaxf(e2, __shfl_xor(e2, o)); dbg_report(ctl, ph, e2); }
        return; }
    if (s == 6 && !(L & 1)) {
        const float* W = a.in[IN_FGU] + (size_t)(L >> 1) * 1024 * 5632; const bf16_t* H = (const bf16_t*)(a.ws + (L == 0 ? WS_QA : WS_XB0));
        for (int rep = 0; rep < 6; ++rep) { const int j = (k * 389 + rep * 997 + 7) % DFF; const float g = dbg_dot(XBl1 + (size_t)r * DM, 1024, W, 5632, j, lane), u = dbg_dot(XBl1 + (size_t)r * DM, 1024, W, 5632, DFF + j, lane);
            const float ex = g / (1.f + expf(-g)) * u; const float got = bf2f(H[(size_t)r * DFF + j]); dbg_report(ctl, ph, fabsf(got - ex) / (0.03f * fabsf(ex) + 0.03f)); }
        return; }
    if (s == 6 && (L & 1)) {
        const int* tabg = (const int*)(a.ws + WS_MISC + MS_TAB); const i32x4* elist = (const i32x4*)(a.ws + WS_MISC + MS_ELIST); const i32x4* rec = (const i32x4*)(a.ws + WS_MISC + MS_REC);
        const int total = tabg[TB_EOFF + NE]; const int idx = (int)(((long long)k * 7919 + 13) % total); const i32x4 en = elist[idx];
        int e = 0; for (int q = 1; q < NE; ++q) e += (idx >= tabg[TB_EOFF + q]) ? 1 : 0;
        if (lane == 0) atomicAdd(ctl + CW_DBG + 55, 1u);
        if (en.y < 0) { if (lane == 0) atomicAdd(ctl + CW_DBG + 57, 1u); return; }
        const int tok = en.x; const i32x4 rr = rec[tok]; const int e1 = rr.x & 0xff, e2 = (rr.x >> 8) & 0xff;
        float bad = 0.f; if (e != e1 && e != e2) bad = 10.f;
        const float gate = ((const float*)(a.ws + WS_MISC + MS_EGATE))[idx]; const float gexp = (e == e1) ? ((const float*)(a.ws + WS_MISC + MS_GATE))[tok] : ((const float*)(a.ws + WS_MISC + MS_GATE))[T + tok]; if (fabsf(gate - gexp) > 1e-6f) bad = 20.f;
        if (lane == 0 && gate > 0.01f && gate < 0.999f) atomicAdd(ctl + CW_DBG + 60, 1u);
        if (lane == 0 && ((const int*)(a.ws + WS_MISC + MS_PLIST))[en.y / 1408] == tok) atomicAdd(ctl + CW_DBG + 59, 1u);
        const int half = (en.y % 1408) / DFE; if (half != ((e == (e1 < e2 ? e1 : e2)) ? 0 : 1)) bad = 30.f;
        dbg_report(ctl, ph, bad); if (lane == 0 && L == 1) { if (bad == 10.f) atomicAdd(ctl + CW_DBG + 72, 1u); if (bad == 20.f) atomicAdd(ctl + CW_DBG + 73, 1u); if (bad == 30.f) atomicAdd(ctl + CW_DBG + 74, 1u); }
        const float* Wg = a.in[IN_MGU] + (size_t)((L >> 1) * NE + e) * 1024 * 1408; const bf16_t* HS = (const bf16_t*)(a.ws + (L == 1 ? WS_QA : WS_WDEAD));
        for (int rep = 0; rep < 6; ++rep) { const int j = (k * 389 + rep * 131 + 5) % DFE; const float g = dbg_dot(XBl1 + (size_t)tok * DM, 1024, Wg, 1408, j, lane), u = dbg_dot(XBl1 + (size_t)tok * DM, 1024, Wg, 1408, DFE + j, lane);
            const float ex = gate * g / (1.f + expf(-g)) * u; const float got = bf2f(HS[(size_t)en.y + j]); const float er = fabsf(got - ex) / (0.03f * fabsf(ex) + 0.03f);
            dbg_report(ctl, ph, er); if (L == 1 && rep == 0 && lane == 0 && er <= 1.f) atomicAdd(ctl + CW_DBG + 56, 1u); if (L == 1 && rep == 0 && lane == 0 && fabsf(got) < 1e-6f) atomicAdd(ctl + CW_DBG + 75, 1u); }
        return; }
    if (s == 7 && (L & 1)) {
        __shared__ float hid[2][DFE]; __shared__ float lgs[NE];
        const float* Wr = a.in[IN_MR] + (size_t)(L >> 1) * DM * NE;
        for (int e = 0; e < NE; ++e) { float d = 0.f; for (int q = lane; q < DM; q += 64) d += snap[q] * Wr[(size_t)q * NE + e]; d = wave_sum(d); if (lane == 0) lgs[e] = d; }
        __syncthreads();
        int i1 = 0; for (int e = 1; e < NE; ++e) if (lgs[e] > lgs[i1]) i1 = e; int i2 = -1; for (int e = 0; e < NE; ++e) if (e != i1 && (i2 < 0 || lgs[e] > lgs[i2])) i2 = e;
        const float ex2 = expf(lgs[i2] - lgs[i1]), g1 = 1.f / (1.f + ex2), g2 = ex2 * g1; const int es[2] = {i1, i2}; const float gs[2] = {g1, g2};
        float third = -1.0e30f; for (int e = 0; e < NE; ++e) if (e != i1 && e != i2) third = fmaxf(third, lgs[e]);
        if (lgs[i2] - third < 1e-3f) return;
        for (int q = 0; q < 2; ++q) { const float* Wg = a.in[IN_MGU] + (size_t)((L >> 1) * NE + es[q]) * 1024 * 1408;
            for (int j = 0; j < DFE; ++j) { const float g = dbg_dot(XBl1 + (size_t)r * DM, 1024, Wg, 1408, j, lane), u = dbg_dot(XBl1 + (size_t)r * DM, 1024, Wg, 1408, DFE + j, lane);
                if (lane == 0) hid[q][j] = bf2f((unsigned short)f2bf(g / (1.f + expf(-g)) * u)); } }
        __syncthreads();
        for (int rep = 0; rep < 2; ++rep) { const int n = (lane * 16 + k + rep * 5) % 1024; float ac[2] = {0.f, 0.f};
            for (int q = 0; q < 2; ++q) { const float* Wdn = a.in[IN_MDN] + (size_t)((L >> 1) * NE + es[q]) * DFE * 1024; for (int j = 0; j < DFE; ++j) ac[q] += hid[q][j] * Wdn[(size_t)j * 1024 + n]; }
            const float base = ALPHA * snap[n]; const float got = a.res[(size_t)r * DM + n];
            const int* plist = (const int*)(a.ws + WS_MISC + MS_PLIST); const int* tabg = (const int*)(a.ws + WS_MISC + MS_TAB); const int nslot = tabg[TB_NRT] * 256; int ps = -1;
            for (int i = lane; i < nslot; i += 64) if (plist[i] == r) ps = i;
            for (int o = 1; o < 64; o <<= 1) ps = max(ps, __shfl_xor(ps, o));
            float ah = 0.f; float exact0 = fabsf(got - base);
            if (ps >= 0) { const bf16_t* HS = (const bf16_t*)(a.ws + (L == 1 ? WS_QA : WS_WDEAD)) + (size_t)ps * 1408; const int pp = tabg[TB_RT2P + (ps >> 8)]; const int ea = pp & 0xff, eb = (pp >> 8) & 0xff;
                const float* Wa = a.in[IN_MDN] + (size_t)((L >> 1) * NE + ea) * DFE * 1024; const float* Wb = a.in[IN_MDN] + (size_t)((L >> 1) * NE + eb) * DFE * 1024;
                for (int j = 0; j < DFE; ++j) ah += bf2f(HS[j]) * Wa[(size_t)j * 1024 + n] + bf2f(HS[DFE + j]) * Wb[(size_t)j * 1024 + n]; }
            const float hy[6] = {base + gs[0] * ac[0] + gs[1] * ac[1], base, base + ah, base + gs[1] * ac[1], base + ac[0] + ac[1], base + gs[1] * ac[0] + gs[0] * ac[1]};
            for (int hq = 0; hq < 6; ++hq) { float e = fabsf(got - hy[hq]) / (0.01f * fabsf(hy[hq]) + 0.02f);
                for (int o = 1; o < 64; o <<= 1) e = fmaxf(e, __shfl_xor(e, o));
                if (hq == 0) dbg_report(ctl, ph, e);
                if (ph == DBG_FOCUS && rep == 0 && lane == 0 && e <= 1.0f) atomicAdd(ctl + CW_DBG + 56 + hq, 1u); }
            for (int o = 1; o < 64; o <<= 1) exact0 = fmaxf(exact0, __shfl_xor(exact0, o));
            float ahm = fabsf(ah); for (int o = 1; o < 64; o <<= 1) ahm = fmaxf(ahm, __shfl_xor(ahm, o));
            if (ph == DBG_FOCUS && rep == 0 && lane == 0 && ahm > 0.05f) atomicAdd(ctl + CW_DBG + 61, 1u);
            if (ph == DBG_FOCUS && rep == 0 && lane == 0 && exact0 < 1e-5f) atomicAdd(ctl + CW_DBG + 62, 1u);
            if (ph == DBG_FOCUS && rep == 0 && lane == 0 && ps < 0) atomicAdd(ctl + CW_DBG + 63, 1u); }
        if (ph == DBG_FOCUS && lane == 0) atomicAdd(ctl + CW_DBG + 55, 1u);
        return; }
    if (s == 9 && a.pad == 1) {
        const float* Wg = a.in[IN_PG] + (size_t)L * 1024 * 1024;
        for (int rep = 0; rep < 6; ++rep) { const int n = (k * 613 + rep * 211 + 3) % 1024; const float gl = dbg_dot(XBin + (size_t)r * DM, 1024, Wg, 1024, n, lane); const float sg = 1.f / (1.f + expf(-gl));
            dbg_report(ctl, 41 + L, fabsf(bf2f(XBl1[(size_t)r * DM + n]) - sg) / 0.02f); }
        return; }
    if (s == 9) {
        const float* Wg = a.in[IN_PG] + (size_t)L * 1024 * 1024; const float* Wp = a.in[IN_PP] + (size_t)L * PLE * 1024; const bf16_t* pbp = (const bf16_t*)(a.ws + WS_PB) + (size_t)r * PLE;
        for (int rep = 0; rep < 6; ++rep) { const int n = (k * 613 + rep * 211 + 3) % 1024; const float gl = dbg_dot(XBin + (size_t)r * DM, 1024, Wg, 1024, n, lane), pj = dbg_dot(pbp, PLE, Wp, 1024, n, lane);
            const float sg = 1.f / (1.f + expf(-gl)); const float ex = snap[n] + pj * sg; const float got = a.res[(size_t)r * DM + n], gb = bf2f(XBl1[(size_t)r * DM + n]);
            dbg_report(ctl, ph, fabsf(got - ex) / (0.01f * fabsf(ex) + 0.01f)); dbg_report(ctl, ph, fabsf(gb - ex) / (0.02f * fabsf(ex) + 0.02f));
            if (ph == DBG_FOCUS) {
                dbg_report(ctl, 48 + 1, fabsf(got - ex) / (0.01f * fabsf(ex) + 0.01f));
                dbg_report(ctl, 48 + 2, fabsf(got - (snap[n] + pj)) / 0.02f);
                dbg_report(ctl, 48 + 3, fabsf(got - (snap[n] + sg)) / 0.02f);
                dbg_report(ctl, 48 + 4, fabsf(got - snap[n]) / 0.02f);
                dbg_report(ctl, 48 + 5, fabsf(gb - got) / (0.02f * fabsf(got) + 0.02f));
                dbg_report(ctl, 48 + 6, fabsf(got - (snap[n] + pj * 0.5f)) / 0.02f);
            } }
        return; }
}
__global__ void dbg_snap_q(const bf16_t* Q, float* snap) { const int k = blockIdx.x, r = samp_row(k); for (int i = threadIdx.x; i < DM; i += blockDim.x) snap[(size_t)k * DM + i] = bf2f(Q[(size_t)r * DM + i]); }
__global__ void dbg_poison(float* out, const unsigned* ctl, size_t n) {
    int code = 0; for (int kk = 0; kk < NPH; ++kk) { if (kk > 0 && (kk - 1) % 10 == 9 && __builtin_bit_cast(float, ctl[CW_DBG + 41 + (kk - 1) / 10]) > 1.0f) { code = 42 + (kk - 1) / 10; break; }
        if (__builtin_bit_cast(float, ctl[CW_DBG + kk]) > 1.0f) { code = kk + 1; break; } }
    if (ctl[CW_TMO] || ctl[CW_BAR + XB_TMO]) code = 60;
    if (code == 0) return;
    float V = exp2f((float)code);
    if (DBG_SHOW_A >= 0) { const unsigned n0 = ctl[CW_DBG + DBG_SHOW_A], nh = ctl[CW_DBG + DBG_SHOW_B]; V = exp2f(64.f + (float)(n0 > 60u ? 60u : n0)) * (1.f + (float)(nh > 63u ? 63u : nh) / 128.f); }
    else if (code == DBG_FOCUS + 1) {
        const unsigned n0 = ctl[CW_DBG + 63], nh = ctl[CW_DBG + 61];
        V = exp2f(64.f + (float)(n0 > 60u ? 60u : n0)) * (1.f + (float)(nh > 63u ? 63u : nh) / 128.f); }
    for (size_t i = (size_t)blockIdx.x * blockDim.x + threadIdx.x; i < n; i += (size_t)gridDim.x * blockDim.x) out[i] = V;
}
#endif

extern "C" void kernel_launch(void* const* d_in, const int* in_sizes, int n_in, void* d_out, int out_size, void* d_ws, size_t ws_size, hipStream_t stream) {
    static int grid = 0;
    if (grid == 0) {
        if (n_in != N_IN || out_size != T * DM || ws_size < WS_END) { fprintf(stderr, "kernel_launch: unexpected problem (n_in %d, out %d, ws %zu < %zu)\n", n_in, out_size, ws_size, (size_t)WS_END); grid = -1; return; }
        int dev = 0, cus = 0, per_cu = 0;
        if (hipGetDevice(&dev) != hipSuccess || hipDeviceGetAttribute(&cus, hipDeviceAttributeMultiprocessorCount, dev) != hipSuccess) { grid = -1; return; }
        if (hipFuncSetAttribute((const void*)mk_fwd, hipFuncAttributeMaxDynamicSharedMemorySize, LDS_BYTES) != hipSuccess) { fprintf(stderr, "kernel_launch: hipFuncSetAttribute failed\n"); grid = -1; return; }
        if (hipOccupancyMaxActiveBlocksPerMultiprocessor(&per_cu, (const void*)mk_fwd, NTHREADS, LDS_BYTES) != hipSuccess || per_cu < 1) { fprintf(stderr, "kernel_launch: occupancy query says %d blocks per CU\n", per_cu); }
        (void)hipGetLastError();
        grid = cus;
    }
    if (grid < 0) return;
    (void)hipMemsetAsync((char*)d_ws + WS_CTL, 0, CTL_ZERO_BYTES, stream);
    Args a{};
    for (int i = 0; i < N_IN; ++i) a.in[i] = (const float*)d_in[i];
    a.out = (float*)d_out; a.ws = (unsigned char*)d_ws;
#if !MK_DEBUG
    a.ph_lo = 0; a.ph_hi = NPH;
    hipLaunchKernelGGL(mk_fwd, dim3(grid), dim3(NTHREADS), LDS_BYTES, stream, a);
#else
    DbgArgs da{}; for (int i = 0; i < N_IN; ++i) da.in[i] = (const float*)d_in[i]; da.res = (float*)d_out; da.ws = (unsigned char*)d_ws;
    float* snap = (float*)((char*)d_ws + WS_MISC + MS_SNAP);
    for (int k = 0; k < NPH; ++k) {
        if (!phase_nonempty(k)) continue;
        const int L = (k - 1) / 10, s = (k - 1) % 10;
        if (k > 0) {
            if (s == 2) hipLaunchKernelGGL(dbg_snap_q, dim3(NSAMP), dim3(256), 0, stream, (const bf16_t*)((char*)d_ws + WS_QA), snap);
            if (s == 3) hipLaunchKernelGGL(dbg_snapshot, dim3(NSAMP), dim3(256), 0, stream, L == 0 ? (const float*)d_in[IN_X] : (const float*)d_out, snap);
            if (s == 4 || s == 7 || s == 8 || s == 9) hipLaunchKernelGGL(dbg_snapshot, dim3(NSAMP), dim3(256), 0, stream, (const float*)d_out, snap);
        }
        a.ph_lo = k; a.ph_hi = k + 1; a.sub = 0;
        if (k > 0 && s == 9) { a.sub = 1; hipLaunchKernelGGL(mk_fwd, dim3(grid), dim3(NTHREADS), LDS_BYTES, stream, a); da.phase = k; da.pad = 1; hipLaunchKernelGGL(dbg_check, dim3(NSAMP), dim3(64), 0, stream, da); da.pad = 0; a.sub = 2; }
        hipLaunchKernelGGL(mk_fwd, dim3(grid), dim3(NTHREADS), LDS_BYTES, stream, a);
        if (k == 0 || s == 0 || s == 2 || s == 3 || s == 4 || s == 6 || s == 7 || s == 8 || s == 9) { da.phase = k; hipLaunchKernelGGL(dbg_check, dim3(NSAMP), dim3(64), 0, stream, da); }
    }
    hipLaunchKernelGGL(dbg_poison, dim3(1024), dim3(256), 0, stream, (float*)d_out, (const unsigned*)d_ws, (size_t)T * DM);
#endif
}
```

```cpp
#include <hip/hip_runtime.h>
#include <cstdio>
#include <cstdint>

#ifndef MK_DEBUG
#define MK_DEBUG 0
#endif

#define LAS __attribute__((address_space(3)))
#define GAS __attribute__((address_space(1)))
typedef unsigned short bf16_t;
typedef short bf16x8 __attribute__((ext_vector_type(8)));
typedef short bf16x4 __attribute__((ext_vector_type(4)));
typedef float f32x4 __attribute__((ext_vector_type(4)));
typedef float f32x2 __attribute__((ext_vector_type(2)));
typedef unsigned u32x4 __attribute__((ext_vector_type(4)));
typedef unsigned u32x2 __attribute__((ext_vector_type(2)));
typedef int i32x4 __attribute__((ext_vector_type(4)));

constexpr int DM = 1024, NBATCH = 2, SEQ = 16384, T = NBATCH * SEQ, NH = 4, HD = 256, DFF = 2816, NE = 8, DFE = 704, PLE = 256, DEPTH = 4;
constexpr float ALPHA = 1.6817928305074292f;
constexpr float LN_EPS = 1e-5f;
constexpr int NWAVES = 8, NTHREADS = 512;
enum { IN_X = 0, IN_P, IN_AQKV, IN_AO, IN_KVF, IN_KVFB, IN_BQ, IN_BO, IN_FGU, IN_FDN, IN_MR, IN_MGU, IN_MDN, IN_PP, IN_PG, IN_LNG, IN_LNB, N_IN };

constexpr size_t MiB = 1u << 20;
constexpr size_t WS_CTL = 0, CTL_ZERO_BYTES = 1 * MiB;
constexpr size_t WS_MISC = 1 * MiB;
constexpr size_t WS_WLIVE = 8 * MiB;
constexpr size_t WS_PB = 77 * MiB;
constexpr size_t WS_XB1 = 93 * MiB, WS_XB0 = 157 * MiB;
constexpr size_t WS_WDEAD = 221 * MiB;
constexpr size_t WS_QA = 294 * MiB, WS_KS = 358 * MiB, WS_VS = 422 * MiB, WS_END = 486 * MiB;
constexpr size_t MS_REC = 0;
constexpr size_t MS_HIST = 512 * 1024;
constexpr size_t MS_ELIST = 576 * 1024;
constexpr int ELIST_CAP = 2 * T + NE * 256;
constexpr size_t MS_PLIST = MS_ELIST + (size_t)ELIST_CAP * 16;
constexpr int NPAIR = 28, PLIST_CAP = T + NPAIR * 256;
constexpr size_t MS_TAB = 2 * MiB;
constexpr size_t MS_CL = 2 * MiB + 64 * 1024;
constexpr size_t MS_TOT = MS_CL + (size_t)8 * SEQ * 4;
constexpr size_t MS_SNAP = 3 * MiB;
constexpr size_t MS_EGATE = 4 * MiB + 512 * 1024;
constexpr size_t MS_GATE = 4 * MiB;
static_assert(MS_PLIST + (size_t)PLIST_CAP * 4 <= MS_TAB && MS_TOT + 8 * 256 * 4 <= MS_SNAP, "misc map");
enum { TB_ECUM = 0  , TB_EOFF = 16  , TB_NRT = 32, TB_RT2P = 64  , TB_WORDS = 320 };
constexpr int CW_TMO = 0, CW_CODE = 1, CW_DBG = 64  , CW_KN2 = 192  , CW_BAR = 4096;

constexpr size_t WSZ_QKV = (size_t)3072 * 1024, WSZ_SQ = (size_t)1024 * 1024, WSZ_GU = (size_t)5632 * 1024, WSZ_DN = (size_t)1024 * 2816,
                 WSZ_MGU = (size_t)NE * 1536 * 1024, WSZ_MDN = (size_t)1024 * 5632, WSZ_PP = (size_t)1024 * 256;
constexpr size_t WD_QKV0 = 0, WD_O0 = WD_QKV0 + WSZ_QKV, WD_QKV1 = WD_O0 + WSZ_SQ, WD_O1 = WD_QKV1 + WSZ_QKV, WD_GU0 = WD_O1 + WSZ_SQ, WD_DN0 = WD_GU0 + WSZ_GU,
                 WD_MGU0 = WD_DN0 + WSZ_DN, WD_MDN0 = WD_MGU0 + WSZ_MGU, WD_PP0 = WD_MDN0 + WSZ_MDN, WD_PG0 = WD_PP0 + WSZ_PP, WD_PP1 = WD_PG0 + WSZ_SQ, WD_PG1 = WD_PP1 + WSZ_PP, WD_END = WD_PG1 + WSZ_SQ;
constexpr size_t WL_QKV2 = 0, WL_O2 = WL_QKV2 + WSZ_QKV, WL_Q3 = WL_O2 + WSZ_SQ, WL_O3 = WL_Q3 + WSZ_SQ, WL_GU1 = WL_O3 + WSZ_SQ, WL_DN1 = WL_GU1 + WSZ_GU,
                 WL_MGU1 = WL_DN1 + WSZ_DN, WL_MDN1 = WL_MGU1 + WSZ_MGU, WL_PP2 = WL_MDN1 + WSZ_MDN, WL_PG2 = WL_PP2 + WSZ_PP, WL_PP3 = WL_PG2 + WSZ_SQ, WL_PG3 = WL_PP3 + WSZ_PP, WL_END = WL_PG3 + WSZ_SQ;
static_assert(WD_END * 2 <= 73 * MiB && WL_END * 2 <= 69 * MiB, "weight regions");
static_assert((size_t)T * DFF * 2 <= WS_END - WS_QA && WS_XB0 + (size_t)T * DFF * 2 <= WS_KS && WS_WDEAD + (size_t)(T + NPAIR * 256) * 1408 * 2 <= WS_KS, "h overlays");

constexpr int RING_BYTES = 131072;
constexpr int LDS_CTL = 135168;
constexpr int LDS_TAB = LDS_CTL + 128;
constexpr int LDS_FLAGS = LDS_TAB + TB_WORDS * 4;
constexpr int LDS_BYTES = 147456;
static_assert(LDS_FLAGS + 64 <= LDS_BYTES, "LDS map");

#define RLX_AGENT __ATOMIC_RELAXED, __HIP_MEMORY_SCOPE_AGENT
__device__ __forceinline__ unsigned f2bf(float f) { unsigned u = __builtin_bit_cast(unsigned, f); return (u + 0x7fffu + ((u >> 16) & 1u)) >> 16; }
__device__ __forceinline__ unsigned pk2(float lo, float hi) { return f2bf(lo) | (f2bf(hi) << 16); }
__device__ __forceinline__ float bf2f(unsigned short b) { return __builtin_bit_cast(float, (unsigned)b << 16); }
typedef __bf16 bf16v2_t __attribute__((ext_vector_type(2)));
__device__ __forceinline__ unsigned cvt_pk_bf16(float lo, float hi) { bf16v2_t v; v[0] = (__bf16)lo; v[1] = (__bf16)hi; return __builtin_bit_cast(unsigned, v); }
__device__ __forceinline__ float shx(float v, int m, int lane) { return __builtin_bit_cast(float, __builtin_amdgcn_ds_bpermute((lane ^ m) << 2, __builtin_bit_cast(int, v))); }
__device__ __forceinline__ int shxi(int v, int m, int lane) { return __builtin_amdgcn_ds_bpermute((lane ^ m) << 2, v); }
__device__ __forceinline__ float shup(float v, int o, int lane) { return __builtin_bit_cast(float, __builtin_amdgcn_ds_bpermute(((lane - o) & 63) << 2, __builtin_bit_cast(int, v))); }
__device__ __forceinline__ float wave_sum(float v, int lane) {
#pragma unroll
    for (int o = 1; o < 64; o <<= 1) v += shx(v, o, lane);
    return v;
}
template <int CTRL> __device__ __forceinline__ float dpp_mov(float v) { return __builtin_bit_cast(float, __builtin_amdgcn_update_dpp(0, __builtin_bit_cast(int, v), CTRL, 0xF, 0xF, true)); }
__device__ __forceinline__ float wave_sum_dpp(float v) {
    v += dpp_mov<0xB1>(v); v += dpp_mov<0x4E>(v); v += dpp_mov<0x141>(v); v += dpp_mov<0x140>(v);
    const int b = __builtin_bit_cast(int, v);
    return (__builtin_bit_cast(float, __builtin_amdgcn_readlane(b, 0)) + __builtin_bit_cast(float, __builtin_amdgcn_readlane(b, 16))) + (__builtin_bit_cast(float, __builtin_amdgcn_readlane(b, 32)) + __builtin_bit_cast(float, __builtin_amdgcn_readlane(b, 48)));
}
__device__ __forceinline__ float fast_exp(float x) { return __builtin_amdgcn_exp2f(x * 1.4426950408889634f); }
__device__ __forceinline__ float fast_log(float x) { return __builtin_amdgcn_logf(x) * 0.6931471805599453f; }
__device__ __forceinline__ float softplus_f(float z) { return fmaxf(z, 0.f) + fast_log(1.f + fast_exp(-fabsf(z))); }
__device__ __forceinline__ float sigmoid_f(float z) { return __builtin_amdgcn_rcpf(1.f + fast_exp(-z)); }

typedef const GAS float* fptr_t;
__device__ __forceinline__ const GAS float* in_sel(int idx) { const __attribute__((address_space(4))) fptr_t* ka = (const __attribute__((address_space(4))) fptr_t*)__builtin_amdgcn_kernarg_segment_ptr(); return ka[idx]; }

template <class Tp> __device__ __forceinline__ GAS Tp* launder_ptr(GAS Tp* p) { unsigned lo = (unsigned)(unsigned long long)p, hi = (unsigned)((unsigned long long)p >> 32); asm volatile("" : "+v"(lo), "+v"(hi));
    lo = __builtin_amdgcn_readfirstlane(lo); hi = __builtin_amdgcn_readfirstlane(hi); return (GAS Tp*)(((unsigned long long)hi << 32) | lo); }
__device__ __forceinline__ int launder_int(int v) { asm volatile("" : "+v"(v)); return __builtin_amdgcn_readfirstlane(v); }

#define XB_TMO      128
#define XB_XCNT(j)  (256  + 64 * (j))
#define XB_XSUB(j)  (1280 + 64 * (j))
#define XB_XGEN(j)  (2304 + 64 * (j))
#define XB_TOP      3328
#define XB_TOPGEN   3392
#define XCD_BAR_WORDS 3456
#define XB_SPIN_CAP (1u << 18)
__device__ __forceinline__ unsigned xb_ld(GAS unsigned* p)              { return __hip_atomic_load(p, __ATOMIC_RELAXED, __HIP_MEMORY_SCOPE_AGENT); }
__device__ __forceinline__ unsigned xb_add(GAS unsigned* p, unsigned v) { return __hip_atomic_fetch_add(p, v, __ATOMIC_RELAXED, __HIP_MEMORY_SCOPE_AGENT); }
__device__ __forceinline__ unsigned xb_xcc_id() { return (unsigned)__builtin_amdgcn_s_getreg((3 << 11) | 20) & 0xFu; }
#define XB_SPIN(cond, bar) do { unsigned _sp = 0; while (cond) { __builtin_amdgcn_s_sleep(1); \
    if ((++_sp & 255u) == 0u) { if (xb_ld(&(bar)[XB_TMO])) break; if (_sp > XB_SPIN_CAP) { (void)xb_add(&(bar)[XB_TMO], 1u); break; } } } } while (0)
struct XcdBarrier { GAS unsigned* bar; unsigned x; volatile LAS unsigned* st; };
__device__ __forceinline__ XcdBarrier xcd_barrier_post(GAS unsigned* bar, volatile LAS unsigned* st) {
    XcdBarrier b; b.bar = bar; b.x = xb_xcc_id(); b.st = st;
    if (threadIdx.x == 0) (void)xb_add(&bar[XB_XCNT(b.x)], 1u);
    return b;
}
__device__ __forceinline__ void xcd_barrier_complete(GAS unsigned* bar, unsigned x, unsigned& nloc, unsigned& nx) {
    const unsigned G = gridDim.x * gridDim.y * gridDim.z;
    unsigned sum, cnt, mine, sp = 0u;
    for (;;) {
        sum = 0u; cnt = 0u; mine = 0u;
#pragma unroll
        for (unsigned j = 0; j < 16; ++j) { const unsigned c = xb_ld(&bar[XB_XCNT(j)]); sum += c; cnt += (c > 0u) ? 1u : 0u; mine = (j == x) ? c : mine; }
        if (sum == G) break;
        __builtin_amdgcn_s_sleep(1);
        if ((++sp & 255u) == 0u) { if (xb_ld(&bar[XB_TMO])) break; if (sp > XB_SPIN_CAP) { (void)xb_add(&bar[XB_TMO], 1u); break; } }
    }
    nloc = mine > 0u ? mine : 1u; nx = cnt > 0u ? cnt : 1u;
}
__device__ __forceinline__ void xcd_barrier(const XcdBarrier& b) {
    asm volatile("s_waitcnt vmcnt(0)" ::: "memory");
    __syncthreads();
    if (threadIdx.x == 0) {
        GAS unsigned* bar = b.bar;
        __builtin_amdgcn_s_waitcnt(0);
        unsigned nloc = b.st[0], nx = b.st[1];
        if (nloc == 0u) { xcd_barrier_complete(bar, b.x, nloc, nx); b.st[0] = nloc; b.st[1] = nx; }
        const unsigned old = xb_add(&bar[XB_XSUB(b.x)], 1u);
        const unsigned gen = old / nloc;
        if (old + 1u == (gen + 1u) * nloc) {
            __builtin_amdgcn_fence(__ATOMIC_RELEASE, "agent");
            asm volatile("s_waitcnt vmcnt(0)" ::: "memory");
            const unsigned og = xb_add(&bar[XB_TOP], 1u);
            const unsigned tg = og / nx;
            if (og + 1u == (tg + 1u) * nx) xb_add(&bar[XB_TOPGEN], 1u);
            else XB_SPIN(xb_ld(&bar[XB_TOPGEN]) == tg, bar);
            __builtin_amdgcn_fence(__ATOMIC_ACQUIRE, "agent");
            xb_add(&bar[XB_XGEN(b.x)], 1u);
            asm volatile("s_waitcnt vmcnt(0)" ::: "memory");
        } else {
            XB_SPIN(xb_ld(&bar[XB_XGEN(b.x)]) == gen, bar);
            __builtin_amdgcn_fence(__ATOMIC_ACQUIRE, "agent");
            asm volatile("s_waitcnt vmcnt(0)" ::: "memory");
        }
    }
    __syncthreads();
}

namespace g8 {
constexpr int BM = 256, BK = 64, HALF = 128, HTB = HALF * BK * 2, STAGE_BYTES = 8 * HTB, NXCD = 8, WGM = 8;
__host__ __device__ __forceinline__ int lds_byte(int r, int c) { const int st = (r >> 4) * 2 + (c >> 5), rr = r & 15, cc = c & 31, ob = rr * 64 + cc * 2; return st * 1024 + (ob ^ (((ob >> 9) & 1) << 5)); }
__host__ __device__ __forceinline__ void stage_rc(int b, int& R, int& C) { const int st = b / 1024, sb = b % 1024, swz = sb ^ (((sb >> 9) & 1) << 5); R = (st >> 1) * 16 + swz / 64; C = (st & 1) * 32 + (swz % 64) / 2; }
__host__ __device__ __forceinline__ int perm32(int rho) { const int n = rho >> 4, i = rho & 15; return 8 * (i >> 2) + 4 * n + (i & 3); }
struct Unit { int pm, pn, x0, x1; };
__device__ __forceinline__ bool static_order(int i, int G, int c, int nM, int nN, int& pm, int& pn) {
    const int nwg = nM * nN; const long L = (long)i * G + c; if (L >= nwg) return false;
    int wgid = (int)L; { const int q = nwg / NXCD, r = nwg % NXCD, xcd = wgid % NXCD, off = wgid / NXCD; wgid = (xcd < r ? xcd * (q + 1) : r * (q + 1) + (xcd - r) * q) + off; }
    const int nig = WGM * nN, gid = wgid / nig, fm = gid * WGM, gsz = (nM - fm) < WGM ? (nM - fm) : WGM;
    pm = fm + ((wgid % nig) % gsz); pn = (wgid % nig) / gsz; return true;
}

template <class Prob, class Epi, bool ALIGN_EPI = true>
__device__ __forceinline__ void gemm_phase(LAS unsigned char* lds, const Prob& P, const Epi& E, int wave_id) {
    int tid_; asm volatile("v_mbcnt_lo_u32_b32 %0, -1, 0\n\tv_mbcnt_hi_u32_b32 %0, -1, %0" : "=v"(tid_)); tid_ += wave_id * 64;
    const int tid = tid_, wid = __builtin_amdgcn_readfirstlane(tid >> 6), lane = tid & 63, wr = wid >> 2, wc = wid & 3, fr = lane & 15, fq = lane >> 4;
    const int nt = P.nt;
    unsigned voffA[2], voffB[2]; int Rr0 = 0; unsigned voffC = 0;
#pragma unroll
    for (int i = 0; i < 2; ++i) { int R, C; stage_rc(tid * 16 + i * 8192, R, C); const int Rb = Epi::PERM ? ((R & ~31) + perm32(R & 31)) : R;
        voffA[i] = (unsigned)(R * P.lda + C) * 2u; voffB[i] = (unsigned)(Rb * P.ldb + C) * 2u; if (i == 0) { Rr0 = R; voffC = (unsigned)C * 2u; } }
    const size_t kstep = (size_t)(BK * 2);
    const size_t hstepA = (size_t)HALF * P.lda * 2, hstepB = (size_t)HALF * P.ldb * 2;
    const unsigned ldsw = (unsigned)wid * 1024u;
    const int aoff = lds_byte(wr * 64 + fr, fq * 8), boff = lds_byte(wc * 32 + fr, fq * 8);
#define G8_SA(b, h) (((b) * 2 + (h)) * HTB)
#define G8_SB(b, h) ((4 + (b) * 2 + (h)) * HTB)
#define G8_STAGE(bufoff, gbase, voff) do { _Pragma("unroll") for (int _i = 0; _i < 2; ++_i) \
        __builtin_amdgcn_global_load_lds((const GAS unsigned*)((const GAS char*)(gbase) + (voff)[_i]), (LAS unsigned*)(lds + (bufoff) + ldsw + _i * 8192), 16, 0, 0); } while (0)
#define G8_STAGE_A(bufoff, h, kb, NX) do { if constexpr (Prob::GATHER) { const unsigned pk_ = (NX) ? gAn[h] : gAc[h]; const unsigned vo_[2] = {(pk_ & 0xffffu) * (unsigned)(P.lda * 2) + voffC, (pk_ >> 16) * (unsigned)(P.lda * 2) + voffC}; \
        G8_STAGE(bufoff, P.a_base() + (kb), vo_); } \
        else { G8_STAGE(bufoff, ((NX) ? nA : cA) + (h) * hstepA + (kb), voffA); } } while (0)
#define G8_LDA(dst, b, h) do { _Pragma("unroll") for (int m = 0; m < 4; ++m) _Pragma("unroll") for (int k = 0; k < 2; ++k) dst[m][k] = *(const LAS bf16x8*)(lds + G8_SA(b, h) + aoff + m * 2048 + k * 1024); } while (0)
#define G8_LDB(dst, b, h) do { _Pragma("unroll") for (int n = 0; n < 2; ++n) _Pragma("unroll") for (int k = 0; k < 2; ++k) dst[n][k] = *(const LAS bf16x8*)(lds + G8_SB(b, h) + boff + n * 2048 + k * 1024); } while (0)
#define G8_MMA(ai, bj, At, Bt) do { __builtin_amdgcn_s_setprio(1); _Pragma("unroll") for (int m = 0; m < 4; ++m) _Pragma("unroll") for (int n = 0; n < 2; ++n) _Pragma("unroll") for (int k = 0; k < 2; ++k) \
        acc[ai][bj][m][n] = __builtin_amdgcn_mfma_f32_16x16x32_bf16(Bt[n][k], At[m][k], acc[ai][bj][m][n], 0, 0, 0); __builtin_amdgcn_s_setprio(0); } while (0)
#define G8_WAIT_V(n) asm volatile("s_waitcnt vmcnt(" #n ")" ::: "memory")
#define G8_WAIT_L(n) asm volatile("s_waitcnt lgkmcnt(" #n ")" ::: "memory")
#define G8_BAR __builtin_amdgcn_s_barrier()
#define G8_SCHED __builtin_amdgcn_sched_barrier(0)
    Unit cur, nxt; int ui = 0;
    if (!P.next(0, cur)) return;
    f32x4 acc[2][2][4][2];
#pragma unroll
    for (int a = 0; a < 2; ++a)
#pragma unroll
        for (int b = 0; b < 2; ++b)
#pragma unroll
            for (int m = 0; m < 4; ++m)
#pragma unroll
                for (int n = 0; n < 2; ++n) acc[a][b][m][n] = (f32x4){0.f, 0.f, 0.f, 0.f};
    bf16x8 At[4][2], B0[2][2], B1[2][2];
    unsigned gAc[2], gAn[2];
    const GAS char* cA = nullptr; const GAS char* nA = nullptr;
    if constexpr (Prob::GATHER) { P.gather(cur, Rr0, gAc); } else { cA = P.a_tile(cur); }
    {
        const GAS char* b0 = P.b_ptr(cur, 0); const GAS char* b1 = P.b_ptr(cur, 1);
        G8_STAGE(G8_SB(0, 0), b0, voffB); G8_STAGE(G8_SB(0, 1), b0 + hstepB, voffB); G8_STAGE_A(G8_SA(0, 0), 0, 0, false); G8_STAGE_A(G8_SA(0, 1), 1, 0, false);
        if (wr == 1) G8_BAR;
        G8_WAIT_V(2); G8_BAR;
        G8_STAGE(G8_SB(1, 0), b1, voffB); G8_STAGE_A(G8_SA(1, 0), 0, kstep, false); G8_STAGE(G8_SB(1, 1), b1 + hstepB, voffB);
        G8_WAIT_V(6); G8_BAR;
    }
    for (;;) {
        const bool has_next = P.next(ui + 1, nxt);
        if (!has_next) nxt = cur;
        if constexpr (Prob::GATHER) { if (has_next) P.gather(nxt, Rr0, gAn); else { gAn[0] = gAc[0]; gAn[1] = gAc[1]; } }
        else { nA = P.a_tile(nxt); }
        for (int t = 0; t < nt; t += 2) {
            const bool last = (t == nt - 2);
            const size_t a1k = (size_t)(t + 1) * kstep;
            const size_t a2k = last ? 0 : (size_t)(t + 2) * kstep, a3k = last ? kstep : (size_t)(t + 3) * kstep;
            const GAS char* b2 = last ? P.b_ptr(nxt, 0) : P.b_ptr(cur, t + 2); const GAS char* b3 = last ? P.b_ptr(nxt, 1) : P.b_ptr(cur, t + 3);
            G8_LDB(B0, 0, 0); G8_LDB(B1, 0, 1); G8_SCHED; G8_LDA(At, 0, 0); G8_STAGE_A(G8_SA(1, 1), 1, a1k, false);
            G8_WAIT_V(8); G8_WAIT_L(0); G8_BAR; G8_MMA(0, 0, At, B0); G8_MMA(0, 1, At, B1); G8_BAR; G8_SCHED;
            G8_LDA(At, 0, 1); G8_STAGE(G8_SB(0, 0), b2, voffB); G8_STAGE(G8_SB(0, 1), b2 + hstepB, voffB);
            if (last) { G8_STAGE_A(G8_SA(0, 0), 0, a2k, true); } else { G8_STAGE_A(G8_SA(0, 0), 0, a2k, false); }
            G8_WAIT_V(8); G8_WAIT_L(0); G8_BAR; G8_MMA(1, 0, At, B0); G8_MMA(1, 1, At, B1); G8_BAR; G8_SCHED;
            G8_LDB(B0, 1, 0); G8_LDB(B1, 1, 1); G8_SCHED; G8_LDA(At, 1, 0);
            if (last) { G8_STAGE_A(G8_SA(0, 1), 1, a2k, true); } else { G8_STAGE_A(G8_SA(0, 1), 1, a2k, false); }
            G8_WAIT_V(8); G8_WAIT_L(0); G8_BAR; G8_MMA(0, 0, At, B0); G8_MMA(0, 1, At, B1); G8_BAR; G8_SCHED;
            G8_LDA(At, 1, 1); G8_STAGE(G8_SB(1, 0), b3, voffB); G8_STAGE(G8_SB(1, 1), b3 + hstepB, voffB);
            if (last) { G8_STAGE_A(G8_SA(1, 0), 0, a3k, true); } else { G8_STAGE_A(G8_SA(1, 0), 0, a3k, false); }
            G8_WAIT_V(8); G8_WAIT_L(0); G8_BAR; G8_MMA(1, 0, At, B0); G8_MMA(1, 1, At, B1); G8_BAR; G8_SCHED;
        }
        if constexpr (ALIGN_EPI) { if (wr == 0) G8_BAR; }
        { int l2_; asm volatile("v_mbcnt_lo_u32_b32 %0, -1, 0\n\tv_mbcnt_hi_u32_b32 %0, -1, %0" : "=v"(l2_)); E(acc, cur, wr, wc, l2_ & 15, l2_ >> 4); }
        if (!has_next) break;
#pragma unroll
        for (int a = 0; a < 2; ++a)
#pragma unroll
            for (int b = 0; b < 2; ++b)
#pragma unroll
                for (int m = 0; m < 4; ++m)
#pragma unroll
                    for (int n = 0; n < 2; ++n) acc[a][b][m][n] = (f32x4){0.f, 0.f, 0.f, 0.f};
        cur = nxt; ++ui;
        if constexpr (Prob::GATHER) { gAc[0] = gAn[0]; gAc[1] = gAn[1]; }
        else { cA = nA; }
        if constexpr (ALIGN_EPI) { if (wr == 1) G8_BAR; }
    }
    G8_WAIT_V(0);
    if constexpr (!ALIGN_EPI) { if (wr == 0) G8_BAR; }
    G8_BAR;
#undef G8_SA
#undef G8_SB
#undef G8_STAGE
#undef G8_STAGE_A
#undef G8_LDA
#undef G8_LDB
#undef G8_MMA
#undef G8_WAIT_V
#undef G8_WAIT_L
#undef G8_BAR
#undef G8_SCHED
}

struct ProbPlain {
    static constexpr bool GATHER = false;
    const GAS bf16_t* A; const GAS bf16_t* Bt; int lda, ldb, nt, nM, nN, G, c;
    __device__ __forceinline__ bool next(int i, Unit& u) const { u.x0 = 0; u.x1 = 0; return static_order(i, G, c, nM, nN, u.pm, u.pn); }
    __device__ __forceinline__ const GAS char* a_tile(const Unit& u) const { return (const GAS char*)A + (size_t)u.pm * BM * lda * 2; }
    __device__ __forceinline__ const GAS char* a_base() const { return (const GAS char*)A; }
    __device__ __forceinline__ void gather(const Unit&, int, unsigned (&)[2]) const {}
    __device__ __forceinline__ const GAS char* b_ptr(const Unit& u, int t) const { return (const GAS char*)Bt + ((size_t)u.pn * BM * ldb + (size_t)t * BK) * 2; }
};
struct ProbMoeGU {
    static constexpr bool GATHER = true;
    const GAS bf16_t* A; const GAS bf16_t* Bt; const GAS i32x4* elist; const LAS int* tab; int lda, ldb, nt, G, c;
    __device__ __forceinline__ bool next(int i, Unit& u) const {
        const int total = tab[TB_ECUM + NE]; const long L = (long)i * G + c; if (L >= total) return false;
        int wgid = (int)L; { const int q = total / NXCD, r = total % NXCD, xcd = wgid % NXCD, off = wgid / NXCD; wgid = (xcd < r ? xcd * (q + 1) : r * (q + 1) + (xcd - r) * q) + off; }
        int e = 0;
#pragma unroll
        for (int k = 1; k < NE; ++k) e += (wgid >= tab[TB_ECUM + k]) ? 1 : 0;
        const int loc = wgid - tab[TB_ECUM + e], nM = (tab[TB_ECUM + e + 1] - tab[TB_ECUM + e]) / 6;
        const int nig = WGM * 6, gid = loc / nig, fm = gid * WGM, gsz = (nM - fm) < WGM ? (nM - fm) : WGM;
        u.pm = fm + ((loc % nig) % gsz); u.pn = (loc % nig) / gsz; u.x0 = e; u.x1 = tab[TB_EOFF + e] + 256 * u.pm; return true;
    }
    __device__ __forceinline__ const GAS char* a_tile(const Unit&) const { return (const GAS char*)A; }
    __device__ __forceinline__ const GAS char* a_base() const { return (const GAS char*)A; }
    __device__ __forceinline__ void gather(const Unit& u, int R0, unsigned (&g)[2]) const {
#pragma unroll
        for (int h = 0; h < 2; ++h) { const int t0 = elist[u.x1 + h * HALF + R0].x, t1 = elist[u.x1 + h * HALF + R0 + 64].x; g[h] = (unsigned)t0 | ((unsigned)t1 << 16); }
    }
    __device__ __forceinline__ const GAS char* b_ptr(const Unit& u, int t) const { return (const GAS char*)Bt + ((size_t)(u.x0 * 1536 + u.pn * BM) * ldb + (size_t)t * BK) * 2; }
};
struct ProbMoeDown {
    static constexpr bool GATHER = false;
    const GAS bf16_t* A; const GAS bf16_t* Bt; const LAS int* tab; int lda, ldb, nt, G, c;
    __device__ __forceinline__ bool next(int i, Unit& u) const {
        const int nM = tab[TB_NRT]; if (!static_order(i, G, c, nM, 4, u.pm, u.pn)) return false;
        const int p = tab[TB_RT2P + u.pm]; u.x0 = (p & 0xff) * DFE; u.x1 = ((p >> 8) & 0xff) * DFE; return true;
    }
    __device__ __forceinline__ const GAS char* a_tile(const Unit& u) const { return (const GAS char*)A + (size_t)u.pm * BM * lda * 2; }
    __device__ __forceinline__ const GAS char* a_base() const { return (const GAS char*)A; }
    __device__ __forceinline__ void gather(const Unit&, int, unsigned (&)[2]) const {}
    __device__ __forceinline__ const GAS char* b_ptr(const Unit& u, int t) const { const int ko = (t < 11) ? (u.x0 + t * BK) : (u.x1 + (t - 11) * BK); return (const GAS char*)Bt + ((size_t)u.pn * BM * ldb + (size_t)ko) * 2; }
};

#define G8_ROWLOOP _Pragma("unroll") for (int ai = 0; ai < 2; ++ai) _Pragma("unroll") for (int m = 0; m < 4; ++m)
struct EpiBf16Split {
    static constexpr bool PERM = true;
    GAS bf16_t* O; int ldc; int split_cols; size_t split_stride;
    __device__ __forceinline__ void operator()(const f32x4 (&acc)[2][2][4][2], const Unit& u, int wr, int wc, int fr, int fq) const {
        const int row0 = u.pm * BM + wr * 64 + fr; int colt = u.pn * BM; GAS bf16_t* base = O;
        if (split_cols) { const int t = colt / split_cols; base += (size_t)t * split_stride; colt -= t * split_cols; }
        const int col0 = colt + wc * 32 + 8 * fq;
        G8_ROWLOOP { GAS bf16_t* rowp = base + (size_t)(row0 + ai * HALF + m * 16) * ldc + col0;
#pragma unroll
            for (int bj = 0; bj < 2; ++bj) { const f32x4 v0 = acc[ai][bj][m][0], v1 = acc[ai][bj][m][1];
                u32x4 w; w.x = cvt_pk_bf16(v0[0], v0[1]); w.y = cvt_pk_bf16(v0[2], v0[3]); w.z = cvt_pk_bf16(v1[0], v1[1]); w.w = cvt_pk_bf16(v1[2], v1[3]);
                *(GAS u32x4*)(rowp + bj * HALF) = w; } }
    }
};
struct EpiResid {
    static constexpr bool PERM = false;
    const GAS float* rin; GAS float* out;
    __device__ __forceinline__ void operator()(const f32x4 (&acc)[2][2][4][2], const Unit& u, int wr, int wc, int fr, int fq) const {
        const int row0 = u.pm * BM + wr * 64 + fr, col0 = u.pn * BM + wc * 32 + 4 * fq;
        G8_ROWLOOP { const size_t off = (size_t)(row0 + ai * HALF + m * 16) * DM + col0;
#pragma unroll
            for (int bj = 0; bj < 2; ++bj)
#pragma unroll
                for (int n = 0; n < 2; ++n) { const f32x4 r = *(const GAS f32x4*)(rin + off + bj * HALF + n * 16); *(GAS f32x4*)(out + off + bj * HALF + n * 16) = r * ALPHA + acc[ai][bj][m][n]; }
            asm volatile("" ::: "memory"); }
    }
};
struct EpiSwiglu {
    static constexpr bool PERM = true;
    GAS bf16_t* H; int ldh;
    __device__ __forceinline__ void operator()(const f32x4 (&acc)[2][2][4][2], const Unit& u, int wr, int wc, int fr, int fq) const {
        const int row0 = u.pm * BM + wr * 64 + fr, col0 = u.pn * HALF + wc * 32 + 8 * fq;
        G8_ROWLOOP { u32x4 w; unsigned ww[4];
#pragma unroll
            for (int n = 0; n < 2; ++n) { const f32x4 g = acc[ai][0][m][n], uu = acc[ai][1][m][n]; float hv[4];
#pragma unroll
                for (int i = 0; i < 4; ++i) hv[i] = g[i] * sigmoid_f(g[i]) * uu[i];
                ww[2 * n] = cvt_pk_bf16(hv[0], hv[1]); ww[2 * n + 1] = cvt_pk_bf16(hv[2], hv[3]); }
            w.x = ww[0]; w.y = ww[1]; w.z = ww[2]; w.w = ww[3];
            *(GAS u32x4*)(H + (size_t)(row0 + ai * HALF + m * 16) * ldh + col0) = w; }
    }
};
struct EpiGate {
    static constexpr bool PERM = true;
    GAS bf16_t* O;
    __device__ __forceinline__ void operator()(const f32x4 (&acc)[2][2][4][2], const Unit& u, int wr, int wc, int fr, int fq) const {
        const int row0 = u.pm * BM + wr * 64 + fr, col0 = u.pn * BM + wc * 32 + 8 * fq;
        G8_ROWLOOP { GAS bf16_t* rowp = O + (size_t)(row0 + ai * HALF + m * 16) * DM + col0;
#pragma unroll
            for (int bj = 0; bj < 2; ++bj) { const f32x4 v0 = acc[ai][bj][m][0], v1 = acc[ai][bj][m][1];
                u32x4 w; w.x = cvt_pk_bf16(sigmoid_f(v0[0]), sigmoid_f(v0[1])); w.y = cvt_pk_bf16(sigmoid_f(v0[2]), sigmoid_f(v0[3]));
                w.z = cvt_pk_bf16(sigmoid_f(v1[0]), sigmoid_f(v1[1])); w.w = cvt_pk_bf16(sigmoid_f(v1[2]), sigmoid_f(v1[3]));
                *(GAS u32x4*)(rowp + bj * HALF) = w; } }
    }
};
struct EpiPle {
    static constexpr bool PERM = true;
    GAS float* res; GAS bf16_t* XG;
    __device__ __forceinline__ void operator()(const f32x4 (&acc)[2][2][4][2], const Unit& u, int wr, int wc, int fr, int fq) const {
        const int row0 = u.pm * BM + wr * 64 + fr, col0 = u.pn * BM + wc * 32 + 8 * fq;
        G8_ROWLOOP { const size_t off = (size_t)(row0 + ai * HALF + m * 16) * DM + col0;
#pragma unroll
            for (int bj = 0; bj < 2; ++bj)
#pragma unroll
                for (int n = 0; n < 2; ++n) { const u32x2 gw = *(const GAS u32x2*)(XG + off + bj * HALF + 4 * n); const f32x4 r = *(const GAS f32x4*)(res + off + bj * HALF + 4 * n); const f32x4 a = acc[ai][bj][m][n]; f32x4 o;
                    o[0] = r[0] + a[0] * __builtin_bit_cast(float, gw.x << 16); o[1] = r[1] + a[1] * __builtin_bit_cast(float, gw.x & 0xffff0000u);
                    o[2] = r[2] + a[2] * __builtin_bit_cast(float, gw.y << 16); o[3] = r[3] + a[3] * __builtin_bit_cast(float, gw.y & 0xffff0000u);
                    *(GAS f32x4*)(res + off + bj * HALF + 4 * n) = o; u32x2 w; w.x = cvt_pk_bf16(o[0], o[1]); w.y = cvt_pk_bf16(o[2], o[3]); *(GAS u32x2*)(XG + off + bj * HALF + 4 * n) = w;
                    asm volatile("" ::: "memory"); } }
    }
};
struct EpiMoeGU {
    static constexpr bool PERM = true;
    GAS bf16_t* HS; const GAS i32x4* elist; const GAS float* egate;
    __device__ __forceinline__ void operator()(const f32x4 (&acc)[2][2][4][2], const Unit& u, int wr, int wc, int fr, int fq) const {
        const int j0 = u.pn * HALF + wc * 32 + 8 * fq; const bool colok = j0 < DFE;
        G8_ROWLOOP { const int sl = u.x1 + ai * HALF + wr * 64 + m * 16 + fr; const i32x4 en = elist[sl]; const float gate = egate[sl];
            if (colok && en.y >= 0) { u32x4 w; unsigned ww[4];
#pragma unroll
                for (int n = 0; n < 2; ++n) { const f32x4 g = acc[ai][0][m][n], uu = acc[ai][1][m][n]; float hv[4];
#pragma unroll
                    for (int i = 0; i < 4; ++i) hv[i] = gate * g[i] * sigmoid_f(g[i]) * uu[i];
                    ww[2 * n] = cvt_pk_bf16(hv[0], hv[1]); ww[2 * n + 1] = cvt_pk_bf16(hv[2], hv[3]); }
                w.x = ww[0]; w.y = ww[1]; w.z = ww[2]; w.w = ww[3];
                *(GAS u32x4*)(HS + (size_t)en.y + j0) = w; } }
    }
};
struct EpiMoeDown {
    static constexpr bool PERM = false;
    GAS float* res; const GAS int* plist;
    __device__ __forceinline__ void operator()(const f32x4 (&acc)[2][2][4][2], const Unit& u, int wr, int wc, int fr, int fq) const {
        const int col0 = u.pn * BM + wc * 32 + 4 * fq;
        G8_ROWLOOP { const int tok = plist[u.pm * BM + ai * HALF + wr * 64 + m * 16 + fr];
            if (tok >= 0) { const size_t off = (size_t)tok * DM + col0;
#pragma unroll
                for (int bj = 0; bj < 2; ++bj)
#pragma unroll
                    for (int n = 0; n < 2; ++n) { const f32x4 r = *(const GAS f32x4*)(res + off + bj * HALF + n * 16); *(GAS f32x4*)(res + off + bj * HALF + n * 16) = r * ALPHA + acc[ai][bj][m][n]; } }
            asm volatile("" ::: "memory"); }
    }
};
__device__ __forceinline__ void unpack8(const u32x4 w, float (&x)[8]) {
    x[0] = __builtin_bit_cast(float, w.x << 16); x[1] = __builtin_bit_cast(float, w.x & 0xffff0000u); x[2] = __builtin_bit_cast(float, w.y << 16); x[3] = __builtin_bit_cast(float, w.y & 0xffff0000u);
    x[4] = __builtin_bit_cast(float, w.z << 16); x[5] = __builtin_bit_cast(float, w.z & 0xffff0000u); x[6] = __builtin_bit_cast(float, w.w << 16); x[7] = __builtin_bit_cast(float, w.w & 0xffff0000u); }
struct EpiResidB {
    static constexpr bool PERM = true;
    GAS bf16_t* S;
    __device__ __forceinline__ void operator()(const f32x4 (&acc)[2][2][4][2], const Unit& u, int wr, int wc, int fr, int fq) const {
        const int row0 = u.pm * BM + wr * 64 + fr, col0 = u.pn * BM + wc * 32 + 8 * fq;
        G8_ROWLOOP { GAS bf16_t* rowp = S + (size_t)(row0 + ai * HALF + m * 16) * DM + col0;
#pragma unroll
            for (int bj = 0; bj < 2; ++bj) { float x[8]; unpack8(*(const GAS u32x4*)(rowp + bj * HALF), x); const f32x4 a0 = acc[ai][bj][m][0], a1 = acc[ai][bj][m][1];
                u32x4 w; w.x = cvt_pk_bf16(x[0] * ALPHA + a0[0], x[1] * ALPHA + a0[1]); w.y = cvt_pk_bf16(x[2] * ALPHA + a0[2], x[3] * ALPHA + a0[3]);
                w.z = cvt_pk_bf16(x[4] * ALPHA + a1[0], x[5] * ALPHA + a1[1]); w.w = cvt_pk_bf16(x[6] * ALPHA + a1[2], x[7] * ALPHA + a1[3]);
                *(GAS u32x4*)(rowp + bj * HALF) = w; }
            asm volatile("" ::: "memory"); }
    }
};
struct EpiMoeDownB {
    static constexpr bool PERM = true;
    GAS bf16_t* S; const GAS int* plist;
    __device__ __forceinline__ void operator()(const f32x4 (&acc)[2][2][4][2], const Unit& u, int wr, int wc, int fr, int fq) const {
        const int col0 = u.pn * BM + wc * 32 + 8 * fq;
        G8_ROWLOOP { const int tok = plist[u.pm * BM + ai * HALF + wr * 64 + m * 16 + fr];
            if (tok >= 0) { GAS bf16_t* rowp = S + (size_t)tok * DM + col0;
#pragma unroll
                for (int bj = 0; bj < 2; ++bj) { float x[8]; unpack8(*(const GAS u32x4*)(rowp + bj * HALF), x); const f32x4 a0 = acc[ai][bj][m][0], a1 = acc[ai][bj][m][1];
                    u32x4 w; w.x = cvt_pk_bf16(x[0] * ALPHA + a0[0], x[1] * ALPHA + a0[1]); w.y = cvt_pk_bf16(x[2] * ALPHA + a0[2], x[3] * ALPHA + a0[3]);
                    w.z = cvt_pk_bf16(x[4] * ALPHA + a1[0], x[5] * ALPHA + a1[1]); w.w = cvt_pk_bf16(x[6] * ALPHA + a1[2], x[7] * ALPHA + a1[3]);
                    *(GAS u32x4*)(rowp + bj * HALF) = w; } }
            asm volatile("" ::: "memory"); }
    }
};
struct EpiPleB {
    static constexpr bool PERM = true;
    const GAS bf16_t* S; GAS bf16_t* XG; GAS float* out32;
    __device__ __forceinline__ void operator()(const f32x4 (&acc)[2][2][4][2], const Unit& u, int wr, int wc, int fr, int fq) const {
        const int row0 = u.pm * BM + wr * 64 + fr, col0 = u.pn * BM + wc * 32 + 8 * fq;
        G8_ROWLOOP { const size_t off = (size_t)(row0 + ai * HALF + m * 16) * DM + col0;
#pragma unroll
            for (int bj = 0; bj < 2; ++bj) { float x[8], g[8]; unpack8(*(const GAS u32x4*)(S + off + bj * HALF), x); unpack8(*(const GAS u32x4*)(XG + off + bj * HALF), g);
                const f32x4 a0 = acc[ai][bj][m][0], a1 = acc[ai][bj][m][1]; f32x4 o0, o1;
#pragma unroll
                for (int i = 0; i < 4; ++i) { o0[i] = x[i] + a0[i] * g[i]; o1[i] = x[4 + i] + a1[i] * g[4 + i]; }
                u32x4 w; w.x = cvt_pk_bf16(o0[0], o0[1]); w.y = cvt_pk_bf16(o0[2], o0[3]); w.z = cvt_pk_bf16(o1[0], o1[1]); w.w = cvt_pk_bf16(o1[2], o1[3]);
                *(GAS u32x4*)(XG + off + bj * HALF) = w;
                if (out32) { *(GAS f32x4*)(out32 + off + bj * HALF) = o0; *(GAS f32x4*)(out32 + off + bj * HALF + 4) = o1; }
                asm volatile("" ::: "memory"); } }
    }
};
}

struct Frame {
    LAS unsigned char* lds; GAS unsigned* ctl; GAS unsigned char* ws; GAS float* res;
    int wave, vcu, G;
    __device__ __forceinline__ int lane_id() const { int l; asm volatile("v_mbcnt_lo_u32_b32 %0, -1, 0\n\tv_mbcnt_hi_u32_b32 %0, -1, %0" : "=v"(l)); return l; }
    __device__ __forceinline__ int tid_id() const { return wave * 64 + lane_id(); }
};
__device__ __forceinline__ GAS bf16_t* xb_ptr(const Frame& F, int which) { return (GAS bf16_t*)(F.ws + (which ? WS_XB1 : WS_XB0)); }

struct Job { int in_idx, Ns, nkb, n0, nblk, ldd, drow0, dk0, split, item0; float scale; long long src_off, dst_off; };
constexpr int NJOBS = 55;
struct JobTable { Job j[NJOBS]; int total; int njobs; };
constexpr JobTable make_jobs() {
    JobTable t{}; int n = 0, items = 0;
    auto add = [&](int in_idx, long long src_off, int Ns, int K, int n0, int ncols, long long dst_byte, int ldd, int drow0, int dk0, int split, float scale) {
        Job& j = t.j[n++]; j.in_idx = in_idx; j.src_off = src_off; j.Ns = Ns; j.nkb = K / 64; j.n0 = n0; j.nblk = ncols / 32; j.dst_off = dst_byte; j.ldd = ldd; j.drow0 = drow0; j.dk0 = dk0; j.split = split; j.scale = scale;
        j.item0 = items; items += j.nkb * j.nblk; };
    const long long WD = (long long)WS_WDEAD, WL = (long long)WS_WLIVE;
    const float QS = 0.0625f;
    for (int i = 0; i < 2; ++i) { const long long q = WD + 2 * (long long)(i ? WD_QKV1 : WD_QKV0), o = WD + 2 * (long long)(i ? WD_O1 : WD_O0);
        add(IN_AQKV, (long long)i * 1024 * 3072, 3072, 1024, 0, 1024, q, 1024, 0, 0, 0, QS);
        add(IN_AQKV, (long long)i * 1024 * 3072, 3072, 1024, 1024, 2048, q, 1024, 1024, 0, 0, 1.f);
        add(IN_AO, (long long)i * 1024 * 1024, 1024, 1024, 0, 1024, o, 1024, 0, 0, 0, 1.f); }
    add(IN_BQ, 0, 1024, 1024, 0, 1024, WL + 2 * (long long)WL_QKV2, 1024, 0, 0, 0, QS);
    add(IN_KVF, 0, 2052, 1024, 0, 2048, WL + 2 * (long long)WL_QKV2, 1024, 1024, 0, 0, 1.f);
    add(IN_BQ, (long long)1024 * 1024, 1024, 1024, 0, 1024, WL + 2 * (long long)WL_Q3, 1024, 0, 0, 0, QS);
    add(IN_BO, 0, 1024, 1024, 0, 1024, WL + 2 * (long long)WL_O2, 1024, 0, 0, 0, 1.f);
    add(IN_BO, (long long)1024 * 1024, 1024, 1024, 0, 1024, WL + 2 * (long long)WL_O3, 1024, 0, 0, 0, 1.f);
    for (int i = 0; i < 2; ++i) { const long long gu = i ? WL + 2 * (long long)WL_GU1 : WD + 2 * (long long)WD_GU0, dn = i ? WL + 2 * (long long)WL_DN1 : WD + 2 * (long long)WD_DN0;
        add(IN_FGU, (long long)i * 1024 * 5632, 5632, 1024, 0, 5632, gu, 1024, 0, 0, DFF, 1.f);
        add(IN_FDN, (long long)i * 2816 * 1024, 1024, 2816, 0, 1024, dn, 2816, 0, 0, 0, 1.f); }
    for (int i = 0; i < 2; ++i) for (int e = 0; e < NE; ++e) { const long long gu = i ? WL + 2 * (long long)WL_MGU1 : WD + 2 * (long long)WD_MGU0, dn = i ? WL + 2 * (long long)WL_MDN1 : WD + 2 * (long long)WD_MDN0;
        add(IN_MGU, (long long)(i * NE + e) * 1024 * 1408, 1408, 1024, 0, 1408, gu, 1024, e * 1536, 0, DFE, 1.f);
        add(IN_MDN, (long long)(i * NE + e) * 704 * 1024, 1024, 704, 0, 1024, dn, 5632, 0, e * DFE, 0, 1.f); }
    for (int i = 0; i < 4; ++i) { const long long pp = i == 0 ? WD + 2 * (long long)WD_PP0 : i == 1 ? WD + 2 * (long long)WD_PP1 : i == 2 ? WL + 2 * (long long)WL_PP2 : WL + 2 * (long long)WL_PP3;
        const long long pg = i == 0 ? WD + 2 * (long long)WD_PG0 : i == 1 ? WD + 2 * (long long)WD_PG1 : i == 2 ? WL + 2 * (long long)WL_PG2 : WL + 2 * (long long)WL_PG3;
        add(IN_PP, (long long)i * 256 * 1024, 1024, 256, 0, 1024, pp, 256, 0, 0, 0, 1.f);
        add(IN_PG, (long long)i * 1024 * 1024, 1024, 1024, 0, 1024, pg, 1024, 0, 0, 0, 1.f); }
    t.total = items; t.njobs = n; return t;
}
__device__ const JobTable g_jobs = make_jobs();
static_assert(make_jobs().njobs == NJOBS, "job count");

__device__ __forceinline__ void conv_item(const Frame& F, const Job& J, int it, LAS float* scr) {
    const int lane = F.lane_id(); const int kb = it / J.nblk, nb = it % J.nblk, k0 = 64 * kb, ncol = J.n0 + 32 * nb;
    const GAS float* W = in_sel(J.in_idx) + J.src_off;
    { f32x4 wv[8];
#pragma unroll
      for (int i = 0; i < 8; ++i) wv[i] = *(const GAS f32x4*)(W + (size_t)(k0 + (lane >> 3) + 8 * i) * J.Ns + ncol + (lane & 7) * 4);
#pragma unroll
      for (int i = 0; i < 8; ++i) { LAS float* d = scr + ((lane >> 3) + 8 * i) * 33 + (lane & 7) * 4; d[0] = wv[i][0] * J.scale; d[1] = wv[i][1] * J.scale; d[2] = wv[i][2] * J.scale; d[3] = wv[i][3] * J.scale; } }
    asm volatile("s_waitcnt lgkmcnt(0)" ::: "memory");
    int drow;
    if (J.split) { const int ty = ncol / J.split, jj = ncol % J.split; drow = J.drow0 + 256 * (jj >> 7) + 128 * ty + (jj & 127); } else drow = J.drow0 + (ncol - J.n0);
    GAS bf16_t* WT = (GAS bf16_t*)(F.ws + J.dst_off);
    const int c = lane & 7;
#pragma unroll
    for (int j = 0; j < 4; ++j) { const int n = (lane >> 3) + 8 * j; const LAS float* s = scr + (8 * c) * 33 + n;
        u32x4 o; o.x = pk2(s[0 * 33], s[1 * 33]); o.y = pk2(s[2 * 33], s[3 * 33]); o.z = pk2(s[4 * 33], s[5 * 33]); o.w = pk2(s[6 * 33], s[7 * 33]);
        *(GAS u32x4*)(WT + (size_t)(drow + n) * J.ldd + J.dk0 + k0 + 8 * c) = o; }
    asm volatile("s_waitcnt lgkmcnt(0)" ::: "memory");
}
__device__ __forceinline__ void prologue_phase(Frame& F) {
    LAS float* scr = (LAS float*)(F.lds + F.wave * 16384);
    const int gw = F.vcu * NWAVES + F.wave, NGW = F.G * NWAVES;
    const int total = g_jobs.total;
    for (int it = gw; it < total; it += NGW) {
        int jn = 0;
        for (int k = 1; k < NJOBS; ++k) jn += (it >= g_jobs.j[k].item0) ? 1 : 0;
        jn = __builtin_amdgcn_readfirstlane(jn);
        conv_item(F, g_jobs.j[jn], it - g_jobs.j[jn].item0, scr);
    }
    { const size_t gt = (size_t)blockIdx.x * NTHREADS + F.tid_id(), gs = (size_t)F.G * NTHREADS;
      for (size_t i = gt; i < (size_t)2 * NE * 2 * 64 * 128; i += gs) {
          const int ch = (int)(i & 127), row = (int)((i >> 7) & 63), gu = (int)((i >> 13) & 1), e = (int)((i >> 14) & 7), li = (int)(i >> 17);
          GAS bf16_t* base = (GAS bf16_t*)(F.ws + (li ? WS_WLIVE + 2 * WL_MGU1 : WS_WDEAD + 2 * WD_MGU0));
          *(GAS u32x4*)(base + (size_t)(e * 1536 + 1280 + 128 * gu + 64 + row) * 1024 + ch * 8) = (u32x4){0u, 0u, 0u, 0u}; } }
    GAS bf16_t* xb = xb_ptr(F, 1);
    { const int ln = F.lane_id();
      for (int m = gw; m < T; m += 2 * NGW) {
          const GAS f32x4* xa = (const GAS f32x4*)(in_sel(IN_X) + (size_t)m * DM) + ln; const GAS f32x4* xc = (const GAS f32x4*)(in_sel(IN_X) + (size_t)(m + NGW) * DM) + ln;
          GAS u32x2* oa = (GAS u32x2*)(xb + (size_t)m * DM) + ln; GAS u32x2* oc = (GAS u32x2*)(xb + (size_t)(m + NGW) * DM) + ln;
          f32x4 va[4], vc[4];
#pragma unroll
          for (int j = 0; j < 4; ++j) { va[j] = xa[64 * j]; vc[j] = xc[64 * j]; }
#pragma unroll
          for (int j = 0; j < 4; ++j) { u32x2 o; o.x = cvt_pk_bf16(va[j][0], va[j][1]); o.y = cvt_pk_bf16(va[j][2], va[j][3]); oa[64 * j] = o; o.x = cvt_pk_bf16(vc[j][0], vc[j][1]); o.y = cvt_pk_bf16(vc[j][2], vc[j][3]); oc[64 * j] = o; } } }
}

template <bool ROUTER, bool CVT_P>
__device__ __forceinline__ void ln_phase(Frame& F, int L, int which, GAS bf16_t* S) {
    int tid_ = F.tid_id(); asm volatile("" : "+v"(tid_));
    const int lane = tid_ & 63, w = __builtin_amdgcn_readfirstlane(tid_ >> 6);
    const GAS f32x4* gp = (const GAS f32x4*)(in_sel(IN_LNG) + (size_t)(L * 2 + which) * DM) + 4 * lane; const GAS f32x4* bp = (const GAS f32x4*)(in_sel(IN_LNB) + (size_t)(L * 2 + which) * DM) + 4 * lane;
    f32x4 gg[4], bb[4];
#pragma unroll
    for (int j = 0; j < 4; ++j) { gg[j] = gp[j]; bb[j] = bp[j]; }
    LAS f32x4* wrl = (LAS f32x4*)(F.lds + 1024);
    if constexpr (ROUTER) { const GAS float* Wr = in_sel(IN_MR) + (size_t)(L >> 1) * DM * NE;
        __syncthreads();
        for (int i = w; i < 16; i += NWAVES) { const int k = 16 * lane + i;
            wrl[(i * 2 + 0) * 64 + lane] = *(const GAS f32x4*)(Wr + (size_t)k * NE); wrl[(i * 2 + 1) * 64 + lane] = *(const GAS f32x4*)(Wr + (size_t)k * NE + 4); }
        __syncthreads(); }
    LAS int* hist = (LAS int*)F.lds;
    for (int ch = blockIdx.x; ch < T / 128; ch += F.G) {
        if constexpr (ROUTER) { __syncthreads(); if (tid_ < 40) hist[tid_] = 0; __syncthreads(); }
        u32x4 na, nb, ma, mb; f32x4 npv = (f32x4){0.f, 0.f, 0.f, 0.f}, np2 = npv;
        { const GAS u32x4* x0 = (const GAS u32x4*)(S + (size_t)(128 * ch + 16 * w) * DM) + 2 * lane; na = x0[0]; nb = x0[1]; ma = x0[128]; mb = x0[129];
          if constexpr (CVT_P) { const GAS f32x4* p0 = (const GAS f32x4*)(in_sel(IN_P) + ((size_t)L * T + 128 * ch + 16 * w) * PLE) + lane; npv = p0[0]; np2 = p0[64]; } }
        for (int k = 0; k < 16; ++k) {
            const int row = 128 * ch + 16 * w + k;
            GAS u32x4* xr = (GAS u32x4*)(S + (size_t)row * DM) + 2 * lane;
            float v[16]; { float t8[8]; g8::unpack8(na, t8);
#pragma unroll
                for (int i = 0; i < 8; ++i) v[i] = t8[i];
                g8::unpack8(nb, t8);
#pragma unroll
                for (int i = 0; i < 8; ++i) v[8 + i] = t8[i]; }
            const f32x4 pv = npv; na = ma; nb = mb; npv = np2;
            if (k < 14) { ma = xr[256]; mb = xr[257]; if constexpr (CVT_P) np2 = *((const GAS f32x4*)(in_sel(IN_P) + ((size_t)L * T + row + 2) * PLE) + lane); }
            float s = 0.f;
#pragma unroll
            for (int i = 0; i < 16; ++i) s += v[i];
            const float mean = wave_sum_dpp(s) * (1.f / DM); float s2 = 0.f;
#pragma unroll
            for (int i = 0; i < 16; ++i) { v[i] -= mean; s2 += v[i] * v[i]; }
            const float rstd = 1.f / sqrtf(wave_sum_dpp(s2) * (1.f / DM) + LN_EPS);
#pragma unroll
            for (int i = 0; i < 16; ++i) v[i] = v[i] * rstd * gg[i >> 2][i & 3] + bb[i >> 2][i & 3];
            { u32x4 o; o.x = cvt_pk_bf16(v[0], v[1]); o.y = cvt_pk_bf16(v[2], v[3]); o.z = cvt_pk_bf16(v[4], v[5]); o.w = cvt_pk_bf16(v[6], v[7]); xr[0] = o;
              o.x = cvt_pk_bf16(v[8], v[9]); o.y = cvt_pk_bf16(v[10], v[11]); o.z = cvt_pk_bf16(v[12], v[13]); o.w = cvt_pk_bf16(v[14], v[15]); xr[1] = o; }
            if constexpr (CVT_P) { u32x2 o; o.x = cvt_pk_bf16(pv[0], pv[1]); o.y = cvt_pk_bf16(pv[2], pv[3]);
                *((GAS u32x2*)((GAS bf16_t*)(F.ws + WS_PB) + (size_t)row * PLE) + lane) = o; }
            if constexpr (ROUTER) {
                float lg[NE];
#pragma unroll
                for (int e = 0; e < NE; ++e) lg[e] = 0.f;
#pragma unroll
                for (int i = 0; i < 16; ++i) { const float xv = v[i]; const f32x4 w0 = wrl[(i * 2 + 0) * 64 + lane], w1 = wrl[(i * 2 + 1) * 64 + lane];
#pragma unroll
                    for (int e = 0; e < 4; ++e) { lg[e] += xv * w0[e]; lg[4 + e] += xv * w1[e]; } }
#pragma unroll
                for (int e = 0; e < NE; ++e) lg[e] = wave_sum_dpp(lg[e]);
                int i1 = 0; float v1 = lg[0];
#pragma unroll
                for (int e = 1; e < NE; ++e) if (lg[e] > v1) { v1 = lg[e]; i1 = e; }
                int i2 = -1; float v2 = -3.0e38f;
#pragma unroll
                for (int e = 0; e < NE; ++e) if (e != i1 && lg[e] > v2) { v2 = lg[e]; i2 = e; }
                const float ex = fast_exp(v2 - v1), g1 = __builtin_amdgcn_rcpf(1.f + ex), g2 = 1.f - g1;
                const int ea = i1 < i2 ? i1 : i2, eb = i1 < i2 ? i2 : i1, pid = ea * (15 - ea) / 2 + eb - ea - 1;
                if (lane == 0) { GAS int* rp = (GAS int*)(F.ws + WS_MISC + MS_REC) + (size_t)row * 4; GAS float* gpp = (GAS float*)(F.ws + WS_MISC + MS_GATE);
                    rp[0] = i1 | (i2 << 8) | (pid << 16); rp[1] = 0; rp[2] = 0; rp[3] = row; gpp[row] = g1; gpp[T + row] = g2;
                    __hip_atomic_fetch_add(hist + i1, 1, __ATOMIC_RELAXED, __HIP_MEMORY_SCOPE_WORKGROUP); __hip_atomic_fetch_add(hist + i2, 1, __ATOMIC_RELAXED, __HIP_MEMORY_SCOPE_WORKGROUP);
                    __hip_atomic_fetch_add(hist + 8 + pid, 1, __ATOMIC_RELAXED, __HIP_MEMORY_SCOPE_WORKGROUP); }
            }
        }
        if constexpr (ROUTER) { __syncthreads(); if (tid_ < 40) ((GAS int*)(F.ws + WS_MISC + MS_HIST))[ch * 40 + tid_] = hist[tid_]; }
    }
}

__device__ __forceinline__ int pad256(int v) { return (v + 255) & ~255; }
__device__ __forceinline__ void moe_lists_phase(Frame& F) {
    LAS int* pre = (LAS int*)F.lds; LAS int* tot = pre + 40; LAS int* eoff = tot + 40; LAS int* poff = eoff + 16; LAS int* recs = poff + 32; LAS int* tabl = recs + 128;
    const GAS int* hist = (const GAS int*)(F.ws + WS_MISC + MS_HIST);
    const GAS i32x4* rec = (const GAS i32x4*)(F.ws + WS_MISC + MS_REC);
    GAS i32x4* elist = (GAS i32x4*)(F.ws + WS_MISC + MS_ELIST); GAS int* plist = (GAS int*)(F.ws + WS_MISC + MS_PLIST);
    int tid_ = F.tid_id(); asm volatile("" : "+v"(tid_));
    const int lane = tid_ & 63, w = F.wave, tid = tid_;
    bool first = true;
    for (int ch = blockIdx.x; ch < T / 128; ch += F.G) {
        __syncthreads();
        for (int col = w; col < 36; col += NWAVES) { int sp = 0, st = 0;
#pragma unroll
            for (int k = 0; k < 4; ++k) { const int c2 = lane + 64 * k; const int v = hist[c2 * 40 + col]; st += v; sp += (c2 < ch) ? v : 0; }
#pragma unroll
            for (int o = 1; o < 64; o <<= 1) { sp += shxi(sp, o, lane); st += shxi(st, o, lane); }
            if (lane == 0) { pre[col] = sp; tot[col] = st; } }
        __syncthreads();
        if (tid == 0) {
            int acc = 0, ucum = 0;
            for (int e = 0; e < NE; ++e) { eoff[e] = acc; tabl[TB_EOFF + e] = acc; tabl[TB_ECUM + e] = ucum; const int p = pad256(tot[e]); acc += p; ucum += 6 * (p >> 8); }
            eoff[NE] = acc; tabl[TB_EOFF + NE] = acc; tabl[TB_ECUM + NE] = ucum;
            int pacc = 0, pid = 0;
            for (int a = 0; a < NE - 1; ++a) for (int b = a + 1; b < NE; ++b) { poff[pid] = pacc; pacc += pad256(tot[8 + pid]); ++pid; }
            poff[NPAIR] = pacc; tabl[TB_NRT] = pacc >> 8;
        }
        __syncthreads();
        if (tid < 192) { const int r8 = tid << 8; int p = 0;
            for (int k = 1; k < NPAIR; ++k) p += (r8 >= poff[k]) ? 1 : 0;
            int a = 0, rem = p; while (rem >= NE - 1 - a) { rem -= NE - 1 - a; ++a; }
            tabl[TB_RT2P + tid] = a | ((a + 1 + rem) << 8); }
        __syncthreads();
        if (ch == 0) { for (int i = tid; i < TB_WORDS; i += NTHREADS) ((GAS int*)(F.ws + WS_MISC + MS_TAB))[i] = tabl[i]; }
        if (tid < 128) recs[tid] = rec[128 * ch + tid].x;
        __syncthreads();
        if (tid < 128) {
            const int token = 128 * ch + tid; const i32x4 r = rec[token]; const int e1 = r.x & 0xff, e2 = (r.x >> 8) & 0xff, pid = (r.x >> 16) & 0xff;
            int r1 = 0, r2 = 0, rp = 0;
            for (int j = 0; j < tid; ++j) { const int o = recs[j]; const int o1 = o & 0xff, o2 = (o >> 8) & 0xff, op = (o >> 16) & 0xff;
                r1 += ((o1 == e1) | (o2 == e1)) ? 1 : 0; r2 += ((o1 == e2) | (o2 == e2)) ? 1 : 0; rp += (op == pid) ? 1 : 0; }
            const int pslot = poff[pid] + pre[8 + pid] + rp; plist[pslot] = token;
            i32x4 en; en.x = token; en.w = 0;
            const GAS float* gp = (const GAS float*)(F.ws + WS_MISC + MS_GATE);
            GAS float* eg = (GAS float*)(F.ws + WS_MISC + MS_EGATE); en.z = 0;
            { const int sl = eoff[e1] + pre[e1] + r1; en.y = pslot * 1408 + (e1 < e2 ? 0 : DFE); elist[sl] = en; eg[sl] = gp[token]; }
            { const int sl = eoff[e2] + pre[e2] + r2; en.y = pslot * 1408 + (e2 < e1 ? 0 : DFE); elist[sl] = en; eg[sl] = gp[T + token]; }
        }
        if (first) {
            first = false; const int gt = blockIdx.x * NTHREADS + tid, gs = F.G * NTHREADS;
            for (int e = 0; e < NE; ++e) for (int i = eoff[e] + tot[e] + gt; i < eoff[e + 1]; i += gs) elist[i] = (i32x4){0, -1, 0, 0};
            for (int p = 0; p < NPAIR; ++p) for (int i = poff[p] + tot[8 + p] + gt; i < poff[p + 1]; i += gs) plist[i] = -1;
        }
    }
    __syncthreads();
}
__device__ __forceinline__ void load_tab(Frame& F) {
    __syncthreads();
    for (int i = F.tid_id(); i < TB_WORDS; i += NTHREADS) ((LAS int*)(F.lds + LDS_TAB))[i] = ((const GAS int*)(F.ws + WS_MISC + MS_TAB))[i];
    __syncthreads();
}

__device__ __forceinline__ void forget_phase(Frame& F, const GAS bf16_t* S) {
    int tid_ = F.tid_id(); asm volatile("" : "+v"(tid_));
    const int lane = tid_ & 63, w = __builtin_amdgcn_readfirstlane(tid_ >> 6);
    const GAS float* Wf = in_sel(IN_KVF);
    f32x4 wf[16];
#pragma unroll
    for (int i = 0; i < 16; ++i) wf[i] = *(const GAS f32x4*)(Wf + (size_t)(16 * lane + i) * 2052 + 2048);
    const f32x4 bias = *(const GAS f32x4*)in_sel(IN_KVFB);
    LAS float* lf = (LAS float*)F.lds;
    GAS float* cl = (GAS float*)(F.ws + WS_MISC + MS_CL); GAS float* tt = (GAS float*)(F.ws + WS_MISC + MS_TOT);
    for (int ch = blockIdx.x; ch < T / 128; ch += F.G) {
        __syncthreads();
        for (int k = 0; k < 16; ++k) {
            const int row = 128 * ch + 16 * w + k; const GAS u32x4* xr = (const GAS u32x4*)(S + (size_t)row * DM) + 2 * lane;
            float x[8]; f32x4 a = (f32x4){0.f, 0.f, 0.f, 0.f};
            g8::unpack8(xr[0], x);
#pragma unroll
            for (int i = 0; i < 8; ++i) a += wf[i] * x[i];
            g8::unpack8(xr[1], x);
#pragma unroll
            for (int i = 0; i < 8; ++i) a += wf[8 + i] * x[i];
#pragma unroll
            for (int hh = 0; hh < 4; ++hh) a[hh] = wave_sum_dpp(a[hh]);
            if (lane == 0) { f32x4 o;
#pragma unroll
                for (int hh = 0; hh < 4; ++hh) { const float z = a[hh] + bias[hh]; o[hh] = -(fmaxf(-z, 0.f) + log1pf(__expf(-fabsf(z)))); }
                *(LAS f32x4*)(lf + (16 * w + k) * 4) = o; }
        }
        __syncthreads();
        { const int tile = w >> 2, hh = w & 3; float x = lf[(tile * 64 + lane) * 4 + hh];
#pragma unroll
          for (int o = 1; o < 64; o <<= 1) { const float y = shup(x, o, lane); if (lane >= o) x += y; }
          const int row = 128 * ch + tile * 64 + lane, b = row / SEQ, s = row % SEQ;
          cl[(size_t)(b * NH + hh) * SEQ + s] = x; if (lane == 63) tt[(b * NH + hh) * 256 + (s >> 6)] = x; }
    }
    __syncthreads();
}
__device__ __forceinline__ void knorm_phase(Frame& F, const GAS bf16_t* KS) {
    const int lane = F.lane_id(), w = F.wave;
    for (int ch = blockIdx.x; ch < T / 128; ch += F.G) {
        float mx = 0.f;
        for (int k = 0; k < 16; ++k) { const int row = 128 * ch + 16 * w + k; const GAS u32x4* kr = (const GAS u32x4*)(KS + (size_t)row * DM) + 2 * lane; const u32x4 a = kr[0], b = kr[1];
            const unsigned u[8] = {a.x, a.y, a.z, a.w, b.x, b.y, b.z, b.w}; float s = 0.f;
#pragma unroll
            for (int i = 0; i < 8; ++i) { const float lo = __builtin_bit_cast(float, u[i] << 16), hi = __builtin_bit_cast(float, u[i] & 0xffff0000u); s += lo * lo + hi * hi; }
            s += shx(s, 1, lane); s += shx(s, 2, lane); s += shx(s, 4, lane); s += shx(s, 8, lane);
            mx = fmaxf(mx, s); }
        if ((lane & 15) == 0) { const int b = (128 * ch) / SEQ; (void)__hip_atomic_fetch_max(F.ctl + CW_KN2 + b * NH + (lane >> 4), __builtin_bit_cast(unsigned, mx), RLX_AGENT); }
    }
}

constexpr int AT_KB0 = 0, AT_VB0 = 32768, AT_KB1 = 66048, AT_VB1 = 98816, AT_VPANEL = 2080;
constexpr float SB_STOP = -24.f, FOX_STOP = -30.f;
typedef short s16x4 __attribute__((ext_vector_type(4)));
#define AT_TR4(r0, r1, r2, r3, addr, o0, o1, o2, o3) asm volatile("ds_read_b64_tr_b16 %0, %4 offset:%5\n\tds_read_b64_tr_b16 %1, %4 offset:%6\n\tds_read_b64_tr_b16 %2, %4 offset:%7\n\tds_read_b64_tr_b16 %3, %4 offset:%8" \
    : "=&v"(r0), "=&v"(r1), "=&v"(r2), "=&v"(r3) : "v"(addr), "i"(o0), "i"(o1), "i"(o2), "i"(o3) : "memory")
#define AT_WAIT4(r0, r1, r2, r3) asm volatile("s_waitcnt lgkmcnt(0)" : "+v"(r0), "+v"(r1), "+v"(r2), "+v"(r3) :: "memory")

template <bool FOX>
__device__ __forceinline__ void attn_phase(Frame& F, const GAS bf16_t* Q, const GAS bf16_t* Kb, const GAS bf16_t* Vb, GAS bf16_t* O) {
    LAS unsigned char* lds = F.lds;
    volatile LAS unsigned* flags = (volatile LAS unsigned*)(lds + LDS_FLAGS);
    int tid_ = F.tid_id(); asm volatile("" : "+v"(tid_));
    const int tid = tid_, w = __builtin_amdgcn_readfirstlane(tid >> 6), lane = tid & 63, fr = lane & 15, fq = lane >> 4;
    const int srow0 = tid >> 5, schunk = tid & 31;
    const unsigned kst = (unsigned)(srow0 * 512 + ((schunk ^ (srow0 & 15)) * 16));
    const unsigned vst = (unsigned)((schunk >> 1) * AT_VPANEL + srow0 * 32 + (schunk & 1) * 16);
    const unsigned vrd = (unsigned)((4 * fq + ((lane & 15) >> 2)) * 32 + 8 * (lane & 3));
    const GAS float* cl = (const GAS float*)(F.ws + WS_MISC + MS_CL); const GAS float* tt = (const GAS float*)(F.ws + WS_MISC + MS_TOT);
    for (int id = blockIdx.x; id < 8 * 128; id += F.G) {
        const int bh = id & 7, qt = id >> 3, b = bh >> 2, h = bh & 3, t0 = qt * 128;
        const size_t rowbase = (size_t)b * SEQ;
        const int tq = t0 + 16 * w + fr;
        bf16x8 qf[8];
        { const GAS bf16_t* qp = Q + (rowbase + tq) * DM + h * HD + 8 * fq;
#pragma unroll
          for (int s = 0; s < 8; ++s) qf[s] = *(const GAS bf16x8*)(qp + 32 * s); }
        f32x4 o[16];
#pragma unroll
        for (int d = 0; d < 16; ++d) o[d] = (f32x4){0.f, 0.f, 0.f, 0.f};
        float R = 0.f;
        float mrun = -1.0e30f, lsum = 0.f, cq = 0.f, qn = 0.f, KN = 0.f, gacc = 0.f;
        if constexpr (FOX) {
            float s2 = 0.f;
#pragma unroll
            for (int s = 0; s < 8; ++s)
#pragma unroll
                for (int j = 0; j < 8; ++j) { const float x = bf2f((unsigned short)qf[s][j]); s2 += x * x; }
            s2 += shx(s2, 16, lane); s2 += shx(s2, 32, lane); qn = sqrtf(s2);
            KN = sqrtf(__builtin_bit_cast(float, __hip_atomic_load(F.ctl + CW_KN2 + bh, RLX_AGENT))) * 1.002f;
            cq = cl[(size_t)bh * SEQ + tq] + ((tq >= t0 + 64) ? tt[bh * 256 + 2 * qt] : 0.f);
        }
        int kt = 2 * qt + 1, it = 0;
        u32x4 kr[4], vr[4];
        { const GAS bf16_t* kp = Kb + (rowbase + (size_t)64 * kt + srow0) * DM + h * HD + schunk * 8; const GAS bf16_t* vp = Vb + (rowbase + (size_t)64 * kt + srow0) * DM + h * HD + schunk * 8;
#pragma unroll
          for (int j = 0; j < 4; ++j) { kr[j] = *(const GAS u32x4*)(kp + (size_t)16 * j * DM); vr[j] = *(const GAS u32x4*)(vp + (size_t)16 * j * DM); } }
        for (;;) {
            const int kbuf = (it & 1) ? AT_KB1 : AT_KB0, vbuf = (it & 1) ? AT_VB1 : AT_VB0;
#pragma unroll
            for (int j = 0; j < 4; ++j) { *(LAS u32x4*)(lds + kbuf + kst + j * 8192) = kr[j]; *(LAS u32x4*)(lds + vbuf + vst + j * 512) = vr[j]; }
            __syncthreads();
            if (it >= 2) { unsigned any = 0u; const int par = (it - 1) & 1;
#pragma unroll
                for (int k = 0; k < 8; ++k) any |= flags[par * 8 + k];
                if (any == 0u) break; }
            const int kmin = 64 * kt, wmax = t0 + 16 * w + 15, wmin = t0 + 16 * w;
            f32x4 ckv[4]; float ttv = 0.f;
            if constexpr (FOX) {
#pragma unroll
                for (int blk = 0; blk < 4; ++blk) ckv[blk] = *(const GAS f32x4*)(cl + (size_t)bh * SEQ + kmin + 16 * blk + 4 * fq);
                ttv = tt[bh * 256 + (kt > 2 * qt ? 2 * qt : kt)];
                asm volatile("" ::: "memory"); }
            if (kt > 0) { const GAS bf16_t* kp = Kb + (rowbase + (size_t)64 * (kt - 1) + srow0) * DM + h * HD + schunk * 8; const GAS bf16_t* vp = Vb + (rowbase + (size_t)64 * (kt - 1) + srow0) * DM + h * HD + schunk * 8;
#pragma unroll
                for (int j = 0; j < 4; ++j) { kr[j] = *(const GAS u32x4*)(kp + (size_t)16 * j * DM); vr[j] = *(const GAS u32x4*)(vp + (size_t)16 * j * DM); } }
            const bool part = FOX ? (kmin <= wmax) : (kmin < wmax);
            if (part) {
                const bool need_mask = (kmin + 63 >= wmin);
                f32x4 s[4];
#pragma unroll
                for (int blk = 0; blk < 4; ++blk) { s[blk] = (f32x4){0.f, 0.f, 0.f, 0.f};
#pragma unroll
                    for (int st = 0; st < 8; ++st) { const bf16x8 kf = *(const LAS bf16x8*)(lds + kbuf + (16 * blk + fr) * 512 + (((4 * st + fq) ^ fr) * 16));
                        s[blk] = __builtin_amdgcn_mfma_f32_16x16x32_bf16(kf, qf[st], s[blk], 0, 0, 0); } }
                float pv[4][4];
                if constexpr (!FOX) {
                    float lm[4][4], w4[4], Tt[4], Ex[4];
#pragma unroll
                    for (int blk = 0; blk < 4; ++blk) { w4[blk] = 0.f;
#pragma unroll
                        for (int i = 0; i < 4; ++i) { const float z = s[blk][i]; const float sp = softplus_f(z); const bool valid = !need_mask || (kmin + 16 * blk + 4 * fq + i < tq);
                            lm[blk][i] = valid ? -sp : 0.f; pv[blk][i] = valid ? (z - sp) : -1.0e30f; w4[blk] += lm[blk][i]; } }
#pragma unroll
                    for (int blk = 0; blk < 4; ++blk) { const float a = shx(w4[blk], 16, lane), bq = shx(w4[blk], 32, lane), c = shx(a, 32, lane);
                        Tt[blk] = (w4[blk] + a) + (bq + c); Ex[blk] = (fq == 0) ? (a + bq + c) : (fq == 1) ? (bq + c) : (fq == 2) ? a : 0.f; }
                    float bs = 0.f;
#pragma unroll
                    for (int blk = 3; blk >= 0; --blk) { float tail = R + bs + Ex[blk];
#pragma unroll
                        for (int i = 3; i >= 0; --i) { const float e = pv[blk][i] + tail; pv[blk][i] = (e > -80.f) ? fast_exp(e) : 0.f; tail += lm[blk][i]; }
                        bs += Tt[blk]; }
                    R += bs;
                } else {
                    float base;
                    if (kt == 2 * qt + 1) base = ttv; else if (kt == 2 * qt) base = 0.f; else { gacc += ttv; base = -gacc; }
                    float mx = -1.0e30f;
#pragma unroll
                    for (int blk = 0; blk < 4; ++blk) { const f32x4 ck = ckv[blk];
#pragma unroll
                        for (int i = 0; i < 4; ++i) { const bool valid = !need_mask || (kmin + 16 * blk + 4 * fq + i <= tq); const float lg = valid ? (s[blk][i] + cq - (ck[i] + base)) : -1.0e30f; pv[blk][i] = lg; mx = fmaxf(mx, lg); } }
                    mx = fmaxf(mx, shx(mx, 16, lane)); mx = fmaxf(mx, shx(mx, 32, lane));
                    const float mnew = fmaxf(mrun, mx), al = fast_exp(mrun - mnew); float ps = 0.f;
#pragma unroll
                    for (int blk = 0; blk < 4; ++blk)
#pragma unroll
                        for (int i = 0; i < 4; ++i) { const float e = pv[blk][i] - mnew; const float p = (e > -80.f) ? fast_exp(e) : 0.f; pv[blk][i] = p; ps += p; }
                    lsum = lsum * al + ps;
                    if (__any(mnew > mrun)) {
#pragma unroll
                        for (int d = 0; d < 16; ++d) o[d] = o[d] * al; }
                    mrun = mnew;
                }
                bf16x8 pf[2];
#pragma unroll
                for (int c = 0; c < 2; ++c) { u32x4 pw; pw.x = cvt_pk_bf16(pv[2 * c][0], pv[2 * c][1]); pw.y = cvt_pk_bf16(pv[2 * c][2], pv[2 * c][3]); pw.z = cvt_pk_bf16(pv[2 * c + 1][0], pv[2 * c + 1][1]); pw.w = cvt_pk_bf16(pv[2 * c + 1][2], pv[2 * c + 1][3]);
                    pf[c] = __builtin_bit_cast(bf16x8, pw); }
                const unsigned va = (unsigned)(size_t)(lds + vbuf) + vrd;
                s16x4 c0, c1, c2, c3, n0, n1, n2, n3;
                AT_TR4(c0, c1, c2, c3, va, 0, 512, 1024, 1536);
                n0 = c0; n1 = c1; n2 = c2; n3 = c3;
#define AT_PV(db) do { AT_WAIT4(c0, c1, c2, c3); \
                    if ((db) < 15) { AT_TR4(n0, n1, n2, n3, va, ((db) + 1) * AT_VPANEL, ((db) + 1) * AT_VPANEL + 512, ((db) + 1) * AT_VPANEL + 1024, ((db) + 1) * AT_VPANEL + 1536); } \
                    { const bf16x8 v0 = __builtin_shufflevector(c0, c1, 0, 1, 2, 3, 4, 5, 6, 7), v1 = __builtin_shufflevector(c2, c3, 0, 1, 2, 3, 4, 5, 6, 7); \
                      o[db] = __builtin_amdgcn_mfma_f32_16x16x32_bf16(v0, pf[0], o[db], 0, 0, 0); o[db] = __builtin_amdgcn_mfma_f32_16x16x32_bf16(v1, pf[1], o[db], 0, 0, 0); } \
                    c0 = n0; c1 = n1; c2 = n2; c3 = n3; } while (0)
                AT_PV(0); AT_PV(1); AT_PV(2); AT_PV(3); AT_PV(4); AT_PV(5); AT_PV(6); AT_PV(7); AT_PV(8); AT_PV(9); AT_PV(10); AT_PV(11); AT_PV(12); AT_PV(13); AT_PV(14); AT_PV(15);
#undef AT_PV
            } else if constexpr (FOX) { if (kt < 2 * qt) gacc += ttv; }
            { bool cont;
              if constexpr (!FOX) cont = (R >= SB_STOP);
              else cont = (qn * KN + cq + ((kt <= 2 * qt) ? gacc : 0.f) - mrun >= FOX_STOP) || (kt > 2 * qt);
              const bool anyc = __any(cont);
              if (lane == 0) flags[(it & 1) * 8 + w] = anyc ? 1u : 0u; }
            if (kt == 0) break;
            --kt; ++it;
        }
        float inv = 1.f;
        if constexpr (FOX) { float lt = lsum; lt += shx(lt, 16, lane); lt += shx(lt, 32, lane); inv = 1.f / lt; }
        { GAS bf16_t* op = O + (rowbase + tq) * DM + h * HD + 4 * fq;
#pragma unroll
          for (int db = 0; db < 16; ++db) { u32x2 ow; ow.x = cvt_pk_bf16(o[db][0] * inv, o[db][1] * inv); ow.y = cvt_pk_bf16(o[db][2] * inv, o[db][3] * inv); *(GAS u32x2*)(op + 16 * db) = ow; } }
        __syncthreads();
    }
}

constexpr int NPH = 41;
__host__ __device__ inline bool phase_nonempty(int k) { if (k == 0) return true; const int L = (k - 1) / 10, s = (k - 1) % 10; if (s == 1) return L == 2; if (s == 5) return (L & 1) != 0; return true; }
struct Args { const float* in[N_IN]; float* out; unsigned char* ws; int ph_lo, ph_hi, sub, pad; };

__global__ void __launch_bounds__(NTHREADS, 2) mk_fwd(Args args) {
    extern __shared__ __attribute__((aligned(16))) unsigned char lds_raw[];
    Frame F;
    F.lds = (LAS unsigned char*)lds_raw;
    F.wave = __builtin_amdgcn_readfirstlane((int)threadIdx.x >> 6);
    F.G = gridDim.x; { const int bx = blockIdx.x; F.vcu = (F.G % 8 == 0) ? (bx % 8) * (F.G / 8) + bx / 8 : bx; }
    F.ws = (GAS unsigned char*)args.ws; F.ctl = (GAS unsigned*)F.ws; F.res = (GAS float*)args.out;
    for (int u = (int)threadIdx.x; u < (LDS_BYTES - LDS_CTL) / 4; u += NTHREADS) ((LAS unsigned*)(F.lds + LDS_CTL))[u] = 0u;
    __syncthreads();
    const int lo = args.ph_lo, hi = args.ph_hi;
    XcdBarrier bar; bar.bar = F.ctl + CW_BAR; bar.x = 0; bar.st = nullptr;
    if (hi - lo > 1) bar = xcd_barrier_post(F.ctl + CW_BAR, (volatile LAS unsigned*)(F.lds + LDS_CTL) + 8);
#ifndef DUP_MASK
#define DUP_MASK 0
#endif
#define DUP(n) (1 + ((DUP_MASK >> (n)) & 1))
#ifndef SITE_MASK
#define SITE_MASK 0xFFFFF
#endif
#define SITE(n) ((SITE_MASK >> (n)) & 1)
#define IN(k) (lo <= (k) && (k) < hi)
#define SEAM(k) do { if ((k) + 1 < hi) xcd_barrier(bar); } while (0)
    const int c = (int)blockIdx.x;
#define WSB(name) GAS unsigned char* name = launder_ptr(F.ws)
#define XBP(ws_, which) ((GAS bf16_t*)((ws_) + ((which) ? WS_XB1 : WS_XB0)))

    if (SITE(0) && IN(0)) { for (int rep_ = 0; rep_ < DUP(0); ++rep_) prologue_phase(F); SEAM(0); }

    for (int L = 0; L < DEPTH; ++L) {
        const int pb = 1 + 10 * L;
        {
            F.wave = launder_int(F.wave); F.ws = launder_ptr(F.ws); F.res = launder_ptr(F.res); F.ctl = (GAS unsigned*)F.ws; F.G = launder_int(F.G); }
        for (int repa_ = 0; repa_ < DUP(20); ++repa_) {
        if (SITE(1) && IN(pb + 0)) {
            WSB(ws);
            const GAS bf16_t* Wqkv = (const GAS bf16_t*)(ws + (L < 2 ? WS_WDEAD : WS_WLIVE)) + (L == 0 ? WD_QKV0 : L == 1 ? WD_QKV1 : L == 2 ? WL_QKV2 : WL_Q3);
            g8::ProbPlain P{XBP(ws, (L + 1) & 1), Wqkv, 1024, 1024, 16, T / 256, (L == 3) ? 4 : 12, F.G, c};
            g8::EpiBf16Split E{(GAS bf16_t*)(ws + WS_QA), 1024, (L == 3) ? 0 : 1024, (size_t)(WS_KS - WS_QA) / 2};
            for (int rep_ = 0; rep_ < DUP(1); ++rep_) g8::gemm_phase<g8::ProbPlain, g8::EpiBf16Split>(F.lds, P, E, F.wave);
            if (SITE(2) && L == 2) forget_phase(F, XBP(ws, (L + 1) & 1));
            SEAM(pb + 0);
        }
        if (SITE(3) && IN(pb + 1) && L == 2) { WSB(ws); knorm_phase(F, (const GAS bf16_t*)(ws + WS_KS)); SEAM(pb + 1); }
        if (IN(pb + 2)) {
            WSB(ws); GAS bf16_t* QA = (GAS bf16_t*)(ws + WS_QA); const GAS bf16_t* KS = (const GAS bf16_t*)(ws + WS_KS); const GAS bf16_t* VS = (const GAS bf16_t*)(ws + WS_VS);
            if (L < 2) { if (SITE(4)) attn_phase<false>(F, QA, KS, VS, QA); } else { if (SITE(5)) attn_phase<true>(F, QA, KS, VS, QA); }
            SEAM(pb + 2);
        }
        }
        if (SITE(6) && IN(pb + 3)) {
            WSB(ws);
            const GAS bf16_t* Wo = (const GAS bf16_t*)(ws + (L < 2 ? WS_WDEAD : WS_WLIVE)) + (L == 0 ? WD_O0 : L == 1 ? WD_O1 : L == 2 ? WL_O2 : WL_O3);
            g8::ProbPlain P{(const GAS bf16_t*)(ws + WS_QA), Wo, 1024, 1024, 16, T / 256, 4, F.G, c};
            g8::EpiResidB E{XBP(ws, (L + 1) & 1)};
            g8::gemm_phase<g8::ProbPlain, g8::EpiResidB>(F.lds, P, E, F.wave);
            SEAM(pb + 3);
        }
        if (IN(pb + 4)) { WSB(ws); GAS bf16_t* xln1 = XBP(ws, (L + 1) & 1); if (L & 1) { if (SITE(7)) ln_phase<true, true>(F, L, 0, xln1); } else { if (SITE(8)) ln_phase<false, true>(F, L, 0, xln1); } SEAM(pb + 4); }
        if (SITE(9) && IN(pb + 5) && (L & 1)) { moe_lists_phase(F); SEAM(pb + 5); }
        if (IN(pb + 6)) {
            WSB(ws); const GAS bf16_t* xln1 = XBP(ws, (L + 1) & 1);
            if (L & 1) { if (SITE(10)) { load_tab(F);
                const GAS bf16_t* Wmgu = (const GAS bf16_t*)(ws + (L == 1 ? WS_WDEAD : WS_WLIVE)) + (L == 1 ? WD_MGU0 : WL_MGU1); const GAS i32x4* elist = (const GAS i32x4*)(ws + WS_MISC + MS_ELIST);
                g8::ProbMoeGU P{xln1, Wmgu, elist, (const LAS int*)(F.lds + LDS_TAB), 1024, 1024, 16, F.G, c}; g8::EpiMoeGU E{(GAS bf16_t*)(ws + (L == 1 ? WS_QA : WS_WDEAD)), elist, (const GAS float*)(ws + WS_MISC + MS_EGATE)};
                for (int rep_ = 0; rep_ < DUP(10); ++rep_) g8::gemm_phase<g8::ProbMoeGU, g8::EpiMoeGU>(F.lds, P, E, F.wave); } }
            else if (SITE(11)) { const GAS bf16_t* Wgu = (const GAS bf16_t*)(ws + (L == 0 ? WS_WDEAD : WS_WLIVE)) + (L == 0 ? WD_GU0 : WL_GU1);
                g8::ProbPlain P{xln1, Wgu, 1024, 1024, 16, T / 256, 22, F.G, c}; g8::EpiSwiglu E{(GAS bf16_t*)(ws + (L == 0 ? WS_QA : WS_XB0)), DFF};
                for (int rep_ = 0; rep_ < DUP(11); ++rep_) g8::gemm_phase<g8::ProbPlain, g8::EpiSwiglu>(F.lds, P, E, F.wave); }
            SEAM(pb + 6);
        }
        if (IN(pb + 7)) {
            WSB(ws);
            if (L & 1) { if (SITE(12)) { load_tab(F);
                const GAS bf16_t* Wmdn = (const GAS bf16_t*)(ws + (L == 1 ? WS_WDEAD : WS_WLIVE)) + (L == 1 ? WD_MDN0 : WL_MDN1);
                g8::ProbMoeDown P{(const GAS bf16_t*)(ws + (L == 1 ? WS_QA : WS_WDEAD)), Wmdn, (const LAS int*)(F.lds + LDS_TAB), 1408, 5632, 22, F.G, c}; g8::EpiMoeDownB E{XBP(ws, (L + 1) & 1), (const GAS int*)(ws + WS_MISC + MS_PLIST)};
                g8::gemm_phase<g8::ProbMoeDown, g8::EpiMoeDownB>(F.lds, P, E, F.wave); } }
            else if (SITE(13)) { const GAS bf16_t* Wdn = (const GAS bf16_t*)(ws + (L == 0 ? WS_WDEAD : WS_WLIVE)) + (L == 0 ? WD_DN0 : WL_DN1);
                g8::ProbPlain P{(const GAS bf16_t*)(ws + (L == 0 ? WS_QA : WS_XB0)), Wdn, DFF, DFF, 44, T / 256, 4, F.G, c}; g8::EpiResidB E{XBP(ws, (L + 1) & 1)};
                g8::gemm_phase<g8::ProbPlain, g8::EpiResidB>(F.lds, P, E, F.wave); }
            SEAM(pb + 7);
        }
        if (SITE(14) && IN(pb + 8)) { WSB(ws); ln_phase<false, false>(F, L, 1, XBP(ws, (L + 1) & 1)); SEAM(pb + 8); }
        if (IN(pb + 9)) {
            if (SITE(15) && args.sub != 2) { WSB(ws); const GAS bf16_t* Wpg = (const GAS bf16_t*)(ws + (L < 2 ? WS_WDEAD : WS_WLIVE)) + (L == 0 ? WD_PG0 : L == 1 ? WD_PG1 : L == 2 ? WL_PG2 : WL_PG3);
                g8::ProbPlain P{XBP(ws, (L + 1) & 1), Wpg, 1024, 1024, 16, T / 256, 4, F.G, c}; g8::EpiGate E{XBP(ws, L & 1)}; for (int rep_ = 0; rep_ < DUP(15); ++rep_) g8::gemm_phase<g8::ProbPlain, g8::EpiGate>(F.lds, P, E, F.wave); }
            if (SITE(16) && args.sub != 1) { WSB(ws); const GAS bf16_t* Wpp = (const GAS bf16_t*)(ws + (L < 2 ? WS_WDEAD : WS_WLIVE)) + (L == 0 ? WD_PP0 : L == 1 ? WD_PP1 : L == 2 ? WL_PP2 : WL_PP3);
                g8::ProbPlain P{(const GAS bf16_t*)(ws + WS_PB), Wpp, PLE, PLE, 4, T / 256, 4, F.G, c}; g8::EpiPleB E{XBP(ws, (L + 1) & 1), XBP(ws, L & 1), L == DEPTH - 1 ? F.res : (GAS float*)nullptr}; g8::gemm_phase<g8::ProbPlain, g8::EpiPleB>(F.lds, P, E, F.wave); }
            if (pb + 9 < NPH - 1) SEAM(pb + 9);
        }
    }
#undef WSB
#undef XBP
#undef IN
#undef SEAM
}

#if MK_DEBUG
constexpr int NSAMP = 64;
#ifndef DBG_SHOW_A
#define DBG_SHOW_A -1
#define DBG_SHOW_B 75
#endif
#ifndef DBG_HYP
#define DBG_HYP 6
#endif
#ifndef DBG_FOCUS
#define DBG_FOCUS 99
#endif
__device__ __forceinline__ float wave_sum(float v) {
#pragma unroll
    for (int o = 1; o < 64; o <<= 1) v += __shfl_xor(v, o);
    return v;
}
__device__ __forceinline__ int samp_row(int k) { const int fixed[8] = {0, 1, 127, 128, SEQ - 1, SEQ, SEQ + 129, T - 1}; return k < 8 ? fixed[k] : (int)(((long long)k * 40503 + 977) % T); }
__device__ __forceinline__ void dbg_report(unsigned* ctl, int slot, float err_over_tol) { if (!(err_over_tol >= 0.f)) err_over_tol = 1.0e30f; atomicMax(ctl + CW_DBG + slot, __builtin_bit_cast(unsigned, err_over_tol)); }
__device__ __forceinline__ float dbg_dot(const bf16_t* a, int K, const float* W, size_t ldw, int n, int lane) { float s = 0.f; for (int k = lane; k < K; k += 64) s += bf2f(a[k]) * W[(size_t)k * ldw + n]; return wave_sum(s); }
__global__ void dbg_snapshot(const float* src, float* snap) { const int k = blockIdx.x, r = samp_row(k); for (int i = threadIdx.x; i < DM; i += blockDim.x) snap[(size_t)k * DM + i] = src[(size_t)r * DM + i]; }
struct DbgArgs { const float* in[N_IN]; float* res; unsigned char* ws; int phase; int pad; };
__global__ void __launch_bounds__(64) dbg_check(DbgArgs a) {
    const int k = blockIdx.x, lane = threadIdx.x, r = samp_row(k), ph = a.phase, L = (ph - 1) / 10, s = (ph - 1) % 10;
    unsigned* ctl = (unsigned*)(a.ws + WS_CTL); const float* snap = (const float*)(a.ws + WS_MISC + MS_SNAP) + (size_t)k * DM;
    const bf16_t* XBin = (const bf16_t*)(a.ws + ((L & 1) ? WS_XB1 : WS_XB0)); const bf16_t* XBl1 = (const bf16_t*)(a.ws + (((L + 1) & 1) ? WS_XB1 : WS_XB0));
    const bf16_t* QA = (const bf16_t*)(a.ws + WS_QA); const bf16_t* KS = (const bf16_t*)(a.ws + WS_KS); const bf16_t* VS = (const bf16_t*)(a.ws + WS_VS);
    if (ph == 0) {
        float e = 0.f; for (int i = lane; i < DM; i += 64) e = fmaxf(e, fabsf(bf2f(((const bf16_t*)(a.ws + WS_XB0))[(size_t)r * DM + i]) - a.in[IN_X][(size_t)r * DM + i]));
        e = fmaxf(e, __shfl_xor(e, 1)); dbg_report(ctl, ph, e / 0.05f); return; }
    if (s == 0) {
        const int NC = (L == 3) ? 1024 : 3072;
        for (int rep = 0; rep < 6; ++rep) { const int n = (k * 977 + rep * 517 + 131) % NC; const float* W; size_t ldw; int col; float sc = 1.f;
            if (L < 2) { W = a.in[IN_AQKV] + (size_t)L * 1024 * 3072; ldw = 3072; col = n; if (n < 1024) sc = 0.0625f; }
            else if (n < 1024) { W = a.in[IN_BQ] + (size_t)(L - 2) * 1024 * 1024; ldw = 1024; col = n; sc = 0.0625f; }
            else { W = a.in[IN_KVF]; ldw = 2052; col = n - 1024; }
            const float ex = dbg_dot(XBin + (size_t)r * DM, 1024, W, ldw, col, lane) * sc;
            const bf16_t* O = n < 1024 ? QA : n < 2048 ? KS : VS; const float got = bf2f(O[(size_t)r * DM + (n & 1023)]);
            dbg_report(ctl, ph, fabsf(got - ex) / (0.02f * fabsf(ex) + 0.02f)); }
        if (L == 2) {
            const int b = r / SEQ, sq = r % SEQ, hh = k & 3; float acc = 0.f;
            for (int j = (sq & ~63); j <= sq; ++j) { const float* xr = a.res + ((size_t)b * SEQ + j) * DM; float d = 0.f; for (int q = lane; q < DM; q += 64) d += xr[q] * a.in[IN_KVF][(size_t)q * 2052 + 2048 + hh];
                d = wave_sum(d) + a.in[IN_KVFB][hh]; acc += -(fmaxf(-d, 0.f) + log1pf(expf(-fabsf(d)))); }
            const float got = ((const float*)(a.ws + WS_MISC + MS_CL))[(size_t)(b * NH + hh) * SEQ + sq];
            dbg_report(ctl, ph, fabsf(got - acc) / (0.002f * fabsf(acc) + 0.002f)); }
        return; }
    if (s == 2) {
        const int hh = k & 3, b = r / SEQ, sq = r % SEQ; const size_t rb = (size_t)b * SEQ;
        float q4[4], o4[4] = {0.f, 0.f, 0.f, 0.f};
        for (int i = 0; i < 4; ++i) q4[i] = snap[hh * HD + 4 * lane + i];
        if (L < 2) { float Rr = 0.f;
            for (int t = sq - 1; t >= 0; --t) { const bf16_t* kp = KS + (rb + t) * DM + hh * HD + 4 * lane; float z = 0.f; for (int i = 0; i < 4; ++i) z += q4[i] * bf2f(kp[i]); z = wave_sum(z);
                const float sp = fmaxf(z, 0.f) + log1pf(expf(-fabsf(z))); const float aw = expf(z - sp + Rr); Rr -= sp;
                const bf16_t* vp = VS + (rb + t) * DM + hh * HD + 4 * lane; for (int i = 0; i < 4; ++i) o4[i] += aw * bf2f(vp[i]); }
        } else { const float* cl = (const float*)(a.ws + WS_MISC + MS_CL) + (size_t)(b * NH + hh) * SEQ; const float* tt = (const float*)(a.ws + WS_MISC + MS_TOT) + (b * NH + hh) * 256;
            float mx = -1.0e30f, den = 0.f;
            for (int pass = 0; pass < 2; ++pass) { double cacc = 0.0;
                for (int t = sq; t >= 0; --t) { const bf16_t* kp = KS + (rb + t) * DM + hh * HD + 4 * lane; float z = 0.f; for (int i = 0; i < 4; ++i) z += q4[i] * bf2f(kp[i]); z = wave_sum(z);
                    const float lg = z + (float)cacc;
                    if (pass == 0) mx = fmaxf(mx, lg); else { const float p = expf(lg - mx); den += p; const bf16_t* vp = VS + (rb + t) * DM + hh * HD + 4 * lane; for (int i = 0; i < 4; ++i) o4[i] += p * bf2f(vp[i]); }
                    const float lf = (t & 63) ? (cl[t] - cl[t - 1]) : cl[t]; cacc += (double)lf; } }
            for (int i = 0; i < 4; ++i) o4[i] /= den; (void)tt; }
        float em = 0.f, mg = 0.f; for (int i = 0; i < 4; ++i) { const float got = bf2f(QA[(size_t)r * DM + hh * HD + 4 * lane + i]); em = fmaxf(em, fabsf(got - o4[i])); mg = fmaxf(mg, fabsf(o4[i])); }
        for (int o = 1; o < 64; o <<= 1) { em = fmaxf(em, __shfl_xor(em, o)); mg = fmaxf(mg, __shfl_xor(mg, o)); }
        dbg_report(ctl, ph, em / (0.03f * mg + 0.003f)); return; }
    if (s == 3 || (s == 7 && !(L & 1))) {
        const bf16_t* A; const float* W; int K;
        if (s == 3) { A = QA + (size_t)r * DM; K = 1024; W = (L < 2) ? a.in[IN_AO] + (size_t)L * 1024 * 1024 : a.in[IN_BO] + (size_t)(L - 2) * 1024 * 1024; }
        else { A = (const bf16_t*)(a.ws + (L == 0 ? WS_QA : WS_XB0)) + (size_t)r * DFF; K = DFF; W = a.in[IN_FDN] + (size_t)(L >> 1) * DFF * 1024; }
        for (int rep = 0; rep < 6; ++rep) { const int n = (k * 733 + rep * 171 + 29) % 1024; const float ex = ALPHA * snap[n] + dbg_dot(A, K, W, 1024, n, lane); const float got = a.res[(size_t)r * DM + n];
            dbg_report(ctl, ph, fabsf(got - ex) / (0.01f * fabsf(ex) + 0.02f)); }
        return; }
    if (s == 4 || s == 8) {
        const int which = (s == 8); const float* g = a.in[IN_LNG] + (size_t)(L * 2 + which) * DM; const float* bb = a.in[IN_LNB] + (size_t)(L * 2 + which) * DM;
        float sm = 0.f; for (int i = lane; i < DM; i += 64) sm += snap[i]; const float mean = wave_sum(sm) / DM; float sv = 0.f; for (int i = lane; i < DM; i += 64) { const float d = snap[i] - mean; sv += d * d; }
        const float rstd = 1.f / sqrtf(wave_sum(sv) / DM + LN_EPS); const bf16_t* xo = which ? XBin : XBl1; float e = 0.f;
        for (int i = lane; i < DM; i += 64) { const float ex = (snap[i] - mean) * rstd * g[i] + bb[i]; e = fmaxf(e, fabsf(a.res[(size_t)r * DM + i] - ex) / 1e-3f); e = fmaxf(e, fabsf(bf2f(xo[(size_t)r * DM + i]) - ex) / (0.01f * fabsf(ex) + 0.01f)); }
        for (int o = 1; o < 64; o <<= 1) e = fmaxf(e, __shfl_xor(e, o));
        dbg_report(ctl, ph, e);
        if (s == 4 && (L & 1)) {
            const float* Wr = a.in[IN_MR] + (size_t)(L >> 1) * DM * NE; float lgs[NE];
            for (int e8 = 0; e8 < NE; ++e8) { float d = 0.f; for (int q = lane; q < DM; q += 64) d += a.res[(size_t)r * DM + q] * Wr[(size_t)q * NE + e8]; lgs[e8] = wave_sum(d); }
            int i1 = 0; for (int e8 = 1; e8 < NE; ++e8) if (lgs[e8] > lgs[i1]) i1 = e8; int i2 = -1; for (int e8 = 0; e8 < NE; ++e8) if (e8 != i1 && (i2 < 0 || lgs[e8] > lgs[i2])) i2 = e8;
            float third = -1.0e30f; for (int e8 = 0; e8 < NE; ++e8) if (e8 != i1 && e8 != i2) third = fmaxf(third, lgs[e8]);
            const float ex2 = expf(lgs[i2] - lgs[i1]), g1 = 1.f / (1.f + ex2), g2 = ex2 * g1;
            const i32x4 rr = ((const i32x4*)(a.ws + WS_MISC + MS_REC))[r]; const int q1 = rr.x & 0xff, q2 = (rr.x >> 8) & 0xff; const float h1 = ((const float*)(a.ws + WS_MISC + MS_GATE))[r], h2 = ((const float*)(a.ws + WS_MISC + MS_GATE))[T + r];
            if (lgs[i2] - third > 1e-3f && lgs[i1] - lgs[i2] > 1e-3f) { float bad = 0.f; if (q1 != i1 || q2 != i2) bad = 10.f; else if (fabsf(h1 - g1) > 1e-3f || fabsf(h2 - g2) > 1e-3f) bad = 5.f; dbg_report(ctl, ph, bad);
                if (L == 1 && k == 8 && lane == 0) { const float hv2[2] = {h1, h2};
                    for (int q = 0; q < 2; ++q) { const float h = hv2[q]; const unsigned bits = __builtin_bit_cast(unsigned, h); unsigned cat;
                        if (!(h == h)) cat = (bits == 0xffffffffu) ? 1u : (bits >> 31) ? 2u : 3u; else if (fabsf(h) > 3.0e38f) cat = 4u; else if (h < 0.f) cat = 5u; else if (h < 1e-30f) cat = (bits == 0u) ? 6u : 7u; else if (h > 1.f) cat = 8u; else cat = 9u;
                        (void)cat; }
                    { const unsigned bits = __builtin_bit_cast(unsigned, h1); ctl[CW_DBG + 70] = (rr.w == r) ? 9u : ((rr.w == 0) ? 3u : 1u); ctl[CW_DBG + 71] = (__builtin_bit_cast(unsigned, h2) >> 20) & 63u; (void)bits; } }
                if (L == 1) { if (lane == 0 && fabsf(h1 + h2 - 1.f) < 1e-3f) atomicAdd(ctl + CW_DBG + 46, 1u); if (lane == 0 && fabsf(h1 - g1) < 1e-3f) atomicAdd(ctl + CW_DBG + 47, 1u);
                if (lane == 0 && fabsf(h1 - g2) < 1e-3f && fabsf(h2 - g1) < 1e-3f) atomicAdd(ctl + CW_DBG + 45, 1u); if (lane == 0 && !(h1 == h1)) atomicAdd(ctl + CW_DBG + 44, 1u); } } }
        if (s == 4) { float e2 = 0.f; for (int i = lane; i < PLE; i += 64) e2 = fmaxf(e2, fabsf(bf2f(((const bf16_t*)(a.ws + WS_PB))[(size_t)r * PLE + i]) - a.in[IN_P][((size_t)L * T + r) * PLE + i]) / 0.05f);
            for (int o = 1; o < 64; o <<= 1) e2 = fmaxf(e2, __shfl_xor(e2, o)); dbg_report(ctl, ph, e2); }
        return; }
    if (s == 6 && !(L & 1)) {
        const float* W = a.in[IN_FGU] + (size_t)(L >> 1) * 1024 * 5632; const bf16_t* H = (const bf16_t*)(a.ws + (L == 0 ? WS_QA : WS_XB0));
        for (int rep = 0; rep < 6; ++rep) { const int j = (k * 389 + rep * 997 + 7) % DFF; const float g = dbg_dot(XBl1 + (size_t)r * DM, 1024, W, 5632, j, lane), u = dbg_dot(XBl1 + (size_t)r * DM, 1024, W, 5632, DFF + j, lane);
            const float ex = g / (1.f + expf(-g)) * u; const float got = bf2f(H[(size_t)r * DFF + j]); dbg_report(ctl, ph, fabsf(got - ex) / (0.03f * fabsf(ex) + 0.03f)); }
        return; }
    if (s == 6 && (L & 1)) {
        const int* tabg = (const int*)(a.ws + WS_MISC + MS_TAB); const i32x4* elist = (const i32x4*)(a.ws + WS_MISC + MS_ELIST); const i32x4* rec = (const i32x4*)(a.ws + WS_MISC + MS_REC);
        const int total = tabg[TB_EOFF + NE]; const int idx = (int)(((long long)k * 7919 + 13) % total); const i32x4 en = elist[idx];
        int e = 0; for (int q = 1; q < NE; ++q) e += (idx >= tabg[TB_EOFF + q]) ? 1 : 0;
        if (lane == 0) atomicAdd(ctl + CW_DBG + 55, 1u);
        if (en.y < 0) { if (lane == 0) atomicAdd(ctl + CW_DBG + 57, 1u); return; }
        const int tok = en.x; const i32x4 rr = rec[tok]; const int e1 = rr.x & 0xff, e2 = (rr.x >> 8) & 0xff;
        float bad = 0.f; if (e != e1 && e != e2) bad = 10.f;
        const float gate = ((const float*)(a.ws + WS_MISC + MS_EGATE))[idx]; const float gexp = (e == e1) ? ((const float*)(a.ws + WS_MISC + MS_GATE))[tok] : ((const float*)(a.ws + WS_MISC + MS_GATE))[T + tok]; if (fabsf(gate - gexp) > 1e-6f) bad = 20.f;
        if (lane == 0 && gate > 0.01f && gate < 0.999f) atomicAdd(ctl + CW_DBG + 60, 1u);
        if (lane == 0 && ((const int*)(a.ws + WS_MISC + MS_PLIST))[en.y / 1408] == tok) atomicAdd(ctl + CW_DBG + 59, 1u);
        const int half = (en.y % 1408) / DFE; if (half != ((e == (e1 < e2 ? e1 : e2)) ? 0 : 1)) bad = 30.f;
        dbg_report(ctl, ph, bad); if (lane == 0 && L == 1) { if (bad == 10.f) atomicAdd(ctl + CW_DBG + 72, 1u); if (bad == 20.f) atomicAdd(ctl + CW_DBG + 73, 1u); if (bad == 30.f) atomicAdd(ctl + CW_DBG + 74, 1u); }
        const float* Wg = a.in[IN_MGU] + (size_t)((L >> 1) * NE + e) * 1024 * 1408; const bf16_t* HS = (const bf16_t*)(a.ws + (L == 1 ? WS_QA : WS_WDEAD));
        for (int rep = 0; rep < 6; ++rep) { const int j = (k * 389 + rep * 131 + 5) % DFE; const float g = dbg_dot(XBl1 + (size_t)tok * DM, 1024, Wg, 1408, j, lane), u = dbg_dot(XBl1 + (size_t)tok * DM, 1024, Wg, 1408, DFE + j, lane);
            const float ex = gate * g / (1.f + expf(-g)) * u; const float got = bf2f(HS[(size_t)en.y + j]); const float er = fabsf(got - ex) / (0.03f * fabsf(ex) + 0.03f);
            dbg_report(ctl, ph, er); if (L == 1 && rep == 0 && lane == 0 && er <= 1.f) atomicAdd(ctl + CW_DBG + 56, 1u); if (L == 1 && rep == 0 && lane == 0 && fabsf(got) < 1e-6f) atomicAdd(ctl + CW_DBG + 75, 1u); }
        return; }
    if (s == 7 && (L & 1)) {
        __shared__ float hid[2][DFE]; __shared__ float lgs[NE];
        const float* Wr = a.in[IN_MR] + (size_t)(L >> 1) * DM * NE;
        for (int e = 0; e < NE; ++e) { float d = 0.f; for (int q = lane; q < DM; q += 64) d += snap[q] * Wr[(size_t)q * NE + e]; d = wave_sum(d); if (lane == 0) lgs[e] = d; }
        __syncthreads();
        int i1 = 0; for (int e = 1; e < NE; ++e) if (lgs[e] > lgs[i1]) i1 = e; int i2 = -1; for (int e = 0; e < NE; ++e) if (e != i1 && (i2 < 0 || lgs[e] > lgs[i2])) i2 = e;
        const float ex2 = expf(lgs[i2] - lgs[i1]), g1 = 1.f / (1.f + ex2), g2 = ex2 * g1; const int es[2] = {i1, i2}; const float gs[2] = {g1, g2};
        float third = -1.0e30f; for (int e = 0; e < NE; ++e) if (e != i1 && e != i2) third = fmaxf(third, lgs[e]);
        if (lgs[i2] - third < 1e-3f) return;
        for (int q = 0; q < 2; ++q) { const float* Wg = a.in[IN_MGU] + (size_t)((L >> 1) * NE + es[q]) * 1024 * 1408;
            for (int j = 0; j < DFE; ++j) { const float g = dbg_dot(XBl1 + (size_t)r * DM, 1024, Wg, 1408, j, lane), u = dbg_dot(XBl1 + (size_t)r * DM, 1024, Wg, 1408, DFE + j, lane);
                if (lane == 0) hid[q][j] = bf2f((unsigned short)f2bf(g / (1.f + expf(-g)) * u)); } }
        __syncthreads();
        for (int rep = 0; rep < 2; ++rep) { const int n = (lane * 16 + k + rep * 5) % 1024; float ac[2] = {0.f, 0.f};
            for (int q = 0; q < 2; ++q) { const float* Wdn = a.in[IN_MDN] + (size_t)((L >> 1) * NE + es[q]) * DFE * 1024; for (int j = 0; j < DFE; ++j) ac[q] += hid[q][j] * Wdn[(size_t)j * 1024 + n]; }
            const float base = ALPHA * snap[n]; const float got = a.res[(size_t)r * DM + n];
            const int* plist = (const int*)(a.ws + WS_MISC + MS_PLIST); const int* tabg = (const int*)(a.ws + WS_MISC + MS_TAB); const int nslot = tabg[TB_NRT] * 256; int ps = -1;
            for (int i = lane; i < nslot; i += 64) if (plist[i] == r) ps = i;
            for (int o = 1; o < 64; o <<= 1) ps = max(ps, __shfl_xor(ps, o));
            float ah = 0.f; float exact0 = fabsf(got - base);
            if (ps >= 0) { const bf16_t* HS = (const bf16_t*)(a.ws + (L == 1 ? WS_QA : WS_WDEAD)) + (size_t)ps * 1408; const int pp = tabg[TB_RT2P + (ps >> 8)]; const int ea = pp & 0xff, eb = (pp >> 8) & 0xff;
                const float* Wa = a.in[IN_MDN] + (size_t)((L >> 1) * NE + ea) * DFE * 1024; const float* Wb = a.in[IN_MDN] + (size_t)((L >> 1) * NE + eb) * DFE * 1024;
                for (int j = 0; j < DFE; ++j) ah += bf2f(HS[j]) * Wa[(size_t)j * 1024 + n] + bf2f(HS[DFE + j]) * Wb[(size_t)j * 1024 + n]; }
            const float hy[6] = {base + gs[0] * ac[0] + gs[1] * ac[1], base, base + ah, base + gs[1] * ac[1], base + ac[0] + ac[1], base + gs[1] * ac[0] + gs[0] * ac[1]};
            for (int hq = 0; hq < 6; ++hq) { float e = fabsf(got - hy[hq]) / (0.01f * fabsf(hy[hq]) + 0.02f);
                for (int o = 1; o < 64; o <<= 1) e = fmaxf(e, __shfl_xor(e, o));
                if (hq == 0) dbg_report(ctl, ph, e);
                if (ph == DBG_FOCUS && rep == 0 && lane == 0 && e <= 1.0f) atomicAdd(ctl + CW_DBG + 56 + hq, 1u); }
            for (int o = 1; o < 64; o <<= 1) exact0 = fmaxf(exact0, __shfl_xor(exact0, o));
            float ahm = fabsf(ah); for (int o = 1; o < 64; o <<= 1) ahm = fmaxf(ahm, __shfl_xor(ahm, o));
            if (ph == DBG_FOCUS && rep == 0 && lane == 0 && ahm > 0.05f) atomicAdd(ctl + CW_DBG + 61, 1u);
            if (ph == DBG_FOCUS && rep == 0 && lane == 0 && exact0 < 1e-5f) atomicAdd(ctl + CW_DBG + 62, 1u);
            if (ph == DBG_FOCUS && rep == 0 && lane == 0 && ps < 0) atomicAdd(ctl + CW_DBG + 63, 1u); }
        if (ph == DBG_FOCUS && lane == 0) atomicAdd(ctl + CW_DBG + 55, 1u);
        return; }
    if (s == 9 && a.pad == 1) {
        const float* Wg = a.in[IN_PG] + (size_t)L * 1024 * 1024;
        for (int rep = 0; rep < 6; ++rep) { const int n = (k * 613 + rep * 211 + 3) % 1024; const float gl = dbg_dot(XBin + (size_t)r * DM, 1024, Wg, 1024, n, lane); const float sg = 1.f / (1.f + expf(-gl));
            dbg_report(ctl, 41 + L, fabsf(bf2f(XBl1[(size_t)r * DM + n]) - sg) / 0.02f); }
        return; }
    if (s == 9) {
        const float* Wg = a.in[IN_PG] + (size_t)L * 1024 * 1024; const float* Wp = a.in[IN_PP] + (size_t)L * PLE * 1024; const bf16_t* pbp = (const bf16_t*)(a.ws + WS_PB) + (size_t)r * PLE;
        for (int rep = 0; rep < 6; ++rep) { const int n = (k * 613 + rep * 211 + 3) % 1024; const float gl = dbg_dot(XBin + (size_t)r * DM, 1024, Wg, 1024, n, lane), pj = dbg_dot(pbp, PLE, Wp, 1024, n, lane);
            const float sg = 1.f / (1.f + expf(-gl)); const float ex = snap[n] + pj * sg; const float got = a.res[(size_t)r * DM + n], gb = bf2f(XBl1[(size_t)r * DM + n]);
            dbg_report(ctl, ph, fabsf(got - ex) / (0.01f * fabsf(ex) + 0.01f)); dbg_report(ctl, ph, fabsf(gb - ex) / (0.02f * fabsf(ex) + 0.02f));
            if (ph == DBG_FOCUS) {
                dbg_report(ctl, 48 + 1, fabsf(got - ex) / (0.01f * fabsf(ex) + 0.01f));
                dbg_report(ctl, 48 + 2, fabsf(got - (snap[n] + pj)) / 0.02f);
                dbg_report(ctl, 48 + 3, fabsf(got - (snap[n] + sg)) / 0.02f);
                dbg_report(ctl, 48 + 4, fabsf(got - snap[n]) / 0.02f);
                dbg_report(ctl, 48 + 5, fabsf(gb - got) / (0.02f * fabsf(got) + 0.02f));
                dbg_report(ctl, 48 + 6, fabsf(got - (snap[n] + pj * 0.5f)) / 0.02f);
            } }
        return; }
}
__global__ void dbg_snap_q(const bf16_t* Q, float* snap) { const int k = blockIdx.x, r = samp_row(k); for (int i = threadIdx.x; i < DM; i += blockDim.x) snap[(size_t)k * DM + i] = bf2f(Q[(size_t)r * DM + i]); }
__global__ void dbg_poison(float* out, const unsigned* ctl, size_t n) {
    int code = 0; for (int kk = 0; kk < NPH; ++kk) { if (kk > 0 && (kk - 1) % 10 == 9 && __builtin_bit_cast(float, ctl[CW_DBG + 41 + (kk - 1) / 10]) > 1.0f) { code = 42 + (kk - 1) / 10; break; }
        if (__builtin_bit_cast(float, ctl[CW_DBG + kk]) > 1.0f) { code = kk + 1; break; } }
    if (ctl[CW_TMO] || ctl[CW_BAR + XB_TMO]) code = 60;
    if (code == 0) return;
    float V = exp2f((float)code);
    if (DBG_SHOW_A >= 0) { const unsigned n0 = ctl[CW_DBG + DBG_SHOW_A], nh = ctl[CW_DBG + DBG_SHOW_B]; V = exp2f(64.f + (float)(n0 > 60u ? 60u : n0)) * (1.f + (float)(nh > 63u ? 63u : nh) / 128.f); }
    else if (code == DBG_FOCUS + 1) {
        const unsigned n0 = ctl[CW_DBG + 63], nh = ctl[CW_DBG + 61];
        V = exp2f(64.f + (float)(n0 > 60u ? 60u : n0)) * (1.f + (float)(nh > 63u ? 63u : nh) / 128.f); }
    for (size_t i = (size_t)blockIdx.x * blockDim.x + threadIdx.x; i < n; i += (size_t)gridDim.x * blockDim.x) out[i] = V;
}
#endif

extern "C" void kernel_launch(void* const* d_in, const int* in_sizes, int n_in, void* d_out, int out_size, void* d_ws, size_t ws_size, hipStream_t stream) {
    static int grid = 0;
    if (grid == 0) {
        if (n_in != N_IN || out_size != T * DM || ws_size < WS_END) { fprintf(stderr, "kernel_launch: unexpected problem (n_in %d, out %d, ws %zu < %zu)\n", n_in, out_size, ws_size, (size_t)WS_END); grid = -1; return; }
        int dev = 0, cus = 0, per_cu = 0;
        if (hipGetDevice(&dev) != hipSuccess || hipDeviceGetAttribute(&cus, hipDeviceAttributeMultiprocessorCount, dev) != hipSuccess) { grid = -1; return; }
        if (hipFuncSetAttribute((const void*)mk_fwd, hipFuncAttributeMaxDynamicSharedMemorySize, LDS_BYTES) != hipSuccess) { fprintf(stderr, "kernel_launch: hipFuncSetAttribute failed\n"); grid = -1; return; }
        if (hipOccupancyMaxActiveBlocksPerMultiprocessor(&per_cu, (const void*)mk_fwd, NTHREADS, LDS_BYTES) != hipSuccess || per_cu < 1) { fprintf(stderr, "kernel_launch: occupancy query says %d blocks per CU\n", per_cu); }
        (void)hipGetLastError();
        grid = cus;
    }
    if (grid < 0) return;
    (void)hipMemsetAsync((char*)d_ws + WS_CTL, 0, CTL_ZERO_BYTES, stream);
    Args a{};
    for (int i = 0; i < N_IN; ++i) a.in[i] = (const float*)d_in[i];
    a.out = (float*)d_out; a.ws = (unsigned char*)d_ws;
#if !MK_DEBUG
    a.ph_lo = 0; a.ph_hi = NPH;
    hipLaunchKernelGGL(mk_fwd, dim3(grid), dim3(NTHREADS), LDS_BYTES, stream, a);
#else
    DbgArgs da{}; for (int i = 0; i < N_IN; ++i) da.in[i] = (const float*)d_in[i]; da.res = (float*)d_out; da.ws = (unsigned char*)d_ws;
    float* snap = (float*)((char*)d_ws + WS_MISC + MS_SNAP);
    for (int k = 0; k < NPH; ++k) {
        if (!phase_nonempty(k)) continue;
        const int L = (k - 1) / 10, s = (k - 1) % 10;
        if (k > 0) {
            if (s == 2) hipLaunchKernelGGL(dbg_snap_q, dim3(NSAMP), dim3(256), 0, stream, (const bf16_t*)((char*)d_ws + WS_QA), snap);
            if (s == 3) hipLaunchKernelGGL(dbg_snapshot, dim3(NSAMP), dim3(256), 0, stream, L == 0 ? (const float*)d_in[IN_X] : (const float*)d_out, snap);
            if (s == 4 || s == 7 || s == 8 || s == 9) hipLaunchKernelGGL(dbg_snapshot, dim3(NSAMP), dim3(256), 0, stream, (const float*)d_out, snap);
        }
        a.ph_lo = k; a.ph_hi = k + 1; a.sub = 0;
        if (k > 0 && s == 9) { a.sub = 1; hipLaunchKernelGGL(mk_fwd, dim3(grid), dim3(NTHREADS), LDS_BYTES, stream, a); da.phase = k; da.pad = 1; hipLaunchKernelGGL(dbg_check, dim3(NSAMP), dim3(64), 0, stream, da); da.pad = 0; a.sub = 2; }
        hipLaunchKernelGGL(mk_fwd, dim3(grid), dim3(NTHREADS), LDS_BYTES, stream, a);
        if (k == 0 || s == 0 || s == 2 || s == 3 || s == 4 || s == 6 || s == 7 || s == 8 || s == 9) { da.phase = k; hipLaunchKernelGGL(dbg_check, dim3(NSAMP), dim3(64), 0, stream, da); }
    }
    hipLaunchKernelGGL(dbg_poison, dim3(1024), dim3(256), 0, stream, (float*)d_out, (const unsigned*)d_ws, (size_t)T * DM);
#endif
}
```

```cpp
#include <hip/hip_runtime.h>
#include <cstdio>
#include <cstdint>

#ifndef MK_DEBUG
#define MK_DEBUG 0
#endif

#define LAS __attribute__((address_space(3)))
#define GAS __attribute__((address_space(1)))
typedef unsigned short bf16_t;
typedef short bf16x8 __attribute__((ext_vector_type(8)));
typedef short bf16x4 __attribute__((ext_vector_type(4)));
typedef float f32x4 __attribute__((ext_vector_type(4)));
typedef float f32x2 __attribute__((ext_vector_type(2)));
typedef unsigned u32x4 __attribute__((ext_vector_type(4)));
typedef unsigned u32x2 __attribute__((ext_vector_type(2)));
typedef int i32x4 __attribute__((ext_vector_type(4)));

constexpr int DM = 1024, NBATCH = 2, SEQ = 16384, T = NBATCH * SEQ, NH = 4, HD = 256, DFF = 2816, NE = 8, DFE = 704, PLE = 256, DEPTH = 4;
constexpr float ALPHA = 1.6817928305074292f;
constexpr float LN_EPS = 1e-5f;
constexpr int NWAVES = 8, NTHREADS = 512;
enum { IN_X = 0, IN_P, IN_AQKV, IN_AO, IN_KVF, IN_KVFB, IN_BQ, IN_BO, IN_FGU, IN_FDN, IN_MR, IN_MGU, IN_MDN, IN_PP, IN_PG, IN_LNG, IN_LNB, N_IN };

constexpr size_t MiB = 1u << 20;
constexpr size_t WS_CTL = 0, CTL_ZERO_BYTES = 1 * MiB;
constexpr size_t WS_MISC = 1 * MiB;
constexpr size_t WS_WLIVE = 8 * MiB;
constexpr size_t WS_PB = 77 * MiB;
constexpr size_t WS_XB1 = 93 * MiB, WS_XB0 = 157 * MiB;
constexpr size_t WS_WDEAD = 221 * MiB;
constexpr size_t WS_QA = 294 * MiB, WS_KS = 358 * MiB, WS_VS = 422 * MiB, WS_END = 486 * MiB;
constexpr size_t MS_REC = 0;
constexpr size_t MS_HIST = 512 * 1024;
constexpr size_t MS_ELIST = 576 * 1024;
constexpr int ELIST_CAP = 2 * T + NE * 256;
constexpr size_t MS_PLIST = MS_ELIST + (size_t)ELIST_CAP * 16;
constexpr int NPAIR = 28, PLIST_CAP = T + NPAIR * 256;
constexpr size_t MS_TAB = 2 * MiB;
constexpr size_t MS_CL = 2 * MiB + 64 * 1024;
constexpr size_t MS_TOT = MS_CL + (size_t)8 * SEQ * 4;
constexpr size_t MS_SNAP = 3 * MiB;
constexpr size_t MS_EGATE = 4 * MiB + 512 * 1024;
constexpr size_t MS_GATE = 4 * MiB;
static_assert(MS_PLIST + (size_t)PLIST_CAP * 4 <= MS_TAB && MS_TOT + 8 * 256 * 4 <= MS_SNAP, "misc map");
enum { TB_ECUM = 0  , TB_EOFF = 16  , TB_NRT = 32, TB_RT2P = 64  , TB_WORDS = 320 };
constexpr int CW_TMO = 0, CW_CODE = 1, CW_DBG = 64  , CW_KN2 = 192  , CW_BAR = 4096;

constexpr size_t WSZ_QKV = (size_t)3072 * 1024, WSZ_SQ = (size_t)1024 * 1024, WSZ_GU = (size_t)5632 * 1024, WSZ_DN = (size_t)1024 * 2816,
                 WSZ_MGU = (size_t)NE * 1536 * 1024, WSZ_MDN = (size_t)1024 * 5632, WSZ_PP = (size_t)1024 * 256;
constexpr size_t WD_QKV0 = 0, WD_O0 = WD_QKV0 + WSZ_QKV, WD_QKV1 = WD_O0 + WSZ_SQ, WD_O1 = WD_QKV1 + WSZ_QKV, WD_GU0 = WD_O1 + WSZ_SQ, WD_DN0 = WD_GU0 + WSZ_GU,
                 WD_MGU0 = WD_DN0 + WSZ_DN, WD_MDN0 = WD_MGU0 + WSZ_MGU, WD_PP0 = WD_MDN0 + WSZ_MDN, WD_PG0 = WD_PP0 + WSZ_PP, WD_PP1 = WD_PG0 + WSZ_SQ, WD_PG1 = WD_PP1 + WSZ_PP, WD_END = WD_PG1 + WSZ_SQ;
constexpr size_t WL_QKV2 = 0, WL_O2 = WL_QKV2 + WSZ_QKV, WL_Q3 = WL_O2 + WSZ_SQ, WL_O3 = WL_Q3 + WSZ_SQ, WL_GU1 = WL_O3 + WSZ_SQ, WL_DN1 = WL_GU1 + WSZ_GU,
                 WL_MGU1 = WL_DN1 + WSZ_DN, WL_MDN1 = WL_MGU1 + WSZ_MGU, WL_PP2 = WL_MDN1 + WSZ_MDN, WL_PG2 = WL_PP2 + WSZ_PP, WL_PP3 = WL_PG2 + WSZ_SQ, WL_PG3 = WL_PP3 + WSZ_PP, WL_END = WL_PG3 + WSZ_SQ;
static_assert(WD_END * 2 <= 73 * MiB && WL_END * 2 <= 69 * MiB, "weight regions");
static_assert((size_t)T * DFF * 2 <= WS_END - WS_QA && WS_XB0 + (size_t)T * DFF * 2 <= WS_KS && WS_WDEAD + (size_t)(T + NPAIR * 256) * 1408 * 2 <= WS_KS, "h overlays");

constexpr int RING_BYTES = 131072;
constexpr int LDS_CTL = 135168;
constexpr int LDS_TAB = LDS_CTL + 128;
constexpr int LDS_FLAGS = LDS_TAB + TB_WORDS * 4;
constexpr int LDS_BYTES = 147456;
static_assert(LDS_FLAGS + 64 <= LDS_BYTES, "LDS map");

#define RLX_AGENT __ATOMIC_RELAXED, __HIP_MEMORY_SCOPE_AGENT
__device__ __forceinline__ unsigned f2bf(float f) { unsigned u = __builtin_bit_cast(unsigned, f); return (u + 0x7fffu + ((u >> 16) & 1u)) >> 16; }
__device__ __forceinline__ unsigned pk2(float lo, float hi) { return f2bf(lo) | (f2bf(hi) << 16); }
__device__ __forceinline__ float bf2f(unsigned short b) { return __builtin_bit_cast(float, (unsigned)b << 16); }
typedef __bf16 bf16v2_t __attribute__((ext_vector_type(2)));
__device__ __forceinline__ unsigned cvt_pk_bf16(float lo, float hi) { bf16v2_t v; v[0] = (__bf16)lo; v[1] = (__bf16)hi; return __builtin_bit_cast(unsigned, v); }
__device__ __forceinline__ float shx(float v, int m, int lane) { return __builtin_bit_cast(float, __builtin_amdgcn_ds_bpermute((lane ^ m) << 2, __builtin_bit_cast(int, v))); }
__device__ __forceinline__ int shxi(int v, int m, int lane) { return __builtin_amdgcn_ds_bpermute((lane ^ m) << 2, v); }
__device__ __forceinline__ float shup(float v, int o, int lane) { return __builtin_bit_cast(float, __builtin_amdgcn_ds_bpermute(((lane - o) & 63) << 2, __builtin_bit_cast(int, v))); }
__device__ __forceinline__ float wave_sum(float v, int lane) {
#pragma unroll
    for (int o = 1; o < 64; o <<= 1) v += shx(v, o, lane);
    return v;
}
template <int CTRL> __device__ __forceinline__ float dpp_mov(float v) { return __builtin_bit_cast(float, __builtin_amdgcn_update_dpp(0, __builtin_bit_cast(int, v), CTRL, 0xF, 0xF, true)); }
__device__ __forceinline__ float wave_sum_dpp(float v) {
    v += dpp_mov<0xB1>(v); v += dpp_mov<0x4E>(v); v += dpp_mov<0x141>(v); v += dpp_mov<0x140>(v);
    const int b = __builtin_bit_cast(int, v);
    return (__builtin_bit_cast(float, __builtin_amdgcn_readlane(b, 0)) + __builtin_bit_cast(float, __builtin_amdgcn_readlane(b, 16))) + (__builtin_bit_cast(float, __builtin_amdgcn_readlane(b, 32)) + __builtin_bit_cast(float, __builtin_amdgcn_readlane(b, 48)));
}
__device__ __forceinline__ float fast_exp(float x) { return __builtin_amdgcn_exp2f(x * 1.4426950408889634f); }
__device__ __forceinline__ float fast_log(float x) { return __builtin_amdgcn_logf(x) * 0.6931471805599453f; }
__device__ __forceinline__ float softplus_f(float z) { return fmaxf(z, 0.f) + fast_log(1.f + fast_exp(-fabsf(z))); }
__device__ __forceinline__ float sigmoid_f(float z) { return __builtin_amdgcn_rcpf(1.f + fast_exp(-z)); }

typedef const GAS float* fptr_t;
__device__ __forceinline__ const GAS float* in_sel(int idx) { const __attribute__((address_space(4))) fptr_t* ka = (const __attribute__((address_space(4))) fptr_t*)__builtin_amdgcn_kernarg_segment_ptr(); return ka[idx]; }

template <class Tp> __device__ __forceinline__ GAS Tp* launder_ptr(GAS Tp* p) { unsigned lo = (unsigned)(unsigned long long)p, hi = (unsigned)((unsigned long long)p >> 32); asm volatile("" : "+v"(lo), "+v"(hi));
    lo = __builtin_amdgcn_readfirstlane(lo); hi = __builtin_amdgcn_readfirstlane(hi); return (GAS Tp*)(((unsigned long long)hi << 32) | lo); }
__device__ __forceinline__ int launder_int(int v) { asm volatile("" : "+v"(v)); return __builtin_amdgcn_readfirstlane(v); }

#define XB_TMO      128
#define XB_XCNT(j)  (256  + 64 * (j))
#define XB_XSUB(j)  (1280 + 64 * (j))
#define XB_XGEN(j)  (2304 + 64 * (j))
#define XB_TOP      3328
#define XB_TOPGEN   3392
#define XCD_BAR_WORDS 3456
#define XB_SPIN_CAP (1u << 18)
__device__ __forceinline__ unsigned xb_ld(GAS unsigned* p)              { return __hip_atomic_load(p, __ATOMIC_RELAXED, __HIP_MEMORY_SCOPE_AGENT); }
__device__ __forceinline__ unsigned xb_add(GAS unsigned* p, unsigned v) { return __hip_atomic_fetch_add(p, v, __ATOMIC_RELAXED, __HIP_MEMORY_SCOPE_AGENT); }
__device__ __forceinline__ unsigned xb_xcc_id() { return (unsigned)__builtin_amdgcn_s_getreg((3 << 11) | 20) & 0xFu; }
#define XB_SPIN(cond, bar) do { unsigned _sp = 0; while (cond) { __builtin_amdgcn_s_sleep(1); \
    if ((++_sp & 255u) == 0u) { if (xb_ld(&(bar)[XB_TMO])) break; if (_sp > XB_SPIN_CAP) { (void)xb_add(&(bar)[XB_TMO], 1u); break; } } } } while (0)
struct XcdBarrier { GAS unsigned* bar; unsigned x; volatile LAS unsigned* st; };
__device__ __forceinline__ XcdBarrier xcd_barrier_post(GAS unsigned* bar, volatile LAS unsigned* st) {
    XcdBarrier b; b.bar = bar; b.x = xb_xcc_id(); b.st = st;
    if (threadIdx.x == 0) (void)xb_add(&bar[XB_XCNT(b.x)], 1u);
    return b;
}
__device__ __forceinline__ void xcd_barrier_complete(GAS unsigned* bar, unsigned x, unsigned& nloc, unsigned& nx) {
    const unsigned G = gridDim.x * gridDim.y * gridDim.z;
    unsigned sum, cnt, mine, sp = 0u;
    for (;;) {
        sum = 0u; cnt = 0u; mine = 0u;
#pragma unroll
        for (unsigned j = 0; j < 16; ++j) { const unsigned c = xb_ld(&bar[XB_XCNT(j)]); sum += c; cnt += (c > 0u) ? 1u : 0u; mine = (j == x) ? c : mine; }
        if (sum == G) break;
        __builtin_amdgcn_s_sleep(1);
        if ((++sp & 255u) == 0u) { if (xb_ld(&bar[XB_TMO])) break; if (sp > XB_SPIN_CAP) { (void)xb_add(&bar[XB_TMO], 1u); break; } }
    }
    nloc = mine > 0u ? mine : 1u; nx = cnt > 0u ? cnt : 1u;
}
__device__ __forceinline__ void xcd_barrier(const XcdBarrier& b) {
    asm volatile("s_waitcnt vmcnt(0)" ::: "memory");
    __syncthreads();
    if (threadIdx.x == 0) {
        GAS unsigned* bar = b.bar;
        __builtin_amdgcn_s_waitcnt(0);
        unsigned nloc = b.st[0], nx = b.st[1];
        if (nloc == 0u) { xcd_barrier_complete(bar, b.x, nloc, nx); b.st[0] = nloc; b.st[1] = nx; }
        const unsigned old = xb_add(&bar[XB_XSUB(b.x)], 1u);
        const unsigned gen = old / nloc;
        if (old + 1u == (gen + 1u) * nloc) {
            __builtin_amdgcn_fence(__ATOMIC_RELEASE, "agent");
            asm volatile("s_waitcnt vmcnt(0)" ::: "memory");
            const unsigned og = xb_add(&bar[XB_TOP], 1u);
            const unsigned tg = og / nx;
            if (og + 1u == (tg + 1u) * nx) xb_add(&bar[XB_TOPGEN], 1u);
            else XB_SPIN(xb_ld(&bar[XB_TOPGEN]) == tg, bar);
            __builtin_amdgcn_fence(__ATOMIC_ACQUIRE, "agent");
            xb_add(&bar[XB_XGEN(b.x)], 1u);
            asm volatile("s_waitcnt vmcnt(0)" ::: "memory");
        } else {
            XB_SPIN(xb_ld(&bar[XB_XGEN(b.x)]) == gen, bar);
            __builtin_amdgcn_fence(__ATOMIC_ACQUIRE, "agent");
            asm volatile("s_waitcnt vmcnt(0)" ::: "memory");
        }
    }
    __syncthreads();
}

namespace g8 {
constexpr int BM = 256, BK = 64, HALF = 128, HTB = HALF * BK * 2, STAGE_BYTES = 8 * HTB, NXCD = 8, WGM = 8;
__host__ __device__ __forceinline__ int lds_byte(int r, int c) { const int st = (r >> 4) * 2 + (c >> 5), rr = r & 15, cc = c & 31, ob = rr * 64 + cc * 2; return st * 1024 + (ob ^ (((ob >> 9) & 1) << 5)); }
__host__ __device__ __forceinline__ void stage_rc(int b, int& R, int& C) { const int st = b / 1024, sb = b % 1024, swz = sb ^ (((sb >> 9) & 1) << 5); R = (st >> 1) * 16 + swz / 64; C = (st & 1) * 32 + (swz % 64) / 2; }
__host__ __device__ __forceinline__ int perm32(int rho) { const int n = rho >> 4, i = rho & 15; return 8 * (i >> 2) + 4 * n + (i & 3); }
struct Unit { int pm, pn, x0, x1; };
__device__ __forceinline__ bool static_order(int i, int G, int c, int nM, int nN, int& pm, int& pn) {
    const int nwg = nM * nN; const long L = (long)i * G + c; if (L >= nwg) return false;
    int wgid = (int)L; { const int q = nwg / NXCD, r = nwg % NXCD, xcd = wgid % NXCD, off = wgid / NXCD; wgid = (xcd < r ? xcd * (q + 1) : r * (q + 1) + (xcd - r) * q) + off; }
    const int nig = WGM * nN, gid = wgid / nig, fm = gid * WGM, gsz = (nM - fm) < WGM ? (nM - fm) : WGM;
    pm = fm + ((wgid % nig) % gsz); pn = (wgid % nig) / gsz; return true;
}

template <class Prob, class Epi, bool ALIGN_EPI = true>
__device__ __forceinline__ void gemm_phase(LAS unsigned char* lds, const Prob& P, const Epi& E, int wave_id) {
    int tid_; asm volatile("v_mbcnt_lo_u32_b32 %0, -1, 0\n\tv_mbcnt_hi_u32_b32 %0, -1, %0" : "=v"(tid_)); tid_ += wave_id * 64;
    const int tid = tid_, wid = __builtin_amdgcn_readfirstlane(tid >> 6), lane = tid & 63, wr = wid >> 2, wc = wid & 3, fr = lane & 15, fq = lane >> 4;
    const int nt = P.nt;
    unsigned voffA[2], voffB[2]; int Rr0 = 0; unsigned voffC = 0;
#pragma unroll
    for (int i = 0; i < 2; ++i) { int R, C; stage_rc(tid * 16 + i * 8192, R, C); const int Rb = Epi::PERM ? ((R & ~31) + perm32(R & 31)) : R;
        voffA[i] = (unsigned)(R * P.lda + C) * 2u; voffB[i] = (unsigned)(Rb * P.ldb + C) * 2u; if (i == 0) { Rr0 = R; voffC = (unsigned)C * 2u; } }
    const size_t kstep = (size_t)(BK * 2);
    const size_t hstepA = (size_t)HALF * P.lda * 2, hstepB = (size_t)HALF * P.ldb * 2;
    const unsigned ldsw = (unsigned)wid * 1024u;
    const int aoff = lds_byte(wr * 64 + fr, fq * 8), boff = lds_byte(wc * 32 + fr, fq * 8);
#define G8_SA(b, h) (((b) * 2 + (h)) * HTB)
#define G8_SB(b, h) ((4 + (b) * 2 + (h)) * HTB)
#define G8_STAGE(bufoff, gbase, voff) do { _Pragma("unroll") for (int _i = 0; _i < 2; ++_i) \
        __builtin_amdgcn_global_load_lds((const GAS unsigned*)((const GAS char*)(gbase) + (voff)[_i]), (LAS unsigned*)(lds + (bufoff) + ldsw + _i * 8192), 16, 0, 0); } while (0)
#define G8_STAGE_A(bufoff, h, kb, NX) do { if constexpr (Prob::GATHER) { const unsigned pk_ = (NX) ? gAn[h] : gAc[h]; const unsigned vo_[2] = {(pk_ & 0xffffu) * (unsigned)(P.lda * 2) + voffC, (pk_ >> 16) * (unsigned)(P.lda * 2) + voffC}; \
        G8_STAGE(bufoff, P.a_base() + (kb), vo_); } \
        else { G8_STAGE(bufoff, ((NX) ? nA : cA) + (h) * hstepA + (kb), voffA); } } while (0)
#define G8_LDA(dst, b, h) do { _Pragma("unroll") for (int m = 0; m < 4; ++m) _Pragma("unroll") for (int k = 0; k < 2; ++k) dst[m][k] = *(const LAS bf16x8*)(lds + G8_SA(b, h) + aoff + m * 2048 + k * 1024); } while (0)
#define G8_LDB(dst, b, h) do { _Pragma("unroll") for (int n = 0; n < 2; ++n) _Pragma("unroll") for (int k = 0; k < 2; ++k) dst[n][k] = *(const LAS bf16x8*)(lds + G8_SB(b, h) + boff + n * 2048 + k * 1024); } while (0)
#define G8_MMA(ai, bj, At, Bt) do { __builtin_amdgcn_s_setprio(1); _Pragma("unroll") for (int m = 0; m < 4; ++m) _Pragma("unroll") for (int n = 0; n < 2; ++n) _Pragma("unroll") for (int k = 0; k < 2; ++k) \
        acc[ai][bj][m][n] = __builtin_amdgcn_mfma_f32_16x16x32_bf16(Bt[n][k], At[m][k], acc[ai][bj][m][n], 0, 0, 0); __builtin_amdgcn_s_setprio(0); } while (0)
#define G8_WAIT_V(n) asm volatile("s_waitcnt vmcnt(" #n ")" ::: "memory")
#define G8_WAIT_L(n) asm volatile("s_waitcnt lgkmcnt(" #n ")" ::: "memory")
#define G8_BAR __builtin_amdgcn_s_barrier()
#define G8_SCHED __builtin_amdgcn_sched_barrier(0)
    Unit cur, nxt; int ui = 0;
    if (!P.next(0, cur)) return;
    f32x4 acc[2][2][4][2];
#pragma unroll
    for (int a = 0; a < 2; ++a)
#pragma unroll
        for (int b = 0; b < 2; ++b)
#pragma unroll
            for (int m = 0; m < 4; ++m)
#pragma unroll
                for (int n = 0; n < 2; ++n) acc[a][b][m][n] = (f32x4){0.f, 0.f, 0.f, 0.f};
    bf16x8 At[4][2], B0[2][2], B1[2][2];
    unsigned gAc[2], gAn[2];
    const GAS char* cA = nullptr; const GAS char* nA = nullptr;
    if constexpr (Prob::GATHER) { P.gather(cur, Rr0, gAc); } else { cA = P.a_tile(cur); }
    {
        const GAS char* b0 = P.b_ptr(cur, 0); const GAS char* b1 = P.b_ptr(cur, 1);
        G8_STAGE(G8_SB(0, 0), b0, voffB); G8_STAGE(G8_SB(0, 1), b0 + hstepB, voffB); G8_STAGE_A(G8_SA(0, 0), 0, 0, false); G8_STAGE_A(G8_SA(0, 1), 1, 0, false);
        if (wr == 1) G8_BAR;
        G8_WAIT_V(2); G8_BAR;
        G8_STAGE(G8_SB(1, 0), b1, voffB); G8_STAGE_A(G8_SA(1, 0), 0, kstep, false); G8_STAGE(G8_SB(1, 1), b1 + hstepB, voffB);
        G8_WAIT_V(6); G8_BAR;
    }
    for (;;) {
        const bool has_next = P.next(ui + 1, nxt);
        if (!has_next) nxt = cur;
        if constexpr (Prob::GATHER) { if (has_next) P.gather(nxt, Rr0, gAn); else { gAn[0] = gAc[0]; gAn[1] = gAc[1]; } }
        else { nA = P.a_tile(nxt); }
        for (int t = 0; t < nt; t += 2) {
            const bool last = (t == nt - 2);
            const size_t a1k = (size_t)(t + 1) * kstep;
            const size_t a2k = last ? 0 : (size_t)(t + 2) * kstep, a3k = last ? kstep : (size_t)(t + 3) * kstep;
            const GAS char* b2 = last ? P.b_ptr(nxt, 0) : P.b_ptr(cur, t + 2); const GAS char* b3 = last ? P.b_ptr(nxt, 1) : P.b_ptr(cur, t + 3);
            G8_LDB(B0, 0, 0); G8_LDB(B1, 0, 1); G8_SCHED; G8_LDA(At, 0, 0); G8_STAGE_A(G8_SA(1, 1), 1, a1k, false);
            G8_WAIT_V(8); G8_WAIT_L(0); G8_BAR; G8_MMA(0, 0, At, B0); G8_MMA(0, 1, At, B1); G8_BAR; G8_SCHED;
            G8_LDA(At, 0, 1); G8_STAGE(G8_SB(0, 0), b2, voffB); G8_STAGE(G8_SB(0, 1), b2 + hstepB, voffB);
            if (last) { G8_STAGE_A(G8_SA(0, 0), 0, a2k, true); } else { G8_STAGE_A(G8_SA(0, 0), 0, a2k, false); }
            G8_WAIT_V(8); G8_WAIT_L(0); G8_BAR; G8_MMA(1, 0, At, B0); G8_MMA(1, 1, At, B1); G8_BAR; G8_SCHED;
            G8_LDB(B0, 1, 0); G8_LDB(B1, 1, 1); G8_SCHED; G8_LDA(At, 1, 0);
            if (last) { G8_STAGE_A(G8_SA(0, 1), 1, a2k, true); } else { G8_STAGE_A(G8_SA(0, 1), 1, a2k, false); }
            G8_WAIT_V(8); G8_WAIT_L(0); G8_BAR; G8_MMA(0, 0, At, B0); G8_MMA(0, 1, At, B1); G8_BAR; G8_SCHED;
            G8_LDA(At, 1, 1); G8_STAGE(G8_SB(1, 0), b3, voffB); G8_STAGE(G8_SB(1, 1), b3 + hstepB, voffB);
            if (last) { G8_STAGE_A(G8_SA(1, 0), 0, a3k, true); } else { G8_STAGE_A(G8_SA(1, 0), 0, a3k, false); }
            G8_WAIT_V(8); G8_WAIT_L(0); G8_BAR; G8_MMA(1, 0, At, B0); G8_MMA(1, 1, At, B1); G8_BAR; G8_SCHED;
        }
        if constexpr (ALIGN_EPI) { if (wr == 0) G8_BAR; }
        { int l2_; asm volatile("v_mbcnt_lo_u32_b32 %0, -1, 0\n\tv_mbcnt_hi_u32_b32 %0, -1, %0" : "=v"(l2_)); E(acc, cur, wr, wc, l2_ & 15, l2_ >> 4); }
        if (!has_next) break;
#pragma unroll
        for (int a = 0; a < 2; ++a)
#pragma unroll
            for (int b = 0; b < 2; ++b)
#pragma unroll
                for (int m = 0; m < 4; ++m)
#pragma unroll
                    for (int n = 0; n < 2; ++n) acc[a][b][m][n] = (f32x4){0.f, 0.f, 0.f, 0.f};
        cur = nxt; ++ui;
        if constexpr (Prob::GATHER) { gAc[0] = gAn[0]; gAc[1] = gAn[1]; }
        else { cA = nA; }
        if constexpr (ALIGN_EPI) { if (wr == 1) G8_BAR; }
    }
    G8_WAIT_V(0);
    if constexpr (!ALIGN_EPI) { if (wr == 0) G8_BAR; }
    G8_BAR;
#undef G8_SA
#undef G8_SB
#undef G8_STAGE
#undef G8_STAGE_A
#undef G8_LDA
#undef G8_LDB
#undef G8_MMA
#undef G8_WAIT_V
#undef G8_WAIT_L
#undef G8_BAR
#undef G8_SCHED
}

struct ProbPlain {
    static constexpr bool GATHER = false;
    const GAS bf16_t* A; const GAS bf16_t* Bt; int lda, ldb, nt, nM, nN, G, c;
    __device__ __forceinline__ bool next(int i, Unit& u) const { u.x0 = 0; u.x1 = 0; return static_order(i, G, c, nM, nN, u.pm, u.pn); }
    __device__ __forceinline__ const GAS char* a_tile(const Unit& u) const { return (const GAS char*)A + (size_t)u.pm * BM * lda * 2; }
    __device__ __forceinline__ const GAS char* a_base() const { return (const GAS char*)A; }
    __device__ __forceinline__ void gather(const Unit&, int, unsigned (&)[2]) const {}
    __device__ __forceinline__ const GAS char* b_ptr(const Unit& u, int t) const { return (const GAS char*)Bt + ((size_t)u.pn * BM * ldb + (size_t)t * BK) * 2; }
};
struct ProbMoeGU {
    static constexpr bool GATHER = true;
    const GAS bf16_t* A; const GAS bf16_t* Bt; const GAS i32x4* elist; const LAS int* tab; int lda, ldb, nt, G, c;
    __device__ __forceinline__ bool next(int i, Unit& u) const {
        const int total = tab[TB_ECUM + NE]; const long L = (long)i * G + c; if (L >= total) return false;
        int wgid = (int)L; { const int q = total / NXCD, r = total % NXCD, xcd = wgid % NXCD, off = wgid / NXCD; wgid = (xcd < r ? xcd * (q + 1) : r * (q + 1) + (xcd - r) * q) + off; }
        int e = 0;
#pragma unroll
        for (int k = 1; k < NE; ++k) e += (wgid >= tab[TB_ECUM + k]) ? 1 : 0;
        const int loc = wgid - tab[TB_ECUM + e], nM = (tab[TB_ECUM + e + 1] - tab[TB_ECUM + e]) / 6;
        const int nig = WGM * 6, gid = loc / nig, fm = gid * WGM, gsz = (nM - fm) < WGM ? (nM - fm) : WGM;
        u.pm = fm + ((loc % nig) % gsz); u.pn = (loc % nig) / gsz; u.x0 = e; u.x1 = tab[TB_EOFF + e] + 256 * u.pm; return true;
    }
    __device__ __forceinline__ const GAS char* a_tile(const Unit&) const { return (const GAS char*)A; }
    __device__ __forceinline__ const GAS char* a_base() const { return (const GAS char*)A; }
    __device__ __forceinline__ void gather(const Unit& u, int R0, unsigned (&g)[2]) const {
#pragma unroll
        for (int h = 0; h < 2; ++h) { const int t0 = elist[u.x1 + h * HALF + R0].x, t1 = elist[u.x1 + h * HALF + R0 + 64].x; g[h] = (unsigned)t0 | ((unsigned)t1 << 16); }
    }
    __device__ __forceinline__ const GAS char* b_ptr(const Unit& u, int t) const { return (const GAS char*)Bt + ((size_t)(u.x0 * 1536 + u.pn * BM) * ldb + (size_t)t * BK) * 2; }
};
struct ProbMoeDown {
    static constexpr bool GATHER = false;
    const GAS bf16_t* A; const GAS bf16_t* Bt; const LAS int* tab; int lda, ldb, nt, G, c;
    __device__ __forceinline__ bool next(int i, Unit& u) const {
        const int nM = tab[TB_NRT]; if (!static_order(i, G, c, nM, 4, u.pm, u.pn)) return false;
        const int p = tab[TB_RT2P + u.pm]; u.x0 = (p & 0xff) * DFE; u.x1 = ((p >> 8) & 0xff) * DFE; return true;
    }
    __device__ __forceinline__ const GAS char* a_tile(const Unit& u) const { return (const GAS char*)A + (size_t)u.pm * BM * lda * 2; }
    __device__ __forceinline__ const GAS char* a_base() const { return (const GAS char*)A; }
    __device__ __forceinline__ void gather(const Unit&, int, unsigned (&)[2]) const {}
    __device__ __forceinline__ const GAS char* b_ptr(const Unit& u, int t) const { const int ko = (t < 11) ? (u.x0 + t * BK) : (u.x1 + (t - 11) * BK); return (const GAS char*)Bt + ((size_t)u.pn * BM * ldb + (size_t)ko) * 2; }
};

#define G8_ROWLOOP _Pragma("unroll") for (int ai = 0; ai < 2; ++ai) _Pragma("unroll") for (int m = 0; m < 4; ++m)
struct EpiBf16Split {
    static constexpr bool PERM = true;
    GAS bf16_t* O; int ldc; int split_cols; size_t split_stride;
    __device__ __forceinline__ void operator()(const f32x4 (&acc)[2][2][4][2], const Unit& u, int wr, int wc, int fr, int fq) const {
        const int row0 = u.pm * BM + wr * 64 + fr; int colt = u.pn * BM; GAS bf16_t* base = O;
        if (split_cols) { const int t = colt / split_cols; base += (size_t)t * split_stride; colt -= t * split_cols; }
        const int col0 = colt + wc * 32 + 8 * fq;
        G8_ROWLOOP { GAS bf16_t* rowp = base + (size_t)(row0 + ai * HALF + m * 16) * ldc + col0;
#pragma unroll
            for (int bj = 0; bj < 2; ++bj) { const f32x4 v0 = acc[ai][bj][m][0], v1 = acc[ai][bj][m][1];
                u32x4 w; w.x = cvt_pk_bf16(v0[0], v0[1]); w.y = cvt_pk_bf16(v0[2], v0[3]); w.z = cvt_pk_bf16(v1[0], v1[1]); w.w = cvt_pk_bf16(v1[2], v1[3]);
                *(GAS u32x4*)(rowp + bj * HALF) = w; } }
    }
};
struct EpiResid {
    static constexpr bool PERM = false;
    const GAS float* rin; GAS float* out;
    __device__ __forceinline__ void operator()(const f32x4 (&acc)[2][2][4][2], const Unit& u, int wr, int wc, int fr, int fq) const {
        const int row0 = u.pm * BM + wr * 64 + fr, col0 = u.pn * BM + wc * 32 + 4 * fq;
        G8_ROWLOOP { const size_t off = (size_t)(row0 + ai * HALF + m * 16) * DM + col0;
#pragma unroll
            for (int bj = 0; bj < 2; ++bj)
#pragma unroll
                for (int n = 0; n < 2; ++n) { const f32x4 r = *(const GAS f32x4*)(rin + off + bj * HALF + n * 16); *(GAS f32x4*)(out + off + bj * HALF + n * 16) = r * ALPHA + acc[ai][bj][m][n]; }
            asm volatile("" ::: "memory"); }
    }
};
struct EpiSwiglu {
    static constexpr bool PERM = true;
    GAS bf16_t* H; int ldh;
    __device__ __forceinline__ void operator()(const f32x4 (&acc)[2][2][4][2], const Unit& u, int wr, int wc, int fr, int fq) const {
        const int row0 = u.pm * BM + wr * 64 + fr, col0 = u.pn * HALF + wc * 32 + 8 * fq;
        G8_ROWLOOP { u32x4 w; unsigned ww[4];
#pragma unroll
            for (int n = 0; n < 2; ++n) { const f32x4 g = acc[ai][0][m][n], uu = acc[ai][1][m][n]; float hv[4];
#pragma unroll
                for (int i = 0; i < 4; ++i) hv[i] = g[i] * sigmoid_f(g[i]) * uu[i];
                ww[2 * n] = cvt_pk_bf16(hv[0], hv[1]); ww[2 * n + 1] = cvt_pk_bf16(hv[2], hv[3]); }
            w.x = ww[0]; w.y = ww[1]; w.z = ww[2]; w.w = ww[3];
            *(GAS u32x4*)(H + (size_t)(row0 + ai * HALF + m * 16) * ldh + col0) = w; }
    }
};
struct EpiGate {
    static constexpr bool PERM = true;
    GAS bf16_t* O;
    __device__ __forceinline__ void operator()(const f32x4 (&acc)[2][2][4][2], const Unit& u, int wr, int wc, int fr, int fq) const {
        const int row0 = u.pm * BM + wr * 64 + fr, col0 = u.pn * BM + wc * 32 + 8 * fq;
        G8_ROWLOOP { GAS bf16_t* rowp = O + (size_t)(row0 + ai * HALF + m * 16) * DM + col0;
#pragma unroll
            for (int bj = 0; bj < 2; ++bj) { const f32x4 v0 = acc[ai][bj][m][0], v1 = acc[ai][bj][m][1];
                u32x4 w; w.x = cvt_pk_bf16(sigmoid_f(v0[0]), sigmoid_f(v0[1])); w.y = cvt_pk_bf16(sigmoid_f(v0[2]), sigmoid_f(v0[3]));
                w.z = cvt_pk_bf16(sigmoid_f(v1[0]), sigmoid_f(v1[1])); w.w = cvt_pk_bf16(sigmoid_f(v1[2]), sigmoid_f(v1[3]));
                *(GAS u32x4*)(rowp + bj * HALF) = w; } }
    }
};
struct EpiPle {
    static constexpr bool PERM = true;
    GAS float* res; GAS bf16_t* XG;
    __device__ __forceinline__ void operator()(const f32x4 (&acc)[2][2][4][2], const Unit& u, int wr, int wc, int fr, int fq) const {
        const int row0 = u.pm * BM + wr * 64 + fr, col0 = u.pn * BM + wc * 32 + 8 * fq;
        G8_ROWLOOP { const size_t off = (size_t)(row0 + ai * HALF + m * 16) * DM + col0;
#pragma unroll
            for (int bj = 0; bj < 2; ++bj)
#pragma unroll
                for (int n = 0; n < 2; ++n) { const u32x2 gw = *(const GAS u32x2*)(XG + off + bj * HALF + 4 * n); const f32x4 r = *(const GAS f32x4*)(res + off + bj * HALF + 4 * n); const f32x4 a = acc[ai][bj][m][n]; f32x4 o;
                    o[0] = r[0] + a[0] * __builtin_bit_cast(float, gw.x << 16); o[1] = r[1] + a[1] * __builtin_bit_cast(float, gw.x & 0xffff0000u);
                    o[2] = r[2] + a[2] * __builtin_bit_cast(float, gw.y << 16); o[3] = r[3] + a[3] * __builtin_bit_cast(float, gw.y & 0xffff0000u);
                    *(GAS f32x4*)(res + off + bj * HALF + 4 * n) = o; u32x2 w; w.x = cvt_pk_bf16(o[0], o[1]); w.y = cvt_pk_bf16(o[2], o[3]); *(GAS u32x2*)(XG + off + bj * HALF + 4 * n) = w;
                    asm volatile("" ::: "memory"); } }
    }
};
struct EpiMoeGU {
    static constexpr bool PERM = true;
    GAS bf16_t* HS; const GAS i32x4* elist; const GAS float* egate;
    __device__ __forceinline__ void operator()(const f32x4 (&acc)[2][2][4][2], const Unit& u, int wr, int wc, int fr, int fq) const {
        const int j0 = u.pn * HALF + wc * 32 + 8 * fq; const bool colok = j0 < DFE;
        G8_ROWLOOP { const int sl = u.x1 + ai * HALF + wr * 64 + m * 16 + fr; const i32x4 en = elist[sl]; const float gate = egate[sl];
            if (colok && en.y >= 0) { u32x4 w; unsigned ww[4];
#pragma unroll
                for (int n = 0; n < 2; ++n) { const f32x4 g = acc[ai][0][m][n], uu = acc[ai][1][m][n]; float hv[4];
#pragma unroll
                    for (int i = 0; i < 4; ++i) hv[i] = gate * g[i] * sigmoid_f(g[i]) * uu[i];
                    ww[2 * n] = cvt_pk_bf16(hv[0], hv[1]); ww[2 * n + 1] = cvt_pk_bf16(hv[2], hv[3]); }
                w.x = ww[0]; w.y = ww[1]; w.z = ww[2]; w.w = ww[3];
                *(GAS u32x4*)(HS + (size_t)en.y + j0) = w; } }
    }
};
struct EpiMoeDown {
    static constexpr bool PERM = false;
    GAS float* res; const GAS int* plist;
    __device__ __forceinline__ void operator()(const f32x4 (&acc)[2][2][4][2], const Unit& u, int wr, int wc, int fr, int fq) const {
        const int col0 = u.pn * BM + wc * 32 + 4 * fq;
        G8_ROWLOOP { const int tok = plist[u.pm * BM + ai * HALF + wr * 64 + m * 16 + fr];
            if (tok >= 0) { const size_t off = (size_t)tok * DM + col0;
#pragma unroll
                for (int bj = 0; bj < 2; ++bj)
#pragma unroll
                    for (int n = 0; n < 2; ++n) { const f32x4 r = *(const GAS f32x4*)(res + off + bj * HALF + n * 16); *(GAS f32x4*)(res + off + bj * HALF + n * 16) = r * ALPHA + acc[ai][bj][m][n]; } }
            asm volatile("" ::: "memory"); }
    }
};
__device__ __forceinline__ void unpack8(const u32x4 w, float (&x)[8]) {
    x[0] = __builtin_bit_cast(float, w.x << 16); x[1] = __builtin_bit_cast(float, w.x & 0xffff0000u); x[2] = __builtin_bit_cast(float, w.y << 16); x[3] = __builtin_bit_cast(float, w.y & 0xffff0000u);
    x[4] = __builtin_bit_cast(float, w.z << 16); x[5] = __builtin_bit_cast(float, w.z & 0xffff0000u); x[6] = __builtin_bit_cast(float, w.w << 16); x[7] = __builtin_bit_cast(float, w.w & 0xffff0000u); }
struct EpiResidB {
    static constexpr bool PERM = true;
    GAS bf16_t* S;
    __device__ __forceinline__ void operator()(const f32x4 (&acc)[2][2][4][2], const Unit& u, int wr, int wc, int fr, int fq) const {
        const int row0 = u.pm * BM + wr * 64 + fr, col0 = u.pn * BM + wc * 32 + 8 * fq;
        G8_ROWLOOP { GAS bf16_t* rowp = S + (size_t)(row0 + ai * HALF + m * 16) * DM + col0;
#pragma unroll
            for (int bj = 0; bj < 2; ++bj) { float x[8]; unpack8(*(const GAS u32x4*)(rowp + bj * HALF), x); const f32x4 a0 = acc[ai][bj][m][0], a1 = acc[ai][bj][m][1];
                u32x4 w; w.x = cvt_pk_bf16(x[0] * ALPHA + a0[0], x[1] * ALPHA + a0[1]); w.y = cvt_pk_bf16(x[2] * ALPHA + a0[2], x[3] * ALPHA + a0[3]);
                w.z = cvt_pk_bf16(x[4] * ALPHA + a1[0], x[5] * ALPHA + a1[1]); w.w = cvt_pk_bf16(x[6] * ALPHA + a1[2], x[7] * ALPHA + a1[3]);
                *(GAS u32x4*)(rowp + bj * HALF) = w; }
            asm volatile("" ::: "memory"); }
    }
};
struct EpiMoeDownB {
    static constexpr bool PERM = true;
    GAS bf16_t* S; const GAS int* plist;
    __device__ __forceinline__ void operator()(const f32x4 (&acc)[2][2][4][2], const Unit& u, int wr, int wc, int fr, int fq) const {
        const int col0 = u.pn * BM + wc * 32 + 8 * fq;
        G8_ROWLOOP { const int tok = plist[u.pm * BM + ai * HALF + wr * 64 + m * 16 + fr];
            if (tok >= 0) { GAS bf16_t* rowp = S + (size_t)tok * DM + col0;
#pragma unroll
                for (int bj = 0; bj < 2; ++bj) { float x[8]; unpack8(*(const GAS u32x4*)(rowp + bj * HALF), x); const f32x4 a0 = acc[ai][bj][m][0], a1 = acc[ai][bj][m][1];
                    u32x4 w; w.x = cvt_pk_bf16(x[0] * ALPHA + a0[0], x[1] * ALPHA + a0[1]); w.y = cvt_pk_bf16(x[2] * ALPHA + a0[2], x[3] * ALPHA + a0[3]);
                    w.z = cvt_pk_bf16(x[4] * ALPHA + a1[0], x[5] * ALPHA + a1[1]); w.w = cvt_pk_bf16(x[6] * ALPHA + a1[2], x[7] * ALPHA + a1[3]);
                    *(GAS u32x4*)(rowp + bj * HALF) = w; } }
            asm volatile("" ::: "memory"); }
    }
};
struct EpiPleB {
    static constexpr bool PERM = true;
    const GAS bf16_t* S; GAS bf16_t* XG; GAS float* out32;
    __device__ __forceinline__ void operator()(const f32x4 (&acc)[2][2][4][2], const Unit& u, int wr, int wc, int fr, int fq) const {
        const int row0 = u.pm * BM + wr * 64 + fr, col0 = u.pn * BM + wc * 32 + 8 * fq;
        G8_ROWLOOP { const size_t off = (size_t)(row0 + ai * HALF + m * 16) * DM + col0;
#pragma unroll
            for (int bj = 0; bj < 2; ++bj) { float x[8], g[8]; unpack8(*(const GAS u32x4*)(S + off + bj * HALF), x); unpack8(*(const GAS u32x4*)(XG + off + bj * HALF), g);
                const f32x4 a0 = acc[ai][bj][m][0], a1 = acc[ai][bj][m][1]; f32x4 o0, o1;
#pragma unroll
                for (int i = 0; i < 4; ++i) { o0[i] = x[i] + a0[i] * g[i]; o1[i] = x[4 + i] + a1[i] * g[4 + i]; }
                u32x4 w; w.x = cvt_pk_bf16(o0[0], o0[1]); w.y = cvt_pk_bf16(o0[2], o0[3]); w.z = cvt_pk_bf16(o1[0], o1[1]); w.w = cvt_pk_bf16(o1[2], o1[3]);
                *(GAS u32x4*)(XG + off + bj * HALF) = w;
                if (out32) { *(GAS f32x4*)(out32 + off + bj * HALF) = o0; *(GAS f32x4*)(out32 + off + bj * HALF + 4) = o1; }
                asm volatile("" ::: "memory"); } }
    }
};
}

struct Frame {
    LAS unsigned char* lds; GAS unsigned* ctl; GAS unsigned char* ws; GAS float* res;
    int wave, vcu, G;
    __device__ __forceinline__ int lane_id() const { int l; asm volatile("v_mbcnt_lo_u32_b32 %0, -1, 0\n\tv_mbcnt_hi_u32_b32 %0, -1, %0" : "=v"(l)); return l; }
    __device__ __forceinline__ int tid_id() const { return wave * 64 + lane_id(); }
};
__device__ __forceinline__ GAS bf16_t* xb_ptr(const Frame& F, int which) { return (GAS bf16_t*)(F.ws + (which ? WS_XB1 : WS_XB0)); }

struct Job { int in_idx, Ns, nkb, n0, nblk, ldd, drow0, dk0, split, item0; float scale; long long src_off, dst_off; };
constexpr int NJOBS = 55;
struct JobTable { Job j[NJOBS]; int total; int njobs; };
constexpr JobTable make_jobs() {
    JobTable t{}; int n = 0, items = 0;
    auto add = [&](int in_idx, long long src_off, int Ns, int K, int n0, int ncols, long long dst_byte, int ldd, int drow0, int dk0, int split, float scale) {
        Job& j = t.j[n++]; j.in_idx = in_idx; j.src_off = src_off; j.Ns = Ns; j.nkb = K / 64; j.n0 = n0; j.nblk = ncols / 32; j.dst_off = dst_byte; j.ldd = ldd; j.drow0 = drow0; j.dk0 = dk0; j.split = split; j.scale = scale;
        j.item0 = items; items += j.nkb * j.nblk; };
    const long long WD = (long long)WS_WDEAD, WL = (long long)WS_WLIVE;
    const float QS = 0.0625f;
    for (int i = 0; i < 2; ++i) { const long long q = WD + 2 * (long long)(i ? WD_QKV1 : WD_QKV0), o = WD + 2 * (long long)(i ? WD_O1 : WD_O0);
        add(IN_AQKV, (long long)i * 1024 * 3072, 3072, 1024, 0, 1024, q, 1024, 0, 0, 0, QS);
        add(IN_AQKV, (long long)i * 1024 * 3072, 3072, 1024, 1024, 2048, q, 1024, 1024, 0, 0, 1.f);
        add(IN_AO, (long long)i * 1024 * 1024, 1024, 1024, 0, 1024, o, 1024, 0, 0, 0, 1.f); }
    add(IN_BQ, 0, 1024, 1024, 0, 1024, WL + 2 * (long long)WL_QKV2, 1024, 0, 0, 0, QS);
    add(IN_KVF, 0, 2052, 1024, 0, 2048, WL + 2 * (long long)WL_QKV2, 1024, 1024, 0, 0, 1.f);
    add(IN_BQ, (long long)1024 * 1024, 1024, 1024, 0, 1024, WL + 2 * (long long)WL_Q3, 1024, 0, 0, 0, QS);
    add(IN_BO, 0, 1024, 1024, 0, 1024, WL + 2 * (long long)WL_O2, 1024, 0, 0, 0, 1.f);
    add(IN_BO, (long long)1024 * 1024, 1024, 1024, 0, 1024, WL + 2 * (long long)WL_O3, 1024, 0, 0, 0, 1.f);
    for (int i = 0; i < 2; ++i) { const long long gu = i ? WL + 2 * (long long)WL_GU1 : WD + 2 * (long long)WD_GU0, dn = i ? WL + 2 * (long long)WL_DN1 : WD + 2 * (long long)WD_DN0;
        add(IN_FGU, (long long)i * 1024 * 5632, 5632, 1024, 0, 5632, gu, 1024, 0, 0, DFF, 1.f);
        add(IN_FDN, (long long)i * 2816 * 1024, 1024, 2816, 0, 1024, dn, 2816, 0, 0, 0, 1.f); }
    for (int i = 0; i < 2; ++i) for (int e = 0; e < NE; ++e) { const long long gu = i ? WL + 2 * (long long)WL_MGU1 : WD + 2 * (long long)WD_MGU0, dn = i ? WL + 2 * (long long)WL_MDN1 : WD + 2 * (long long)WD_MDN0;
        add(IN_MGU, (long long)(i * NE + e) * 1024 * 1408, 1408, 1024, 0, 1408, gu, 1024, e * 1536, 0, DFE, 1.f);
        add(IN_MDN, (long long)(i * NE + e) * 704 * 1024, 1024, 704, 0, 1024, dn, 5632, 0, e * DFE, 0, 1.f); }
    for (int i = 0; i < 4; ++i) { const long long pp = i == 0 ? WD + 2 * (long long)WD_PP0 : i == 1 ? WD + 2 * (long long)WD_PP1 : i == 2 ? WL + 2 * (long long)WL_PP2 : WL + 2 * (long long)WL_PP3;
        const long long pg = i == 0 ? WD + 2 * (long long)WD_PG0 : i == 1 ? WD + 2 * (long long)WD_PG1 : i == 2 ? WL + 2 * (long long)WL_PG2 : WL + 2 * (long long)WL_PG3;
        add(IN_PP, (long long)i * 256 * 1024, 1024, 256, 0, 1024, pp, 256, 0, 0, 0, 1.f);
        add(IN_PG, (long long)i * 1024 * 1024, 1024, 1024, 0, 1024, pg, 1024, 0, 0, 0, 1.f); }
    t.total = items; t.njobs = n; return t;
}
__device__ const JobTable g_jobs = make_jobs();
static_assert(make_jobs().njobs == NJOBS, "job count");

__device__ __forceinline__ void conv_item(const Frame& F, const Job& J, int it, LAS float* scr) {
    const int lane = F.lane_id(); const int kb = it / J.nblk, nb = it % J.nblk, k0 = 64 * kb, ncol = J.n0 + 32 * nb;
    const GAS float* W = in_sel(J.in_idx) + J.src_off;
    { f32x4 wv[8];
#pragma unroll
      for (int i = 0; i < 8; ++i) wv[i] = *(const GAS f32x4*)(W + (size_t)(k0 + (lane >> 3) + 8 * i) * J.Ns + ncol + (lane & 7) * 4);
#pragma unroll
      for (int i = 0; i < 8; ++i) { LAS float* d = scr + ((lane >> 3) + 8 * i) * 33 + (lane & 7) * 4; d[0] = wv[i][0] * J.scale; d[1] = wv[i][1] * J.scale; d[2] = wv[i][2] * J.scale; d[3] = wv[i][3] * J.scale; } }
    asm volatile("s_waitcnt lgkmcnt(0)" ::: "memory");
    int drow;
    if (J.split) { const int ty = ncol / J.split, jj = ncol % J.split; drow = J.drow0 + 256 * (jj >> 7) + 128 * ty + (jj & 127); } else drow = J.drow0 + (ncol - J.n0);
    GAS bf16_t* WT = (GAS bf16_t*)(F.ws + J.dst_off);
    const int c = lane & 7;
#pragma unroll
    for (int j = 0; j < 4; ++j) { const int n = (lane >> 3) + 8 * j; const LAS float* s = scr + (8 * c) * 33 + n;
        u32x4 o; o.x = pk2(s[0 * 33], s[1 * 33]); o.y = pk2(s[2 * 33], s[3 * 33]); o.z = pk2(s[4 * 33], s[5 * 33]); o.w = pk2(s[6 * 33], s[7 * 33]);
        *(GAS u32x4*)(WT + (size_t)(drow + n) * J.ldd + J.dk0 + k0 + 8 * c) = o; }
    asm volatile("s_waitcnt lgkmcnt(0)" ::: "memory");
}
__device__ __forceinline__ void prologue_phase(Frame& F) {
    LAS float* scr = (LAS float*)(F.lds + F.wave * 16384);
    const int gw = F.vcu * NWAVES + F.wave, NGW = F.G * NWAVES;
    const int total = g_jobs.total;
    for (int it = gw; it < total; it += NGW) {
        int jn = 0;
        for (int k = 1; k < NJOBS; ++k) jn += (it >= g_jobs.j[k].item0) ? 1 : 0;
        jn = __builtin_amdgcn_readfirstlane(jn);
        conv_item(F, g_jobs.j[jn], it - g_jobs.j[jn].item0, scr);
    }
    { const size_t gt = (size_t)blockIdx.x * NTHREADS + F.tid_id(), gs = (size_t)F.G * NTHREADS;
      for (size_t i = gt; i < (size_t)2 * NE * 2 * 64 * 128; i += gs) {
          const int ch = (int)(i & 127), row = (int)((i >> 7) & 63), gu = (int)((i >> 13) & 1), e = (int)((i >> 14) & 7), li = (int)(i >> 17);
          GAS bf16_t* base = (GAS bf16_t*)(F.ws + (li ? WS_WLIVE + 2 * WL_MGU1 : WS_WDEAD + 2 * WD_MGU0));
          *(GAS u32x4*)(base + (size_t)(e * 1536 + 1280 + 128 * gu + 64 + row) * 1024 + ch * 8) = (u32x4){0u, 0u, 0u, 0u}; } }
    GAS bf16_t* xb = xb_ptr(F, 1);
    { const int ln = F.lane_id();
      for (int m = gw; m < T; m += 2 * NGW) {
          const GAS f32x4* xa = (const GAS f32x4*)(in_sel(IN_X) + (size_t)m * DM) + ln; const GAS f32x4* xc = (const GAS f32x4*)(in_sel(IN_X) + (size_t)(m + NGW) * DM) + ln;
          GAS u32x2* oa = (GAS u32x2*)(xb + (size_t)m * DM) + ln; GAS u32x2* oc = (GAS u32x2*)(xb + (size_t)(m + NGW) * DM) + ln;
          f32x4 va[4], vc[4];
#pragma unroll
          for (int j = 0; j < 4; ++j) { va[j] = xa[64 * j]; vc[j] = xc[64 * j]; }
#pragma unroll
          for (int j = 0; j < 4; ++j) { u32x2 o; o.x = cvt_pk_bf16(va[j][0], va[j][1]); o.y = cvt_pk_bf16(va[j][2], va[j][3]); oa[64 * j] = o; o.x = cvt_pk_bf16(vc[j][0], vc[j][1]); o.y = cvt_pk_bf16(vc[j][2], vc[j][3]); oc[64 * j] = o; } } }
}

template <bool ROUTER, bool CVT_P>
__device__ __forceinline__ void ln_phase(Frame& F, int L, int which, GAS bf16_t* S) {
    int tid_ = F.tid_id(); asm volatile("" : "+v"(tid_));
    const int lane = tid_ & 63, w = __builtin_amdgcn_readfirstlane(tid_ >> 6);
    const GAS f32x4* gp = (const GAS f32x4*)(in_sel(IN_LNG) + (size_t)(L * 2 + which) * DM) + 4 * lane; const GAS f32x4* bp = (const GAS f32x4*)(in_sel(IN_LNB) + (size_t)(L * 2 + which) * DM) + 4 * lane;
    f32x4 gg[4], bb[4];
#pragma unroll
    for (int j = 0; j < 4; ++j) { gg[j] = gp[j]; bb[j] = bp[j]; }
    LAS f32x4* wrl = (LAS f32x4*)(F.lds + 1024);
    if constexpr (ROUTER) { const GAS float* Wr = in_sel(IN_MR) + (size_t)(L >> 1) * DM * NE;
        __syncthreads();
        for (int i = w; i < 16; i += NWAVES) { const int k = 16 * lane + i;
            wrl[(i * 2 + 0) * 64 + lane] = *(const GAS f32x4*)(Wr + (size_t)k * NE); wrl[(i * 2 + 1) * 64 + lane] = *(const GAS f32x4*)(Wr + (size_t)k * NE + 4); }
        __syncthreads(); }
    LAS int* hist = (LAS int*)F.lds;
    for (int ch = blockIdx.x; ch < T / 128; ch += F.G) {
        if constexpr (ROUTER) { __syncthreads(); if (tid_ < 40) hist[tid_] = 0; __syncthreads(); }
        u32x4 na, nb, ma, mb; f32x4 npv = (f32x4){0.f, 0.f, 0.f, 0.f}, np2 = npv;
        { const GAS u32x4* x0 = (const GAS u32x4*)(S + (size_t)(128 * ch + 16 * w) * DM) + 2 * lane; na = x0[0]; nb = x0[1]; ma = x0[128]; mb = x0[129];
          if constexpr (CVT_P) { const GAS f32x4* p0 = (const GAS f32x4*)(in_sel(IN_P) + ((size_t)L * T + 128 * ch + 16 * w) * PLE) + lane; npv = p0[0]; np2 = p0[64]; } }
        for (int k = 0; k < 16; ++k) {
            const int row = 128 * ch + 16 * w + k;
            GAS u32x4* xr = (GAS u32x4*)(S + (size_t)row * DM) + 2 * lane;
            float v[16]; { float t8[8]; g8::unpack8(na, t8);
#pragma unroll
                for (int i = 0; i < 8; ++i) v[i] = t8[i];
                g8::unpack8(nb, t8);
#pragma unroll
                for (int i = 0; i < 8; ++i) v[8 + i] = t8[i]; }
            const f32x4 pv = npv; na = ma; nb = mb; npv = np2;
            if (k < 14) { ma = xr[256]; mb = xr[257]; if constexpr (CVT_P) np2 = *((const GAS f32x4*)(in_sel(IN_P) + ((size_t)L * T + row + 2) * PLE) + lane); }
            float s = 0.f;
#pragma unroll
            for (int i = 0; i < 16; ++i) s += v[i];
            const float mean = wave_sum_dpp(s) * (1.f / DM); float s2 = 0.f;
#pragma unroll
            for (int i = 0; i < 16; ++i) { v[i] -= mean; s2 += v[i] * v[i]; }
            const float rstd = 1.f / sqrtf(wave_sum_dpp(s2) * (1.f / DM) + LN_EPS);
#pragma unroll
            for (int i = 0; i < 16; ++i) v[i] = v[i] * rstd * gg[i >> 2][i & 3] + bb[i >> 2][i & 3];
            { u32x4 o; o.x = cvt_pk_bf16(v[0], v[1]); o.y = cvt_pk_bf16(v[2], v[3]); o.z = cvt_pk_bf16(v[4], v[5]); o.w = cvt_pk_bf16(v[6], v[7]); xr[0] = o;
              o.x = cvt_pk_bf16(v[8], v[9]); o.y = cvt_pk_bf16(v[10], v[11]); o.z = cvt_pk_bf16(v[12], v[13]); o.w = cvt_pk_bf16(v[14], v[15]); xr[1] = o; }
            if constexpr (CVT_P) { u32x2 o; o.x = cvt_pk_bf16(pv[0], pv[1]); o.y = cvt_pk_bf16(pv[2], pv[3]);
                *((GAS u32x2*)((GAS bf16_t*)(F.ws + WS_PB) + (size_t)row * PLE) + lane) = o; }
            if constexpr (ROUTER) {
                float lg[NE];
#pragma unroll
                for (int e = 0; e < NE; ++e) lg[e] = 0.f;
#pragma unroll
                for (int i = 0; i < 16; ++i) { const float xv = v[i]; const f32x4 w0 = wrl[(i * 2 + 0) * 64 + lane], w1 = wrl[(i * 2 + 1) * 64 + lane];
#pragma unroll
                    for (int e = 0; e < 4; ++e) { lg[e] += xv * w0[e]; lg[4 + e] += xv * w1[e]; } }
#pragma unroll
                for (int e = 0; e < NE; ++e) lg[e] = wave_sum_dpp(lg[e]);
                int i1 = 0; float v1 = lg[0];
#pragma unroll
                for (int e = 1; e < NE; ++e) if (lg[e] > v1) { v1 = lg[e]; i1 = e; }
                int i2 = -1; float v2 = -3.0e38f;
#pragma unroll
                for (int e = 0; e < NE; ++e) if (e != i1 && lg[e] > v2) { v2 = lg[e]; i2 = e; }
                const float ex = fast_exp(v2 - v1), g1 = __builtin_amdgcn_rcpf(1.f + ex), g2 = 1.f - g1;
                const int ea = i1 < i2 ? i1 : i2, eb = i1 < i2 ? i2 : i1, pid = ea * (15 - ea) / 2 + eb - ea - 1;
                if (lane == 0) { GAS int* rp = (GAS int*)(F.ws + WS_MISC + MS_REC) + (size_t)row * 4; GAS float* gpp = (GAS float*)(F.ws + WS_MISC + MS_GATE);
                    rp[0] = i1 | (i2 << 8) | (pid << 16); rp[1] = 0; rp[2] = 0; rp[3] = row; gpp[row] = g1; gpp[T + row] = g2;
                    __hip_atomic_fetch_add(hist + i1, 1, __ATOMIC_RELAXED, __HIP_MEMORY_SCOPE_WORKGROUP); __hip_atomic_fetch_add(hist + i2, 1, __ATOMIC_RELAXED, __HIP_MEMORY_SCOPE_WORKGROUP);
                    __hip_atomic_fetch_add(hist + 8 + pid, 1, __ATOMIC_RELAXED, __HIP_MEMORY_SCOPE_WORKGROUP); }
            }
        }
        if constexpr (ROUTER) { __syncthreads(); if (tid_ < 40) ((GAS int*)(F.ws + WS_MISC + MS_HIST))[ch * 40 + tid_] = hist[tid_]; }
    }
}

__device__ __forceinline__ int pad256(int v) { return (v + 255) & ~255; }
__device__ __forceinline__ void moe_lists_phase(Frame& F) {
    LAS int* pre = (LAS int*)F.lds; LAS int* tot = pre + 40; LAS int* eoff = tot + 40; LAS int* poff = eoff + 16; LAS int* recs = poff + 32; LAS int* tabl = recs + 128;
    const GAS int* hist = (const GAS int*)(F.ws + WS_MISC + MS_HIST);
    const GAS i32x4* rec = (const GAS i32x4*)(F.ws + WS_MISC + MS_REC);
    GAS i32x4* elist = (GAS i32x4*)(F.ws + WS_MISC + MS_ELIST); GAS int* plist = (GAS int*)(F.ws + WS_MISC + MS_PLIST);
    int tid_ = F.tid_id(); asm volatile("" : "+v"(tid_));
    const int lane = tid_ & 63, w = F.wave, tid = tid_;
    bool first = true;
    for (int ch = blockIdx.x; ch < T / 128; ch += F.G) {
        __syncthreads();
        for (int col = w; col < 36; col += NWAVES) { int sp = 0, st = 0;
#pragma unroll
            for (int k = 0; k < 4; ++k) { const int c2 = lane + 64 * k; const int v = hist[c2 * 40 + col]; st += v; sp += (c2 < ch) ? v : 0; }
#pragma unroll
            for (int o = 1; o < 64; o <<= 1) { sp += shxi(sp, o, lane); st += shxi(st, o, lane); }
            if (lane == 0) { pre[col] = sp; tot[col] = st; } }
        __syncthreads();
        if (tid == 0) {
            int acc = 0, ucum = 0;
            for (int e = 0; e < NE; ++e) { eoff[e] = acc; tabl[TB_EOFF + e] = acc; tabl[TB_ECUM + e] = ucum; const int p = pad256(tot[e]); acc += p; ucum += 6 * (p >> 8); }
            eoff[NE] = acc; tabl[TB_EOFF + NE] = acc; tabl[TB_ECUM + NE] = ucum;
            int pacc = 0, pid = 0;
            for (int a = 0; a < NE - 1; ++a) for (int b = a + 1; b < NE; ++b) { poff[pid] = pacc; pacc += pad256(tot[8 + pid]); ++pid; }
            poff[NPAIR] = pacc; tabl[TB_NRT] = pacc >> 8;
        }
        __syncthreads();
        if (tid < 192) { const int r8 = tid << 8; int p = 0;
            for (int k = 1; k < NPAIR; ++k) p += (r8 >= poff[k]) ? 1 : 0;
            int a = 0, rem = p; while (rem >= NE - 1 - a) { rem -= NE - 1 - a; ++a; }
            tabl[TB_RT2P + tid] = a | ((a + 1 + rem) << 8); }
        __syncthreads();
        if (ch == 0) { for (int i = tid; i < TB_WORDS; i += NTHREADS) ((GAS int*)(F.ws + WS_MISC + MS_TAB))[i] = tabl[i]; }
        if (tid < 128) recs[tid] = rec[128 * ch + tid].x;
        __syncthreads();
        if (tid < 128) {
            const int token = 128 * ch + tid; const i32x4 r = rec[token]; const int e1 = r.x & 0xff, e2 = (r.x >> 8) & 0xff, pid = (r.x >> 16) & 0xff;
            int r1 = 0, r2 = 0, rp = 0;
            for (int j = 0; j < tid; ++j) { const int o = recs[j]; const int o1 = o & 0xff, o2 = (o >> 8) & 0xff, op = (o >> 16) & 0xff;
                r1 += ((o1 == e1) | (o2 == e1)) ? 1 : 0; r2 += ((o1 == e2) | (o2 == e2)) ? 1 : 0; rp += (op == pid) ? 1 : 0; }
            const int pslot = poff[pid] + pre[8 + pid] + rp; plist[pslot] = token;
            i32x4 en; en.x = token; en.w = 0;
            const GAS float* gp = (const GAS float*)(F.ws + WS_MISC + MS_GATE);
            GAS float* eg = (GAS float*)(F.ws + WS_MISC + MS_EGATE); en.z = 0;
            { const int sl = eoff[e1] + pre[e1] + r1; en.y = pslot * 1408 + (e1 < e2 ? 0 : DFE); elist[sl] = en; eg[sl] = gp[token]; }
            { const int sl = eoff[e2] + pre[e2] + r2; en.y = pslot * 1408 + (e2 < e1 ? 0 : DFE); elist[sl] = en; eg[sl] = gp[T + token]; }
        }
        if (first) {
            first = false; const int gt = blockIdx.x * NTHREADS + tid, gs = F.G * NTHREADS;
            for (int e = 0; e < NE; ++e) for (int i = eoff[e] + tot[e] + gt; i < eoff[e + 1]; i += gs) elist[i] = (i32x4){0, -1, 0, 0};
            for (int p = 0; p < NPAIR; ++p) for (int i = poff[p] + tot[8 + p] + gt; i < poff[p + 1]; i += gs) plist[i] = -1;
        }
    }
    __syncthreads();
}
__device__ __forceinline__ void load_tab(Frame& F) {
    __syncthreads();
    for (int i = F.tid_id(); i < TB_WORDS; i += NTHREADS) ((LAS int*)(F.lds + LDS_TAB))[i] = ((const GAS int*)(F.ws + WS_MISC + MS_TAB))[i];
    __syncthreads();
}

__device__ __forceinline__ void forget_phase(Frame& F, const GAS bf16_t* S) {
    int tid_ = F.tid_id(); asm volatile("" : "+v"(tid_));
    const int lane = tid_ & 63, w = __builtin_amdgcn_readfirstlane(tid_ >> 6);
    const GAS float* Wf = in_sel(IN_KVF);
    f32x4 wf[16];
#pragma unroll
    for (int i = 0; i < 16; ++i) wf[i] = *(const GAS f32x4*)(Wf + (size_t)(16 * lane + i) * 2052 + 2048);
    const f32x4 bias = *(const GAS f32x4*)in_sel(IN_KVFB);
    LAS float* lf = (LAS float*)F.lds;
    GAS float* cl = (GAS float*)(F.ws + WS_MISC + MS_CL); GAS float* tt = (GAS float*)(F.ws + WS_MISC + MS_TOT);
    for (int ch = blockIdx.x; ch < T / 128; ch += F.G) {
        __syncthreads();
        for (int k = 0; k < 16; ++k) {
            const int row = 128 * ch + 16 * w + k; const GAS u32x4* xr = (const GAS u32x4*)(S + (size_t)row * DM) + 2 * lane;
            float x[8]; f32x4 a = (f32x4){0.f, 0.f, 0.f, 0.f};
            g8::unpack8(xr[0], x);
#pragma unroll
            for (int i = 0; i < 8; ++i) a += wf[i] * x[i];
            g8::unpack8(xr[1], x);
#pragma unroll
            for (int i = 0; i < 8; ++i) a += wf[8 + i] * x[i];
#pragma unroll
            for (int hh = 0; hh < 4; ++hh) a[hh] = wave_sum_dpp(a[hh]);
            if (lane == 0) { f32x4 o;
#pragma unroll
                for (int hh = 0; hh < 4; ++hh) { const float z = a[hh] + bias[hh]; o[hh] = -(fmaxf(-z, 0.f) + log1pf(__expf(-fabsf(z)))); }
                *(LAS f32x4*)(lf + (16 * w + k) * 4) = o; }
        }
        __syncthreads();
        { const int tile = w >> 2, hh = w & 3; float x = lf[(tile * 64 + lane) * 4 + hh];
#pragma unroll
          for (int o = 1; o < 64; o <<= 1) { const float y = shup(x, o, lane); if (lane >= o) x += y; }
          const int row = 128 * ch + tile * 64 + lane, b = row / SEQ, s = row % SEQ;
          cl[(size_t)(b * NH + hh) * SEQ + s] = x; if (lane == 63) tt[(b * NH + hh) * 256 + (s >> 6)] = x; }
    }
    __syncthreads();
}
__device__ __forceinline__ void knorm_phase(Frame& F, const GAS bf16_t* KS) {
    const int lane = F.lane_id(), w = F.wave;
    for (int ch = blockIdx.x; ch < T / 128; ch += F.G) {
        float mx = 0.f;
        for (int k = 0; k < 16; ++k) { const int row = 128 * ch + 16 * w + k; const GAS u32x4* kr = (const GAS u32x4*)(KS + (size_t)row * DM) + 2 * lane; const u32x4 a = kr[0], b = kr[1];
            const unsigned u[8] = {a.x, a.y, a.z, a.w, b.x, b.y, b.z, b.w}; float s = 0.f;
#pragma unroll
            for (int i = 0; i < 8; ++i) { const float lo = __builtin_bit_cast(float, u[i] << 16), hi = __builtin_bit_cast(float, u[i] & 0xffff0000u); s += lo * lo + hi * hi; }
            s += shx(s, 1, lane); s += shx(s, 2, lane); s += shx(s, 4, lane); s += shx(s, 8, lane);
            mx = fmaxf(mx, s); }
        if ((lane & 15) == 0) { const int b = (128 * ch) / SEQ; (void)__hip_atomic_fetch_max(F.ctl + CW_KN2 + b * NH + (lane >> 4), __builtin_bit_cast(unsigned, mx), RLX_AGENT); }
    }
}

constexpr int AT_KB0 = 0, AT_VB0 = 32768, AT_KB1 = 66048, AT_VB1 = 98816, AT_VPANEL = 2080;
constexpr float SB_STOP = -24.f, FOX_STOP = -30.f;
typedef short s16x4 __attribute__((ext_vector_type(4)));
#define AT_TR4(r0, r1, r2, r3, addr, o0, o1, o2, o3) asm volatile("ds_read_b64_tr_b16 %0, %4 offset:%5\n\tds_read_b64_tr_b16 %1, %4 offset:%6\n\tds_read_b64_tr_b16 %2, %4 offset:%7\n\tds_read_b64_tr_b16 %3, %4 offset:%8" \
    : "=&v"(r0), "=&v"(r1), "=&v"(r2), "=&v"(r3) : "v"(addr), "i"(o0), "i"(o1), "i"(o2), "i"(o3) : "memory")
#define AT_WAIT4(r0, r1, r2, r3) asm volatile("s_waitcnt lgkmcnt(0)" : "+v"(r0), "+v"(r1), "+v"(r2), "+v"(r3) :: "memory")

template <bool FOX>
__device__ __forceinline__ void attn_phase(Frame& F, const GAS bf16_t* Q, const GAS bf16_t* Kb, const GAS bf16_t* Vb, GAS bf16_t* O) {
    LAS unsigned char* lds = F.lds;
    volatile LAS unsigned* flags = (volatile LAS unsigned*)(lds + LDS_FLAGS);
    int tid_ = F.tid_id(); asm volatile("" : "+v"(tid_));
    const int tid = tid_, w = __builtin_amdgcn_readfirstlane(tid >> 6), lane = tid & 63, fr = lane & 15, fq = lane >> 4;
    const int srow0 = tid >> 5, schunk = tid & 31;
    const unsigned kst = (unsigned)(srow0 * 512 + ((schunk ^ (srow0 & 15)) * 16));
    const unsigned vst = (unsigned)((schunk >> 1) * AT_VPANEL + srow0 * 32 + (schunk & 1) * 16);
    const unsigned vrd = (unsigned)((4 * fq + ((lane & 15) >> 2)) * 32 + 8 * (lane & 3));
    const GAS float* cl = (const GAS float*)(F.ws + WS_MISC + MS_CL); const GAS float* tt = (const GAS float*)(F.ws + WS_MISC + MS_TOT);
    for (int id = blockIdx.x; id < 8 * 128; id += F.G) {
        const int bh = id & 7, qt = id >> 3, b = bh >> 2, h = bh & 3, t0 = qt * 128;
        const size_t rowbase = (size_t)b * SEQ;
        const int tq = t0 + 16 * w + fr;
        bf16x8 qf[8];
        { const GAS bf16_t* qp = Q + (rowbase + tq) * DM + h * HD + 8 * fq;
#pragma unroll
          for (int s = 0; s < 8; ++s) qf[s] = *(const GAS bf16x8*)(qp + 32 * s); }
        f32x4 o[16];
#pragma unroll
        for (int d = 0; d < 16; ++d) o[d] = (f32x4){0.f, 0.f, 0.f, 0.f};
        float R = 0.f;
        float mrun = -1.0e30f, lsum = 0.f, cq = 0.f, qn = 0.f, KN = 0.f, gacc = 0.f;
        if constexpr (FOX) {
            float s2 = 0.f;
#pragma unroll
            for (int s = 0; s < 8; ++s)
#pragma unroll
                for (int j = 0; j < 8; ++j) { const float x = bf2f((unsigned short)qf[s][j]); s2 += x * x; }
            s2 += shx(s2, 16, lane); s2 += shx(s2, 32, lane); qn = sqrtf(s2);
            KN = sqrtf(__builtin_bit_cast(float, __hip_atomic_load(F.ctl + CW_KN2 + bh, RLX_AGENT))) * 1.002f;
            cq = cl[(size_t)bh * SEQ + tq] + ((tq >= t0 + 64) ? tt[bh * 256 + 2 * qt] : 0.f);
        }
        int kt = 2 * qt + 1, it = 0; bool wdone = false;
        u32x4 kr[4], vr[4];
        { const GAS bf16_t* kp = Kb + (rowbase + (size_t)64 * kt + srow0) * DM + h * HD + schunk * 8; const GAS bf16_t* vp = Vb + (rowbase + (size_t)64 * kt + srow0) * DM + h * HD + schunk * 8;
#pragma unroll
          for (int j = 0; j < 4; ++j) { kr[j] = *(const GAS u32x4*)(kp + (size_t)16 * j * DM); vr[j] = *(const GAS u32x4*)(vp + (size_t)16 * j * DM); } }
        for (;;) {
            const int kbuf = (it & 1) ? AT_KB1 : AT_KB0, vbuf = (it & 1) ? AT_VB1 : AT_VB0;
#pragma unroll
            for (int j = 0; j < 4; ++j) { *(LAS u32x4*)(lds + kbuf + kst + j * 8192) = kr[j]; *(LAS u32x4*)(lds + vbuf + vst + j * 512) = vr[j]; }
            __syncthreads();
            if (it >= 2) { unsigned any = 0u; const int par = (it - 1) & 1;
#pragma unroll
                for (int k = 0; k < 8; ++k) any |= flags[par * 8 + k];
                if (any == 0u) break; }
            const int kmin = 64 * kt, wmax = t0 + 16 * w + 15, wmin = t0 + 16 * w;
            f32x4 ckv[4]; float ttv = 0.f;
            if constexpr (FOX) {
#pragma unroll
                for (int blk = 0; blk < 4; ++blk) ckv[blk] = *(const GAS f32x4*)(cl + (size_t)bh * SEQ + kmin + 16 * blk + 4 * fq);
                ttv = tt[bh * 256 + (kt > 2 * qt ? 2 * qt : kt)];
                asm volatile("" ::: "memory"); }
            if (kt > 0) { const GAS bf16_t* kp = Kb + (rowbase + (size_t)64 * (kt - 1) + srow0) * DM + h * HD + schunk * 8; const GAS bf16_t* vp = Vb + (rowbase + (size_t)64 * (kt - 1) + srow0) * DM + h * HD + schunk * 8;
#pragma unroll
                for (int j = 0; j < 4; ++j) { kr[j] = *(const GAS u32x4*)(kp + (size_t)16 * j * DM); vr[j] = *(const GAS u32x4*)(vp + (size_t)16 * j * DM); } }
            const bool part = !wdone && (FOX ? (kmin <= wmax) : (kmin < wmax));
            if (part) {
                const bool need_mask = (kmin + 63 >= wmin);
                f32x4 s[4];
#pragma unroll
                for (int blk = 0; blk < 4; ++blk) { s[blk] = (f32x4){0.f, 0.f, 0.f, 0.f};
#pragma unroll
                    for (int st = 0; st < 8; ++st) { const bf16x8 kf = *(const LAS bf16x8*)(lds + kbuf + (16 * blk + fr) * 512 + (((4 * st + fq) ^ fr) * 16));
                        s[blk] = __builtin_amdgcn_mfma_f32_16x16x32_bf16(kf, qf[st], s[blk], 0, 0, 0); } }
                float pv[4][4];
                if constexpr (!FOX) {
                    float lm[4][4], w4[4], Tt[4], Ex[4];
#pragma unroll
                    for (int blk = 0; blk < 4; ++blk) { w4[blk] = 0.f;
#pragma unroll
                        for (int i = 0; i < 4; ++i) { const float z = s[blk][i]; const float sp = softplus_f(z); const bool valid = !need_mask || (kmin + 16 * blk + 4 * fq + i < tq);
                            lm[blk][i] = valid ? -sp : 0.f; pv[blk][i] = valid ? (z - sp) : -1.0e30f; w4[blk] += lm[blk][i]; } }
#pragma unroll
                    for (int blk = 0; blk < 4; ++blk) { const float a = shx(w4[blk], 16, lane), bq = shx(w4[blk], 32, lane), c = shx(a, 32, lane);
                        Tt[blk] = (w4[blk] + a) + (bq + c); Ex[blk] = (fq == 0) ? (a + bq + c) : (fq == 1) ? (bq + c) : (fq == 2) ? a : 0.f; }
                    float bs = 0.f;
#pragma unroll
                    for (int blk = 3; blk >= 0; --blk) { float tail = R + bs + Ex[blk];
#pragma unroll
                        for (int i = 3; i >= 0; --i) { const float e = pv[blk][i] + tail; pv[blk][i] = (e > -80.f) ? fast_exp(e) : 0.f; tail += lm[blk][i]; }
                        bs += Tt[blk]; }
                    R += bs;
                } else {
                    float base;
                    if (kt == 2 * qt + 1) base = ttv; else if (kt == 2 * qt) base = 0.f; else { gacc += ttv; base = -gacc; }
                    float mx = -1.0e30f;
#pragma unroll
                    for (int blk = 0; blk < 4; ++blk) { const f32x4 ck = ckv[blk];
#pragma unroll
                        for (int i = 0; i < 4; ++i) { const bool valid = !need_mask || (kmin + 16 * blk + 4 * fq + i <= tq); const float lg = valid ? (s[blk][i] + cq - (ck[i] + base)) : -1.0e30f; pv[blk][i] = lg; mx = fmaxf(mx, lg); } }
                    mx = fmaxf(mx, shx(mx, 16, lane)); mx = fmaxf(mx, shx(mx, 32, lane));
                    const float mnew = fmaxf(mrun, mx), al = fast_exp(mrun - mnew); float ps = 0.f;
#pragma unroll
                    for (int blk = 0; blk < 4; ++blk)
#pragma unroll
                        for (int i = 0; i < 4; ++i) { const float e = pv[blk][i] - mnew; const float p = (e > -80.f) ? fast_exp(e) : 0.f; pv[blk][i] = p; ps += p; }
                    lsum = lsum * al + ps;
                    if (__any(mnew > mrun)) {
#pragma unroll
                        for (int d = 0; d < 16; ++d) o[d] = o[d] * al; }
                    mrun = mnew;
                }
                bf16x8 pf[2];
#pragma unroll
                for (int c = 0; c < 2; ++c) { u32x4 pw; pw.x = cvt_pk_bf16(pv[2 * c][0], pv[2 * c][1]); pw.y = cvt_pk_bf16(pv[2 * c][2], pv[2 * c][3]); pw.z = cvt_pk_bf16(pv[2 * c + 1][0], pv[2 * c + 1][1]); pw.w = cvt_pk_bf16(pv[2 * c + 1][2], pv[2 * c + 1][3]);
                    pf[c] = __builtin_bit_cast(bf16x8, pw); }
                const unsigned va = (unsigned)(size_t)(lds + vbuf) + vrd;
                s16x4 c0, c1, c2, c3, n0, n1, n2, n3;
                AT_TR4(c0, c1, c2, c3, va, 0, 512, 1024, 1536);
                n0 = c0; n1 = c1; n2 = c2; n3 = c3;
#define AT_PV(db) do { AT_WAIT4(c0, c1, c2, c3); \
                    if ((db) < 15) { AT_TR4(n0, n1, n2, n3, va, ((db) + 1) * AT_VPANEL, ((db) + 1) * AT_VPANEL + 512, ((db) + 1) * AT_VPANEL + 1024, ((db) + 1) * AT_VPANEL + 1536); } \
                    { const bf16x8 v0 = __builtin_shufflevector(c0, c1, 0, 1, 2, 3, 4, 5, 6, 7), v1 = __builtin_shufflevector(c2, c3, 0, 1, 2, 3, 4, 5, 6, 7); \
                      o[db] = __builtin_amdgcn_mfma_f32_16x16x32_bf16(v0, pf[0], o[db], 0, 0, 0); o[db] = __builtin_amdgcn_mfma_f32_16x16x32_bf16(v1, pf[1], o[db], 0, 0, 0); } \
                    c0 = n0; c1 = n1; c2 = n2; c3 = n3; } while (0)
                AT_PV(0); AT_PV(1); AT_PV(2); AT_PV(3); AT_PV(4); AT_PV(5); AT_PV(6); AT_PV(7); AT_PV(8); AT_PV(9); AT_PV(10); AT_PV(11); AT_PV(12); AT_PV(13); AT_PV(14); AT_PV(15);
#undef AT_PV
            } else if constexpr (FOX) { if (kt < 2 * qt) gacc += ttv; }
            { bool cont;
              if constexpr (!FOX) cont = (R >= SB_STOP);
              else cont = (qn * KN + cq + ((kt <= 2 * qt) ? gacc : 0.f) - mrun >= FOX_STOP) || (kt > 2 * qt);
              const bool anyc = !wdone && __any(cont); wdone = !anyc;
              if (lane == 0) flags[(it & 1) * 8 + w] = anyc ? 1u : 0u; }
            if (kt == 0) break;
            --kt; ++it;
        }
        float inv = 1.f;
        if constexpr (FOX) { float lt = lsum; lt += shx(lt, 16, lane); lt += shx(lt, 32, lane); inv = 1.f / lt; }
        { GAS bf16_t* op = O + (rowbase + tq) * DM + h * HD + 4 * fq;
#pragma unroll
          for (int db = 0; db < 16; ++db) { u32x2 ow; ow.x = cvt_pk_bf16(o[db][0] * inv, o[db][1] * inv); ow.y = cvt_pk_bf16(o[db][2] * inv, o[db][3] * inv); *(GAS u32x2*)(op + 16 * db) = ow; } }
        __syncthreads();
    }
}

constexpr int NPH = 41;
__host__ __device__ inline bool phase_nonempty(int k) { if (k == 0) return true; const int L = (k - 1) / 10, s = (k - 1) % 10; if (s == 1) return L == 2; if (s == 5) return (L & 1) != 0; return true; }
struct Args { const float* in[N_IN]; float* out; unsigned char* ws; int ph_lo, ph_hi, sub, pad; };

__global__ void __launch_bounds__(NTHREADS, 2) mk_fwd(Args args) {
    extern __shared__ __attribute__((aligned(16))) unsigned char lds_raw[];
    Frame F;
    F.lds = (LAS unsigned char*)lds_raw;
    F.wave = __builtin_amdgcn_readfirstlane((int)threadIdx.x >> 6);
    F.G = gridDim.x; { const int bx = blockIdx.x; F.vcu = (F.G % 8 == 0) ? (bx % 8) * (F.G / 8) + bx / 8 : bx; }
    F.ws = (GAS unsigned char*)args.ws; F.ctl = (GAS unsigned*)F.ws; F.res = (GAS float*)args.out;
    for (int u = (int)threadIdx.x; u < (LDS_BYTES - LDS_CTL) / 4; u += NTHREADS) ((LAS unsigned*)(F.lds + LDS_CTL))[u] = 0u;
    __syncthreads();
    const int lo = args.ph_lo, hi = args.ph_hi;
    XcdBarrier bar; bar.bar = F.ctl + CW_BAR; bar.x = 0; bar.st = nullptr;
    if (hi - lo > 1) bar = xcd_barrier_post(F.ctl + CW_BAR, (volatile LAS unsigned*)(F.lds + LDS_CTL) + 8);
#ifndef DUP_MASK
#define DUP_MASK 0
#endif
#define DUP(n) (1 + ((DUP_MASK >> (n)) & 1))
#ifndef SITE_MASK
#define SITE_MASK 0xFFFFF
#endif
#define SITE(n) ((SITE_MASK >> (n)) & 1)
#define IN(k) (lo <= (k) && (k) < hi)
#define SEAM(k) do { if ((k) + 1 < hi) xcd_barrier(bar); } while (0)
    const int c = (int)blockIdx.x;
#define WSB(name) GAS unsigned char* name = launder_ptr(F.ws)
#define XBP(ws_, which) ((GAS bf16_t*)((ws_) + ((which) ? WS_XB1 : WS_XB0)))

    if (SITE(0) && IN(0)) { for (int rep_ = 0; rep_ < DUP(0); ++rep_) prologue_phase(F); SEAM(0); }

    for (int L = 0; L < DEPTH; ++L) {
        const int pb = 1 + 10 * L;
        {
            F.wave = launder_int(F.wave); F.ws = launder_ptr(F.ws); F.res = launder_ptr(F.res); F.ctl = (GAS unsigned*)F.ws; F.G = launder_int(F.G); }
        for (int repa_ = 0; repa_ < DUP(20); ++repa_) {
        if (SITE(1) && IN(pb + 0)) {
            WSB(ws);
            const GAS bf16_t* Wqkv = (const GAS bf16_t*)(ws + (L < 2 ? WS_WDEAD : WS_WLIVE)) + (L == 0 ? WD_QKV0 : L == 1 ? WD_QKV1 : L == 2 ? WL_QKV2 : WL_Q3);
            g8::ProbPlain P{XBP(ws, (L + 1) & 1), Wqkv, 1024, 1024, 16, T / 256, (L == 3) ? 4 : 12, F.G, c};
            g8::EpiBf16Split E{(GAS bf16_t*)(ws + WS_QA), 1024, (L == 3) ? 0 : 1024, (size_t)(WS_KS - WS_QA) / 2};
            for (int rep_ = 0; rep_ < DUP(1); ++rep_) g8::gemm_phase<g8::ProbPlain, g8::EpiBf16Split>(F.lds, P, E, F.wave);
            if (SITE(2) && L == 2) forget_phase(F, XBP(ws, (L + 1) & 1));
            SEAM(pb + 0);
        }
        if (SITE(3) && IN(pb + 1) && L == 2) { WSB(ws); knorm_phase(F, (const GAS bf16_t*)(ws + WS_KS)); SEAM(pb + 1); }
        if (IN(pb + 2)) {
            WSB(ws); GAS bf16_t* QA = (GAS bf16_t*)(ws + WS_QA); const GAS bf16_t* KS = (const GAS bf16_t*)(ws + WS_KS); const GAS bf16_t* VS = (const GAS bf16_t*)(ws + WS_VS);
            if (L < 2) { if (SITE(4)) attn_phase<false>(F, QA, KS, VS, QA); } else { if (SITE(5)) attn_phase<true>(F, QA, KS, VS, QA); }
            SEAM(pb + 2);
        }
        }
        if (SITE(6) && IN(pb + 3)) {
            WSB(ws);
            const GAS bf16_t* Wo = (const GAS bf16_t*)(ws + (L < 2 ? WS_WDEAD : WS_WLIVE)) + (L == 0 ? WD_O0 : L == 1 ? WD_O1 : L == 2 ? WL_O2 : WL_O3);
            g8::ProbPlain P{(const GAS bf16_t*)(ws + WS_QA), Wo, 1024, 1024, 16, T / 256, 4, F.G, c};
            g8::EpiResidB E{XBP(ws, (L + 1) & 1)};
            g8::gemm_phase<g8::ProbPlain, g8::EpiResidB>(F.lds, P, E, F.wave);
            SEAM(pb + 3);
        }
        if (IN(pb + 4)) { WSB(ws); GAS bf16_t* xln1 = XBP(ws, (L + 1) & 1); if (L & 1) { if (SITE(7)) ln_phase<true, true>(F, L, 0, xln1); } else { if (SITE(8)) ln_phase<false, true>(F, L, 0, xln1); } SEAM(pb + 4); }
        if (SITE(9) && IN(pb + 5) && (L & 1)) { moe_lists_phase(F); SEAM(pb + 5); }
        if (IN(pb + 6)) {
            WSB(ws); const GAS bf16_t* xln1 = XBP(ws, (L + 1) & 1);
            if (L & 1) { if (SITE(10)) { load_tab(F);
                const GAS bf16_t* Wmgu = (const GAS bf16_t*)(ws + (L == 1 ? WS_WDEAD : WS_WLIVE)) + (L == 1 ? WD_MGU0 : WL_MGU1); const GAS i32x4* elist = (const GAS i32x4*)(ws + WS_MISC + MS_ELIST);
                g8::ProbMoeGU P{xln1, Wmgu, elist, (const LAS int*)(F.lds + LDS_TAB), 1024, 1024, 16, F.G, c}; g8::EpiMoeGU E{(GAS bf16_t*)(ws + (L == 1 ? WS_QA : WS_WDEAD)), elist, (const GAS float*)(ws + WS_MISC + MS_EGATE)};
                for (int rep_ = 0; rep_ < DUP(10); ++rep_) g8::gemm_phase<g8::ProbMoeGU, g8::EpiMoeGU>(F.lds, P, E, F.wave); } }
            else if (SITE(11)) { const GAS bf16_t* Wgu = (const GAS bf16_t*)(ws + (L == 0 ? WS_WDEAD : WS_WLIVE)) + (L == 0 ? WD_GU0 : WL_GU1);
                g8::ProbPlain P{xln1, Wgu, 1024, 1024, 16, T / 256, 22, F.G, c}; g8::EpiSwiglu E{(GAS bf16_t*)(ws + (L == 0 ? WS_QA : WS_XB0)), DFF};
                for (int rep_ = 0; rep_ < DUP(11); ++rep_) g8::gemm_phase<g8::ProbPlain, g8::EpiSwiglu>(F.lds, P, E, F.wave); }
            SEAM(pb + 6);
        }
        if (IN(pb + 7)) {
            WSB(ws);
            if (L & 1) { if (SITE(12)) { load_tab(F);
                const GAS bf16_t* Wmdn = (const GAS bf16_t*)(ws + (L == 1 ? WS_WDEAD : WS_WLIVE)) + (L == 1 ? WD_MDN0 : WL_MDN1);
                g8::ProbMoeDown P{(const GAS bf16_t*)(ws + (L == 1 ? WS_QA : WS_WDEAD)), Wmdn, (const LAS int*)(F.lds + LDS_TAB), 1408, 5632, 22, F.G, c}; g8::EpiMoeDownB E{XBP(ws, (L + 1) & 1), (const GAS int*)(ws + WS_MISC + MS_PLIST)};
                g8::gemm_phase<g8::ProbMoeDown, g8::EpiMoeDownB>(F.lds, P, E, F.wave); } }
            else if (SITE(13)) { const GAS bf16_t* Wdn = (const GAS bf16_t*)(ws + (L == 0 ? WS_WDEAD : WS_WLIVE)) + (L == 0 ? WD_DN0 : WL_DN1);
                g8::ProbPlain P{(const GAS bf16_t*)(ws + (L == 0 ? WS_QA : WS_XB0)), Wdn, DFF, DFF, 44, T / 256, 4, F.G, c}; g8::EpiResidB E{XBP(ws, (L + 1) & 1)};
                g8::gemm_phase<g8::ProbPlain, g8::EpiResidB>(F.lds, P, E, F.wave); }
            SEAM(pb + 7);
        }
        if (SITE(14) && IN(pb + 8)) { WSB(ws); ln_phase<false, false>(F, L, 1, XBP(ws, (L + 1) & 1)); SEAM(pb + 8); }
        if (IN(pb + 9)) {
            if (SITE(15) && args.sub != 2) { WSB(ws); const GAS bf16_t* Wpg = (const GAS bf16_t*)(ws + (L < 2 ? WS_WDEAD : WS_WLIVE)) + (L == 0 ? WD_PG0 : L == 1 ? WD_PG1 : L == 2 ? WL_PG2 : WL_PG3);
                g8::ProbPlain P{XBP(ws, (L + 1) & 1), Wpg, 1024, 1024, 16, T / 256, 4, F.G, c}; g8::EpiGate E{XBP(ws, L & 1)}; for (int rep_ = 0; rep_ < DUP(15); ++rep_) g8::gemm_phase<g8::ProbPlain, g8::EpiGate>(F.lds, P, E, F.wave); }
            if (SITE(16) && args.sub != 1) { WSB(ws); const GAS bf16_t* Wpp = (const GAS bf16_t*)(ws + (L < 2 ? WS_WDEAD : WS_WLIVE)) + (L == 0 ? WD_PP0 : L == 1 ? WD_PP1 : L == 2 ? WL_PP2 : WL_PP3);
                g8::ProbPlain P{(const GAS bf16_t*)(ws + WS_PB), Wpp, PLE, PLE, 4, T / 256, 4, F.G, c}; g8::EpiPleB E{XBP(ws, (L + 1) & 1), XBP(ws, L & 1), L == DEPTH - 1 ? F.res : (GAS float*)nullptr}; g8::gemm_phase<g8::ProbPlain, g8::EpiPleB>(F.lds, P, E, F.wave); }
            if (pb + 9 < NPH - 1) SEAM(pb + 9);
        }
    }
#undef WSB
#undef XBP
#undef IN
#undef SEAM
}

#if MK_DEBUG
constexpr int NSAMP = 64;
#ifndef DBG_SHOW_A
#define DBG_SHOW_A -1
#define DBG_SHOW_B 75
#endif
#ifndef DBG_HYP
#define DBG_HYP 6
#endif
#ifndef DBG_FOCUS
#define DBG_FOCUS 99
#endif
__device__ __forceinline__ float wave_sum(float v) {
#pragma unroll
    for (int o = 1; o < 64; o <<= 1) v += __shfl_xor(v, o);
    return v;
}
__device__ __forceinline__ int samp_row(int k) { const int fixed[8] = {0, 1, 127, 128, SEQ - 1, SEQ, SEQ + 129, T - 1}; return k < 8 ? fixed[k] : (int)(((long long)k * 40503 + 977) % T); }
__device__ __forceinline__ void dbg_report(unsigned* ctl, int slot, float err_over_tol) { if (!(err_over_tol >= 0.f)) err_over_tol = 1.0e30f; atomicMax(ctl + CW_DBG + slot, __builtin_bit_cast(unsigned, err_over_tol)); }
__device__ __forceinline__ float dbg_dot(const bf16_t* a, int K, const float* W, size_t ldw, int n, int lane) { float s = 0.f; for (int k = lane; k < K; k += 64) s += bf2f(a[k]) * W[(size_t)k * ldw + n]; return wave_sum(s); }
__global__ void dbg_snapshot(const float* src, float* snap) { const int k = blockIdx.x, r = samp_row(k); for (int i = threadIdx.x; i < DM; i += blockDim.x) snap[(size_t)k * DM + i] = src[(size_t)r * DM + i]; }
struct DbgArgs { const float* in[N_IN]; float* res; unsigned char* ws; int phase; int pad; };
__global__ void __launch_bounds__(64) dbg_check(DbgArgs a) {
    const int k = blockIdx.x, lane = threadIdx.x, r = samp_row(k), ph = a.phase, L = (ph - 1) / 10, s = (ph - 1) % 10;
    unsigned* ctl = (unsigned*)(a.ws + WS_CTL); const float* snap = (const float*)(a.ws + WS_MISC + MS_SNAP) + (size_t)k * DM;
    const bf16_t* XBin = (const bf16_t*)(a.ws + ((L & 1) ? WS_XB1 : WS_XB0)); const bf16_t* XBl1 = (const bf16_t*)(a.ws + (((L + 1) & 1) ? WS_XB1 : WS_XB0));
    const bf16_t* QA = (const bf16_t*)(a.ws + WS_QA); const bf16_t* KS = (const bf16_t*)(a.ws + WS_KS); const bf16_t* VS = (const bf16_t*)(a.ws + WS_VS);
    if (ph == 0) {
        float e = 0.f; for (int i = lane; i < DM; i += 64) e = fmaxf(e, fabsf(bf2f(((const bf16_t*)(a.ws + WS_XB0))[(size_t)r * DM + i]) - a.in[IN_X][(size_t)r * DM + i]));
        e = fmaxf(e, __shfl_xor(e, 1)); dbg_report(ctl, ph, e / 0.05f); return; }
    if (s == 0) {
        const int NC = (L == 3) ? 1024 : 3072;
        for (int rep = 0; rep < 6; ++rep) { const int n = (k * 977 + rep * 517 + 131) % NC; const float* W; size_t ldw; int col; float sc = 1.f;
            if (L < 2) { W = a.in[IN_AQKV] + (size_t)L * 1024 * 3072; ldw = 3072; col = n; if (n < 1024) sc = 0.0625f; }
            else if (n < 1024) { W = a.in[IN_BQ] + (size_t)(L - 2) * 1024 * 1024; ldw = 1024; col = n; sc = 0.0625f; }
            else { W = a.in[IN_KVF]; ldw = 2052; col = n - 1024; }
            const float ex = dbg_dot(XBin + (size_t)r * DM, 1024, W, ldw, col, lane) * sc;
            const bf16_t* O = n < 1024 ? QA : n < 2048 ? KS : VS; const float got = bf2f(O[(size_t)r * DM + (n & 1023)]);
            dbg_report(ctl, ph, fabsf(got - ex) / (0.02f * fabsf(ex) + 0.02f)); }
        if (L == 2) {
            const int b = r / SEQ, sq = r % SEQ, hh = k & 3; float acc = 0.f;
            for (int j = (sq & ~63); j <= sq; ++j) { const float* xr = a.res + ((size_t)b * SEQ + j) * DM; float d = 0.f; for (int q = lane; q < DM; q += 64) d += xr[q] * a.in[IN_KVF][(size_t)q * 2052 + 2048 + hh];
                d = wave_sum(d) + a.in[IN_KVFB][hh]; acc += -(fmaxf(-d, 0.f) + log1pf(expf(-fabsf(d)))); }
            const float got = ((const float*)(a.ws + WS_MISC + MS_CL))[(size_t)(b * NH + hh) * SEQ + sq];
            dbg_report(ctl, ph, fabsf(got - acc) / (0.002f * fabsf(acc) + 0.002f)); }
        return; }
    if (s == 2) {
        const int hh = k & 3, b = r / SEQ, sq = r % SEQ; const size_t rb = (size_t)b * SEQ;
        float q4[4], o4[4] = {0.f, 0.f, 0.f, 0.f};
        for (int i = 0; i < 4; ++i) q4[i] = snap[hh * HD + 4 * lane + i];
        if (L < 2) { float Rr = 0.f;
            for (int t = sq - 1; t >= 0; --t) { const bf16_t* kp = KS + (rb + t) * DM + hh * HD + 4 * lane; float z = 0.f; for (int i = 0; i < 4; ++i) z += q4[i] * bf2f(kp[i]); z = wave_sum(z);
                const float sp = fmaxf(z, 0.f) + log1pf(expf(-fabsf(z))); const float aw = expf(z - sp + Rr); Rr -= sp;
                const bf16_t* vp = VS + (rb + t) * DM + hh * HD + 4 * lane; for (int i = 0; i < 4; ++i) o4[i] += aw * bf2f(vp[i]); }
        } else { const float* cl = (const float*)(a.ws + WS_MISC + MS_CL) + (size_t)(b * NH + hh) * SEQ; const float* tt = (const float*)(a.ws + WS_MISC + MS_TOT) + (b * NH + hh) * 256;
            float mx = -1.0e30f, den = 0.f;
            for (int pass = 0; pass < 2; ++pass) { double cacc = 0.0;
                for (int t = sq; t >= 0; --t) { const bf16_t* kp = KS + (rb + t) * DM + hh * HD + 4 * lane; float z = 0.f; for (int i = 0; i < 4; ++i) z += q4[i] * bf2f(kp[i]); z = wave_sum(z);
                    const float lg = z + (float)cacc;
                    if (pass == 0) mx = fmaxf(mx, lg); else { const float p = expf(lg - mx); den += p; const bf16_t* vp = VS + (rb + t) * DM + hh * HD + 4 * lane; for (int i = 0; i < 4; ++i) o4[i] += p * bf2f(vp[i]); }
                    const float lf = (t & 63) ? (cl[t] - cl[t - 1]) : cl[t]; cacc += (double)lf; } }
            for (int i = 0; i < 4; ++i) o4[i] /= den; (void)tt; }
        float em = 0.f, mg = 0.f; for (int i = 0; i < 4; ++i) { const float got = bf2f(QA[(size_t)r * DM + hh * HD + 4 * lane + i]); em = fmaxf(em, fabsf(got - o4[i])); mg = fmaxf(mg, fabsf(o4[i])); }
        for (int o = 1; o < 64; o <<= 1) { em = fmaxf(em, __shfl_xor(em, o)); mg = fmaxf(mg, __shfl_xor(mg, o)); }
        dbg_report(ctl, ph, em / (0.03f * mg + 0.003f)); return; }
    if (s == 3 || (s == 7 && !(L & 1))) {
        const bf16_t* A; const float* W; int K;
        if (s == 3) { A = QA + (size_t)r * DM; K = 1024; W = (L < 2) ? a.in[IN_AO] + (size_t)L * 1024 * 1024 : a.in[IN_BO] + (size_t)(L - 2) * 1024 * 1024; }
        else { A = (const bf16_t*)(a.ws + (L == 0 ? WS_QA : WS_XB0)) + (size_t)r * DFF; K = DFF; W = a.in[IN_FDN] + (size_t)(L >> 1) * DFF * 1024; }
        for (int rep = 0; rep < 6; ++rep) { const int n = (k * 733 + rep * 171 + 29) % 1024; const float ex = ALPHA * snap[n] + dbg_dot(A, K, W, 1024, n, lane); const float got = a.res[(size_t)r * DM + n];
            dbg_report(ctl, ph, fabsf(got - ex) / (0.01f * fabsf(ex) + 0.02f)); }
        return; }
    if (s == 4 || s == 8) {
        const int which = (s == 8); const float* g = a.in[IN_LNG] + (size_t)(L * 2 + which) * DM; const float* bb = a.in[IN_LNB] + (size_t)(L * 2 + which) * DM;
        float sm = 0.f; for (int i = lane; i < DM; i += 64) sm += snap[i]; const float mean = wave_sum(sm) / DM; float sv = 0.f; for (int i = lane; i < DM; i += 64) { const float d = snap[i] - mean; sv += d * d; }
        const float rstd = 1.f / sqrtf(wave_sum(sv) / DM + LN_EPS); const bf16_t* xo = which ? XBin : XBl1; float e = 0.f;
        for (int i = lane; i < DM; i += 64) { const float ex = (snap[i] - mean) * rstd * g[i] + bb[i]; e = fmaxf(e, fabsf(a.res[(size_t)r * DM + i] - ex) / 1e-3f); e = fmaxf(e, fabsf(bf2f(xo[(size_t)r * DM + i]) - ex) / (0.01f * fabsf(ex) + 0.01f)); }
        for (int o = 1; o < 64; o <<= 1) e = fmaxf(e, __shfl_xor(e, o));
        dbg_report(ctl, ph, e);
        if (s == 4 && (L & 1)) {
            const float* Wr = a.in[IN_MR] + (size_t)(L >> 1) * DM * NE; float lgs[NE];
            for (int e8 = 0; e8 < NE; ++e8) { float d = 0.f; for (int q = lane; q < DM; q += 64) d += a.res[(size_t)r * DM + q] * Wr[(size_t)q * NE + e8]; lgs[e8] = wave_sum(d); }
            int i1 = 0; for (int e8 = 1; e8 < NE; ++e8) if (lgs[e8] > lgs[i1]) i1 = e8; int i2 = -1; for (int e8 = 0; e8 < NE; ++e8) if (e8 != i1 && (i2 < 0 || lgs[e8] > lgs[i2])) i2 = e8;
            float third = -1.0e30f; for (int e8 = 0; e8 < NE; ++e8) if (e8 != i1 && e8 != i2) third = fmaxf(third, lgs[e8]);
            const float ex2 = expf(lgs[i2] - lgs[i1]), g1 = 1.f / (1.f + ex2), g2 = ex2 * g1;
            const i32x4 rr = ((const i32x4*)(a.ws + WS_MISC + MS_REC))[r]; const int q1 = rr.x & 0xff, q2 = (rr.x >> 8) & 0xff; const float h1 = ((const float*)(a.ws + WS_MISC + MS_GATE))[r], h2 = ((const float*)(a.ws + WS_MISC + MS_GATE))[T + r];
            if (lgs[i2] - third > 1e-3f && lgs[i1] - lgs[i2] > 1e-3f) { float bad = 0.f; if (q1 != i1 || q2 != i2) bad = 10.f; else if (fabsf(h1 - g1) > 1e-3f || fabsf(h2 - g2) > 1e-3f) bad = 5.f; dbg_report(ctl, ph, bad);
                if (L == 1 && k == 8 && lane == 0) { const float hv2[2] = {h1, h2};
                    for (int q = 0; q < 2; ++q) { const float h = hv2[q]; const unsigned bits = __builtin_bit_cast(unsigned, h); unsigned cat;
                        if (!(h == h)) cat = (bits == 0xffffffffu) ? 1u : (bits >> 31) ? 2u : 3u; else if (fabsf(h) > 3.0e38f) cat = 4u; else if (h < 0.f) cat = 5u; else if (h < 1e-30f) cat = (bits == 0u) ? 6u : 7u; else if (h > 1.f) cat = 8u; else cat = 9u;
                        (void)cat; }
                    { const unsigned bits = __builtin_bit_cast(unsigned, h1); ctl[CW_DBG + 70] = (rr.w == r) ? 9u : ((rr.w == 0) ? 3u : 1u); ctl[CW_DBG + 71] = (__builtin_bit_cast(unsigned, h2) >> 20) & 63u; (void)bits; } }
                if (L == 1) { if (lane == 0 && fabsf(h1 + h2 - 1.f) < 1e-3f) atomicAdd(ctl + CW_DBG + 46, 1u); if (lane == 0 && fabsf(h1 - g1) < 1e-3f) atomicAdd(ctl + CW_DBG + 47, 1u);
                if (lane == 0 && fabsf(h1 - g2) < 1e-3f && fabsf(h2 - g1) < 1e-3f) atomicAdd(ctl + CW_DBG + 45, 1u); if (lane == 0 && !(h1 == h1)) atomicAdd(ctl + CW_DBG + 44, 1u); } } }
        if (s == 4) { float e2 = 0.f; for (int i = lane; i < PLE; i += 64) e2 = fmaxf(e2, fabsf(bf2f(((const bf16_t*)(a.ws + WS_PB))[(size_t)r * PLE + i]) - a.in[IN_P][((size_t)L * T + r) * PLE + i]) / 0.05f);
            for (int o = 1; o < 64; o <<= 1) e2 = fmaxf(e2, __shfl_xor(e2, o)); dbg_report(ctl, ph, e2); }
        return; }
    if (s == 6 && !(L & 1)) {
        const float* W = a.in[IN_FGU] + (size_t)(L >> 1) * 1024 * 5632; const bf16_t* H = (const bf16_t*)(a.ws + (L == 0 ? WS_QA : WS_XB0));
        for (int rep = 0; rep < 6; ++rep) { const int j = (k * 389 + rep * 997 + 7) % DFF; const float g = dbg_dot(XBl1 + (size_t)r * DM, 1024, W, 5632, j, lane), u = dbg_dot(XBl1 + (size_t)r * DM, 1024, W, 5632, DFF + j, lane);
            const float ex = g / (1.f + expf(-g)) * u; const float got = bf2f(H[(size_t)r * DFF + j]); dbg_report(ctl, ph, fabsf(got - ex) / (0.03f * fabsf(ex) + 0.03f)); }
        return; }
    if (s == 6 && (L & 1)) {
        const int* tabg = (const int*)(a.ws + WS_MISC + MS_TAB); const i32x4* elist = (const i32x4*)(a.ws + WS_MISC + MS_ELIST); const i32x4* rec = (const i32x4*)(a.ws + WS_MISC + MS_REC);
        const int total = tabg[TB_EOFF + NE]; const int idx = (int)(((long long)k * 7919 + 13) % total); const i32x4 en = elist[idx];
        int e = 0; for (int q = 1; q < NE; ++q) e += (idx >= tabg[TB_EOFF + q]) ? 1 : 0;
        if (lane == 0) atomicAdd(ctl + CW_DBG + 55, 1u);
        if (en.y < 0) { if (lane == 0) atomicAdd(ctl + CW_DBG + 57, 1u); return; }
        const int tok = en.x; const i32x4 rr = rec[tok]; const int e1 = rr.x & 0xff, e2 = (rr.x >> 8) & 0xff;
        float bad = 0.f; if (e != e1 && e != e2) bad = 10.f;
        const float gate = ((const float*)(a.ws + WS_MISC + MS_EGATE))[idx]; const float gexp = (e == e1) ? ((const float*)(a.ws + WS_MISC + MS_GATE))[tok] : ((const float*)(a.ws + WS_MISC + MS_GATE))[T + tok]; if (fabsf(gate - gexp) > 1e-6f) bad = 20.f;
        if (lane == 0 && gate > 0.01f && gate < 0.999f) atomicAdd(ctl + CW_DBG + 60, 1u);
        if (lane == 0 && ((const int*)(a.ws + WS_MISC + MS_PLIST))[en.y / 1408] == tok) atomicAdd(ctl + CW_DBG + 59, 1u);
        const int half = (en.y % 1408) / DFE; if (half != ((e == (e1 < e2 ? e1 : e2)) ? 0 : 1)) bad = 30.f;
        dbg_report(ctl, ph, bad); if (lane == 0 && L == 1) { if (bad == 10.f) atomicAdd(ctl + CW_DBG + 72, 1u); if (bad == 20.f) atomicAdd(ctl + CW_DBG + 73, 1u); if (bad == 30.f) atomicAdd(ctl + CW_DBG + 74, 1u); }
        const float* Wg = a.in[IN_MGU] + (size_t)((L >> 1) * NE + e) * 1024 * 1408; const bf16_t* HS = (const bf16_t*)(a.ws + (L == 1 ? WS_QA : WS_WDEAD));
        for (int rep = 0; rep < 6; ++rep) { const int j = (k * 389 + rep * 131 + 5) % DFE; const float g = dbg_dot(XBl1 + (size_t)tok * DM, 1024, Wg, 1408, j, lane), u = dbg_dot(XBl1 + (size_t)tok * DM, 1024, Wg, 1408, DFE + j, lane);
            const float ex = gate * g / (1.f + expf(-g)) * u; const float got = bf2f(HS[(size_t)en.y + j]); const float er = fabsf(got - ex) / (0.03f * fabsf(ex) + 0.03f);
            dbg_report(ctl, ph, er); if (L == 1 && rep == 0 && lane == 0 && er <= 1.f) atomicAdd(ctl + CW_DBG + 56, 1u); if (L == 1 && rep == 0 && lane == 0 && fabsf(got) < 1e-6f) atomicAdd(ctl + CW_DBG + 75, 1u); }
        return; }
    if (s == 7 && (L & 1)) {
        __shared__ float hid[2][DFE]; __shared__ float lgs[NE];
        const float* Wr = a.in[IN_MR] + (size_t)(L >> 1) * DM * NE;
        for (int e = 0; e < NE; ++e) { float d = 0.f; for (int q = lane; q < DM; q += 64) d += snap[q] * Wr[(size_t)q * NE + e]; d = wave_sum(d); if (lane == 0) lgs[e] = d; }
        __syncthreads();
        int i1 = 0; for (int e = 1; e < NE; ++e) if (lgs[e] > lgs[i1]) i1 = e; int i2 = -1; for (int e = 0; e < NE; ++e) if (e != i1 && (i2 < 0 || lgs[e] > lgs[i2])) i2 = e;
        const float ex2 = expf(lgs[i2] - lgs[i1]), g1 = 1.f / (1.f + ex2), g2 = ex2 * g1; const int es[2] = {i1, i2}; const float gs[2] = {g1, g2};
        float third = -1.0e30f; for (int e = 0; e < NE; ++e) if (e != i1 && e != i2) third = fmaxf(third, lgs[e]);
        if (lgs[i2] - third < 1e-3f) return;
        for (int q = 0; q < 2; ++q) { const float* Wg = a.in[IN_MGU] + (size_t)((L >> 1) * NE + es[q]) * 1024 * 1408;
            for (int j = 0; j < DFE; ++j) { const float g = dbg_dot(XBl1 + (size_t)r * DM, 1024, Wg, 1408, j, lane), u = dbg_dot(XBl1 + (size_t)r * DM, 1024, Wg, 1408, DFE + j, lane);
                if (lane == 0) hid[q][j] = bf2f((unsigned short)f2bf(g / (1.f + expf(-g)) * u)); } }
        __syncthreads();
        for (int rep = 0; rep < 2; ++rep) { const int n = (lane * 16 + k + rep * 5) % 1024; float ac[2] = {0.f, 0.f};
            for (int q = 0; q < 2; ++q) { const float* Wdn = a.in[IN_MDN] + (size_t)((L >> 1) * NE + es[q]) * DFE * 1024; for (int j = 0; j < DFE; ++j) ac[q] += hid[q][j] * Wdn[(size_t)j * 1024 + n]; }
            const float base = ALPHA * snap[n]; const float got = a.res[(size_t)r * DM + n];
            const int* plist = (const int*)(a.ws + WS_MISC + MS_PLIST); const int* tabg = (const int*)(a.ws + WS_MISC + MS_TAB); const int nslot = tabg[TB_NRT] * 256; int ps = -1;
            for (int i = lane; i < nslot; i += 64) if (plist[i] == r) ps = i;
            for (int o = 1; o < 64; o <<= 1) ps = max(ps, __shfl_xor(ps, o));
            float ah = 0.f; float exact0 = fabsf(got - base);
            if (ps >= 0) { const bf16_t* HS = (const bf16_t*)(a.ws + (L == 1 ? WS_QA : WS_WDEAD)) + (size_t)ps * 1408; const int pp = tabg[TB_RT2P + (ps >> 8)]; const int ea = pp & 0xff, eb = (pp >> 8) & 0xff;
                const float* Wa = a.in[IN_MDN] + (size_t)((L >> 1) * NE + ea) * DFE * 1024; const float* Wb = a.in[IN_MDN] + (size_t)((L >> 1) * NE + eb) * DFE * 1024;
                for (int j = 0; j < DFE; ++j) ah += bf2f(HS[j]) * Wa[(size_t)j * 1024 + n] + bf2f(HS[DFE + j]) * Wb[(size_t)j * 1024 + n]; }
            const float hy[6] = {base + gs[0] * ac[0] + gs[1] * ac[1], base, base + ah, base + gs[1] * ac[1], base + ac[0] + ac[1], base + gs[1] * ac[0] + gs[0] * ac[1]};
            for (int hq = 0; hq < 6; ++hq) { float e = fabsf(got - hy[hq]) / (0.01f * fabsf(hy[hq]) + 0.02f);
                for (int o = 1; o < 64; o <<= 1) e = fmaxf(e, __shfl_xor(e, o));
                if (hq == 0) dbg_report(ctl, ph, e);
                if (ph == DBG_FOCUS && rep == 0 && lane == 0 && e <= 1.0f) atomicAdd(ctl + CW_DBG + 56 + hq, 1u); }
            for (int o = 1; o < 64; o <<= 1) exact0 = fmaxf(exact0, __shfl_xor(exact0, o));
            float ahm = fabsf(ah); for (int o = 1; o < 64; o <<= 1) ahm = fmaxf(ahm, __shfl_xor(ahm, o));
            if (ph == DBG_FOCUS && rep == 0 && lane == 0 && ahm > 0.05f) atomicAdd(ctl + CW_DBG + 61, 1u);
            if (ph == DBG_FOCUS && rep == 0 && lane == 0 && exact0 < 1e-5f) atomicAdd(ctl + CW_DBG + 62, 1u);
            if (ph == DBG_FOCUS && rep == 0 && lane == 0 && ps < 0) atomicAdd(ctl + CW_DBG + 63, 1u); }
        if (ph == DBG_FOCUS && lane == 0) atomicAdd(ctl + CW_DBG + 55, 1u);
        return; }
    if (s == 9 && a.pad == 1) {
        const float* Wg = a.in[IN_PG] + (size_t)L * 1024 * 1024;
        for (int rep = 0; rep < 6; ++rep) { const int n = (k * 613 + rep * 211 + 3) % 1024; const float gl = dbg_dot(XBin + (size_t)r * DM, 1024, Wg, 1024, n, lane); const float sg = 1.f / (1.f + expf(-gl));
            dbg_report(ctl, 41 + L, fabsf(bf2f(XBl1[(size_t)r * DM + n]) - sg) / 0.02f); }
        return; }
    if (s == 9) {
        const float* Wg = a.in[IN_PG] + (size_t)L * 1024 * 1024; const float* Wp = a.in[IN_PP] + (size_t)L * PLE * 1024; const bf16_t* pbp = (const bf16_t*)(a.ws + WS_PB) + (size_t)r * PLE;
        for (int rep = 0; rep < 6; ++rep) { const int n = (k * 613 + rep * 211 + 3) % 1024; const float gl = dbg_dot(XBin + (size_t)r * DM, 1024, Wg, 1024, n, lane), pj = dbg_dot(pbp, PLE, Wp, 1024, n, lane);
            const float sg = 1.f / (1.f + expf(-gl)); const float ex = snap[n] + pj * sg; const float got = a.res[(size_t)r * DM + n], gb = bf2f(XBl1[(size_t)r * DM + n]);
            dbg_report(ctl, ph, fabsf(got - ex) / (0.01f * fabsf(ex) + 0.01f)); dbg_report(ctl, ph, fabsf(gb - ex) / (0.02f * fabsf(ex) + 0.02f));
            if (ph == DBG_FOCUS) {
                dbg_report(ctl, 48 + 1, fabsf(got - ex) / (0.01f * fabsf(ex) + 0.01f));
                dbg_report(ctl, 48 + 2, fabsf(got - (snap[n] + pj)) / 0.02f);
                dbg_report(ctl, 48 + 3, fabsf(got - (snap[n] + sg)) / 0.02f);
                dbg_report(ctl, 48 + 4, fabsf(got - snap[n]) / 0.02f);
                dbg_report(ctl, 48 + 5, fabsf(gb - got) / (0.02f * fabsf(got) + 0.02f));
                dbg_report(ctl, 48 + 6, fabsf(got - (snap[n] + pj * 0.5f)) / 0.02f);
            } }
        return; }
}
__global__ void dbg_snap_q(const bf16_t* Q, float* snap) { const int k = blockIdx.x, r = samp_row(k); for (int i = threadIdx.x; i < DM; i += blockDim.x) snap[(size_t)k * DM + i] = bf2f(Q[(size_t)r * DM + i]); }
__global__ void dbg_poison(float* out, const unsigned* ctl, size_t n) {
    int code = 0; for (int kk = 0; kk < NPH; ++kk) { if (kk > 0 && (kk - 1) % 10 == 9 && __builtin_bit_cast(float, ctl[CW_DBG + 41 + (kk - 1) / 10]) > 1.0f) { code = 42 + (kk - 1) / 10; break; }
        if (__builtin_bit_cast(float, ctl[CW_DBG + kk]) > 1.0f) { code = kk + 1; break; } }
    if (ctl[CW_TMO] || ctl[CW_BAR + XB_TMO]) code = 60;
    if (code == 0) return;
    float V = exp2f((float)code);
    if (DBG_SHOW_A >= 0) { const unsigned n0 = ctl[CW_DBG + DBG_SHOW_A], nh = ctl[CW_DBG + DBG_SHOW_B]; V = exp2f(64.f + (float)(n0 > 60u ? 60u : n0)) * (1.f + (float)(nh > 63u ? 63u : nh) / 128.f); }
    else if (code == DBG_FOCUS + 1) {
        const unsigned n0 = ctl[CW_DBG + 63], nh = ctl[CW_DBG + 61];
        V = exp2f(64.f + (float)(n0 > 60u ? 60u : n0)) * (1.f + (float)(nh > 63u ? 63u : nh) / 128.f); }
    for (size_t i = (size_t)blockIdx.x * blockDim.x + threadIdx.x; i < n; i += (size_t)gridDim.x * blockDim.x) out[i] = V;
}
#endif

extern "C" void kernel_launch(void* const* d_in, const int* in_sizes, int n_in, void* d_out, int out_size, void* d_ws, size_t ws_size, hipStream_t stream) {
    static int grid = 0;
    if (grid == 0) {
        if (n_in != N_IN || out_size != T * DM || ws_size < WS_END) { fprintf(stderr, "kernel_launch: unexpected problem (n_in %d, out %d, ws %zu < %zu)\n", n_in, out_size, ws_size, (size_t)WS_END); grid = -1; return; }
        int dev = 0, cus = 0, per_cu = 0;
        if (hipGetDevice(&dev) != hipSuccess || hipDeviceGetAttribute(&cus, hipDeviceAttributeMultiprocessorCount, dev) != hipSuccess) { grid = -1; return; }
        if (hipFuncSetAttribute((const void*)mk_fwd, hipFuncAttributeMaxDynamicSharedMemorySize, LDS_BYTES) != hipSuccess) { fprintf(stderr, "kernel_launch: hipFuncSetAttribute failed\n"); grid = -1; return; }
        if (hipOccupancyMaxActiveBlocksPerMultiprocessor(&per_cu, (const void*)mk_fwd, NTHREADS, LDS_BYTES) != hipSuccess || per_cu < 1) { fprintf(stderr, "kernel_launch: occupancy query says %d blocks per CU\n", per_cu); }
        (void)hipGetLastError();
        grid = cus;
    }
    if (grid < 0) return;
    (void)hipMemsetAsync((char*)d_ws + WS_CTL, 0, CTL_ZERO_BYTES, stream);
    Args a{};
    for (int i = 0; i < N_IN; ++i) a.in[i] = (const float*)d_in[i];
    a.out = (float*)d_out; a.ws = (unsigned char*)d_ws;
#if !MK_DEBUG
    a.ph_lo = 0; a.ph_hi = NPH;
    hipLaunchKernelGGL(mk_fwd, dim3(grid), dim3(NTHREADS), LDS_BYTES, stream, a);
#else
    DbgArgs da{}; for (int i = 0; i < N_IN; ++i) da.in[i] = (const float*)d_in[i]; da.res = (float*)d_out; da.ws = (unsigned char*)d_ws;
    float* snap = (float*)((char*)d_ws + WS_MISC + MS_SNAP);
    for (int k = 0; k < NPH; ++k) {
        if (!phase_nonempty(k)) continue;
        const int L = (k - 1) / 10, s = (k - 1) % 10;
        if (k > 0) {
            if (s == 2) hipLaunchKernelGGL(dbg_snap_q, dim3(NSAMP), dim3(256), 0, stream, (const bf16_t*)((char*)d_ws + WS_QA), snap);
            if (s == 3) hipLaunchKernelGGL(dbg_snapshot, dim3(NSAMP), dim3(256), 0, stream, L == 0 ? (const float*)d_in[IN_X] : (const float*)d_out, snap);
            if (s == 4 || s == 7 || s == 8 || s == 9) hipLaunchKernelGGL(dbg_snapshot, dim3(NSAMP), dim3(256), 0, stream, (const float*)d_out, snap);
        }
        a.ph_lo = k; a.ph_hi = k + 1; a.sub = 0;
        if (k > 0 && s == 9) { a.sub = 1; hipLaunchKernelGGL(mk_fwd, dim3(grid), dim3(NTHREADS), LDS_BYTES, stream, a); da.phase = k; da.pad = 1; hipLaunchKernelGGL(dbg_check, dim3(NSAMP), dim3(64), 0, stream, da); da.pad = 0; a.sub = 2; }
        hipLaunchKernelGGL(mk_fwd, dim3(grid), dim3(NTHREADS), LDS_BYTES, stream, a);
        if (k == 0 || s == 0 || s == 2 || s == 3 || s == 4 || s == 6 || s == 7 || s == 8 || s == 9) { da.phase = k; hipLaunchKernelGGL(dbg_check, dim3(NSAMP), dim3(64), 0, stream, da); }
    }
    hipLaunchKernelGGL(dbg_poison, dim3(1024), dim3(256), 0, stream, (float*)d_out, (const unsigned*)d_ws, (size_t)T * DM);
#endif
}
```

```cpp
#include <hip/hip_runtime.h>
#include <cstdio>
#include <cstdint>


#define LAS __attribute__((address_space(3)))
#define GAS __attribute__((address_space(1)))
typedef unsigned short bf16_t;
typedef short bf16x8 __attribute__((ext_vector_type(8)));
typedef short bf16x4 __attribute__((ext_vector_type(4)));
typedef float f32x4 __attribute__((ext_vector_type(4)));
typedef float f32x2 __attribute__((ext_vector_type(2)));
typedef unsigned u32x4 __attribute__((ext_vector_type(4)));
typedef unsigned u32x2 __attribute__((ext_vector_type(2)));
typedef int i32x4 __attribute__((ext_vector_type(4)));

constexpr int DM = 1024, NBATCH = 2, SEQ = 16384, T = NBATCH * SEQ, NH = 4, HD = 256, DFF = 2816, NE = 8, DFE = 704, PLE = 256, DEPTH = 4;
constexpr float ALPHA = 1.6817928305074292f;
constexpr float LN_EPS = 1e-5f;
constexpr int NWAVES = 8, NTHREADS = 512;
enum { IN_X = 0, IN_P, IN_AQKV, IN_AO, IN_KVF, IN_KVFB, IN_BQ, IN_BO, IN_FGU, IN_FDN, IN_MR, IN_MGU, IN_MDN, IN_PP, IN_PG, IN_LNG, IN_LNB, N_IN };

constexpr size_t MiB = 1u << 20;
constexpr size_t WS_CTL = 0, CTL_ZERO_BYTES = 1 * MiB;
constexpr size_t WS_MISC = 1 * MiB;
constexpr size_t WS_WLIVE = 8 * MiB;
constexpr size_t WS_PB = 77 * MiB;
constexpr size_t WS_XB1 = 93 * MiB, WS_XB0 = 157 * MiB;
constexpr size_t WS_WDEAD = 221 * MiB;
constexpr size_t WS_QA = 294 * MiB, WS_KS = 358 * MiB, WS_VS = 422 * MiB, WS_END = 486 * MiB;
constexpr size_t MS_REC = 0;
constexpr size_t MS_HIST = 512 * 1024;
constexpr size_t MS_ELIST = 576 * 1024;
constexpr int ELIST_CAP = 2 * T + NE * 256;
constexpr size_t MS_PLIST = MS_ELIST + (size_t)ELIST_CAP * 16;
constexpr int NPAIR = 28, PLIST_CAP = T + NPAIR * 256;
constexpr size_t MS_TAB = 2 * MiB;
constexpr size_t MS_CL = 2 * MiB + 64 * 1024;
constexpr size_t MS_TOT = MS_CL + (size_t)8 * SEQ * 4;
constexpr size_t MS_SNAP = 3 * MiB;
constexpr size_t MS_EGATE = 4 * MiB + 512 * 1024;
constexpr size_t MS_GATE = 4 * MiB;
static_assert(MS_PLIST + (size_t)PLIST_CAP * 4 <= MS_TAB && MS_TOT + 8 * 256 * 4 <= MS_SNAP, "misc map");
enum { TB_ECUM = 0  , TB_EOFF = 16  , TB_NRT = 32, TB_RT2P = 64  , TB_WORDS = 320 };
constexpr int CW_TMO = 0, CW_CODE = 1, CW_DBG = 64  , CW_KN2 = 192  , CW_BAR = 4096;

constexpr size_t WSZ_QKV = (size_t)3072 * 1024, WSZ_SQ = (size_t)1024 * 1024, WSZ_GU = (size_t)5632 * 1024, WSZ_DN = (size_t)1024 * 2816,
                 WSZ_MGU = (size_t)NE * 1536 * 1024, WSZ_MDN = (size_t)1024 * 5632, WSZ_PP = (size_t)1024 * 256;
constexpr size_t WD_QKV0 = 0, WD_O0 = WD_QKV0 + WSZ_QKV, WD_QKV1 = WD_O0 + WSZ_SQ, WD_O1 = WD_QKV1 + WSZ_QKV, WD_GU0 = WD_O1 + WSZ_SQ, WD_DN0 = WD_GU0 + WSZ_GU,
                 WD_MGU0 = WD_DN0 + WSZ_DN, WD_MDN0 = WD_MGU0 + WSZ_MGU, WD_PP0 = WD_MDN0 + WSZ_MDN, WD_PG0 = WD_PP0 + WSZ_PP, WD_PP1 = WD_PG0 + WSZ_SQ, WD_PG1 = WD_PP1 + WSZ_PP, WD_END = WD_PG1 + WSZ_SQ;
constexpr size_t WL_QKV2 = 0, WL_O2 = WL_QKV2 + WSZ_QKV, WL_Q3 = WL_O2 + WSZ_SQ, WL_O3 = WL_Q3 + WSZ_SQ, WL_GU1 = WL_O3 + WSZ_SQ, WL_DN1 = WL_GU1 + WSZ_GU,
                 WL_MGU1 = WL_DN1 + WSZ_DN, WL_MDN1 = WL_MGU1 + WSZ_MGU, WL_PP2 = WL_MDN1 + WSZ_MDN, WL_PG2 = WL_PP2 + WSZ_PP, WL_PP3 = WL_PG2 + WSZ_SQ, WL_PG3 = WL_PP3 + WSZ_PP, WL_END = WL_PG3 + WSZ_SQ;
static_assert(WD_END * 2 <= 73 * MiB && WL_END * 2 <= 69 * MiB, "weight regions");
static_assert((size_t)T * DFF * 2 <= WS_END - WS_QA && WS_XB0 + (size_t)T * DFF * 2 <= WS_KS && WS_WDEAD + (size_t)(T + NPAIR * 256) * 1408 * 2 <= WS_KS, "h overlays");

constexpr int RING_BYTES = 131072;
constexpr int LDS_CTL = 135168;
constexpr int LDS_TAB = LDS_CTL + 128;
constexpr int LDS_FLAGS = LDS_TAB + TB_WORDS * 4;
constexpr int LDS_BYTES = 147456;
static_assert(LDS_FLAGS + 64 <= LDS_BYTES, "LDS map");

#define RLX_AGENT __ATOMIC_RELAXED, __HIP_MEMORY_SCOPE_AGENT
__device__ __forceinline__ unsigned f2bf(float f) { unsigned u = __builtin_bit_cast(unsigned, f); return (u + 0x7fffu + ((u >> 16) & 1u)) >> 16; }
__device__ __forceinline__ unsigned pk2(float lo, float hi) { return f2bf(lo) | (f2bf(hi) << 16); }
__device__ __forceinline__ float bf2f(unsigned short b) { return __builtin_bit_cast(float, (unsigned)b << 16); }
typedef __bf16 bf16v2_t __attribute__((ext_vector_type(2)));
__device__ __forceinline__ unsigned cvt_pk_bf16(float lo, float hi) { bf16v2_t v; v[0] = (__bf16)lo; v[1] = (__bf16)hi; return __builtin_bit_cast(unsigned, v); }
__device__ __forceinline__ float shx(float v, int m, int lane) { return __builtin_bit_cast(float, __builtin_amdgcn_ds_bpermute((lane ^ m) << 2, __builtin_bit_cast(int, v))); }
__device__ __forceinline__ int shxi(int v, int m, int lane) { return __builtin_amdgcn_ds_bpermute((lane ^ m) << 2, v); }
__device__ __forceinline__ float shup(float v, int o, int lane) { return __builtin_bit_cast(float, __builtin_amdgcn_ds_bpermute(((lane - o) & 63) << 2, __builtin_bit_cast(int, v))); }
__device__ __forceinline__ float wave_sum(float v, int lane) {
#pragma unroll
    for (int o = 1; o < 64; o <<= 1) v += shx(v, o, lane);
    return v;
}
template <int CTRL> __device__ __forceinline__ float dpp_mov(float v) { return __builtin_bit_cast(float, __builtin_amdgcn_update_dpp(0, __builtin_bit_cast(int, v), CTRL, 0xF, 0xF, true)); }
__device__ __forceinline__ float wave_sum_dpp(float v) {
    v += dpp_mov<0xB1>(v); v += dpp_mov<0x4E>(v); v += dpp_mov<0x141>(v); v += dpp_mov<0x140>(v);
    const int b = __builtin_bit_cast(int, v);
    return (__builtin_bit_cast(float, __builtin_amdgcn_readlane(b, 0)) + __builtin_bit_cast(float, __builtin_amdgcn_readlane(b, 16))) + (__builtin_bit_cast(float, __builtin_amdgcn_readlane(b, 32)) + __builtin_bit_cast(float, __builtin_amdgcn_readlane(b, 48)));
}
__device__ __forceinline__ float fast_exp(float x) { return __builtin_amdgcn_exp2f(x * 1.4426950408889634f); }
__device__ __forceinline__ float fast_log(float x) { return __builtin_amdgcn_logf(x) * 0.6931471805599453f; }
__device__ __forceinline__ float softplus_f(float z) { return fmaxf(z, 0.f) + fast_log(1.f + fast_exp(-fabsf(z))); }
__device__ __forceinline__ float sigmoid_f(float z) { return __builtin_amdgcn_rcpf(1.f + fast_exp(-z)); }

typedef const GAS float* fptr_t;
__device__ __forceinline__ const GAS float* in_sel(int idx) { const __attribute__((address_space(4))) fptr_t* ka = (const __attribute__((address_space(4))) fptr_t*)__builtin_amdgcn_kernarg_segment_ptr(); return ka[idx]; }

template <class Tp> __device__ __forceinline__ GAS Tp* launder_ptr(GAS Tp* p) { unsigned lo = (unsigned)(unsigned long long)p, hi = (unsigned)((unsigned long long)p >> 32); asm volatile("" : "+v"(lo), "+v"(hi));
    lo = __builtin_amdgcn_readfirstlane(lo); hi = __builtin_amdgcn_readfirstlane(hi); return (GAS Tp*)(((unsigned long long)hi << 32) | lo); }
__device__ __forceinline__ int launder_int(int v) { asm volatile("" : "+v"(v)); return __builtin_amdgcn_readfirstlane(v); }

#define XB_TMO      128
#define XB_XCNT(j)  (256  + 64 * (j))
#define XB_XSUB(j)  (1280 + 64 * (j))
#define XB_XGEN(j)  (2304 + 64 * (j))
#define XB_TOP      3328
#define XB_TOPGEN   3392
#define XCD_BAR_WORDS 3456
#define XB_SPIN_CAP (1u << 18)
__device__ __forceinline__ unsigned xb_ld(GAS unsigned* p)              { return __hip_atomic_load(p, __ATOMIC_RELAXED, __HIP_MEMORY_SCOPE_AGENT); }
__device__ __forceinline__ unsigned xb_add(GAS unsigned* p, unsigned v) { return __hip_atomic_fetch_add(p, v, __ATOMIC_RELAXED, __HIP_MEMORY_SCOPE_AGENT); }
__device__ __forceinline__ unsigned xb_xcc_id() { return (unsigned)__builtin_amdgcn_s_getreg((3 << 11) | 20) & 0xFu; }
#define XB_SPIN(cond, bar) do { unsigned _sp = 0; while (cond) { __builtin_amdgcn_s_sleep(1); \
    if ((++_sp & 255u) == 0u) { if (xb_ld(&(bar)[XB_TMO])) break; if (_sp > XB_SPIN_CAP) { (void)xb_add(&(bar)[XB_TMO], 1u); break; } } } } while (0)
struct XcdBarrier { GAS unsigned* bar; unsigned x; volatile LAS unsigned* st; };
__device__ __forceinline__ XcdBarrier xcd_barrier_post(GAS unsigned* bar, volatile LAS unsigned* st) {
    XcdBarrier b; b.bar = bar; b.x = xb_xcc_id(); b.st = st;
    if (threadIdx.x == 0) (void)xb_add(&bar[XB_XCNT(b.x)], 1u);
    return b;
}
__device__ __forceinline__ void xcd_barrier_complete(GAS unsigned* bar, unsigned x, unsigned& nloc, unsigned& nx) {
    const unsigned G = gridDim.x * gridDim.y * gridDim.z;
    unsigned sum, cnt, mine, sp = 0u;
    for (;;) {
        sum = 0u; cnt = 0u; mine = 0u;
#pragma unroll
        for (unsigned j = 0; j < 16; ++j) { const unsigned c = xb_ld(&bar[XB_XCNT(j)]); sum += c; cnt += (c > 0u) ? 1u : 0u; mine = (j == x) ? c : mine; }
        if (sum == G) break;
        __builtin_amdgcn_s_sleep(1);
        if ((++sp & 255u) == 0u) { if (xb_ld(&bar[XB_TMO])) break; if (sp > XB_SPIN_CAP) { (void)xb_add(&bar[XB_TMO], 1u); break; } }
    }
    nloc = mine > 0u ? mine : 1u; nx = cnt > 0u ? cnt : 1u;
}
__device__ __forceinline__ void xcd_barrier(const XcdBarrier& b) {
    asm volatile("s_waitcnt vmcnt(0)" ::: "memory");
    __syncthreads();
    if (threadIdx.x == 0) {
        GAS unsigned* bar = b.bar;
        __builtin_amdgcn_s_waitcnt(0);
        unsigned nloc = b.st[0], nx = b.st[1];
        if (nloc == 0u) { xcd_barrier_complete(bar, b.x, nloc, nx); b.st[0] = nloc; b.st[1] = nx; }
        const unsigned old = xb_add(&bar[XB_XSUB(b.x)], 1u);
        const unsigned gen = old / nloc;
        if (old + 1u == (gen + 1u) * nloc) {
            __builtin_amdgcn_fence(__ATOMIC_RELEASE, "agent");
            asm volatile("s_waitcnt vmcnt(0)" ::: "memory");
            const unsigned og = xb_add(&bar[XB_TOP], 1u);
            const unsigned tg = og / nx;
            if (og + 1u == (tg + 1u) * nx) xb_add(&bar[XB_TOPGEN], 1u);
            else XB_SPIN(xb_ld(&bar[XB_TOPGEN]) == tg, bar);
            __builtin_amdgcn_fence(__ATOMIC_ACQUIRE, "agent");
            xb_add(&bar[XB_XGEN(b.x)], 1u);
            asm volatile("s_waitcnt vmcnt(0)" ::: "memory");
        } else {
            XB_SPIN(xb_ld(&bar[XB_XGEN(b.x)]) == gen, bar);
            __builtin_amdgcn_fence(__ATOMIC_ACQUIRE, "agent");
            asm volatile("s_waitcnt vmcnt(0)" ::: "memory");
        }
    }
    __syncthreads();
}

namespace g8 {
constexpr int BM = 256, BK = 64, HALF = 128, HTB = HALF * BK * 2, STAGE_BYTES = 8 * HTB, NXCD = 8, WGM = 8;
__host__ __device__ __forceinline__ int lds_byte(int r, int c) { const int st = (r >> 4) * 2 + (c >> 5), rr = r & 15, cc = c & 31, ob = rr * 64 + cc * 2; return st * 1024 + (ob ^ (((ob >> 9) & 1) << 5)); }
__host__ __device__ __forceinline__ void stage_rc(int b, int& R, int& C) { const int st = b / 1024, sb = b % 1024, swz = sb ^ (((sb >> 9) & 1) << 5); R = (st >> 1) * 16 + swz / 64; C = (st & 1) * 32 + (swz % 64) / 2; }
__host__ __device__ __forceinline__ int perm32(int rho) { const int n = rho >> 4, i = rho & 15; return 8 * (i >> 2) + 4 * n + (i & 3); }
struct Unit { int pm, pn, x0, x1; };
__device__ __forceinline__ bool static_order(int i, int G, int c, int nM, int nN, int& pm, int& pn) {
    const int nwg = nM * nN; const long L = (long)i * G + c; if (L >= nwg) return false;
    int wgid = (int)L; { const int q = nwg / NXCD, r = nwg % NXCD, xcd = wgid % NXCD, off = wgid / NXCD; wgid = (xcd < r ? xcd * (q + 1) : r * (q + 1) + (xcd - r) * q) + off; }
    const int nig = WGM * nN, gid = wgid / nig, fm = gid * WGM, gsz = (nM - fm) < WGM ? (nM - fm) : WGM;
    pm = fm + ((wgid % nig) % gsz); pn = (wgid % nig) / gsz; return true;
}

template <class Prob, class Epi, bool ALIGN_EPI = true>
__device__ __forceinline__ void gemm_phase(LAS unsigned char* lds, const Prob& P, const Epi& E, int wave_id) {
    int tid_; asm volatile("v_mbcnt_lo_u32_b32 %0, -1, 0\n\tv_mbcnt_hi_u32_b32 %0, -1, %0" : "=v"(tid_)); tid_ += wave_id * 64;
    const int tid = tid_, wid = __builtin_amdgcn_readfirstlane(tid >> 6), lane = tid & 63, wr = wid >> 2, wc = wid & 3, fr = lane & 15, fq = lane >> 4;
    const int nt = P.nt;
    unsigned voffA[2], voffB[2]; int Rr0 = 0; unsigned voffC = 0;
#pragma unroll
    for (int i = 0; i < 2; ++i) { int R, C; stage_rc(tid * 16 + i * 8192, R, C); const int Rb = Epi::PERM ? ((R & ~31) + perm32(R & 31)) : R;
        voffA[i] = (unsigned)(R * P.lda + C) * 2u; voffB[i] = (unsigned)(Rb * P.ldb + C) * 2u; if (i == 0) { Rr0 = R; voffC = (unsigned)C * 2u; } }
    const size_t kstep = (size_t)(BK * 2);
    const size_t hstepA = (size_t)HALF * P.lda * 2, hstepB = (size_t)HALF * P.ldb * 2;
    const unsigned ldsw = (unsigned)wid * 1024u;
    const int aoff = lds_byte(wr * 64 + fr, fq * 8), boff = lds_byte(wc * 32 + fr, fq * 8);
#define G8_SA(b, h) (((b) * 2 + (h)) * HTB)
#define G8_SB(b, h) ((4 + (b) * 2 + (h)) * HTB)
#define G8_STAGE(bufoff, gbase, voff) do { _Pragma("unroll") for (int _i = 0; _i < 2; ++_i) \
        __builtin_amdgcn_global_load_lds((const GAS unsigned*)((const GAS char*)(gbase) + (voff)[_i]), (LAS unsigned*)(lds + (bufoff) + ldsw + _i * 8192), 16, 0, 0); } while (0)
#define G8_STAGE_A(bufoff, h, kb, NX) do { if constexpr (Prob::GATHER) { const unsigned pk_ = (NX) ? gAn[h] : gAc[h]; const unsigned vo_[2] = {(pk_ & 0xffffu) * (unsigned)(P.lda * 2) + voffC, (pk_ >> 16) * (unsigned)(P.lda * 2) + voffC}; \
        G8_STAGE(bufoff, P.a_base() + (kb), vo_); } \
        else { G8_STAGE(bufoff, ((NX) ? nA : cA) + (h) * hstepA + (kb), voffA); } } while (0)
#define G8_LDA(dst, b, h) do { _Pragma("unroll") for (int m = 0; m < 4; ++m) _Pragma("unroll") for (int k = 0; k < 2; ++k) dst[m][k] = *(const LAS bf16x8*)(lds + G8_SA(b, h) + aoff + m * 2048 + k * 1024); } while (0)
#define G8_LDB(dst, b, h) do { _Pragma("unroll") for (int n = 0; n < 2; ++n) _Pragma("unroll") for (int k = 0; k < 2; ++k) dst[n][k] = *(const LAS bf16x8*)(lds + G8_SB(b, h) + boff + n * 2048 + k * 1024); } while (0)
#define G8_MMA(ai, bj, At, Bt) do { __builtin_amdgcn_s_setprio(1); _Pragma("unroll") for (int m = 0; m < 4; ++m) _Pragma("unroll") for (int n = 0; n < 2; ++n) _Pragma("unroll") for (int k = 0; k < 2; ++k) \
        acc[ai][bj][m][n] = __builtin_amdgcn_mfma_f32_16x16x32_bf16(Bt[n][k], At[m][k], acc[ai][bj][m][n], 0, 0, 0); __builtin_amdgcn_s_setprio(0); } while (0)
#define G8_WAIT_V(n) asm volatile("s_waitcnt vmcnt(" #n ")" ::: "memory")
#define G8_WAIT_L(n) asm volatile("s_waitcnt lgkmcnt(" #n ")" ::: "memory")
#define G8_BAR __builtin_amdgcn_s_barrier()
#define G8_SCHED __builtin_amdgcn_sched_barrier(0)
    Unit cur, nxt; int ui = 0;
    if (!P.next(0, cur)) return;
    f32x4 acc[2][2][4][2];
#pragma unroll
    for (int a = 0; a < 2; ++a)
#pragma unroll
        for (int b = 0; b < 2; ++b)
#pragma unroll
            for (int m = 0; m < 4; ++m)
#pragma unroll
                for (int n = 0; n < 2; ++n) acc[a][b][m][n] = (f32x4){0.f, 0.f, 0.f, 0.f};
    bf16x8 At[4][2], B0[2][2], B1[2][2];
    unsigned gAc[2], gAn[2];
    const GAS char* cA = nullptr; const GAS char* nA = nullptr;
    if constexpr (Prob::GATHER) { P.gather(cur, Rr0, gAc); } else { cA = P.a_tile(cur); }
    {
        const GAS char* b0 = P.b_ptr(cur, 0); const GAS char* b1 = P.b_ptr(cur, 1);
        G8_STAGE(G8_SB(0, 0), b0, voffB); G8_STAGE(G8_SB(0, 1), b0 + hstepB, voffB); G8_STAGE_A(G8_SA(0, 0), 0, 0, false); G8_STAGE_A(G8_SA(0, 1), 1, 0, false);
        if (wr == 1) G8_BAR;
        G8_WAIT_V(2); G8_BAR;
        G8_STAGE(G8_SB(1, 0), b1, voffB); G8_STAGE_A(G8_SA(1, 0), 0, kstep, false); G8_STAGE(G8_SB(1, 1), b1 + hstepB, voffB);
        G8_WAIT_V(6); G8_BAR;
    }
    for (;;) {
        const bool has_next = P.next(ui + 1, nxt);
        if (!has_next) nxt = cur;
        if constexpr (Prob::GATHER) { if (has_next) P.gather(nxt, Rr0, gAn); else { gAn[0] = gAc[0]; gAn[1] = gAc[1]; } }
        else { nA = P.a_tile(nxt); }
        for (int t = 0; t < nt; t += 2) {
            const bool last = (t == nt - 2);
            const size_t a1k = (size_t)(t + 1) * kstep;
            const size_t a2k = last ? 0 : (size_t)(t + 2) * kstep, a3k = last ? kstep : (size_t)(t + 3) * kstep;
            const GAS char* b2 = last ? P.b_ptr(nxt, 0) : P.b_ptr(cur, t + 2); const GAS char* b3 = last ? P.b_ptr(nxt, 1) : P.b_ptr(cur, t + 3);
            G8_LDB(B0, 0, 0); G8_LDB(B1, 0, 1); G8_SCHED; G8_LDA(At, 0, 0); G8_STAGE_A(G8_SA(1, 1), 1, a1k, false);
            G8_WAIT_V(8); G8_WAIT_L(0); G8_BAR; G8_MMA(0, 0, At, B0); G8_MMA(0, 1, At, B1); G8_BAR; G8_SCHED;
            G8_LDA(At, 0, 1); G8_STAGE(G8_SB(0, 0), b2, voffB); G8_STAGE(G8_SB(0, 1), b2 + hstepB, voffB);
            if (last) { G8_STAGE_A(G8_SA(0, 0), 0, a2k, true); } else { G8_STAGE_A(G8_SA(0, 0), 0, a2k, false); }
            G8_WAIT_V(8); G8_WAIT_L(0); G8_BAR; G8_MMA(1, 0, At, B0); G8_MMA(1, 1, At, B1); G8_BAR; G8_SCHED;
            G8_LDB(B0, 1, 0); G8_LDB(B1, 1, 1); G8_SCHED; G8_LDA(At, 1, 0);
            if (last) { G8_STAGE_A(G8_SA(0, 1), 1, a2k, true); } else { G8_STAGE_A(G8_SA(0, 1), 1, a2k, false); }
            G8_WAIT_V(8); G8_WAIT_L(0); G8_BAR; G8_MMA(0, 0, At, B0); G8_MMA(0, 1, At, B1); G8_BAR; G8_SCHED;
            G8_LDA(At, 1, 1); G8_STAGE(G8_SB(1, 0), b3, voffB); G8_STAGE(G8_SB(1, 1), b3 + hstepB, voffB);
            if (last) { G8_STAGE_A(G8_SA(1, 0), 0, a3k, true); } else { G8_STAGE_A(G8_SA(1, 0), 0, a3k, false); }
            G8_WAIT_V(8); G8_WAIT_L(0); G8_BAR; G8_MMA(1, 0, At, B0); G8_MMA(1, 1, At, B1); G8_BAR; G8_SCHED;
        }
        if constexpr (ALIGN_EPI) { if (wr == 0) G8_BAR; }
        { int l2_; asm volatile("v_mbcnt_lo_u32_b32 %0, -1, 0\n\tv_mbcnt_hi_u32_b32 %0, -1, %0" : "=v"(l2_)); E(acc, cur, wr, wc, l2_ & 15, l2_ >> 4); }
        if (!has_next) break;
#pragma unroll
        for (int a = 0; a < 2; ++a)
#pragma unroll
            for (int b = 0; b < 2; ++b)
#pragma unroll
                for (int m = 0; m < 4; ++m)
#pragma unroll
                    for (int n = 0; n < 2; ++n) acc[a][b][m][n] = (f32x4){0.f, 0.f, 0.f, 0.f};
        cur = nxt; ++ui;
        if constexpr (Prob::GATHER) { gAc[0] = gAn[0]; gAc[1] = gAn[1]; }
        else { cA = nA; }
        if constexpr (ALIGN_EPI) { if (wr == 1) G8_BAR; }
    }
    G8_WAIT_V(0);
    if constexpr (!ALIGN_EPI) { if (wr == 0) G8_BAR; }
    G8_BAR;
#undef G8_SA
#undef G8_SB
#undef G8_STAGE
#undef G8_STAGE_A
#undef G8_LDA
#undef G8_LDB
#undef G8_MMA
#undef G8_WAIT_V
#undef G8_WAIT_L
#undef G8_BAR
#undef G8_SCHED
}

struct ProbPlain {
    static constexpr bool GATHER = false;
    const GAS bf16_t* A; const GAS bf16_t* Bt; int lda, ldb, nt, nM, nN, G, c;
    __device__ __forceinline__ bool next(int i, Unit& u) const { u.x0 = 0; u.x1 = 0; return static_order(i, G, c, nM, nN, u.pm, u.pn); }
    __device__ __forceinline__ const GAS char* a_tile(const Unit& u) const { return (const GAS char*)A + (size_t)u.pm * BM * lda * 2; }
    __device__ __forceinline__ const GAS char* a_base() const { return (const GAS char*)A; }
    __device__ __forceinline__ void gather(const Unit&, int, unsigned (&)[2]) const {}
    __device__ __forceinline__ const GAS char* b_ptr(const Unit& u, int t) const { return (const GAS char*)Bt + ((size_t)u.pn * BM * ldb + (size_t)t * BK) * 2; }
};
struct ProbMoeGU {
    static constexpr bool GATHER = true;
    const GAS bf16_t* A; const GAS bf16_t* Bt; const GAS i32x4* elist; const LAS int* tab; int lda, ldb, nt, G, c;
    __device__ __forceinline__ bool next(int i, Unit& u) const {
        const int total = tab[TB_ECUM + NE]; const long L = (long)i * G + c; if (L >= total) return false;
        int wgid = (int)L; { const int q = total / NXCD, r = total % NXCD, xcd = wgid % NXCD, off = wgid / NXCD; wgid = (xcd < r ? xcd * (q + 1) : r * (q + 1) + (xcd - r) * q) + off; }
        int e = 0;
#pragma unroll
        for (int k = 1; k < NE; ++k) e += (wgid >= tab[TB_ECUM + k]) ? 1 : 0;
        const int loc = wgid - tab[TB_ECUM + e], nM = (tab[TB_ECUM + e + 1] - tab[TB_ECUM + e]) / 6;
        const int nig = WGM * 6, gid = loc / nig, fm = gid * WGM, gsz = (nM - fm) < WGM ? (nM - fm) : WGM;
        u.pm = fm + ((loc % nig) % gsz); u.pn = (loc % nig) / gsz; u.x0 = e; u.x1 = tab[TB_EOFF + e] + 256 * u.pm; return true;
    }
    __device__ __forceinline__ const GAS char* a_tile(const Unit&) const { return (const GAS char*)A; }
    __device__ __forceinline__ const GAS char* a_base() const { return (const GAS char*)A; }
    __device__ __forceinline__ void gather(const Unit& u, int R0, unsigned (&g)[2]) const {
#pragma unroll
        for (int h = 0; h < 2; ++h) { const int t0 = elist[u.x1 + h * HALF + R0].x, t1 = elist[u.x1 + h * HALF + R0 + 64].x; g[h] = (unsigned)t0 | ((unsigned)t1 << 16); }
    }
    __device__ __forceinline__ const GAS char* b_ptr(const Unit& u, int t) const { return (const GAS char*)Bt + ((size_t)(u.x0 * 1536 + u.pn * BM) * ldb + (size_t)t * BK) * 2; }
};
struct ProbMoeDown {
    static constexpr bool GATHER = false;
    const GAS bf16_t* A; const GAS bf16_t* Bt; const LAS int* tab; int lda, ldb, nt, G, c;
    __device__ __forceinline__ bool next(int i, Unit& u) const {
        const int nM = tab[TB_NRT]; if (!static_order(i, G, c, nM, 4, u.pm, u.pn)) return false;
        const int p = tab[TB_RT2P + u.pm]; u.x0 = (p & 0xff) * DFE; u.x1 = ((p >> 8) & 0xff) * DFE; return true;
    }
    __device__ __forceinline__ const GAS char* a_tile(const Unit& u) const { return (const GAS char*)A + (size_t)u.pm * BM * lda * 2; }
    __device__ __forceinline__ const GAS char* a_base() const { return (const GAS char*)A; }
    __device__ __forceinline__ void gather(const Unit&, int, unsigned (&)[2]) const {}
    __device__ __forceinline__ const GAS char* b_ptr(const Unit& u, int t) const { const int ko = (t < 11) ? (u.x0 + t * BK) : (u.x1 + (t - 11) * BK); return (const GAS char*)Bt + ((size_t)u.pn * BM * ldb + (size_t)ko) * 2; }
};

#define G8_ROWLOOP _Pragma("unroll") for (int ai = 0; ai < 2; ++ai) _Pragma("unroll") for (int m = 0; m < 4; ++m)
struct EpiBf16Split {
    static constexpr bool PERM = true;
    GAS bf16_t* O; int ldc; int split_cols; size_t split_stride;
    __device__ __forceinline__ void operator()(const f32x4 (&acc)[2][2][4][2], const Unit& u, int wr, int wc, int fr, int fq) const {
        const int row0 = u.pm * BM + wr * 64 + fr; int colt = u.pn * BM; GAS bf16_t* base = O;
        if (split_cols) { const int t = colt / split_cols; base += (size_t)t * split_stride; colt -= t * split_cols; }
        const int col0 = colt + wc * 32 + 8 * fq;
        G8_ROWLOOP { GAS bf16_t* rowp = base + (size_t)(row0 + ai * HALF + m * 16) * ldc + col0;
#pragma unroll
            for (int bj = 0; bj < 2; ++bj) { const f32x4 v0 = acc[ai][bj][m][0], v1 = acc[ai][bj][m][1];
                u32x4 w; w.x = cvt_pk_bf16(v0[0], v0[1]); w.y = cvt_pk_bf16(v0[2], v0[3]); w.z = cvt_pk_bf16(v1[0], v1[1]); w.w = cvt_pk_bf16(v1[2], v1[3]);
                *(GAS u32x4*)(rowp + bj * HALF) = w; } }
    }
};
struct EpiResid {
    static constexpr bool PERM = false;
    const GAS float* rin; GAS float* out;
    __device__ __forceinline__ void operator()(const f32x4 (&acc)[2][2][4][2], const Unit& u, int wr, int wc, int fr, int fq) const {
        const int row0 = u.pm * BM + wr * 64 + fr, col0 = u.pn * BM + wc * 32 + 4 * fq;
        G8_ROWLOOP { const size_t off = (size_t)(row0 + ai * HALF + m * 16) * DM + col0;
#pragma unroll
            for (int bj = 0; bj < 2; ++bj)
#pragma unroll
                for (int n = 0; n < 2; ++n) { const f32x4 r = *(const GAS f32x4*)(rin + off + bj * HALF + n * 16); *(GAS f32x4*)(out + off + bj * HALF + n * 16) = r * ALPHA + acc[ai][bj][m][n]; }
            asm volatile("" ::: "memory"); }
    }
};
struct EpiSwiglu {
    static constexpr bool PERM = true;
    GAS bf16_t* H; int ldh;
    __device__ __forceinline__ void operator()(const f32x4 (&acc)[2][2][4][2], const Unit& u, int wr, int wc, int fr, int fq) const {
        const int row0 = u.pm * BM + wr * 64 + fr, col0 = u.pn * HALF + wc * 32 + 8 * fq;
        G8_ROWLOOP { u32x4 w; unsigned ww[4];
#pragma unroll
            for (int n = 0; n < 2; ++n) { const f32x4 g = acc[ai][0][m][n], uu = acc[ai][1][m][n]; float hv[4];
#pragma unroll
                for (int i = 0; i < 4; ++i) hv[i] = g[i] * sigmoid_f(g[i]) * uu[i];
                ww[2 * n] = cvt_pk_bf16(hv[0], hv[1]); ww[2 * n + 1] = cvt_pk_bf16(hv[2], hv[3]); }
            w.x = ww[0]; w.y = ww[1]; w.z = ww[2]; w.w = ww[3];
            *(GAS u32x4*)(H + (size_t)(row0 + ai * HALF + m * 16) * ldh + col0) = w; }
    }
};
struct EpiGate {
    static constexpr bool PERM = true;
    GAS bf16_t* O;
    __device__ __forceinline__ void operator()(const f32x4 (&acc)[2][2][4][2], const Unit& u, int wr, int wc, int fr, int fq) const {
        const int row0 = u.pm * BM + wr * 64 + fr, col0 = u.pn * BM + wc * 32 + 8 * fq;
        G8_ROWLOOP { GAS bf16_t* rowp = O + (size_t)(row0 + ai * HALF + m * 16) * DM + col0;
#pragma unroll
            for (int bj = 0; bj < 2; ++bj) { const f32x4 v0 = acc[ai][bj][m][0], v1 = acc[ai][bj][m][1];
                u32x4 w; w.x = cvt_pk_bf16(sigmoid_f(v0[0]), sigmoid_f(v0[1])); w.y = cvt_pk_bf16(sigmoid_f(v0[2]), sigmoid_f(v0[3]));
                w.z = cvt_pk_bf16(sigmoid_f(v1[0]), sigmoid_f(v1[1])); w.w = cvt_pk_bf16(sigmoid_f(v1[2]), sigmoid_f(v1[3]));
                *(GAS u32x4*)(rowp + bj * HALF) = w; } }
    }
};
struct EpiPle {
    static constexpr bool PERM = true;
    GAS float* res; GAS bf16_t* XG;
    __device__ __forceinline__ void operator()(const f32x4 (&acc)[2][2][4][2], const Unit& u, int wr, int wc, int fr, int fq) const {
        const int row0 = u.pm * BM + wr * 64 + fr, col0 = u.pn * BM + wc * 32 + 8 * fq;
        G8_ROWLOOP { const size_t off = (size_t)(row0 + ai * HALF + m * 16) * DM + col0;
#pragma unroll
            for (int bj = 0; bj < 2; ++bj)
#pragma unroll
                for (int n = 0; n < 2; ++n) { const u32x2 gw = *(const GAS u32x2*)(XG + off + bj * HALF + 4 * n); const f32x4 r = *(const GAS f32x4*)(res + off + bj * HALF + 4 * n); const f32x4 a = acc[ai][bj][m][n]; f32x4 o;
                    o[0] = r[0] + a[0] * __builtin_bit_cast(float, gw.x << 16); o[1] = r[1] + a[1] * __builtin_bit_cast(float, gw.x & 0xffff0000u);
                    o[2] = r[2] + a[2] * __builtin_bit_cast(float, gw.y << 16); o[3] = r[3] + a[3] * __builtin_bit_cast(float, gw.y & 0xffff0000u);
                    *(GAS f32x4*)(res + off + bj * HALF + 4 * n) = o; u32x2 w; w.x = cvt_pk_bf16(o[0], o[1]); w.y = cvt_pk_bf16(o[2], o[3]); *(GAS u32x2*)(XG + off + bj * HALF + 4 * n) = w;
                    asm volatile("" ::: "memory"); } }
    }
};
struct EpiMoeGU {
    static constexpr bool PERM = true;
    GAS bf16_t* HS; const GAS i32x4* elist; const GAS float* egate;
    __device__ __forceinline__ void operator()(const f32x4 (&acc)[2][2][4][2], const Unit& u, int wr, int wc, int fr, int fq) const {
        const int j0 = u.pn * HALF + wc * 32 + 8 * fq; const bool colok = j0 < DFE;
        G8_ROWLOOP { const int sl = u.x1 + ai * HALF + wr * 64 + m * 16 + fr; const i32x4 en = elist[sl]; const float gate = egate[sl];
            if (colok && en.y >= 0) { u32x4 w; unsigned ww[4];
#pragma unroll
                for (int n = 0; n < 2; ++n) { const f32x4 g = acc[ai][0][m][n], uu = acc[ai][1][m][n]; float hv[4];
#pragma unroll
                    for (int i = 0; i < 4; ++i) hv[i] = gate * g[i] * sigmoid_f(g[i]) * uu[i];
                    ww[2 * n] = cvt_pk_bf16(hv[0], hv[1]); ww[2 * n + 1] = cvt_pk_bf16(hv[2], hv[3]); }
                w.x = ww[0]; w.y = ww[1]; w.z = ww[2]; w.w = ww[3];
                *(GAS u32x4*)(HS + (size_t)en.y + j0) = w; } }
    }
};
struct EpiMoeDown {
    static constexpr bool PERM = false;
    GAS float* res; const GAS int* plist;
    __device__ __forceinline__ void operator()(const f32x4 (&acc)[2][2][4][2], const Unit& u, int wr, int wc, int fr, int fq) const {
        const int col0 = u.pn * BM + wc * 32 + 4 * fq;
        G8_ROWLOOP { const int tok = plist[u.pm * BM + ai * HALF + wr * 64 + m * 16 + fr];
            if (tok >= 0) { const size_t off = (size_t)tok * DM + col0;
#pragma unroll
                for (int bj = 0; bj < 2; ++bj)
#pragma unroll
                    for (int n = 0; n < 2; ++n) { const f32x4 r = *(const GAS f32x4*)(res + off + bj * HALF + n * 16); *(GAS f32x4*)(res + off + bj * HALF + n * 16) = r * ALPHA + acc[ai][bj][m][n]; } }
            asm volatile("" ::: "memory"); }
    }
};
__device__ __forceinline__ void unpack8(const u32x4 w, float (&x)[8]) {
    x[0] = __builtin_bit_cast(float, w.x << 16); x[1] = __builtin_bit_cast(float, w.x & 0xffff0000u); x[2] = __builtin_bit_cast(float, w.y << 16); x[3] = __builtin_bit_cast(float, w.y & 0xffff0000u);
    x[4] = __builtin_bit_cast(float, w.z << 16); x[5] = __builtin_bit_cast(float, w.z & 0xffff0000u); x[6] = __builtin_bit_cast(float, w.w << 16); x[7] = __builtin_bit_cast(float, w.w & 0xffff0000u); }
struct EpiResidB {
    static constexpr bool PERM = true;
    GAS bf16_t* S;
    __device__ __forceinline__ void operator()(const f32x4 (&acc)[2][2][4][2], const Unit& u, int wr, int wc, int fr, int fq) const {
        const int row0 = u.pm * BM + wr * 64 + fr, col0 = u.pn * BM + wc * 32 + 8 * fq;
        G8_ROWLOOP { GAS bf16_t* rowp = S + (size_t)(row0 + ai * HALF + m * 16) * DM + col0;
#pragma unroll
            for (int bj = 0; bj < 2; ++bj) { float x[8]; unpack8(*(const GAS u32x4*)(rowp + bj * HALF), x); const f32x4 a0 = acc[ai][bj][m][0], a1 = acc[ai][bj][m][1];
                u32x4 w; w.x = cvt_pk_bf16(x[0] * ALPHA + a0[0], x[1] * ALPHA + a0[1]); w.y = cvt_pk_bf16(x[2] * ALPHA + a0[2], x[3] * ALPHA + a0[3]);
                w.z = cvt_pk_bf16(x[4] * ALPHA + a1[0], x[5] * ALPHA + a1[1]); w.w = cvt_pk_bf16(x[6] * ALPHA + a1[2], x[7] * ALPHA + a1[3]);
                *(GAS u32x4*)(rowp + bj * HALF) = w; }
            asm volatile("" ::: "memory"); }
    }
};
struct EpiMoeDownB {
    static constexpr bool PERM = true;
    GAS bf16_t* S; const GAS int* plist;
    __device__ __forceinline__ void operator()(const f32x4 (&acc)[2][2][4][2], const Unit& u, int wr, int wc, int fr, int fq) const {
        const int col0 = u.pn * BM + wc * 32 + 8 * fq;
        G8_ROWLOOP { const int tok = plist[u.pm * BM + ai * HALF + wr * 64 + m * 16 + fr];
            if (tok >= 0) { GAS bf16_t* rowp = S + (size_t)tok * DM + col0;
#pragma unroll
                for (int bj = 0; bj < 2; ++bj) { float x[8]; unpack8(*(const GAS u32x4*)(rowp + bj * HALF), x); const f32x4 a0 = acc[ai][bj][m][0], a1 = acc[ai][bj][m][1];
                    u32x4 w; w.x = cvt_pk_bf16(x[0] * ALPHA + a0[0], x[1] * ALPHA + a0[1]); w.y = cvt_pk_bf16(x[2] * ALPHA + a0[2], x[3] * ALPHA + a0[3]);
                    w.z = cvt_pk_bf16(x[4] * ALPHA + a1[0], x[5] * ALPHA + a1[1]); w.w = cvt_pk_bf16(x[6] * ALPHA + a1[2], x[7] * ALPHA + a1[3]);
                    *(GAS u32x4*)(rowp + bj * HALF) = w; } }
            asm volatile("" ::: "memory"); }
    }
};
struct EpiPleB {
    static constexpr bool PERM = true;
    const GAS bf16_t* S; GAS bf16_t* XG; GAS float* out32;
    __device__ __forceinline__ void operator()(const f32x4 (&acc)[2][2][4][2], const Unit& u, int wr, int wc, int fr, int fq) const {
        const int row0 = u.pm * BM + wr * 64 + fr, col0 = u.pn * BM + wc * 32 + 8 * fq;
        G8_ROWLOOP { const size_t off = (size_t)(row0 + ai * HALF + m * 16) * DM + col0;
#pragma unroll
            for (int bj = 0; bj < 2; ++bj) { float x[8], g[8]; unpack8(*(const GAS u32x4*)(S + off + bj * HALF), x); unpack8(*(const GAS u32x4*)(XG + off + bj * HALF), g);
                const f32x4 a0 = acc[ai][bj][m][0], a1 = acc[ai][bj][m][1]; f32x4 o0, o1;
#pragma unroll
                for (int i = 0; i < 4; ++i) { o0[i] = x[i] + a0[i] * g[i]; o1[i] = x[4 + i] + a1[i] * g[4 + i]; }
                u32x4 w; w.x = cvt_pk_bf16(o0[0], o0[1]); w.y = cvt_pk_bf16(o0[2], o0[3]); w.z = cvt_pk_bf16(o1[0], o1[1]); w.w = cvt_pk_bf16(o1[2], o1[3]);
                *(GAS u32x4*)(XG + off + bj * HALF) = w;
                if (out32) { *(GAS f32x4*)(out32 + off + bj * HALF) = o0; *(GAS f32x4*)(out32 + off + bj * HALF + 4) = o1; }
                asm volatile("" ::: "memory"); } }
    }
};
}

struct Frame {
    LAS unsigned char* lds; GAS unsigned* ctl; GAS unsigned char* ws; GAS float* res;
    int wave, vcu, G;
    __device__ __forceinline__ int lane_id() const { int l; asm volatile("v_mbcnt_lo_u32_b32 %0, -1, 0\n\tv_mbcnt_hi_u32_b32 %0, -1, %0" : "=v"(l)); return l; }
    __device__ __forceinline__ int tid_id() const { return wave * 64 + lane_id(); }
};
__device__ __forceinline__ GAS bf16_t* xb_ptr(const Frame& F, int which) { return (GAS bf16_t*)(F.ws + (which ? WS_XB1 : WS_XB0)); }

struct Job { int in_idx, Ns, nkb, n0, nblk, ldd, drow0, dk0, split, item0; float scale; long long src_off, dst_off; };
constexpr int NJOBS = 55;
struct JobTable { Job j[NJOBS]; int total; int njobs; };
constexpr JobTable make_jobs() {
    JobTable t{}; int n = 0, items = 0;
    auto add = [&](int in_idx, long long src_off, int Ns, int K, int n0, int ncols, long long dst_byte, int ldd, int drow0, int dk0, int split, float scale) {
        Job& j = t.j[n++]; j.in_idx = in_idx; j.src_off = src_off; j.Ns = Ns; j.nkb = K / 64; j.n0 = n0; j.nblk = ncols / 32; j.dst_off = dst_byte; j.ldd = ldd; j.drow0 = drow0; j.dk0 = dk0; j.split = split; j.scale = scale;
        j.item0 = items; items += j.nkb * j.nblk; };
    const long long WD = (long long)WS_WDEAD, WL = (long long)WS_WLIVE;
    const float QS = 0.0625f;
    for (int i = 0; i < 2; ++i) { const long long q = WD + 2 * (long long)(i ? WD_QKV1 : WD_QKV0), o = WD + 2 * (long long)(i ? WD_O1 : WD_O0);
        add(IN_AQKV, (long long)i * 1024 * 3072, 3072, 1024, 0, 1024, q, 1024, 0, 0, 0, QS);
        add(IN_AQKV, (long long)i * 1024 * 3072, 3072, 1024, 1024, 2048, q, 1024, 1024, 0, 0, 1.f);
        add(IN_AO, (long long)i * 1024 * 1024, 1024, 1024, 0, 1024, o, 1024, 0, 0, 0, 1.f); }
    add(IN_BQ, 0, 1024, 1024, 0, 1024, WL + 2 * (long long)WL_QKV2, 1024, 0, 0, 0, QS);
    add(IN_KVF, 0, 2052, 1024, 0, 2048, WL + 2 * (long long)WL_QKV2, 1024, 1024, 0, 0, 1.f);
    add(IN_BQ, (long long)1024 * 1024, 1024, 1024, 0, 1024, WL + 2 * (long long)WL_Q3, 1024, 0, 0, 0, QS);
    add(IN_BO, 0, 1024, 1024, 0, 1024, WL + 2 * (long long)WL_O2, 1024, 0, 0, 0, 1.f);
    add(IN_BO, (long long)1024 * 1024, 1024, 1024, 0, 1024, WL + 2 * (long long)WL_O3, 1024, 0, 0, 0, 1.f);
    for (int i = 0; i < 2; ++i) { const long long gu = i ? WL + 2 * (long long)WL_GU1 : WD + 2 * (long long)WD_GU0, dn = i ? WL + 2 * (long long)WL_DN1 : WD + 2 * (long long)WD_DN0;
        add(IN_FGU, (long long)i * 1024 * 5632, 5632, 1024, 0, 5632, gu, 1024, 0, 0, DFF, 1.f);
        add(IN_FDN, (long long)i * 2816 * 1024, 1024, 2816, 0, 1024, dn, 2816, 0, 0, 0, 1.f); }
    for (int i = 0; i < 2; ++i) for (int e = 0; e < NE; ++e) { const long long gu = i ? WL + 2 * (long long)WL_MGU1 : WD + 2 * (long long)WD_MGU0, dn = i ? WL + 2 * (long long)WL_MDN1 : WD + 2 * (long long)WD_MDN0;
        add(IN_MGU, (long long)(i * NE + e) * 1024 * 1408, 1408, 1024, 0, 1408, gu, 1024, e * 1536, 0, DFE, 1.f);
        add(IN_MDN, (long long)(i * NE + e) * 704 * 1024, 1024, 704, 0, 1024, dn, 5632, 0, e * DFE, 0, 1.f); }
    for (int i = 0; i < 4; ++i) { const long long pp = i == 0 ? WD + 2 * (long long)WD_PP0 : i == 1 ? WD + 2 * (long long)WD_PP1 : i == 2 ? WL + 2 * (long long)WL_PP2 : WL + 2 * (long long)WL_PP3;
        const long long pg = i == 0 ? WD + 2 * (long long)WD_PG0 : i == 1 ? WD + 2 * (long long)WD_PG1 : i == 2 ? WL + 2 * (long long)WL_PG2 : WL + 2 * (long long)WL_PG3;
        add(IN_PP, (long long)i * 256 * 1024, 1024, 256, 0, 1024, pp, 256, 0, 0, 0, 1.f);
        add(IN_PG, (long long)i * 1024 * 1024, 1024, 1024, 0, 1024, pg, 1024, 0, 0, 0, 1.f); }
    t.total = items; t.njobs = n; return t;
}
__device__ const JobTable g_jobs = make_jobs();
static_assert(make_jobs().njobs == NJOBS, "job count");

__device__ __forceinline__ void conv_item(const Frame& F, const Job& J, int it, LAS float* scr) {
    const int lane = F.lane_id(); const int kb = it / J.nblk, nb = it % J.nblk, k0 = 64 * kb, ncol = J.n0 + 32 * nb;
    const GAS float* W = in_sel(J.in_idx) + J.src_off;
    { f32x4 wv[8];
#pragma unroll
      for (int i = 0; i < 8; ++i) wv[i] = *(const GAS f32x4*)(W + (size_t)(k0 + (lane >> 3) + 8 * i) * J.Ns + ncol + (lane & 7) * 4);
#pragma unroll
      for (int i = 0; i < 8; ++i) { LAS float* d = scr + ((lane >> 3) + 8 * i) * 33 + (lane & 7) * 4; d[0] = wv[i][0] * J.scale; d[1] = wv[i][1] * J.scale; d[2] = wv[i][2] * J.scale; d[3] = wv[i][3] * J.scale; } }
    asm volatile("s_waitcnt lgkmcnt(0)" ::: "memory");
    int drow;
    if (J.split) { const int ty = ncol / J.split, jj = ncol % J.split; drow = J.drow0 + 256 * (jj >> 7) + 128 * ty + (jj & 127); } else drow = J.drow0 + (ncol - J.n0);
    GAS bf16_t* WT = (GAS bf16_t*)(F.ws + J.dst_off);
    const int c = lane & 7;
#pragma unroll
    for (int j = 0; j < 4; ++j) { const int n = (lane >> 3) + 8 * j; const LAS float* s = scr + (8 * c) * 33 + n;
        u32x4 o; o.x = pk2(s[0 * 33], s[1 * 33]); o.y = pk2(s[2 * 33], s[3 * 33]); o.z = pk2(s[4 * 33], s[5 * 33]); o.w = pk2(s[6 * 33], s[7 * 33]);
        *(GAS u32x4*)(WT + (size_t)(drow + n) * J.ldd + J.dk0 + k0 + 8 * c) = o; }
    asm volatile("s_waitcnt lgkmcnt(0)" ::: "memory");
}
__device__ __forceinline__ void prologue_phase(Frame& F) {
    LAS float* scr = (LAS float*)(F.lds + F.wave * 16384);
    const int gw = F.vcu * NWAVES + F.wave, NGW = F.G * NWAVES;
    const int total = g_jobs.total;
    for (int it = gw; it < total; it += NGW) {
        int jn = 0;
        for (int k = 1; k < NJOBS; ++k) jn += (it >= g_jobs.j[k].item0) ? 1 : 0;
        jn = __builtin_amdgcn_readfirstlane(jn);
        conv_item(F, g_jobs.j[jn], it - g_jobs.j[jn].item0, scr);
    }
    { const size_t gt = (size_t)blockIdx.x * NTHREADS + F.tid_id(), gs = (size_t)F.G * NTHREADS;
      for (size_t i = gt; i < (size_t)2 * NE * 2 * 64 * 128; i += gs) {
          const int ch = (int)(i & 127), row = (int)((i >> 7) & 63), gu = (int)((i >> 13) & 1), e = (int)((i >> 14) & 7), li = (int)(i >> 17);
          GAS bf16_t* base = (GAS bf16_t*)(F.ws + (li ? WS_WLIVE + 2 * WL_MGU1 : WS_WDEAD + 2 * WD_MGU0));
          *(GAS u32x4*)(base + (size_t)(e * 1536 + 1280 + 128 * gu + 64 + row) * 1024 + ch * 8) = (u32x4){0u, 0u, 0u, 0u}; } }
    GAS bf16_t* xb = xb_ptr(F, 1);
    { const int ln = F.lane_id();
      for (int m = gw; m < T; m += 2 * NGW) {
          const GAS f32x4* xa = (const GAS f32x4*)(in_sel(IN_X) + (size_t)m * DM) + ln; const GAS f32x4* xc = (const GAS f32x4*)(in_sel(IN_X) + (size_t)(m + NGW) * DM) + ln;
          GAS u32x2* oa = (GAS u32x2*)(xb + (size_t)m * DM) + ln; GAS u32x2* oc = (GAS u32x2*)(xb + (size_t)(m + NGW) * DM) + ln;
          f32x4 va[4], vc[4];
#pragma unroll
          for (int j = 0; j < 4; ++j) { va[j] = xa[64 * j]; vc[j] = xc[64 * j]; }
#pragma unroll
          for (int j = 0; j < 4; ++j) { u32x2 o; o.x = cvt_pk_bf16(va[j][0], va[j][1]); o.y = cvt_pk_bf16(va[j][2], va[j][3]); oa[64 * j] = o; o.x = cvt_pk_bf16(vc[j][0], vc[j][1]); o.y = cvt_pk_bf16(vc[j][2], vc[j][3]); oc[64 * j] = o; } } }
}

template <bool ROUTER, bool CVT_P>
__device__ __forceinline__ void ln_phase(Frame& F, int L, int which, GAS bf16_t* S) {
    int tid_ = F.tid_id(); asm volatile("" : "+v"(tid_));
    const int lane = tid_ & 63, w = __builtin_amdgcn_readfirstlane(tid_ >> 6);
    const GAS f32x4* gp = (const GAS f32x4*)(in_sel(IN_LNG) + (size_t)(L * 2 + which) * DM) + 4 * lane; const GAS f32x4* bp = (const GAS f32x4*)(in_sel(IN_LNB) + (size_t)(L * 2 + which) * DM) + 4 * lane;
    f32x4 gg[4], bb[4];
#pragma unroll
    for (int j = 0; j < 4; ++j) { gg[j] = gp[j]; bb[j] = bp[j]; }
    LAS f32x4* wrl = (LAS f32x4*)(F.lds + 1024);
    if constexpr (ROUTER) { const GAS float* Wr = in_sel(IN_MR) + (size_t)(L >> 1) * DM * NE;
        __syncthreads();
        for (int i = w; i < 16; i += NWAVES) { const int k = 16 * lane + i;
            wrl[(i * 2 + 0) * 64 + lane] = *(const GAS f32x4*)(Wr + (size_t)k * NE); wrl[(i * 2 + 1) * 64 + lane] = *(const GAS f32x4*)(Wr + (size_t)k * NE + 4); }
        __syncthreads(); }
    LAS int* hist = (LAS int*)F.lds;
    for (int ch = blockIdx.x; ch < T / 128; ch += F.G) {
        if constexpr (ROUTER) { __syncthreads(); if (tid_ < 40) hist[tid_] = 0; __syncthreads(); }
        u32x4 na, nb, ma, mb; f32x4 npv = (f32x4){0.f, 0.f, 0.f, 0.f}, np2 = npv;
        { const GAS u32x4* x0 = (const GAS u32x4*)(S + (size_t)(128 * ch + 16 * w) * DM) + 2 * lane; na = x0[0]; nb = x0[1]; ma = x0[128]; mb = x0[129];
          if constexpr (CVT_P) { const GAS f32x4* p0 = (const GAS f32x4*)(in_sel(IN_P) + ((size_t)L * T + 128 * ch + 16 * w) * PLE) + lane; npv = p0[0]; np2 = p0[64]; } }
        for (int k = 0; k < 16; ++k) {
            const int row = 128 * ch + 16 * w + k;
            GAS u32x4* xr = (GAS u32x4*)(S + (size_t)row * DM) + 2 * lane;
            float v[16]; { float t8[8]; g8::unpack8(na, t8);
#pragma unroll
                for (int i = 0; i < 8; ++i) v[i] = t8[i];
                g8::unpack8(nb, t8);
#pragma unroll
                for (int i = 0; i < 8; ++i) v[8 + i] = t8[i]; }
            const f32x4 pv = npv; na = ma; nb = mb; npv = np2;
            if (k < 14) { ma = xr[256]; mb = xr[257]; if constexpr (CVT_P) np2 = *((const GAS f32x4*)(in_sel(IN_P) + ((size_t)L * T + row + 2) * PLE) + lane); }
            float s = 0.f;
#pragma unroll
            for (int i = 0; i < 16; ++i) s += v[i];
            const float mean = wave_sum_dpp(s) * (1.f / DM); float s2 = 0.f;
#pragma unroll
            for (int i = 0; i < 16; ++i) { v[i] -= mean; s2 += v[i] * v[i]; }
            const float rstd = 1.f / sqrtf(wave_sum_dpp(s2) * (1.f / DM) + LN_EPS);
#pragma unroll
            for (int i = 0; i < 16; ++i) v[i] = v[i] * rstd * gg[i >> 2][i & 3] + bb[i >> 2][i & 3];
            { u32x4 o; o.x = cvt_pk_bf16(v[0], v[1]); o.y = cvt_pk_bf16(v[2], v[3]); o.z = cvt_pk_bf16(v[4], v[5]); o.w = cvt_pk_bf16(v[6], v[7]); xr[0] = o;
              o.x = cvt_pk_bf16(v[8], v[9]); o.y = cvt_pk_bf16(v[10], v[11]); o.z = cvt_pk_bf16(v[12], v[13]); o.w = cvt_pk_bf16(v[14], v[15]); xr[1] = o; }
            if constexpr (CVT_P) { u32x2 o; o.x = cvt_pk_bf16(pv[0], pv[1]); o.y = cvt_pk_bf16(pv[2], pv[3]);
                *((GAS u32x2*)((GAS bf16_t*)(F.ws + WS_PB) + (size_t)row * PLE) + lane) = o; }
            if constexpr (ROUTER) {
                float lg[NE];
#pragma unroll
                for (int e = 0; e < NE; ++e) lg[e] = 0.f;
#pragma unroll
                for (int i = 0; i < 16; ++i) { const float xv = v[i]; const f32x4 w0 = wrl[(i * 2 + 0) * 64 + lane], w1 = wrl[(i * 2 + 1) * 64 + lane];
#pragma unroll
                    for (int e = 0; e < 4; ++e) { lg[e] += xv * w0[e]; lg[4 + e] += xv * w1[e]; } }
#pragma unroll
                for (int e = 0; e < NE; ++e) lg[e] = wave_sum_dpp(lg[e]);
                int i1 = 0; float v1 = lg[0];
#pragma unroll
                for (int e = 1; e < NE; ++e) if (lg[e] > v1) { v1 = lg[e]; i1 = e; }
                int i2 = -1; float v2 = -3.0e38f;
#pragma unroll
                for (int e = 0; e < NE; ++e) if (e != i1 && lg[e] > v2) { v2 = lg[e]; i2 = e; }
                const float ex = fast_exp(v2 - v1), g1 = __builtin_amdgcn_rcpf(1.f + ex), g2 = 1.f - g1;
                const int ea = i1 < i2 ? i1 : i2, eb = i1 < i2 ? i2 : i1, pid = ea * (15 - ea) / 2 + eb - ea - 1;
                if (lane == 0) { GAS int* rp = (GAS int*)(F.ws + WS_MISC + MS_REC) + (size_t)row * 4; GAS float* gpp = (GAS float*)(F.ws + WS_MISC + MS_GATE);
                    rp[0] = i1 | (i2 << 8) | (pid << 16); rp[1] = 0; rp[2] = 0; rp[3] = row; gpp[row] = g1; gpp[T + row] = g2;
                    __hip_atomic_fetch_add(hist + i1, 1, __ATOMIC_RELAXED, __HIP_MEMORY_SCOPE_WORKGROUP); __hip_atomic_fetch_add(hist + i2, 1, __ATOMIC_RELAXED, __HIP_MEMORY_SCOPE_WORKGROUP);
                    __hip_atomic_fetch_add(hist + 8 + pid, 1, __ATOMIC_RELAXED, __HIP_MEMORY_SCOPE_WORKGROUP); }
            }
        }
        if constexpr (ROUTER) { __syncthreads(); if (tid_ < 40) ((GAS int*)(F.ws + WS_MISC + MS_HIST))[ch * 40 + tid_] = hist[tid_]; }
    }
}

__device__ __forceinline__ int pad256(int v) { return (v + 255) & ~255; }
__device__ __forceinline__ void moe_lists_phase(Frame& F) {
    LAS int* pre = (LAS int*)F.lds; LAS int* tot = pre + 40; LAS int* eoff = tot + 40; LAS int* poff = eoff + 16; LAS int* recs = poff + 32; LAS int* tabl = recs + 128;
    const GAS int* hist = (const GAS int*)(F.ws + WS_MISC + MS_HIST);
    const GAS i32x4* rec = (const GAS i32x4*)(F.ws + WS_MISC + MS_REC);
    GAS i32x4* elist = (GAS i32x4*)(F.ws + WS_MISC + MS_ELIST); GAS int* plist = (GAS int*)(F.ws + WS_MISC + MS_PLIST);
    int tid_ = F.tid_id(); asm volatile("" : "+v"(tid_));
    const int lane = tid_ & 63, w = F.wave, tid = tid_;
    bool first = true;
    for (int ch = blockIdx.x; ch < T / 128; ch += F.G) {
        __syncthreads();
        for (int col = w; col < 36; col += NWAVES) { int sp = 0, st = 0;
#pragma unroll
            for (int k = 0; k < 4; ++k) { const int c2 = lane + 64 * k; const int v = hist[c2 * 40 + col]; st += v; sp += (c2 < ch) ? v : 0; }
#pragma unroll
            for (int o = 1; o < 64; o <<= 1) { sp += shxi(sp, o, lane); st += shxi(st, o, lane); }
            if (lane == 0) { pre[col] = sp; tot[col] = st; } }
        __syncthreads();
        if (tid == 0) {
            int acc = 0, ucum = 0;
            for (int e = 0; e < NE; ++e) { eoff[e] = acc; tabl[TB_EOFF + e] = acc; tabl[TB_ECUM + e] = ucum; const int p = pad256(tot[e]); acc += p; ucum += 6 * (p >> 8); }
            eoff[NE] = acc; tabl[TB_EOFF + NE] = acc; tabl[TB_ECUM + NE] = ucum;
            int pacc = 0, pid = 0;
            for (int a = 0; a < NE - 1; ++a) for (int b = a + 1; b < NE; ++b) { poff[pid] = pacc; pacc += pad256(tot[8 + pid]); ++pid; }
            poff[NPAIR] = pacc; tabl[TB_NRT] = pacc >> 8;
        }
        __syncthreads();
        if (tid < 192) { const int r8 = tid << 8; int p = 0;
            for (int k = 1; k < NPAIR; ++k) p += (r8 >= poff[k]) ? 1 : 0;
            int a = 0, rem = p; while (rem >= NE - 1 - a) { rem -= NE - 1 - a; ++a; }
            tabl[TB_RT2P + tid] = a | ((a + 1 + rem) << 8); }
        __syncthreads();
        if (ch == 0) { for (int i = tid; i < TB_WORDS; i += NTHREADS) ((GAS int*)(F.ws + WS_MISC + MS_TAB))[i] = tabl[i]; }
        if (tid < 128) recs[tid] = rec[128 * ch + tid].x;
        __syncthreads();
        if (tid < 128) {
            const int token = 128 * ch + tid; const i32x4 r = rec[token]; const int e1 = r.x & 0xff, e2 = (r.x >> 8) & 0xff, pid = (r.x >> 16) & 0xff;
            int r1 = 0, r2 = 0, rp = 0;
            for (int j = 0; j < tid; ++j) { const int o = recs[j]; const int o1 = o & 0xff, o2 = (o >> 8) & 0xff, op = (o >> 16) & 0xff;
                r1 += ((o1 == e1) | (o2 == e1)) ? 1 : 0; r2 += ((o1 == e2) | (o2 == e2)) ? 1 : 0; rp += (op == pid) ? 1 : 0; }
            const int pslot = poff[pid] + pre[8 + pid] + rp; plist[pslot] = token;
            i32x4 en; en.x = token; en.w = 0;
            const GAS float* gp = (const GAS float*)(F.ws + WS_MISC + MS_GATE);
            GAS float* eg = (GAS float*)(F.ws + WS_MISC + MS_EGATE); en.z = 0;
            { const int sl = eoff[e1] + pre[e1] + r1; en.y = pslot * 1408 + (e1 < e2 ? 0 : DFE); elist[sl] = en; eg[sl] = gp[token]; }
            { const int sl = eoff[e2] + pre[e2] + r2; en.y = pslot * 1408 + (e2 < e1 ? 0 : DFE); elist[sl] = en; eg[sl] = gp[T + token]; }
        }
        if (first) {
            first = false; const int gt = blockIdx.x * NTHREADS + tid, gs = F.G * NTHREADS;
            for (int e = 0; e < NE; ++e) for (int i = eoff[e] + tot[e] + gt; i < eoff[e + 1]; i += gs) elist[i] = (i32x4){0, -1, 0, 0};
            for (int p = 0; p < NPAIR; ++p) for (int i = poff[p] + tot[8 + p] + gt; i < poff[p + 1]; i += gs) plist[i] = -1;
        }
    }
    __syncthreads();
}
__device__ __forceinline__ void load_tab(Frame& F) {
    __syncthreads();
    for (int i = F.tid_id(); i < TB_WORDS; i += NTHREADS) ((LAS int*)(F.lds + LDS_TAB))[i] = ((const GAS int*)(F.ws + WS_MISC + MS_TAB))[i];
    __syncthreads();
}

__device__ __forceinline__ void forget_phase(Frame& F, const GAS bf16_t* S) {
    int tid_ = F.tid_id(); asm volatile("" : "+v"(tid_));
    const int lane = tid_ & 63, w = __builtin_amdgcn_readfirstlane(tid_ >> 6);
    const GAS float* Wf = in_sel(IN_KVF);
    f32x4 wf[16];
#pragma unroll
    for (int i = 0; i < 16; ++i) wf[i] = *(const GAS f32x4*)(Wf + (size_t)(16 * lane + i) * 2052 + 2048);
    const f32x4 bias = *(const GAS f32x4*)in_sel(IN_KVFB);
    LAS float* lf = (LAS float*)F.lds;
    GAS float* cl = (GAS float*)(F.ws + WS_MISC + MS_CL); GAS float* tt = (GAS float*)(F.ws + WS_MISC + MS_TOT);
    for (int ch = blockIdx.x; ch < T / 128; ch += F.G) {
        __syncthreads();
        for (int k = 0; k < 16; ++k) {
            const int row = 128 * ch + 16 * w + k; const GAS u32x4* xr = (const GAS u32x4*)(S + (size_t)row * DM) + 2 * lane;
            float x[8]; f32x4 a = (f32x4){0.f, 0.f, 0.f, 0.f};
            g8::unpack8(xr[0], x);
#pragma unroll
            for (int i = 0; i < 8; ++i) a += wf[i] * x[i];
            g8::unpack8(xr[1], x);
#pragma unroll
            for (int i = 0; i < 8; ++i) a += wf[8 + i] * x[i];
#pragma unroll
            for (int hh = 0; hh < 4; ++hh) a[hh] = wave_sum_dpp(a[hh]);
            if (lane == 0) { f32x4 o;
#pragma unroll
                for (int hh = 0; hh < 4; ++hh) { const float z = a[hh] + bias[hh]; o[hh] = -(fmaxf(-z, 0.f) + log1pf(__expf(-fabsf(z)))); }
                *(LAS f32x4*)(lf + (16 * w + k) * 4) = o; }
        }
        __syncthreads();
        { const int tile = w >> 2, hh = w & 3; float x = lf[(tile * 64 + lane) * 4 + hh];
#pragma unroll
          for (int o = 1; o < 64; o <<= 1) { const float y = shup(x, o, lane); if (lane >= o) x += y; }
          const int row = 128 * ch + tile * 64 + lane, b = row / SEQ, s = row % SEQ;
          cl[(size_t)(b * NH + hh) * SEQ + s] = x; if (lane == 63) tt[(b * NH + hh) * 256 + (s >> 6)] = x; }
    }
    __syncthreads();
}
__device__ __forceinline__ void knorm_phase(Frame& F, const GAS bf16_t* KS) {
    const int lane = F.lane_id(), w = F.wave;
    for (int ch = blockIdx.x; ch < T / 128; ch += F.G) {
        float mx = 0.f;
        for (int k = 0; k < 16; ++k) { const int row = 128 * ch + 16 * w + k; const GAS u32x4* kr = (const GAS u32x4*)(KS + (size_t)row * DM) + 2 * lane; const u32x4 a = kr[0], b = kr[1];
            const unsigned u[8] = {a.x, a.y, a.z, a.w, b.x, b.y, b.z, b.w}; float s = 0.f;
#pragma unroll
            for (int i = 0; i < 8; ++i) { const float lo = __builtin_bit_cast(float, u[i] << 16), hi = __builtin_bit_cast(float, u[i] & 0xffff0000u); s += lo * lo + hi * hi; }
            s += shx(s, 1, lane); s += shx(s, 2, lane); s += shx(s, 4, lane); s += shx(s, 8, lane);
            mx = fmaxf(mx, s); }
        if ((lane & 15) == 0) { const int b = (128 * ch) / SEQ; (void)__hip_atomic_fetch_max(F.ctl + CW_KN2 + b * NH + (lane >> 4), __builtin_bit_cast(unsigned, mx), RLX_AGENT); }
    }
}

constexpr int AT_KB0 = 0, AT_VB0 = 32768, AT_KB1 = 66048, AT_VB1 = 98816, AT_VPANEL = 2080;
constexpr float SB_STOP = -24.f, FOX_STOP = -30.f;
typedef short s16x4 __attribute__((ext_vector_type(4)));
#define AT_TR4(r0, r1, r2, r3, addr, o0, o1, o2, o3) asm volatile("ds_read_b64_tr_b16 %0, %4 offset:%5\n\tds_read_b64_tr_b16 %1, %4 offset:%6\n\tds_read_b64_tr_b16 %2, %4 offset:%7\n\tds_read_b64_tr_b16 %3, %4 offset:%8" \
    : "=&v"(r0), "=&v"(r1), "=&v"(r2), "=&v"(r3) : "v"(addr), "i"(o0), "i"(o1), "i"(o2), "i"(o3) : "memory")
#define AT_WAIT4(r0, r1, r2, r3) asm volatile("s_waitcnt lgkmcnt(0)" : "+v"(r0), "+v"(r1), "+v"(r2), "+v"(r3) :: "memory")

template <bool FOX>
__device__ __forceinline__ void attn_phase(Frame& F, const GAS bf16_t* Q, const GAS bf16_t* Kb, const GAS bf16_t* Vb, GAS bf16_t* O) {
    LAS unsigned char* lds = F.lds;
    volatile LAS unsigned* flags = (volatile LAS unsigned*)(lds + LDS_FLAGS);
    int tid_ = F.tid_id(); asm volatile("" : "+v"(tid_));
    const int tid = tid_, w = __builtin_amdgcn_readfirstlane(tid >> 6), lane = tid & 63, fr = lane & 15, fq = lane >> 4;
    const int srow0 = tid >> 5, schunk = tid & 31;
    const unsigned kst = (unsigned)(srow0 * 512 + ((schunk ^ (srow0 & 15)) * 16));
    const unsigned vst = (unsigned)((schunk >> 1) * AT_VPANEL + srow0 * 32 + (schunk & 1) * 16);
    const unsigned vrd = (unsigned)((4 * fq + ((lane & 15) >> 2)) * 32 + 8 * (lane & 3));
    const GAS float* cl = (const GAS float*)(F.ws + WS_MISC + MS_CL); const GAS float* tt = (const GAS float*)(F.ws + WS_MISC + MS_TOT);
    for (int id = blockIdx.x; id < 8 * 128; id += F.G) {
        const int bh = id & 7, qt = id >> 3, b = bh >> 2, h = bh & 3, t0 = qt * 128;
        const size_t rowbase = (size_t)b * SEQ;
        const int tq = t0 + 16 * w + fr;
        bf16x8 qf[8];
        { const GAS bf16_t* qp = Q + (rowbase + tq) * DM + h * HD + 8 * fq;
#pragma unroll
          for (int s = 0; s < 8; ++s) qf[s] = *(const GAS bf16x8*)(qp + 32 * s); }
        f32x4 o[16];
#pragma unroll
        for (int d = 0; d < 16; ++d) o[d] = (f32x4){0.f, 0.f, 0.f, 0.f};
        float R = 0.f;
        float mrun = -1.0e30f, lsum = 0.f, cq = 0.f, qn = 0.f, KN = 0.f, gacc = 0.f;
        if constexpr (FOX) {
            float s2 = 0.f;
#pragma unroll
            for (int s = 0; s < 8; ++s)
#pragma unroll
                for (int j = 0; j < 8; ++j) { const float x = bf2f((unsigned short)qf[s][j]); s2 += x * x; }
            s2 += shx(s2, 16, lane); s2 += shx(s2, 32, lane); qn = sqrtf(s2);
            KN = sqrtf(__builtin_bit_cast(float, __hip_atomic_load(F.ctl + CW_KN2 + bh, RLX_AGENT))) * 1.002f;
            cq = cl[(size_t)bh * SEQ + tq] + ((tq >= t0 + 64) ? tt[bh * 256 + 2 * qt] : 0.f);
        }
        int kt = 2 * qt + 1, it = 0; bool wdone = false;
        u32x4 kr[4], vr[4];
        { const GAS bf16_t* kp = Kb + (rowbase + (size_t)64 * kt + srow0) * DM + h * HD + schunk * 8; const GAS bf16_t* vp = Vb + (rowbase + (size_t)64 * kt + srow0) * DM + h * HD + schunk * 8;
#pragma unroll
          for (int j = 0; j < 4; ++j) { kr[j] = *(const GAS u32x4*)(kp + (size_t)16 * j * DM); vr[j] = *(const GAS u32x4*)(vp + (size_t)16 * j * DM); } }
        for (;;) {
            const int kbuf = (it & 1) ? AT_KB1 : AT_KB0, vbuf = (it & 1) ? AT_VB1 : AT_VB0;
#pragma unroll
            for (int j = 0; j < 4; ++j) { *(LAS u32x4*)(lds + kbuf + kst + j * 8192) = kr[j]; *(LAS u32x4*)(lds + vbuf + vst + j * 512) = vr[j]; }
            __syncthreads();
            if (it >= 2) { unsigned any = 0u; const int par = (it - 1) & 1;
#pragma unroll
                for (int k = 0; k < 8; ++k) any |= flags[par * 8 + k];
                if (any == 0u) break; }
            const int kmin = 64 * kt, wmax = t0 + 16 * w + 15, wmin = t0 + 16 * w;
            f32x4 ckv[4]; float ttv = 0.f;
            if constexpr (FOX) {
#pragma unroll
                for (int blk = 0; blk < 4; ++blk) ckv[blk] = *(const GAS f32x4*)(cl + (size_t)bh * SEQ + kmin + 16 * blk + 4 * fq);
                ttv = tt[bh * 256 + (kt > 2 * qt ? 2 * qt : kt)];
                asm volatile("" ::: "memory"); }
            if (kt > 0) { const GAS bf16_t* kp = Kb + (rowbase + (size_t)64 * (kt - 1) + srow0) * DM + h * HD + schunk * 8; const GAS bf16_t* vp = Vb + (rowbase + (size_t)64 * (kt - 1) + srow0) * DM + h * HD + schunk * 8;
#pragma unroll
                for (int j = 0; j < 4; ++j) { kr[j] = *(const GAS u32x4*)(kp + (size_t)16 * j * DM); vr[j] = *(const GAS u32x4*)(vp + (size_t)16 * j * DM); } }
            const bool part = !wdone && (FOX ? (kmin <= wmax) : (kmin < wmax));
            if (part) {
                const bool need_mask = (kmin + 63 >= wmin);
                f32x4 s[4];
#pragma unroll
                for (int blk = 0; blk < 4; ++blk) { s[blk] = (f32x4){0.f, 0.f, 0.f, 0.f};
#pragma unroll
                    for (int st = 0; st < 8; ++st) { const bf16x8 kf = *(const LAS bf16x8*)(lds + kbuf + (16 * blk + fr) * 512 + (((4 * st + fq) ^ fr) * 16));
                        s[blk] = __builtin_amdgcn_mfma_f32_16x16x32_bf16(kf, qf[st], s[blk], 0, 0, 0); } }
                float pv[4][4];
                if constexpr (!FOX) {
                    float lm[4][4], w4[4], Tt[4], Ex[4];
#pragma unroll
                    for (int blk = 0; blk < 4; ++blk) { w4[blk] = 0.f;
#pragma unroll
                        for (int i = 0; i < 4; ++i) { const float z = s[blk][i]; const float sp = softplus_f(z); const bool valid = !need_mask || (kmin + 16 * blk + 4 * fq + i < tq);
                            lm[blk][i] = valid ? -sp : 0.f; pv[blk][i] = valid ? (z - sp) : -1.0e30f; w4[blk] += lm[blk][i]; } }
#pragma unroll
                    for (int blk = 0; blk < 4; ++blk) { const float a = shx(w4[blk], 16, lane), bq = shx(w4[blk], 32, lane), c = shx(a, 32, lane);
                        Tt[blk] = (w4[blk] + a) + (bq + c); Ex[blk] = (fq == 0) ? (a + bq + c) : (fq == 1) ? (bq + c) : (fq == 2) ? a : 0.f; }
                    float bs = 0.f;
#pragma unroll
                    for (int blk = 3; blk >= 0; --blk) { float tail = R + bs + Ex[blk];
#pragma unroll
                        for (int i = 3; i >= 0; --i) { const float e = pv[blk][i] + tail; pv[blk][i] = (e > -80.f) ? fast_exp(e) : 0.f; tail += lm[blk][i]; }
                        bs += Tt[blk]; }
                    R += bs;
                } else {
                    float base;
                    if (kt == 2 * qt + 1) base = ttv; else if (kt == 2 * qt) base = 0.f; else { gacc += ttv; base = -gacc; }
                    float mx = -1.0e30f;
#pragma unroll
                    for (int blk = 0; blk < 4; ++blk) { const f32x4 ck = ckv[blk];
#pragma unroll
                        for (int i = 0; i < 4; ++i) { const bool valid = !need_mask || (kmin + 16 * blk + 4 * fq + i <= tq); const float lg = valid ? (s[blk][i] + cq - (ck[i] + base)) : -1.0e30f; pv[blk][i] = lg; mx = fmaxf(mx, lg); } }
                    mx = fmaxf(mx, shx(mx, 16, lane)); mx = fmaxf(mx, shx(mx, 32, lane));
                    const float mnew = fmaxf(mrun, mx), al = fast_exp(mrun - mnew); float ps = 0.f;
#pragma unroll
                    for (int blk = 0; blk < 4; ++blk)
#pragma unroll
                        for (int i = 0; i < 4; ++i) { const float e = pv[blk][i] - mnew; const float p = (e > -80.f) ? fast_exp(e) : 0.f; pv[blk][i] = p; ps += p; }
                    lsum = lsum * al + ps;
                    if (__any(mnew > mrun)) {
#pragma unroll
                        for (int d = 0; d < 16; ++d) o[d] = o[d] * al; }
                    mrun = mnew;
                }
                bf16x8 pf[2];
#pragma unroll
                for (int c = 0; c < 2; ++c) { u32x4 pw; pw.x = cvt_pk_bf16(pv[2 * c][0], pv[2 * c][1]); pw.y = cvt_pk_bf16(pv[2 * c][2], pv[2 * c][3]); pw.z = cvt_pk_bf16(pv[2 * c + 1][0], pv[2 * c + 1][1]); pw.w = cvt_pk_bf16(pv[2 * c + 1][2], pv[2 * c + 1][3]);
                    pf[c] = __builtin_bit_cast(bf16x8, pw); }
                const unsigned va = (unsigned)(size_t)(lds + vbuf) + vrd;
                s16x4 c0, c1, c2, c3, n0, n1, n2, n3;
                AT_TR4(c0, c1, c2, c3, va, 0, 512, 1024, 1536);
                n0 = c0; n1 = c1; n2 = c2; n3 = c3;
#define AT_PV(db) do { AT_WAIT4(c0, c1, c2, c3); \
                    if ((db) < 15) { AT_TR4(n0, n1, n2, n3, va, ((db) + 1) * AT_VPANEL, ((db) + 1) * AT_VPANEL + 512, ((db) + 1) * AT_VPANEL + 1024, ((db) + 1) * AT_VPANEL + 1536); } \
                    { const bf16x8 v0 = __builtin_shufflevector(c0, c1, 0, 1, 2, 3, 4, 5, 6, 7), v1 = __builtin_shufflevector(c2, c3, 0, 1, 2, 3, 4, 5, 6, 7); \
                      o[db] = __builtin_amdgcn_mfma_f32_16x16x32_bf16(v0, pf[0], o[db], 0, 0, 0); o[db] = __builtin_amdgcn_mfma_f32_16x16x32_bf16(v1, pf[1], o[db], 0, 0, 0); } \
                    c0 = n0; c1 = n1; c2 = n2; c3 = n3; } while (0)
                AT_PV(0); AT_PV(1); AT_PV(2); AT_PV(3); AT_PV(4); AT_PV(5); AT_PV(6); AT_PV(7); AT_PV(8); AT_PV(9); AT_PV(10); AT_PV(11); AT_PV(12); AT_PV(13); AT_PV(14); AT_PV(15);
#undef AT_PV
            } else if constexpr (FOX) { if (kt < 2 * qt) gacc += ttv; }
            { bool cont;
              if constexpr (!FOX) cont = (R >= SB_STOP);
              else cont = (qn * KN + cq + ((kt <= 2 * qt) ? gacc : 0.f) - mrun >= FOX_STOP) || (kt > 2 * qt);
              const bool anyc = !wdone && __any(cont); wdone = !anyc;
              if (lane == 0) flags[(it & 1) * 8 + w] = anyc ? 1u : 0u; }
            if (kt == 0) break;
            --kt; ++it;
        }
        float inv = 1.f;
        if constexpr (FOX) { float lt = lsum; lt += shx(lt, 16, lane); lt += shx(lt, 32, lane); inv = 1.f / lt; }
        { GAS bf16_t* op = O + (rowbase + tq) * DM + h * HD + 4 * fq;
#pragma unroll
          for (int db = 0; db < 16; ++db) { u32x2 ow; ow.x = cvt_pk_bf16(o[db][0] * inv, o[db][1] * inv); ow.y = cvt_pk_bf16(o[db][2] * inv, o[db][3] * inv); *(GAS u32x2*)(op + 16 * db) = ow; } }
        __syncthreads();
    }
}

constexpr int NPH = 41;
__host__ __device__ inline bool phase_nonempty(int k) { if (k == 0) return true; const int L = (k - 1) / 10, s = (k - 1) % 10; if (s == 1) return L == 2; if (s == 5) return (L & 1) != 0; return true; }
struct Args { const float* in[N_IN]; float* out; unsigned char* ws; int ph_lo, ph_hi, sub, pad; };

__global__ void __launch_bounds__(NTHREADS, 2) mk_fwd(Args args) {
    extern __shared__ __attribute__((aligned(16))) unsigned char lds_raw[];
    Frame F;
    F.lds = (LAS unsigned char*)lds_raw;
    F.wave = __builtin_amdgcn_readfirstlane((int)threadIdx.x >> 6);
    F.G = gridDim.x; { const int bx = blockIdx.x; F.vcu = (F.G % 8 == 0) ? (bx % 8) * (F.G / 8) + bx / 8 : bx; }
    F.ws = (GAS unsigned char*)args.ws; F.ctl = (GAS unsigned*)F.ws; F.res = (GAS float*)args.out;
    for (int u = (int)threadIdx.x; u < (LDS_BYTES - LDS_CTL) / 4; u += NTHREADS) ((LAS unsigned*)(F.lds + LDS_CTL))[u] = 0u;
    __syncthreads();
    const int lo = args.ph_lo, hi = args.ph_hi;
    XcdBarrier bar; bar.bar = F.ctl + CW_BAR; bar.x = 0; bar.st = nullptr;
    if (hi - lo > 1) bar = xcd_barrier_post(F.ctl + CW_BAR, (volatile LAS unsigned*)(F.lds + LDS_CTL) + 8);
#ifndef DUP_MASK
#define DUP_MASK 0
#endif
#define DUP(n) (1 + ((DUP_MASK >> (n)) & 1))
#ifndef SITE_MASK
#define SITE_MASK 0xFFFFF
#endif
#define SITE(n) ((SITE_MASK >> (n)) & 1)
#define IN(k) (lo <= (k) && (k) < hi)
#define SEAM(k) do { if ((k) + 1 < hi) xcd_barrier(bar); } while (0)
    const int c = (int)blockIdx.x;
#define WSB(name) GAS unsigned char* name = launder_ptr(F.ws)
#define XBP(ws_, which) ((GAS bf16_t*)((ws_) + ((which) ? WS_XB1 : WS_XB0)))

    if (SITE(0) && IN(0)) { for (int rep_ = 0; rep_ < DUP(0); ++rep_) prologue_phase(F); SEAM(0); }

    for (int L = 0; L < DEPTH; ++L) {
        const int pb = 1 + 10 * L;
        {
            F.wave = launder_int(F.wave); F.ws = launder_ptr(F.ws); F.res = launder_ptr(F.res); F.ctl = (GAS unsigned*)F.ws; F.G = launder_int(F.G); }
        for (int repa_ = 0; repa_ < DUP(20); ++repa_) {
        if (SITE(1) && IN(pb + 0)) {
            WSB(ws);
            const GAS bf16_t* Wqkv = (const GAS bf16_t*)(ws + (L < 2 ? WS_WDEAD : WS_WLIVE)) + (L == 0 ? WD_QKV0 : L == 1 ? WD_QKV1 : L == 2 ? WL_QKV2 : WL_Q3);
            g8::ProbPlain P{XBP(ws, (L + 1) & 1), Wqkv, 1024, 1024, 16, T / 256, (L == 3) ? 4 : 12, F.G, c};
            g8::EpiBf16Split E{(GAS bf16_t*)(ws + WS_QA), 1024, (L == 3) ? 0 : 1024, (size_t)(WS_KS - WS_QA) / 2};
            for (int rep_ = 0; rep_ < DUP(1); ++rep_) g8::gemm_phase<g8::ProbPlain, g8::EpiBf16Split>(F.lds, P, E, F.wave);
            if (SITE(2) && L == 2) forget_phase(F, XBP(ws, (L + 1) & 1));
            SEAM(pb + 0);
        }
        if (SITE(3) && IN(pb + 1) && L == 2) { WSB(ws); knorm_phase(F, (const GAS bf16_t*)(ws + WS_KS)); SEAM(pb + 1); }
        if (IN(pb + 2)) {
            WSB(ws); GAS bf16_t* QA = (GAS bf16_t*)(ws + WS_QA); const GAS bf16_t* KS = (const GAS bf16_t*)(ws + WS_KS); const GAS bf16_t* VS = (const GAS bf16_t*)(ws + WS_VS);
            if (L < 2) { if (SITE(4)) attn_phase<false>(F, QA, KS, VS, QA); } else { if (SITE(5)) attn_phase<true>(F, QA, KS, VS, QA); }
            SEAM(pb + 2);
        }
        }
        if (SITE(6) && IN(pb + 3)) {
            WSB(ws);
            const GAS bf16_t* Wo = (const GAS bf16_t*)(ws + (L < 2 ? WS_WDEAD : WS_WLIVE)) + (L == 0 ? WD_O0 : L == 1 ? WD_O1 : L == 2 ? WL_O2 : WL_O3);
            g8::ProbPlain P{(const GAS bf16_t*)(ws + WS_QA), Wo, 1024, 1024, 16, T / 256, 4, F.G, c};
            g8::EpiResidB E{XBP(ws, (L + 1) & 1)};
            g8::gemm_phase<g8::ProbPlain, g8::EpiResidB>(F.lds, P, E, F.wave);
            SEAM(pb + 3);
        }
        if (IN(pb + 4)) { WSB(ws); GAS bf16_t* xln1 = XBP(ws, (L + 1) & 1); if (L & 1) { if (SITE(7)) ln_phase<true, true>(F, L, 0, xln1); } else { if (SITE(8)) ln_phase<false, true>(F, L, 0, xln1); } SEAM(pb + 4); }
        if (SITE(9) && IN(pb + 5) && (L & 1)) { moe_lists_phase(F); SEAM(pb + 5); }
        if (IN(pb + 6)) {
            WSB(ws); const GAS bf16_t* xln1 = XBP(ws, (L + 1) & 1);
            if (L & 1) { if (SITE(10)) { load_tab(F);
                const GAS bf16_t* Wmgu = (const GAS bf16_t*)(ws + (L == 1 ? WS_WDEAD : WS_WLIVE)) + (L == 1 ? WD_MGU0 : WL_MGU1); const GAS i32x4* elist = (const GAS i32x4*)(ws + WS_MISC + MS_ELIST);
                g8::ProbMoeGU P{xln1, Wmgu, elist, (const LAS int*)(F.lds + LDS_TAB), 1024, 1024, 16, F.G, c}; g8::EpiMoeGU E{(GAS bf16_t*)(ws + (L == 1 ? WS_QA : WS_WDEAD)), elist, (const GAS float*)(ws + WS_MISC + MS_EGATE)};
                for (int rep_ = 0; rep_ < DUP(10); ++rep_) g8::gemm_phase<g8::ProbMoeGU, g8::EpiMoeGU>(F.lds, P, E, F.wave); } }
            else if (SITE(11)) { const GAS bf16_t* Wgu = (const GAS bf16_t*)(ws + (L == 0 ? WS_WDEAD : WS_WLIVE)) + (L == 0 ? WD_GU0 : WL_GU1);
                g8::ProbPlain P{xln1, Wgu, 1024, 1024, 16, T / 256, 22, F.G, c}; g8::EpiSwiglu E{(GAS bf16_t*)(ws + (L == 0 ? WS_QA : WS_XB0)), DFF};
                for (int rep_ = 0; rep_ < DUP(11); ++rep_) g8::gemm_phase<g8::ProbPlain, g8::EpiSwiglu>(F.lds, P, E, F.wave); }
            SEAM(pb + 6);
        }
        if (IN(pb + 7)) {
            WSB(ws);
            if (L & 1) { if (SITE(12)) { load_tab(F);
                const GAS bf16_t* Wmdn = (const GAS bf16_t*)(ws + (L == 1 ? WS_WDEAD : WS_WLIVE)) + (L == 1 ? WD_MDN0 : WL_MDN1);
                g8::ProbMoeDown P{(const GAS bf16_t*)(ws + (L == 1 ? WS_QA : WS_WDEAD)), Wmdn, (const LAS int*)(F.lds + LDS_TAB), 1408, 5632, 22, F.G, c}; g8::EpiMoeDownB E{XBP(ws, (L + 1) & 1), (const GAS int*)(ws + WS_MISC + MS_PLIST)};
                g8::gemm_phase<g8::ProbMoeDown, g8::EpiMoeDownB>(F.lds, P, E, F.wave); } }
            else if (SITE(13)) { const GAS bf16_t* Wdn = (const GAS bf16_t*)(ws + (L == 0 ? WS_WDEAD : WS_WLIVE)) + (L == 0 ? WD_DN0 : WL_DN1);
                g8::ProbPlain P{(const GAS bf16_t*)(ws + (L == 0 ? WS_QA : WS_XB0)), Wdn, DFF, DFF, 44, T / 256, 4, F.G, c}; g8::EpiResidB E{XBP(ws, (L + 1) & 1)};
                g8::gemm_phase<g8::ProbPlain, g8::EpiResidB>(F.lds, P, E, F.wave); }
            SEAM(pb + 7);
        }
        if (SITE(14) && IN(pb + 8)) { WSB(ws); ln_phase<false, false>(F, L, 1, XBP(ws, (L + 1) & 1)); SEAM(pb + 8); }
        if (IN(pb + 9)) {
            if (SITE(15) && args.sub != 2) { WSB(ws); const GAS bf16_t* Wpg = (const GAS bf16_t*)(ws + (L < 2 ? WS_WDEAD : WS_WLIVE)) + (L == 0 ? WD_PG0 : L == 1 ? WD_PG1 : L == 2 ? WL_PG2 : WL_PG3);
                g8::ProbPlain P{XBP(ws, (L + 1) & 1), Wpg, 1024, 1024, 16, T / 256, 4, F.G, c}; g8::EpiGate E{XBP(ws, L & 1)}; for (int rep_ = 0; rep_ < DUP(15); ++rep_) g8::gemm_phase<g8::ProbPlain, g8::EpiGate>(F.lds, P, E, F.wave); }
            if (SITE(16) && args.sub != 1) { WSB(ws); const GAS bf16_t* Wpp = (const GAS bf16_t*)(ws + (L < 2 ? WS_WDEAD : WS_WLIVE)) + (L == 0 ? WD_PP0 : L == 1 ? WD_PP1 : L == 2 ? WL_PP2 : WL_PP3);
                g8::ProbPlain P{(const GAS bf16_t*)(ws + WS_PB), Wpp, PLE, PLE, 4, T / 256, 4, F.G, c}; g8::EpiPleB E{XBP(ws, (L + 1) & 1), XBP(ws, L & 1), L == DEPTH - 1 ? F.res : (GAS float*)nullptr}; g8::gemm_phase<g8::ProbPlain, g8::EpiPleB>(F.lds, P, E, F.wave); }
            if (pb + 9 < NPH - 1) SEAM(pb + 9);
        }
    }
#undef WSB
#undef XBP
#undef IN
#undef SEAM
}

extern "C" void kernel_launch(void* const* d_in, const int* in_sizes, int n_in, void* d_out, int out_size, void* d_ws, size_t ws_size, hipStream_t stream) {
    static int grid = 0;
    if (grid == 0) {
        if (n_in != N_IN || out_size != T * DM || ws_size < WS_END) { fprintf(stderr, "kernel_launch: unexpected problem (n_in %d, out %d, ws %zu < %zu)\n", n_in, out_size, ws_size, (size_t)WS_END); grid = -1; return; }
        int dev = 0, cus = 0, per_cu = 0;
        if (hipGetDevice(&dev) != hipSuccess || hipDeviceGetAttribute(&cus, hipDeviceAttributeMultiprocessorCount, dev) != hipSuccess) { grid = -1; return; }
        if (hipFuncSetAttribute((const void*)mk_fwd, hipFuncAttributeMaxDynamicSharedMemorySize, LDS_BYTES) != hipSuccess) { fprintf(stderr, "kernel_launch: hipFuncSetAttribute failed\n"); grid = -1; return; }
        if (hipOccupancyMaxActiveBlocksPerMultiprocessor(&per_cu, (const void*)mk_fwd, NTHREADS, LDS_BYTES) != hipSuccess || per_cu < 1) { fprintf(stderr, "kernel_launch: occupancy query says %d blocks per CU\n", per_cu); }
        (void)hipGetLastError();
        grid = cus;
    }
    if (grid < 0) return;
    (void)hipMemsetAsync((char*)d_ws + WS_CTL, 0, CTL_ZERO_BYTES, stream);
    Args a{};
    for (int i = 0; i < N_IN; ++i) a.in[i] = (const float*)d_in[i];
    a.out = (float*)d_out; a.ws = (unsigned char*)d_ws;
    a.ph_lo = 0; a.ph_hi = NPH; a.sub = 0; a.pad = 0;
    hipLaunchKernelGGL(mk_fwd, dim3(grid), dim3(NTHREADS), LDS_BYTES, stream, a);
}
```

```cpp
#include <hip/hip_runtime.h>
#include <cstdio>
#include <cstdint>


#define LAS __attribute__((address_space(3)))
#define GAS __attribute__((address_space(1)))
typedef unsigned short bf16_t;
typedef short bf16x8 __attribute__((ext_vector_type(8)));
typedef short bf16x4 __attribute__((ext_vector_type(4)));
typedef float f32x4 __attribute__((ext_vector_type(4)));
typedef float f32x2 __attribute__((ext_vector_type(2)));
typedef unsigned u32x4 __attribute__((ext_vector_type(4)));
typedef unsigned u32x2 __attribute__((ext_vector_type(2)));
typedef int i32x4 __attribute__((ext_vector_type(4)));

constexpr int DM = 1024, NBATCH = 2, SEQ = 16384, T = NBATCH * SEQ, NH = 4, HD = 256, DFF = 2816, NE = 8, DFE = 704, PLE = 256, DEPTH = 4;
constexpr float ALPHA = 1.6817928305074292f;
constexpr float LN_EPS = 1e-5f;
constexpr int NWAVES = 8, NTHREADS = 512;
enum { IN_X = 0, IN_P, IN_AQKV, IN_AO, IN_KVF, IN_KVFB, IN_BQ, IN_BO, IN_FGU, IN_FDN, IN_MR, IN_MGU, IN_MDN, IN_PP, IN_PG, IN_LNG, IN_LNB, N_IN };

constexpr size_t MiB = 1u << 20;
constexpr size_t WS_CTL = 0, CTL_ZERO_BYTES = 1 * MiB;
constexpr size_t WS_MISC = 1 * MiB;
constexpr size_t WS_WLIVE = 8 * MiB;
constexpr size_t WS_PB = 77 * MiB;
constexpr size_t WS_XB1 = 93 * MiB, WS_XB0 = 157 * MiB;
constexpr size_t WS_WDEAD = 221 * MiB;
constexpr size_t WS_QA = 294 * MiB, WS_KS = 358 * MiB, WS_VS = 422 * MiB, WS_END = 486 * MiB;
constexpr size_t MS_REC = 0;
constexpr size_t MS_HIST = 512 * 1024;
constexpr size_t MS_ELIST = 576 * 1024;
constexpr int ELIST_CAP = 2 * T + NE * 256;
constexpr size_t MS_PLIST = MS_ELIST + (size_t)ELIST_CAP * 16;
constexpr int NPAIR = 28, PLIST_CAP = T + NPAIR * 256;
constexpr size_t MS_TAB = 2 * MiB;
constexpr size_t MS_CL = 2 * MiB + 64 * 1024;
constexpr size_t MS_TOT = MS_CL + (size_t)8 * SEQ * 4;
constexpr size_t MS_SNAP = 3 * MiB;
constexpr size_t MS_EGATE = 4 * MiB + 512 * 1024;
constexpr size_t MS_GATE = 4 * MiB;
static_assert(MS_PLIST + (size_t)PLIST_CAP * 4 <= MS_TAB && MS_TOT + 8 * 256 * 4 <= MS_SNAP, "misc map");
enum { TB_ECUM = 0  , TB_EOFF = 16  , TB_NRT = 32, TB_RT2P = 64  , TB_WORDS = 320 };
constexpr int CW_TMO = 0, CW_CODE = 1, CW_DBG = 64  , CW_KN2 = 192  , CW_BAR = 4096;

constexpr size_t WSZ_QKV = (size_t)3072 * 1024, WSZ_SQ = (size_t)1024 * 1024, WSZ_GU = (size_t)5632 * 1024, WSZ_DN = (size_t)1024 * 2816,
                 WSZ_MGU = (size_t)NE * 1536 * 1024, WSZ_MDN = (size_t)1024 * 5632, WSZ_PP = (size_t)1024 * 256;
constexpr size_t WD_QKV0 = 0, WD_O0 = WD_QKV0 + WSZ_QKV, WD_QKV1 = WD_O0 + WSZ_SQ, WD_O1 = WD_QKV1 + WSZ_QKV, WD_GU0 = WD_O1 + WSZ_SQ, WD_DN0 = WD_GU0 + WSZ_GU,
                 WD_MGU0 = WD_DN0 + WSZ_DN, WD_MDN0 = WD_MGU0 + WSZ_MGU, WD_PP0 = WD_MDN0 + WSZ_MDN, WD_PG0 = WD_PP0 + WSZ_PP, WD_PP1 = WD_PG0 + WSZ_SQ, WD_PG1 = WD_PP1 + WSZ_PP, WD_END = WD_PG1 + WSZ_SQ;
constexpr size_t WL_QKV2 = 0, WL_O2 = WL_QKV2 + WSZ_QKV, WL_Q3 = WL_O2 + WSZ_SQ, WL_O3 = WL_Q3 + WSZ_SQ, WL_GU1 = WL_O3 + WSZ_SQ, WL_DN1 = WL_GU1 + WSZ_GU,
                 WL_MGU1 = WL_DN1 + WSZ_DN, WL_MDN1 = WL_MGU1 + WSZ_MGU, WL_PP2 = WL_MDN1 + WSZ_MDN, WL_PG2 = WL_PP2 + WSZ_PP, WL_PP3 = WL_PG2 + WSZ_SQ, WL_PG3 = WL_PP3 + WSZ_PP, WL_END = WL_PG3 + WSZ_SQ;
static_assert(WD_END * 2 <= 73 * MiB && WL_END * 2 <= 69 * MiB, "weight regions");
static_assert((size_t)T * DFF * 2 <= WS_END - WS_QA && WS_XB0 + (size_t)T * DFF * 2 <= WS_KS && WS_WDEAD + (size_t)(T + NPAIR * 256) * 1408 * 2 <= WS_KS, "h overlays");

constexpr int RING_BYTES = 131072;
constexpr int LDS_CTL = 135168;
constexpr int LDS_TAB = LDS_CTL + 128;
constexpr int LDS_FLAGS = LDS_TAB + TB_WORDS * 4;
constexpr int LDS_BYTES = 147456;
static_assert(LDS_FLAGS + 64 <= LDS_BYTES, "LDS map");

#define RLX_AGENT __ATOMIC_RELAXED, __HIP_MEMORY_SCOPE_AGENT
__device__ __forceinline__ unsigned f2bf(float f) { unsigned u = __builtin_bit_cast(unsigned, f); return (u + 0x7fffu + ((u >> 16) & 1u)) >> 16; }
__device__ __forceinline__ unsigned pk2(float lo, float hi) { return f2bf(lo) | (f2bf(hi) << 16); }
__device__ __forceinline__ float bf2f(unsigned short b) { return __builtin_bit_cast(float, (unsigned)b << 16); }
typedef __bf16 bf16v2_t __attribute__((ext_vector_type(2)));
__device__ __forceinline__ unsigned cvt_pk_bf16(float lo, float hi) { bf16v2_t v; v[0] = (__bf16)lo; v[1] = (__bf16)hi; return __builtin_bit_cast(unsigned, v); }
__device__ __forceinline__ float shx(float v, int m, int lane) { return __builtin_bit_cast(float, __builtin_amdgcn_ds_bpermute((lane ^ m) << 2, __builtin_bit_cast(int, v))); }
__device__ __forceinline__ int shxi(int v, int m, int lane) { return __builtin_amdgcn_ds_bpermute((lane ^ m) << 2, v); }
__device__ __forceinline__ float shup(float v, int o, int lane) { return __builtin_bit_cast(float, __builtin_amdgcn_ds_bpermute(((lane - o) & 63) << 2, __builtin_bit_cast(int, v))); }
__device__ __forceinline__ float wave_sum(float v, int lane) {
#pragma unroll
    for (int o = 1; o < 64; o <<= 1) v += shx(v, o, lane);
    return v;
}
template <int CTRL> __device__ __forceinline__ float dpp_mov(float v) { return __builtin_bit_cast(float, __builtin_amdgcn_update_dpp(0, __builtin_bit_cast(int, v), CTRL, 0xF, 0xF, true)); }
__device__ __forceinline__ float wave_sum_dpp(float v) {
    v += dpp_mov<0xB1>(v); v += dpp_mov<0x4E>(v); v += dpp_mov<0x141>(v); v += dpp_mov<0x140>(v);
    const int b = __builtin_bit_cast(int, v);
    return (__builtin_bit_cast(float, __builtin_amdgcn_readlane(b, 0)) + __builtin_bit_cast(float, __builtin_amdgcn_readlane(b, 16))) + (__builtin_bit_cast(float, __builtin_amdgcn_readlane(b, 32)) + __builtin_bit_cast(float, __builtin_amdgcn_readlane(b, 48)));
}
__device__ __forceinline__ float fast_exp(float x) { return __builtin_amdgcn_exp2f(x * 1.4426950408889634f); }
__device__ __forceinline__ float fast_log(float x) { return __builtin_amdgcn_logf(x) * 0.6931471805599453f; }
__device__ __forceinline__ float softplus_f(float z) { return fmaxf(z, 0.f) + fast_log(1.f + fast_exp(-fabsf(z))); }
__device__ __forceinline__ float sigmoid_f(float z) { return __builtin_amdgcn_rcpf(1.f + fast_exp(-z)); }

typedef const GAS float* fptr_t;
__device__ __forceinline__ const GAS float* in_sel(int idx) { const __attribute__((address_space(4))) fptr_t* ka = (const __attribute__((address_space(4))) fptr_t*)__builtin_amdgcn_kernarg_segment_ptr(); return ka[idx]; }

template <class Tp> __device__ __forceinline__ GAS Tp* launder_ptr(GAS Tp* p) { unsigned lo = (unsigned)(unsigned long long)p, hi = (unsigned)((unsigned long long)p >> 32); asm volatile("" : "+v"(lo), "+v"(hi));
    lo = __builtin_amdgcn_readfirstlane(lo); hi = __builtin_amdgcn_readfirstlane(hi); return (GAS Tp*)(((unsigned long long)hi << 32) | lo); }
__device__ __forceinline__ int launder_int(int v) { asm volatile("" : "+v"(v)); return __builtin_amdgcn_readfirstlane(v); }

#define XB_TMO      128
#define XB_XCNT(j)  (256  + 64 * (j))
#define XB_XSUB(j)  (1280 + 64 * (j))
#define XB_XGEN(j)  (2304 + 64 * (j))
#define XB_TOP      3328
#define XB_TOPGEN   3392
#define XCD_BAR_WORDS 3456
#define XB_SPIN_CAP (1u << 18)
__device__ __forceinline__ unsigned xb_ld(GAS unsigned* p)              { return __hip_atomic_load(p, __ATOMIC_RELAXED, __HIP_MEMORY_SCOPE_AGENT); }
__device__ __forceinline__ unsigned xb_add(GAS unsigned* p, unsigned v) { return __hip_atomic_fetch_add(p, v, __ATOMIC_RELAXED, __HIP_MEMORY_SCOPE_AGENT); }
__device__ __forceinline__ unsigned xb_xcc_id() { return (unsigned)__builtin_amdgcn_s_getreg((3 << 11) | 20) & 0xFu; }
#define XB_SPIN(cond, bar) do { unsigned _sp = 0; while (cond) { __builtin_amdgcn_s_sleep(1); \
    if ((++_sp & 255u) == 0u) { if (xb_ld(&(bar)[XB_TMO])) break; if (_sp > XB_SPIN_CAP) { (void)xb_add(&(bar)[XB_TMO], 1u); break; } } } } while (0)
struct XcdBarrier { GAS unsigned* bar; unsigned x; volatile LAS unsigned* st; };
__device__ __forceinline__ XcdBarrier xcd_barrier_post(GAS unsigned* bar, volatile LAS unsigned* st) {
    XcdBarrier b; b.bar = bar; b.x = xb_xcc_id(); b.st = st;
    if (threadIdx.x == 0) (void)xb_add(&bar[XB_XCNT(b.x)], 1u);
    return b;
}
__device__ __forceinline__ void xcd_barrier_complete(GAS unsigned* bar, unsigned x, unsigned& nloc, unsigned& nx) {
    const unsigned G = gridDim.x * gridDim.y * gridDim.z;
    unsigned sum, cnt, mine, sp = 0u;
    for (;;) {
        sum = 0u; cnt = 0u; mine = 0u;
#pragma unroll
        for (unsigned j = 0; j < 16; ++j) { const unsigned c = xb_ld(&bar[XB_XCNT(j)]); sum += c; cnt += (c > 0u) ? 1u : 0u; mine = (j == x) ? c : mine; }
        if (sum == G) break;
        __builtin_amdgcn_s_sleep(1);
        if ((++sp & 255u) == 0u) { if (xb_ld(&bar[XB_TMO])) break; if (sp > XB_SPIN_CAP) { (void)xb_add(&bar[XB_TMO], 1u); break; } }
    }
    nloc = mine > 0u ? mine : 1u; nx = cnt > 0u ? cnt : 1u;
}
__device__ __forceinline__ void xcd_barrier(const XcdBarrier& b) {
    asm volatile("s_waitcnt vmcnt(0)" ::: "memory");
    __syncthreads();
    if (threadIdx.x == 0) {
        GAS unsigned* bar = b.bar;
        __builtin_amdgcn_s_waitcnt(0);
        unsigned nloc = b.st[0], nx = b.st[1];
        if (nloc == 0u) { xcd_barrier_complete(bar, b.x, nloc, nx); b.st[0] = nloc; b.st[1] = nx; }
        const unsigned old = xb_add(&bar[XB_XSUB(b.x)], 1u);
        const unsigned gen = old / nloc;
        if (old + 1u == (gen + 1u) * nloc) {
            __builtin_amdgcn_fence(__ATOMIC_RELEASE, "agent");
            asm volatile("s_waitcnt vmcnt(0)" ::: "memory");
            const unsigned og = xb_add(&bar[XB_TOP], 1u);
            const unsigned tg = og / nx;
            if (og + 1u == (tg + 1u) * nx) xb_add(&bar[XB_TOPGEN], 1u);
            else XB_SPIN(xb_ld(&bar[XB_TOPGEN]) == tg, bar);
            __builtin_amdgcn_fence(__ATOMIC_ACQUIRE, "agent");
            xb_add(&bar[XB_XGEN(b.x)], 1u);
            asm volatile("s_waitcnt vmcnt(0)" ::: "memory");
        } else {
            XB_SPIN(xb_ld(&bar[XB_XGEN(b.x)]) == gen, bar);
            __builtin_amdgcn_fence(__ATOMIC_ACQUIRE, "agent");
            asm volatile("s_waitcnt vmcnt(0)" ::: "memory");
        }
    }
    __syncthreads();
}

namespace g8 {
constexpr int BM = 256, BK = 64, HALF = 128, HTB = HALF * BK * 2, STAGE_BYTES = 8 * HTB, NXCD = 8, WGM = 8;
__host__ __device__ __forceinline__ int lds_byte(int r, int c) { const int st = (r >> 4) * 2 + (c >> 5), rr = r & 15, cc = c & 31, ob = rr * 64 + cc * 2; return st * 1024 + (ob ^ (((ob >> 9) & 1) << 5)); }
__host__ __device__ __forceinline__ void stage_rc(int b, int& R, int& C) { const int st = b / 1024, sb = b % 1024, swz = sb ^ (((sb >> 9) & 1) << 5); R = (st >> 1) * 16 + swz / 64; C = (st & 1) * 32 + (swz % 64) / 2; }
__host__ __device__ __forceinline__ int perm32(int rho) { const int n = rho >> 4, i = rho & 15; return 8 * (i >> 2) + 4 * n + (i & 3); }
struct Unit { int pm, pn, x0, x1; };
__device__ __forceinline__ bool static_order(int i, int G, int c, int nM, int nN, int& pm, int& pn) {
    const int nwg = nM * nN; const long L = (long)i * G + c; if (L >= nwg) return false;
    int wgid = (int)L; { const int q = nwg / NXCD, r = nwg % NXCD, xcd = wgid % NXCD, off = wgid / NXCD; wgid = (xcd < r ? xcd * (q + 1) : r * (q + 1) + (xcd - r) * q) + off; }
    const int nig = WGM * nN, gid = wgid / nig, fm = gid * WGM, gsz = (nM - fm) < WGM ? (nM - fm) : WGM;
    pm = fm + ((wgid % nig) % gsz); pn = (wgid % nig) / gsz; return true;
}

template <class Prob, class Epi, bool ALIGN_EPI = true>
__device__ __forceinline__ void gemm_phase(LAS unsigned char* lds, const Prob& P, const Epi& E, int wave_id) {
    int tid_; asm volatile("v_mbcnt_lo_u32_b32 %0, -1, 0\n\tv_mbcnt_hi_u32_b32 %0, -1, %0" : "=v"(tid_)); tid_ += wave_id * 64;
    const int tid = tid_, wid = __builtin_amdgcn_readfirstlane(tid >> 6), lane = tid & 63, wr = wid >> 2, wc = wid & 3, fr = lane & 15, fq = lane >> 4;
    const int nt = P.nt;
    unsigned voffA[2], voffB[2]; int Rr0 = 0; unsigned voffC = 0;
#pragma unroll
    for (int i = 0; i < 2; ++i) { int R, C; stage_rc(tid * 16 + i * 8192, R, C); const int Rb = Epi::PERM ? ((R & ~31) + perm32(R & 31)) : R;
        voffA[i] = (unsigned)(R * P.lda + C) * 2u; voffB[i] = (unsigned)(Rb * P.ldb + C) * 2u; if (i == 0) { Rr0 = R; voffC = (unsigned)C * 2u; } }
    const size_t kstep = (size_t)(BK * 2);
    const size_t hstepA = (size_t)HALF * P.lda * 2, hstepB = (size_t)HALF * P.ldb * 2;
    const unsigned ldsw = (unsigned)wid * 1024u;
    const int aoff = lds_byte(wr * 64 + fr, fq * 8), boff = lds_byte(wc * 32 + fr, fq * 8);
#define G8_SA(b, h) (((b) * 2 + (h)) * HTB)
#define G8_SB(b, h) ((4 + (b) * 2 + (h)) * HTB)
#define G8_STAGE(bufoff, gbase, voff) do { _Pragma("unroll") for (int _i = 0; _i < 2; ++_i) \
        __builtin_amdgcn_global_load_lds((const GAS unsigned*)((const GAS char*)(gbase) + (voff)[_i]), (LAS unsigned*)(lds + (bufoff) + ldsw + _i * 8192), 16, 0, 0); } while (0)
#define G8_STAGE_A(bufoff, h, kb, NX) do { if constexpr (Prob::GATHER) { const unsigned pk_ = (NX) ? gAn[h] : gAc[h]; const unsigned vo_[2] = {(pk_ & 0xffffu) * (unsigned)(P.lda * 2) + voffC, (pk_ >> 16) * (unsigned)(P.lda * 2) + voffC}; \
        G8_STAGE(bufoff, P.a_base() + (kb), vo_); } \
        else { G8_STAGE(bufoff, ((NX) ? nA : cA) + (h) * hstepA + (kb), voffA); } } while (0)
#define G8_LDA(dst, b, h) do { _Pragma("unroll") for (int m = 0; m < 4; ++m) _Pragma("unroll") for (int k = 0; k < 2; ++k) dst[m][k] = *(const LAS bf16x8*)(lds + G8_SA(b, h) + aoff + m * 2048 + k * 1024); } while (0)
#define G8_LDB(dst, b, h) do { _Pragma("unroll") for (int n = 0; n < 2; ++n) _Pragma("unroll") for (int k = 0; k < 2; ++k) dst[n][k] = *(const LAS bf16x8*)(lds + G8_SB(b, h) + boff + n * 2048 + k * 1024); } while (0)
#define G8_MMA(ai, bj, At, Bt) do { __builtin_amdgcn_s_setprio(1); _Pragma("unroll") for (int m = 0; m < 4; ++m) _Pragma("unroll") for (int n = 0; n < 2; ++n) _Pragma("unroll") for (int k = 0; k < 2; ++k) \
        acc[ai][bj][m][n] = __builtin_amdgcn_mfma_f32_16x16x32_bf16(Bt[n][k], At[m][k], acc[ai][bj][m][n], 0, 0, 0); __builtin_amdgcn_s_setprio(0); } while (0)
#define G8_WAIT_V(n) asm volatile("s_waitcnt vmcnt(" #n ")" ::: "memory")
#define G8_WAIT_L(n) asm volatile("s_waitcnt lgkmcnt(" #n ")" ::: "memory")
#define G8_BAR __builtin_amdgcn_s_barrier()
#define G8_SCHED __builtin_amdgcn_sched_barrier(0)
    Unit cur, nxt; int ui = 0;
    if (!P.next(0, cur)) return;
    f32x4 acc[2][2][4][2];
#pragma unroll
    for (int a = 0; a < 2; ++a)
#pragma unroll
        for (int b = 0; b < 2; ++b)
#pragma unroll
            for (int m = 0; m < 4; ++m)
#pragma unroll
                for (int n = 0; n < 2; ++n) acc[a][b][m][n] = (f32x4){0.f, 0.f, 0.f, 0.f};
    bf16x8 At[4][2], B0[2][2], B1[2][2];
    unsigned gAc[2], gAn[2];
    const GAS char* cA = nullptr; const GAS char* nA = nullptr;
    if constexpr (Prob::GATHER) { P.gather(cur, Rr0, gAc); } else { cA = P.a_tile(cur); }
    {
        const GAS char* b0 = P.b_ptr(cur, 0); const GAS char* b1 = P.b_ptr(cur, 1);
        G8_STAGE(G8_SB(0, 0), b0, voffB); G8_STAGE(G8_SB(0, 1), b0 + hstepB, voffB); G8_STAGE_A(G8_SA(0, 0), 0, 0, false); G8_STAGE_A(G8_SA(0, 1), 1, 0, false);
        if (wr == 1) G8_BAR;
        G8_WAIT_V(2); G8_BAR;
        G8_STAGE(G8_SB(1, 0), b1, voffB); G8_STAGE_A(G8_SA(1, 0), 0, kstep, false); G8_STAGE(G8_SB(1, 1), b1 + hstepB, voffB);
        G8_WAIT_V(6); G8_BAR;
    }
    for (;;) {
        const bool has_next = P.next(ui + 1, nxt);
        if (!has_next) nxt = cur;
        if constexpr (Prob::GATHER) { if (has_next) P.gather(nxt, Rr0, gAn); else { gAn[0] = gAc[0]; gAn[1] = gAc[1]; } }
        else { nA = P.a_tile(nxt); }
        for (int t = 0; t < nt; t += 2) {
            const bool last = (t == nt - 2);
            const size_t a1k = (size_t)(t + 1) * kstep;
            const size_t a2k = last ? 0 : (size_t)(t + 2) * kstep, a3k = last ? kstep : (size_t)(t + 3) * kstep;
            const GAS char* b2 = last ? P.b_ptr(nxt, 0) : P.b_ptr(cur, t + 2); const GAS char* b3 = last ? P.b_ptr(nxt, 1) : P.b_ptr(cur, t + 3);
            G8_LDB(B0, 0, 0); G8_LDB(B1, 0, 1); G8_SCHED; G8_LDA(At, 0, 0); G8_STAGE_A(G8_SA(1, 1), 1, a1k, false);
            G8_WAIT_V(8); G8_WAIT_L(0); G8_BAR; G8_MMA(0, 0, At, B0); G8_MMA(0, 1, At, B1); G8_BAR; G8_SCHED;
            G8_LDA(At, 0, 1); G8_STAGE(G8_SB(0, 0), b2, voffB); G8_STAGE(G8_SB(0, 1), b2 + hstepB, voffB);
            if (last) { G8_STAGE_A(G8_SA(0, 0), 0, a2k, true); } else { G8_STAGE_A(G8_SA(0, 0), 0, a2k, false); }
            G8_WAIT_V(8); G8_WAIT_L(0); G8_BAR; G8_MMA(1, 0, At, B0); G8_MMA(1, 1, At, B1); G8_BAR; G8_SCHED;
            G8_LDB(B0, 1, 0); G8_LDB(B1, 1, 1); G8_SCHED; G8_LDA(At, 1, 0);
            if (last) { G8_STAGE_A(G8_SA(0, 1), 1, a2k, true); } else { G8_STAGE_A(G8_SA(0, 1), 1, a2k, false); }
            G8_WAIT_V(8); G8_WAIT_L(0); G8_BAR; G8_MMA(0, 0, At, B0); G8_MMA(0, 1, At, B1); G8_BAR; G8_SCHED;
            G8_LDA(At, 1, 1); G8_STAGE(G8_SB(1, 0), b3, voffB); G8_STAGE(G8_SB(1, 1), b3 + hstepB, voffB);
            if (last) { G8_STAGE_A(G8_SA(1, 0), 0, a3k, true); } else { G8_STAGE_A(G8_SA(1, 0), 0, a3k, false); }
            G8_WAIT_V(8); G8_WAIT_L(0); G8_BAR; G8_MMA(1, 0, At, B0); G8_MMA(1, 1, At, B1); G8_BAR; G8_SCHED;
        }
        if constexpr (ALIGN_EPI) { if (wr == 0) G8_BAR; }
        { int l2_; asm volatile("v_mbcnt_lo_u32_b32 %0, -1, 0\n\tv_mbcnt_hi_u32_b32 %0, -1, %0" : "=v"(l2_)); E(acc, cur, wr, wc, l2_ & 15, l2_ >> 4); }
        if (!has_next) break;
#pragma unroll
        for (int a = 0; a < 2; ++a)
#pragma unroll
            for (int b = 0; b < 2; ++b)
#pragma unroll
                for (int m = 0; m < 4; ++m)
#pragma unroll
                    for (int n = 0; n < 2; ++n) acc[a][b][m][n] = (f32x4){0.f, 0.f, 0.f, 0.f};
        cur = nxt; ++ui;
        if constexpr (Prob::GATHER) { gAc[0] = gAn[0]; gAc[1] = gAn[1]; }
        else { cA = nA; }
        if constexpr (ALIGN_EPI) { if (wr == 1) G8_BAR; }
    }
    G8_WAIT_V(0);
    if constexpr (!ALIGN_EPI) { if (wr == 0) G8_BAR; }
    G8_BAR;
#undef G8_SA
#undef G8_SB
#undef G8_STAGE
#undef G8_STAGE_A
#undef G8_LDA
#undef G8_LDB
#undef G8_MMA
#undef G8_WAIT_V
#undef G8_WAIT_L
#undef G8_BAR
#undef G8_SCHED
}

struct ProbPlain {
    static constexpr bool GATHER = false;
    const GAS bf16_t* A; const GAS bf16_t* Bt; int lda, ldb, nt, nM, nN, G, c;
    __device__ __forceinline__ bool next(int i, Unit& u) const { u.x0 = 0; u.x1 = 0; return static_order(i, G, c, nM, nN, u.pm, u.pn); }
    __device__ __forceinline__ const GAS char* a_tile(const Unit& u) const { return (const GAS char*)A + (size_t)u.pm * BM * lda * 2; }
    __device__ __forceinline__ const GAS char* a_base() const { return (const GAS char*)A; }
    __device__ __forceinline__ void gather(const Unit&, int, unsigned (&)[2]) const {}
    __device__ __forceinline__ const GAS char* b_ptr(const Unit& u, int t) const { return (const GAS char*)Bt + ((size_t)u.pn * BM * ldb + (size_t)t * BK) * 2; }
};
struct ProbMoeGU {
    static constexpr bool GATHER = true;
    const GAS bf16_t* A; const GAS bf16_t* Bt; const GAS i32x4* elist; const LAS int* tab; int lda, ldb, nt, G, c;
    __device__ __forceinline__ bool next(int i, Unit& u) const {
        const int total = tab[TB_ECUM + NE]; const long L = (long)i * G + c; if (L >= total) return false;
        int wgid = (int)L; { const int q = total / NXCD, r = total % NXCD, xcd = wgid % NXCD, off = wgid / NXCD; wgid = (xcd < r ? xcd * (q + 1) : r * (q + 1) + (xcd - r) * q) + off; }
        int e = 0;
#pragma unroll
        for (int k = 1; k < NE; ++k) e += (wgid >= tab[TB_ECUM + k]) ? 1 : 0;
        const int loc = wgid - tab[TB_ECUM + e], nM = (tab[TB_ECUM + e + 1] - tab[TB_ECUM + e]) / 6;
        const int nig = WGM * 6, gid = loc / nig, fm = gid * WGM, gsz = (nM - fm) < WGM ? (nM - fm) : WGM;
        u.pm = fm + ((loc % nig) % gsz); u.pn = (loc % nig) / gsz; u.x0 = e; u.x1 = tab[TB_EOFF + e] + 256 * u.pm; return true;
    }
    __device__ __forceinline__ const GAS char* a_tile(const Unit&) const { return (const GAS char*)A; }
    __device__ __forceinline__ const GAS char* a_base() const { return (const GAS char*)A; }
    __device__ __forceinline__ void gather(const Unit& u, int R0, unsigned (&g)[2]) const {
#pragma unroll
        for (int h = 0; h < 2; ++h) { const int t0 = elist[u.x1 + h * HALF + R0].x, t1 = elist[u.x1 + h * HALF + R0 + 64].x; g[h] = (unsigned)t0 | ((unsigned)t1 << 16); }
    }
    __device__ __forceinline__ const GAS char* b_ptr(const Unit& u, int t) const { return (const GAS char*)Bt + ((size_t)(u.x0 * 1536 + u.pn * BM) * ldb + (size_t)t * BK) * 2; }
};
struct ProbMoeDown {
    static constexpr bool GATHER = false;
    const GAS bf16_t* A; const GAS bf16_t* Bt; const LAS int* tab; int lda, ldb, nt, G, c;
    __device__ __forceinline__ bool next(int i, Unit& u) const {
        const int nM = tab[TB_NRT]; if (!static_order(i, G, c, nM, 4, u.pm, u.pn)) return false;
        const int p = tab[TB_RT2P + u.pm]; u.x0 = (p & 0xff) * DFE; u.x1 = ((p >> 8) & 0xff) * DFE; return true;
    }
    __device__ __forceinline__ const GAS char* a_tile(const Unit& u) const { return (const GAS char*)A + (size_t)u.pm * BM * lda * 2; }
    __device__ __forceinline__ const GAS char* a_base() const { return (const GAS char*)A; }
    __device__ __forceinline__ void gather(const Unit&, int, unsigned (&)[2]) const {}
    __device__ __forceinline__ const GAS char* b_ptr(const Unit& u, int t) const { const int ko = (t < 11) ? (u.x0 + t * BK) : (u.x1 + (t - 11) * BK); return (const GAS char*)Bt + ((size_t)u.pn * BM * ldb + (size_t)ko) * 2; }
};

#define G8_ROWLOOP _Pragma("unroll") for (int ai = 0; ai < 2; ++ai) _Pragma("unroll") for (int m = 0; m < 4; ++m)
struct EpiBf16Split {
    static constexpr bool PERM = true;
    GAS bf16_t* O; int ldc; int split_cols; size_t split_stride;
    __device__ __forceinline__ void operator()(const f32x4 (&acc)[2][2][4][2], const Unit& u, int wr, int wc, int fr, int fq) const {
        const int row0 = u.pm * BM + wr * 64 + fr; int colt = u.pn * BM; GAS bf16_t* base = O;
        if (split_cols) { const int t = colt / split_cols; base += (size_t)t * split_stride; colt -= t * split_cols; }
        const int col0 = colt + wc * 32 + 8 * fq;
        G8_ROWLOOP { GAS bf16_t* rowp = base + (size_t)(row0 + ai * HALF + m * 16) * ldc + col0;
#pragma unroll
            for (int bj = 0; bj < 2; ++bj) { const f32x4 v0 = acc[ai][bj][m][0], v1 = acc[ai][bj][m][1];
                u32x4 w; w.x = cvt_pk_bf16(v0[0], v0[1]); w.y = cvt_pk_bf16(v0[2], v0[3]); w.z = cvt_pk_bf16(v1[0], v1[1]); w.w = cvt_pk_bf16(v1[2], v1[3]);
                *(GAS u32x4*)(rowp + bj * HALF) = w; } }
    }
};
struct EpiResid {
    static constexpr bool PERM = false;
    const GAS float* rin; GAS float* out;
    __device__ __forceinline__ void operator()(const f32x4 (&acc)[2][2][4][2], const Unit& u, int wr, int wc, int fr, int fq) const {
        const int row0 = u.pm * BM + wr * 64 + fr, col0 = u.pn * BM + wc * 32 + 4 * fq;
        G8_ROWLOOP { const size_t off = (size_t)(row0 + ai * HALF + m * 16) * DM + col0;
#pragma unroll
            for (int bj = 0; bj < 2; ++bj)
#pragma unroll
                for (int n = 0; n < 2; ++n) { const f32x4 r = *(const GAS f32x4*)(rin + off + bj * HALF + n * 16); *(GAS f32x4*)(out + off + bj * HALF + n * 16) = r * ALPHA + acc[ai][bj][m][n]; }
            asm volatile("" ::: "memory"); }
    }
};
struct EpiSwiglu {
    static constexpr bool PERM = true;
    GAS bf16_t* H; int ldh;
    __device__ __forceinline__ void operator()(const f32x4 (&acc)[2][2][4][2], const Unit& u, int wr, int wc, int fr, int fq) const {
        const int row0 = u.pm * BM + wr * 64 + fr, col0 = u.pn * HALF + wc * 32 + 8 * fq;
        G8_ROWLOOP { u32x4 w; unsigned ww[4];
#pragma unroll
            for (int n = 0; n < 2; ++n) { const f32x4 g = acc[ai][0][m][n], uu = acc[ai][1][m][n]; float hv[4];
#pragma unroll
                for (int i = 0; i < 4; ++i) hv[i] = g[i] * sigmoid_f(g[i]) * uu[i];
                ww[2 * n] = cvt_pk_bf16(hv[0], hv[1]); ww[2 * n + 1] = cvt_pk_bf16(hv[2], hv[3]); }
            w.x = ww[0]; w.y = ww[1]; w.z = ww[2]; w.w = ww[3];
            *(GAS u32x4*)(H + (size_t)(row0 + ai * HALF + m * 16) * ldh + col0) = w; }
    }
};
struct EpiGate {
    static constexpr bool PERM = true;
    GAS bf16_t* O;
    __device__ __forceinline__ void operator()(const f32x4 (&acc)[2][2][4][2], const Unit& u, int wr, int wc, int fr, int fq) const {
        const int row0 = u.pm * BM + wr * 64 + fr, col0 = u.pn * BM + wc * 32 + 8 * fq;
        G8_ROWLOOP { GAS bf16_t* rowp = O + (size_t)(row0 + ai * HALF + m * 16) * DM + col0;
#pragma unroll
            for (int bj = 0; bj < 2; ++bj) { const f32x4 v0 = acc[ai][bj][m][0], v1 = acc[ai][bj][m][1];
                u32x4 w; w.x = cvt_pk_bf16(sigmoid_f(v0[0]), sigmoid_f(v0[1])); w.y = cvt_pk_bf16(sigmoid_f(v0[2]), sigmoid_f(v0[3]));
                w.z = cvt_pk_bf16(sigmoid_f(v1[0]), sigmoid_f(v1[1])); w.w = cvt_pk_bf16(sigmoid_f(v1[2]), sigmoid_f(v1[3]));
                *(GAS u32x4*)(rowp + bj * HALF) = w; } }
    }
};
struct EpiPle {
    static constexpr bool PERM = true;
    GAS float* res; GAS bf16_t* XG;
    __device__ __forceinline__ void operator()(const f32x4 (&acc)[2][2][4][2], const Unit& u, int wr, int wc, int fr, int fq) const {
        const int row0 = u.pm * BM + wr * 64 + fr, col0 = u.pn * BM + wc * 32 + 8 * fq;
        G8_ROWLOOP { const size_t off = (size_t)(row0 + ai * HALF + m * 16) * DM + col0;
#pragma unroll
            for (int bj = 0; bj < 2; ++bj)
#pragma unroll
                for (int n = 0; n < 2; ++n) { const u32x2 gw = *(const GAS u32x2*)(XG + off + bj * HALF + 4 * n); const f32x4 r = *(const GAS f32x4*)(res + off + bj * HALF + 4 * n); const f32x4 a = acc[ai][bj][m][n]; f32x4 o;
                    o[0] = r[0] + a[0] * __builtin_bit_cast(float, gw.x << 16); o[1] = r[1] + a[1] * __builtin_bit_cast(float, gw.x & 0xffff0000u);
                    o[2] = r[2] + a[2] * __builtin_bit_cast(float, gw.y << 16); o[3] = r[3] + a[3] * __builtin_bit_cast(float, gw.y & 0xffff0000u);
                    *(GAS f32x4*)(res + off + bj * HALF + 4 * n) = o; u32x2 w; w.x = cvt_pk_bf16(o[0], o[1]); w.y = cvt_pk_bf16(o[2], o[3]); *(GAS u32x2*)(XG + off + bj * HALF + 4 * n) = w;
                    asm volatile("" ::: "memory"); } }
    }
};
struct EpiMoeGU {
    static constexpr bool PERM = true;
    GAS bf16_t* HS; const GAS i32x4* elist; const GAS float* egate;
    __device__ __forceinline__ void operator()(const f32x4 (&acc)[2][2][4][2], const Unit& u, int wr, int wc, int fr, int fq) const {
        const int j0 = u.pn * HALF + wc * 32 + 8 * fq; const bool colok = j0 < DFE;
        G8_ROWLOOP { const int sl = u.x1 + ai * HALF + wr * 64 + m * 16 + fr; const i32x4 en = elist[sl]; const float gate = egate[sl];
            if (colok && en.y >= 0) { u32x4 w; unsigned ww[4];
#pragma unroll
                for (int n = 0; n < 2; ++n) { const f32x4 g = acc[ai][0][m][n], uu = acc[ai][1][m][n]; float hv[4];
#pragma unroll
                    for (int i = 0; i < 4; ++i) hv[i] = gate * g[i] * sigmoid_f(g[i]) * uu[i];
                    ww[2 * n] = cvt_pk_bf16(hv[0], hv[1]); ww[2 * n + 1] = cvt_pk_bf16(hv[2], hv[3]); }
                w.x = ww[0]; w.y = ww[1]; w.z = ww[2]; w.w = ww[3];
                *(GAS u32x4*)(HS + (size_t)en.y + j0) = w; } }
    }
};
struct EpiMoeDown {
    static constexpr bool PERM = false;
    GAS float* res; const GAS int* plist;
    __device__ __forceinline__ void operator()(const f32x4 (&acc)[2][2][4][2], const Unit& u, int wr, int wc, int fr, int fq) const {
        const int col0 = u.pn * BM + wc * 32 + 4 * fq;
        G8_ROWLOOP { const int tok = plist[u.pm * BM + ai * HALF + wr * 64 + m * 16 + fr];
            if (tok >= 0) { const size_t off = (size_t)tok * DM + col0;
#pragma unroll
                for (int bj = 0; bj < 2; ++bj)
#pragma unroll
                    for (int n = 0; n < 2; ++n) { const f32x4 r = *(const GAS f32x4*)(res + off + bj * HALF + n * 16); *(GAS f32x4*)(res + off + bj * HALF + n * 16) = r * ALPHA + acc[ai][bj][m][n]; } }
            asm volatile("" ::: "memory"); }
    }
};
__device__ __forceinline__ void unpack8(const u32x4 w, float (&x)[8]) {
    x[0] = __builtin_bit_cast(float, w.x << 16); x[1] = __builtin_bit_cast(float, w.x & 0xffff0000u); x[2] = __builtin_bit_cast(float, w.y << 16); x[3] = __builtin_bit_cast(float, w.y & 0xffff0000u);
    x[4] = __builtin_bit_cast(float, w.z << 16); x[5] = __builtin_bit_cast(float, w.z & 0xffff0000u); x[6] = __builtin_bit_cast(float, w.w << 16); x[7] = __builtin_bit_cast(float, w.w & 0xffff0000u); }
struct EpiResidB {
    static constexpr bool PERM = true;
    GAS bf16_t* S;
    __device__ __forceinline__ void operator()(const f32x4 (&acc)[2][2][4][2], const Unit& u, int wr, int wc, int fr, int fq) const {
        const int row0 = u.pm * BM + wr * 64 + fr, col0 = u.pn * BM + wc * 32 + 8 * fq;
        G8_ROWLOOP { GAS bf16_t* rowp = S + (size_t)(row0 + ai * HALF + m * 16) * DM + col0;
#pragma unroll
            for (int bj = 0; bj < 2; ++bj) { float x[8]; unpack8(*(const GAS u32x4*)(rowp + bj * HALF), x); const f32x4 a0 = acc[ai][bj][m][0], a1 = acc[ai][bj][m][1];
                u32x4 w; w.x = cvt_pk_bf16(x[0] * ALPHA + a0[0], x[1] * ALPHA + a0[1]); w.y = cvt_pk_bf16(x[2] * ALPHA + a0[2], x[3] * ALPHA + a0[3]);
                w.z = cvt_pk_bf16(x[4] * ALPHA + a1[0], x[5] * ALPHA + a1[1]); w.w = cvt_pk_bf16(x[6] * ALPHA + a1[2], x[7] * ALPHA + a1[3]);
                *(GAS u32x4*)(rowp + bj * HALF) = w; }
            asm volatile("" ::: "memory"); }
    }
};
struct EpiMoeDownB {
    static constexpr bool PERM = true;
    GAS bf16_t* S; const GAS int* plist;
    __device__ __forceinline__ void operator()(const f32x4 (&acc)[2][2][4][2], const Unit& u, int wr, int wc, int fr, int fq) const {
        const int col0 = u.pn * BM + wc * 32 + 8 * fq;
        G8_ROWLOOP { const int tok = plist[u.pm * BM + ai * HALF + wr * 64 + m * 16 + fr];
            if (tok >= 0) { GAS bf16_t* rowp = S + (size_t)tok * DM + col0;
#pragma unroll
                for (int bj = 0; bj < 2; ++bj) { float x[8]; unpack8(*(const GAS u32x4*)(rowp + bj * HALF), x); const f32x4 a0 = acc[ai][bj][m][0], a1 = acc[ai][bj][m][1];
                    u32x4 w; w.x = cvt_pk_bf16(x[0] * ALPHA + a0[0], x[1] * ALPHA + a0[1]); w.y = cvt_pk_bf16(x[2] * ALPHA + a0[2], x[3] * ALPHA + a0[3]);
                    w.z = cvt_pk_bf16(x[4] * ALPHA + a1[0], x[5] * ALPHA + a1[1]); w.w = cvt_pk_bf16(x[6] * ALPHA + a1[2], x[7] * ALPHA + a1[3]);
                    *(GAS u32x4*)(rowp + bj * HALF) = w; } }
            asm volatile("" ::: "memory"); }
    }
};
struct EpiPleB {
    static constexpr bool PERM = true;
    const GAS bf16_t* S; GAS bf16_t* XG; GAS float* out32;
    __device__ __forceinline__ void operator()(const f32x4 (&acc)[2][2][4][2], const Unit& u, int wr, int wc, int fr, int fq) const {
        const int row0 = u.pm * BM + wr * 64 + fr, col0 = u.pn * BM + wc * 32 + 8 * fq;
        G8_ROWLOOP { const size_t off = (size_t)(row0 + ai * HALF + m * 16) * DM + col0;
#pragma unroll
            for (int bj = 0; bj < 2; ++bj) { float x[8], g[8]; unpack8(*(const GAS u32x4*)(S + off + bj * HALF), x); unpack8(*(const GAS u32x4*)(XG + off + bj * HALF), g);
                const f32x4 a0 = acc[ai][bj][m][0], a1 = acc[ai][bj][m][1]; f32x4 o0, o1;
#pragma unroll
                for (int i = 0; i < 4; ++i) { o0[i] = x[i] + a0[i] * g[i]; o1[i] = x[4 + i] + a1[i] * g[4 + i]; }
                u32x4 w; w.x = cvt_pk_bf16(o0[0], o0[1]); w.y = cvt_pk_bf16(o0[2], o0[3]); w.z = cvt_pk_bf16(o1[0], o1[1]); w.w = cvt_pk_bf16(o1[2], o1[3]);
                *(GAS u32x4*)(XG + off + bj * HALF) = w;
                if (out32) { *(GAS f32x4*)(out32 + off + bj * HALF) = o0; *(GAS f32x4*)(out32 + off + bj * HALF + 4) = o1; }
                asm volatile("" ::: "memory"); } }
    }
};
}

struct Frame {
    LAS unsigned char* lds; GAS unsigned* ctl; GAS unsigned char* ws; GAS float* res;
    int wave, vcu, G;
    __device__ __forceinline__ int lane_id() const { int l; asm volatile("v_mbcnt_lo_u32_b32 %0, -1, 0\n\tv_mbcnt_hi_u32_b32 %0, -1, %0" : "=v"(l)); return l; }
    __device__ __forceinline__ int tid_id() const { return wave * 64 + lane_id(); }
};
__device__ __forceinline__ GAS bf16_t* xb_ptr(const Frame& F, int which) { return (GAS bf16_t*)(F.ws + (which ? WS_XB1 : WS_XB0)); }

struct Job { int in_idx, Ns, nkb, n0, nblk, ldd, drow0, dk0, split, item0; float scale; long long src_off, dst_off; };
constexpr int NJOBS = 55;
struct JobTable { Job j[NJOBS]; int total; int njobs; };
constexpr JobTable make_jobs() {
    JobTable t{}; int n = 0, items = 0;
    auto add = [&](int in_idx, long long src_off, int Ns, int K, int n0, int ncols, long long dst_byte, int ldd, int drow0, int dk0, int split, float scale) {
        Job& j = t.j[n++]; j.in_idx = in_idx; j.src_off = src_off; j.Ns = Ns; j.nkb = K / 64; j.n0 = n0; j.nblk = ncols / 32; j.dst_off = dst_byte; j.ldd = ldd; j.drow0 = drow0; j.dk0 = dk0; j.split = split; j.scale = scale;
        j.item0 = items; items += j.nkb * j.nblk; };
    const long long WD = (long long)WS_WDEAD, WL = (long long)WS_WLIVE;
    const float QS = 0.0625f;
    for (int i = 0; i < 2; ++i) { const long long q = WD + 2 * (long long)(i ? WD_QKV1 : WD_QKV0), o = WD + 2 * (long long)(i ? WD_O1 : WD_O0);
        add(IN_AQKV, (long long)i * 1024 * 3072, 3072, 1024, 0, 1024, q, 1024, 0, 0, 0, QS);
        add(IN_AQKV, (long long)i * 1024 * 3072, 3072, 1024, 1024, 2048, q, 1024, 1024, 0, 0, 1.f);
        add(IN_AO, (long long)i * 1024 * 1024, 1024, 1024, 0, 1024, o, 1024, 0, 0, 0, 1.f); }
    add(IN_BQ, 0, 1024, 1024, 0, 1024, WL + 2 * (long long)WL_QKV2, 1024, 0, 0, 0, QS);
    add(IN_KVF, 0, 2052, 1024, 0, 2048, WL + 2 * (long long)WL_QKV2, 1024, 1024, 0, 0, 1.f);
    add(IN_BQ, (long long)1024 * 1024, 1024, 1024, 0, 1024, WL + 2 * (long long)WL_Q3, 1024, 0, 0, 0, QS);
    add(IN_BO, 0, 1024, 1024, 0, 1024, WL + 2 * (long long)WL_O2, 1024, 0, 0, 0, 1.f);
    add(IN_BO, (long long)1024 * 1024, 1024, 1024, 0, 1024, WL + 2 * (long long)WL_O3, 1024, 0, 0, 0, 1.f);
    for (int i = 0; i < 2; ++i) { const long long gu = i ? WL + 2 * (long long)WL_GU1 : WD + 2 * (long long)WD_GU0, dn = i ? WL + 2 * (long long)WL_DN1 : WD + 2 * (long long)WD_DN0;
        add(IN_FGU, (long long)i * 1024 * 5632, 5632, 1024, 0, 5632, gu, 1024, 0, 0, DFF, 1.f);
        add(IN_FDN, (long long)i * 2816 * 1024, 1024, 2816, 0, 1024, dn, 2816, 0, 0, 0, 1.f); }
    for (int i = 0; i < 2; ++i) for (int e = 0; e < NE; ++e) { const long long gu = i ? WL + 2 * (long long)WL_MGU1 : WD + 2 * (long long)WD_MGU0, dn = i ? WL + 2 * (long long)WL_MDN1 : WD + 2 * (long long)WD_MDN0;
        add(IN_MGU, (long long)(i * NE + e) * 1024 * 1408, 1408, 1024, 0, 1408, gu, 1024, e * 1536, 0, DFE, 1.f);
        add(IN_MDN, (long long)(i * NE + e) * 704 * 1024, 1024, 704, 0, 1024, dn, 5632, 0, e * DFE, 0, 1.f); }
    for (int i = 0; i < 4; ++i) { const long long pp = i == 0 ? WD + 2 * (long long)WD_PP0 : i == 1 ? WD + 2 * (long long)WD_PP1 : i == 2 ? WL + 2 * (long long)WL_PP2 : WL + 2 * (long long)WL_PP3;
        const long long pg = i == 0 ? WD + 2 * (long long)WD_PG0 : i == 1 ? WD + 2 * (long long)WD_PG1 : i == 2 ? WL + 2 * (long long)WL_PG2 : WL + 2 * (long long)WL_PG3;
        add(IN_PP, (long long)i * 256 * 1024, 1024, 256, 0, 1024, pp, 256, 0, 0, 0, 1.f);
        add(IN_PG, (long long)i * 1024 * 1024, 1024, 1024, 0, 1024, pg, 1024, 0, 0, 0, 1.f); }
    t.total = items; t.njobs = n; return t;
}
__device__ const JobTable g_jobs = make_jobs();
static_assert(make_jobs().njobs == NJOBS, "job count");

__device__ __forceinline__ void conv_item(const Frame& F, const Job& J, int it, LAS float* scr) {
    const int lane = F.lane_id(); const int kb = it / J.nblk, nb = it % J.nblk, k0 = 64 * kb, ncol = J.n0 + 32 * nb;
    const GAS float* W = in_sel(J.in_idx) + J.src_off;
    { f32x4 wv[8];
#pragma unroll
      for (int i = 0; i < 8; ++i) wv[i] = *(const GAS f32x4*)(W + (size_t)(k0 + (lane >> 3) + 8 * i) * J.Ns + ncol + (lane & 7) * 4);
#pragma unroll
      for (int i = 0; i < 8; ++i) { LAS float* d = scr + ((lane >> 3) + 8 * i) * 33 + (lane & 7) * 4; d[0] = wv[i][0] * J.scale; d[1] = wv[i][1] * J.scale; d[2] = wv[i][2] * J.scale; d[3] = wv[i][3] * J.scale; } }
    asm volatile("s_waitcnt lgkmcnt(0)" ::: "memory");
    int drow;
    if (J.split) { const int ty = ncol / J.split, jj = ncol % J.split; drow = J.drow0 + 256 * (jj >> 7) + 128 * ty + (jj & 127); } else drow = J.drow0 + (ncol - J.n0);
    GAS bf16_t* WT = (GAS bf16_t*)(F.ws + J.dst_off);
    const int c = lane & 7;
#pragma unroll
    for (int j = 0; j < 4; ++j) { const int n = (lane >> 3) + 8 * j; const LAS float* s = scr + (8 * c) * 33 + n;
        u32x4 o; o.x = pk2(s[0 * 33], s[1 * 33]); o.y = pk2(s[2 * 33], s[3 * 33]); o.z = pk2(s[4 * 33], s[5 * 33]); o.w = pk2(s[6 * 33], s[7 * 33]);
        *(GAS u32x4*)(WT + (size_t)(drow + n) * J.ldd + J.dk0 + k0 + 8 * c) = o; }
    asm volatile("s_waitcnt lgkmcnt(0)" ::: "memory");
}
__device__ __forceinline__ void prologue_phase(Frame& F) {
    LAS float* scr = (LAS float*)(F.lds + F.wave * 16384);
    const int gw = F.vcu * NWAVES + F.wave, NGW = F.G * NWAVES;
    const int total = g_jobs.total;
    for (int it = gw; it < total; it += NGW) {
        int jn = 0;
        for (int k = 1; k < NJOBS; ++k) jn += (it >= g_jobs.j[k].item0) ? 1 : 0;
        jn = __builtin_amdgcn_readfirstlane(jn);
        conv_item(F, g_jobs.j[jn], it - g_jobs.j[jn].item0, scr);
    }
    { const size_t gt = (size_t)blockIdx.x * NTHREADS + F.tid_id(), gs = (size_t)F.G * NTHREADS;
      for (size_t i = gt; i < (size_t)2 * NE * 2 * 64 * 128; i += gs) {
          const int ch = (int)(i & 127), row = (int)((i >> 7) & 63), gu = (int)((i >> 13) & 1), e = (int)((i >> 14) & 7), li = (int)(i >> 17);
          GAS bf16_t* base = (GAS bf16_t*)(F.ws + (li ? WS_WLIVE + 2 * WL_MGU1 : WS_WDEAD + 2 * WD_MGU0));
          *(GAS u32x4*)(base + (size_t)(e * 1536 + 1280 + 128 * gu + 64 + row) * 1024 + ch * 8) = (u32x4){0u, 0u, 0u, 0u}; } }
    GAS bf16_t* xb = xb_ptr(F, 1);
    { const int ln = F.lane_id();
      for (int m = gw; m < T; m += 2 * NGW) {
          const GAS f32x4* xa = (const GAS f32x4*)(in_sel(IN_X) + (size_t)m * DM) + ln; const GAS f32x4* xc = (const GAS f32x4*)(in_sel(IN_X) + (size_t)(m + NGW) * DM) + ln;
          GAS u32x2* oa = (GAS u32x2*)(xb + (size_t)m * DM) + ln; GAS u32x2* oc = (GAS u32x2*)(xb + (size_t)(m + NGW) * DM) + ln;
          f32x4 va[4], vc[4];
#pragma unroll
          for (int j = 0; j < 4; ++j) { va[j] = xa[64 * j]; vc[j] = xc[64 * j]; }
#pragma unroll
          for (int j = 0; j < 4; ++j) { u32x2 o; o.x = cvt_pk_bf16(va[j][0], va[j][1]); o.y = cvt_pk_bf16(va[j][2], va[j][3]); oa[64 * j] = o; o.x = cvt_pk_bf16(vc[j][0], vc[j][1]); o.y = cvt_pk_bf16(vc[j][2], vc[j][3]); oc[64 * j] = o; } } }
}

template <bool ROUTER, bool CVT_P>
__device__ __forceinline__ void ln_phase(Frame& F, int L, int which, GAS bf16_t* S) {
    int tid_ = F.tid_id(); asm volatile("" : "+v"(tid_));
    const int lane = tid_ & 63, w = __builtin_amdgcn_readfirstlane(tid_ >> 6);
    const GAS f32x4* gp = (const GAS f32x4*)(in_sel(IN_LNG) + (size_t)(L * 2 + which) * DM) + 4 * lane; const GAS f32x4* bp = (const GAS f32x4*)(in_sel(IN_LNB) + (size_t)(L * 2 + which) * DM) + 4 * lane;
    f32x4 gg[4], bb[4];
#pragma unroll
    for (int j = 0; j < 4; ++j) { gg[j] = gp[j]; bb[j] = bp[j]; }
    LAS f32x4* wrl = (LAS f32x4*)(F.lds + 1024);
    if constexpr (ROUTER) { const GAS float* Wr = in_sel(IN_MR) + (size_t)(L >> 1) * DM * NE;
        __syncthreads();
        for (int i = w; i < 16; i += NWAVES) { const int k = 16 * lane + i;
            wrl[(i * 2 + 0) * 64 + lane] = *(const GAS f32x4*)(Wr + (size_t)k * NE); wrl[(i * 2 + 1) * 64 + lane] = *(const GAS f32x4*)(Wr + (size_t)k * NE + 4); }
        __syncthreads(); }
    LAS int* hist = (LAS int*)F.lds;
    for (int ch = blockIdx.x; ch < T / 128; ch += F.G) {
        if constexpr (ROUTER) { __syncthreads(); if (tid_ < 40) hist[tid_] = 0; __syncthreads(); }
        u32x4 na, nb, ma, mb; f32x4 npv = (f32x4){0.f, 0.f, 0.f, 0.f}, np2 = npv;
        { const GAS u32x4* x0 = (const GAS u32x4*)(S + (size_t)(128 * ch + 16 * w) * DM) + 2 * lane; na = x0[0]; nb = x0[1]; ma = x0[128]; mb = x0[129];
          if constexpr (CVT_P) { const GAS f32x4* p0 = (const GAS f32x4*)(in_sel(IN_P) + ((size_t)L * T + 128 * ch + 16 * w) * PLE) + lane; npv = p0[0]; np2 = p0[64]; } }
        for (int k = 0; k < 16; ++k) {
            const int row = 128 * ch + 16 * w + k;
            GAS u32x4* xr = (GAS u32x4*)(S + (size_t)row * DM) + 2 * lane;
            float v[16]; { float t8[8]; g8::unpack8(na, t8);
#pragma unroll
                for (int i = 0; i < 8; ++i) v[i] = t8[i];
                g8::unpack8(nb, t8);
#pragma unroll
                for (int i = 0; i < 8; ++i) v[8 + i] = t8[i]; }
            const f32x4 pv = npv; na = ma; nb = mb; npv = np2;
            if (k < 14) { ma = xr[256]; mb = xr[257]; if constexpr (CVT_P) np2 = *((const GAS f32x4*)(in_sel(IN_P) + ((size_t)L * T + row + 2) * PLE) + lane); }
            float s = 0.f;
#pragma unroll
            for (int i = 0; i < 16; ++i) s += v[i];
            const float mean = wave_sum_dpp(s) * (1.f / DM); float s2 = 0.f;
#pragma unroll
            for (int i = 0; i < 16; ++i) { v[i] -= mean; s2 += v[i] * v[i]; }
            const float rstd = 1.f / sqrtf(wave_sum_dpp(s2) * (1.f / DM) + LN_EPS);
#pragma unroll
            for (int i = 0; i < 16; ++i) v[i] = v[i] * rstd * gg[i >> 2][i & 3] + bb[i >> 2][i & 3];
            { u32x4 o; o.x = cvt_pk_bf16(v[0], v[1]); o.y = cvt_pk_bf16(v[2], v[3]); o.z = cvt_pk_bf16(v[4], v[5]); o.w = cvt_pk_bf16(v[6], v[7]); xr[0] = o;
              o.x = cvt_pk_bf16(v[8], v[9]); o.y = cvt_pk_bf16(v[10], v[11]); o.z = cvt_pk_bf16(v[12], v[13]); o.w = cvt_pk_bf16(v[14], v[15]); xr[1] = o; }
            if constexpr (CVT_P) { u32x2 o; o.x = cvt_pk_bf16(pv[0], pv[1]); o.y = cvt_pk_bf16(pv[2], pv[3]);
                *((GAS u32x2*)((GAS bf16_t*)(F.ws + WS_PB) + (size_t)row * PLE) + lane) = o; }
            if constexpr (ROUTER) {
                float lg[NE];
#pragma unroll
                for (int e = 0; e < NE; ++e) lg[e] = 0.f;
#pragma unroll
                for (int i = 0; i < 16; ++i) { const float xv = v[i]; const f32x4 w0 = wrl[(i * 2 + 0) * 64 + lane], w1 = wrl[(i * 2 + 1) * 64 + lane];
#pragma unroll
                    for (int e = 0; e < 4; ++e) { lg[e] += xv * w0[e]; lg[4 + e] += xv * w1[e]; } }
#pragma unroll
                for (int e = 0; e < NE; ++e) lg[e] = wave_sum_dpp(lg[e]);
                int i1 = 0; float v1 = lg[0];
#pragma unroll
                for (int e = 1; e < NE; ++e) if (lg[e] > v1) { v1 = lg[e]; i1 = e; }
                int i2 = -1; float v2 = -3.0e38f;
#pragma unroll
                for (int e = 0; e < NE; ++e) if (e != i1 && lg[e] > v2) { v2 = lg[e]; i2 = e; }
                const float ex = fast_exp(v2 - v1), g1 = __builtin_amdgcn_rcpf(1.f + ex), g2 = 1.f - g1;
                const int ea = i1 < i2 ? i1 : i2, eb = i1 < i2 ? i2 : i1, pid = ea * (15 - ea) / 2 + eb - ea - 1;
                if (lane == 0) { GAS int* rp = (GAS int*)(F.ws + WS_MISC + MS_REC) + (size_t)row * 4; GAS float* gpp = (GAS float*)(F.ws + WS_MISC + MS_GATE);
                    rp[0] = i1 | (i2 << 8) | (pid << 16); rp[1] = 0; rp[2] = 0; rp[3] = row; gpp[row] = g1; gpp[T + row] = g2;
                    __hip_atomic_fetch_add(hist + i1, 1, __ATOMIC_RELAXED, __HIP_MEMORY_SCOPE_WORKGROUP); __hip_atomic_fetch_add(hist + i2, 1, __ATOMIC_RELAXED, __HIP_MEMORY_SCOPE_WORKGROUP);
                    __hip_atomic_fetch_add(hist + 8 + pid, 1, __ATOMIC_RELAXED, __HIP_MEMORY_SCOPE_WORKGROUP); }
            }
        }
        if constexpr (ROUTER) { __syncthreads(); if (tid_ < 40) ((GAS int*)(F.ws + WS_MISC + MS_HIST))[ch * 40 + tid_] = hist[tid_]; }
    }
}

__device__ __forceinline__ int pad256(int v) { return (v + 255) & ~255; }
__device__ __forceinline__ void moe_lists_phase(Frame& F) {
    LAS int* pre = (LAS int*)F.lds; LAS int* tot = pre + 40; LAS int* eoff = tot + 40; LAS int* poff = eoff + 16; LAS int* recs = poff + 32; LAS int* tabl = recs + 128;
    const GAS int* hist = (const GAS int*)(F.ws + WS_MISC + MS_HIST);
    const GAS i32x4* rec = (const GAS i32x4*)(F.ws + WS_MISC + MS_REC);
    GAS i32x4* elist = (GAS i32x4*)(F.ws + WS_MISC + MS_ELIST); GAS int* plist = (GAS int*)(F.ws + WS_MISC + MS_PLIST);
    int tid_ = F.tid_id(); asm volatile("" : "+v"(tid_));
    const int lane = tid_ & 63, w = F.wave, tid = tid_;
    bool first = true;
    for (int ch = blockIdx.x; ch < T / 128; ch += F.G) {
        __syncthreads();
        for (int col = w; col < 36; col += NWAVES) { int sp = 0, st = 0;
#pragma unroll
            for (int k = 0; k < 4; ++k) { const int c2 = lane + 64 * k; const int v = hist[c2 * 40 + col]; st += v; sp += (c2 < ch) ? v : 0; }
#pragma unroll
            for (int o = 1; o < 64; o <<= 1) { sp += shxi(sp, o, lane); st += shxi(st, o, lane); }
            if (lane == 0) { pre[col] = sp; tot[col] = st; } }
        __syncthreads();
        if (tid == 0) {
            int acc = 0, ucum = 0;
            for (int e = 0; e < NE; ++e) { eoff[e] = acc; tabl[TB_EOFF + e] = acc; tabl[TB_ECUM + e] = ucum; const int p = pad256(tot[e]); acc += p; ucum += 6 * (p >> 8); }
            eoff[NE] = acc; tabl[TB_EOFF + NE] = acc; tabl[TB_ECUM + NE] = ucum;
            int pacc = 0, pid = 0;
            for (int a = 0; a < NE - 1; ++a) for (int b = a + 1; b < NE; ++b) { poff[pid] = pacc; pacc += pad256(tot[8 + pid]); ++pid; }
            poff[NPAIR] = pacc; tabl[TB_NRT] = pacc >> 8;
        }
        __syncthreads();
        if (tid < 192) { const int r8 = tid << 8; int p = 0;
            for (int k = 1; k < NPAIR; ++k) p += (r8 >= poff[k]) ? 1 : 0;
            int a = 0, rem = p; while (rem >= NE - 1 - a) { rem -= NE - 1 - a; ++a; }
            tabl[TB_RT2P + tid] = a | ((a + 1 + rem) << 8); }
        __syncthreads();
        if (ch == 0) { for (int i = tid; i < TB_WORDS; i += NTHREADS) ((GAS int*)(F.ws + WS_MISC + MS_TAB))[i] = tabl[i]; }
        if (tid < 128) recs[tid] = rec[128 * ch + tid].x;
        __syncthreads();
        if (tid < 128) {
            const int token = 128 * ch + tid; const i32x4 r = rec[token]; const int e1 = r.x & 0xff, e2 = (r.x >> 8) & 0xff, pid = (r.x >> 16) & 0xff;
            int r1 = 0, r2 = 0, rp = 0;
            for (int j = 0; j < tid; ++j) { const int o = recs[j]; const int o1 = o & 0xff, o2 = (o >> 8) & 0xff, op = (o >> 16) & 0xff;
                r1 += ((o1 == e1) | (o2 == e1)) ? 1 : 0; r2 += ((o1 == e2) | (o2 == e2)) ? 1 : 0; rp += (op == pid) ? 1 : 0; }
            const int pslot = poff[pid] + pre[8 + pid] + rp; plist[pslot] = token;
            i32x4 en; en.x = token; en.w = 0;
            const GAS float* gp = (const GAS float*)(F.ws + WS_MISC + MS_GATE);
            GAS float* eg = (GAS float*)(F.ws + WS_MISC + MS_EGATE); en.z = 0;
            { const int sl = eoff[e1] + pre[e1] + r1; en.y = pslot * 1408 + (e1 < e2 ? 0 : DFE); elist[sl] = en; eg[sl] = gp[token]; }
            { const int sl = eoff[e2] + pre[e2] + r2; en.y = pslot * 1408 + (e2 < e1 ? 0 : DFE); elist[sl] = en; eg[sl] = gp[T + token]; }
        }
        if (first) {
            first = false; const int gt = blockIdx.x * NTHREADS + tid, gs = F.G * NTHREADS;
            for (int e = 0; e < NE; ++e) for (int i = eoff[e] + tot[e] + gt; i < eoff[e + 1]; i += gs) elist[i] = (i32x4){0, -1, 0, 0};
            for (int p = 0; p < NPAIR; ++p) for (int i = poff[p] + tot[8 + p] + gt; i < poff[p + 1]; i += gs) plist[i] = -1;
        }
    }
    __syncthreads();
}
__device__ __forceinline__ void load_tab(Frame& F) {
    __syncthreads();
    for (int i = F.tid_id(); i < TB_WORDS; i += NTHREADS) ((LAS int*)(F.lds + LDS_TAB))[i] = ((const GAS int*)(F.ws + WS_MISC + MS_TAB))[i];
    __syncthreads();
}

__device__ __forceinline__ void forget_phase(Frame& F, const GAS bf16_t* S) {
    int tid_ = F.tid_id(); asm volatile("" : "+v"(tid_));
    const int lane = tid_ & 63, w = __builtin_amdgcn_readfirstlane(tid_ >> 6);
    const GAS float* Wf = in_sel(IN_KVF);
    f32x4 wf[16];
#pragma unroll
    for (int i = 0; i < 16; ++i) wf[i] = *(const GAS f32x4*)(Wf + (size_t)(16 * lane + i) * 2052 + 2048);
    const f32x4 bias = *(const GAS f32x4*)in_sel(IN_KVFB);
    LAS float* lf = (LAS float*)F.lds;
    GAS float* cl = (GAS float*)(F.ws + WS_MISC + MS_CL); GAS float* tt = (GAS float*)(F.ws + WS_MISC + MS_TOT);
    for (int ch = blockIdx.x; ch < T / 128; ch += F.G) {
        __syncthreads();
        for (int k = 0; k < 16; ++k) {
            const int row = 128 * ch + 16 * w + k; const GAS u32x4* xr = (const GAS u32x4*)(S + (size_t)row * DM) + 2 * lane;
            float x[8]; f32x4 a = (f32x4){0.f, 0.f, 0.f, 0.f};
            g8::unpack8(xr[0], x);
#pragma unroll
            for (int i = 0; i < 8; ++i) a += wf[i] * x[i];
            g8::unpack8(xr[1], x);
#pragma unroll
            for (int i = 0; i < 8; ++i) a += wf[8 + i] * x[i];
#pragma unroll
            for (int hh = 0; hh < 4; ++hh) a[hh] = wave_sum_dpp(a[hh]);
            if (lane == 0) { f32x4 o;
#pragma unroll
                for (int hh = 0; hh < 4; ++hh) { const float z = a[hh] + bias[hh]; o[hh] = -(fmaxf(-z, 0.f) + log1pf(__expf(-fabsf(z)))); }
                *(LAS f32x4*)(lf + (16 * w + k) * 4) = o; }
        }
        __syncthreads();
        { const int tile = w >> 2, hh = w & 3; float x = lf[(tile * 64 + lane) * 4 + hh];
#pragma unroll
          for (int o = 1; o < 64; o <<= 1) { const float y = shup(x, o, lane); if (lane >= o) x += y; }
          const int row = 128 * ch + tile * 64 + lane, b = row / SEQ, s = row % SEQ;
          cl[(size_t)(b * NH + hh) * SEQ + s] = x; if (lane == 63) tt[(b * NH + hh) * 256 + (s >> 6)] = x; }
    }
    __syncthreads();
}
__device__ __forceinline__ void knorm_phase(Frame& F, const GAS bf16_t* KS) {
    const int lane = F.lane_id(), w = F.wave;
    for (int ch = blockIdx.x; ch < T / 128; ch += F.G) {
        float mx = 0.f;
        for (int k = 0; k < 16; ++k) { const int row = 128 * ch + 16 * w + k; const GAS u32x4* kr = (const GAS u32x4*)(KS + (size_t)row * DM) + 2 * lane; const u32x4 a = kr[0], b = kr[1];
            const unsigned u[8] = {a.x, a.y, a.z, a.w, b.x, b.y, b.z, b.w}; float s = 0.f;
#pragma unroll
            for (int i = 0; i < 8; ++i) { const float lo = __builtin_bit_cast(float, u[i] << 16), hi = __builtin_bit_cast(float, u[i] & 0xffff0000u); s += lo * lo + hi * hi; }
            s += shx(s, 1, lane); s += shx(s, 2, lane); s += shx(s, 4, lane); s += shx(s, 8, lane);
            mx = fmaxf(mx, s); }
        if ((lane & 15) == 0) { const int b = (128 * ch) / SEQ; (void)__hip_atomic_fetch_max(F.ctl + CW_KN2 + b * NH + (lane >> 4), __builtin_bit_cast(unsigned, mx), RLX_AGENT); }
    }
}

constexpr int AT_KB0 = 0, AT_VB0 = 32768, AT_KB1 = 66048, AT_VB1 = 98816, AT_VPANEL = 2080;
constexpr float SB_STOP = -24.f, FOX_STOP = -30.f;
typedef short s16x4 __attribute__((ext_vector_type(4)));
#define AT_TR4(r0, r1, r2, r3, addr, o0, o1, o2, o3) asm volatile("ds_read_b64_tr_b16 %0, %4 offset:%5\n\tds_read_b64_tr_b16 %1, %4 offset:%6\n\tds_read_b64_tr_b16 %2, %4 offset:%7\n\tds_read_b64_tr_b16 %3, %4 offset:%8" \
    : "=&v"(r0), "=&v"(r1), "=&v"(r2), "=&v"(r3) : "v"(addr), "i"(o0), "i"(o1), "i"(o2), "i"(o3) : "memory")
#define AT_WAIT4(r0, r1, r2, r3) asm volatile("s_waitcnt lgkmcnt(0)" : "+v"(r0), "+v"(r1), "+v"(r2), "+v"(r3) :: "memory")

template <bool FOX>
__device__ __forceinline__ void attn_phase(Frame& F, const GAS bf16_t* Q, const GAS bf16_t* Kb, const GAS bf16_t* Vb, GAS bf16_t* O) {
    LAS unsigned char* lds = F.lds;
    volatile LAS unsigned* flags = (volatile LAS unsigned*)(lds + LDS_FLAGS);
    int tid_ = F.tid_id(); asm volatile("" : "+v"(tid_));
    const int tid = tid_, w = __builtin_amdgcn_readfirstlane(tid >> 6), lane = tid & 63, fr = lane & 15, fq = lane >> 4;
    const int srow0 = tid >> 5, schunk = tid & 31;
    const unsigned kst = (unsigned)(srow0 * 512 + ((schunk ^ (srow0 & 15)) * 16));
    const unsigned vst = (unsigned)((schunk >> 1) * AT_VPANEL + srow0 * 32 + (schunk & 1) * 16);
    const unsigned vrd = (unsigned)((4 * fq + ((lane & 15) >> 2)) * 32 + 8 * (lane & 3));
    const GAS float* cl = (const GAS float*)(F.ws + WS_MISC + MS_CL); const GAS float* tt = (const GAS float*)(F.ws + WS_MISC + MS_TOT);
    for (int id = blockIdx.x; id < 8 * 128; id += F.G) {
        const int bh = id & 7, qt = id >> 3, b = bh >> 2, h = bh & 3, t0 = qt * 128;
        const size_t rowbase = (size_t)b * SEQ;
        const int tq = t0 + 16 * w + fr;
        bf16x8 qf[8];
        { const GAS bf16_t* qp = Q + (rowbase + tq) * DM + h * HD + 8 * fq;
#pragma unroll
          for (int s = 0; s < 8; ++s) qf[s] = *(const GAS bf16x8*)(qp + 32 * s); }
        f32x4 o[16];
#pragma unroll
        for (int d = 0; d < 16; ++d) o[d] = (f32x4){0.f, 0.f, 0.f, 0.f};
        float R = 0.f;
        float mrun = -1.0e30f, lsum = 0.f, cq = 0.f, qn = 0.f, KN = 0.f, gacc = 0.f;
        if constexpr (FOX) {
            float s2 = 0.f;
#pragma unroll
            for (int s = 0; s < 8; ++s)
#pragma unroll
                for (int j = 0; j < 8; ++j) { const float x = bf2f((unsigned short)qf[s][j]); s2 += x * x; }
            s2 += shx(s2, 16, lane); s2 += shx(s2, 32, lane); qn = sqrtf(s2);
            KN = sqrtf(__builtin_bit_cast(float, __hip_atomic_load(F.ctl + CW_KN2 + bh, RLX_AGENT))) * 1.002f;
            cq = cl[(size_t)bh * SEQ + tq] + ((tq >= t0 + 64) ? tt[bh * 256 + 2 * qt] : 0.f);
        }
        int kt = 2 * qt + 1, it = 0; bool wdone = false;
        u32x4 kr[4], vr[4];
#define AT_LOAD(KT) do { const GAS bf16_t* kp_ = Kb + (rowbase + (size_t)64 * (KT) + srow0) * DM + h * HD + schunk * 8; const GAS bf16_t* vp_ = Vb + (rowbase + (size_t)64 * (KT) + srow0) * DM + h * HD + schunk * 8; \
            _Pragma("unroll") for (int j = 0; j < 4; ++j) { kr[j] = *(const GAS u32x4*)(kp_ + (size_t)16 * j * DM); vr[j] = *(const GAS u32x4*)(vp_ + (size_t)16 * j * DM); } } while (0)
#define AT_WRITE(IT) do { const int kb_ = ((IT) & 1) ? AT_KB1 : AT_KB0, vb_ = ((IT) & 1) ? AT_VB1 : AT_VB0; \
            _Pragma("unroll") for (int j = 0; j < 4; ++j) { *(LAS u32x4*)(lds + kb_ + kst + j * 8192) = kr[j]; *(LAS u32x4*)(lds + vb_ + vst + j * 512) = vr[j]; } } while (0)
        AT_LOAD(kt); AT_WRITE(0); AT_LOAD(kt - 1);
        __syncthreads();
        for (;;) {
            const int kbuf = (it & 1) ? AT_KB1 : AT_KB0, vbuf = (it & 1) ? AT_VB1 : AT_VB0;
            if (it >= 2) { unsigned any = 0u; const int par = (it - 1) & 1;
#pragma unroll
                for (int k = 0; k < 8; ++k) any |= flags[par * 8 + k];
                if (any == 0u) break; }
            const int kmin = 64 * kt, wmax = t0 + 16 * w + 15, wmin = t0 + 16 * w;
            f32x4 ckv[4]; float ttv = 0.f;
            if constexpr (FOX) {
#pragma unroll
                for (int blk = 0; blk < 4; ++blk) ckv[blk] = *(const GAS f32x4*)(cl + (size_t)bh * SEQ + kmin + 16 * blk + 4 * fq);
                ttv = tt[bh * 256 + (kt > 2 * qt ? 2 * qt : kt)];
                asm volatile("" ::: "memory"); }
            if (kt > 0) { AT_WRITE(it + 1); if (kt > 1) AT_LOAD(kt - 2); }
            const bool part = !wdone && (FOX ? (kmin <= wmax) : (kmin < wmax));
            if (part) {
                const bool need_mask = (kmin + 63 >= wmin);
                f32x4 s[4];
#pragma unroll
                for (int blk = 0; blk < 4; ++blk) { s[blk] = (f32x4){0.f, 0.f, 0.f, 0.f};
#pragma unroll
                    for (int st = 0; st < 8; ++st) { const bf16x8 kf = *(const LAS bf16x8*)(lds + kbuf + (16 * blk + fr) * 512 + (((4 * st + fq) ^ fr) * 16));
                        s[blk] = __builtin_amdgcn_mfma_f32_16x16x32_bf16(kf, qf[st], s[blk], 0, 0, 0); } }
                float pv[4][4];
                if constexpr (!FOX) {
                    float lm[4][4], w4[4], Tt[4], Ex[4];
#pragma unroll
                    for (int blk = 0; blk < 4; ++blk) { w4[blk] = 0.f;
#pragma unroll
                        for (int i = 0; i < 4; ++i) { const float z = s[blk][i]; const float sp = softplus_f(z); const bool valid = !need_mask || (kmin + 16 * blk + 4 * fq + i < tq);
                            lm[blk][i] = valid ? -sp : 0.f; pv[blk][i] = valid ? (z - sp) : -1.0e30f; w4[blk] += lm[blk][i]; } }
#pragma unroll
                    for (int blk = 0; blk < 4; ++blk) { const float a = shx(w4[blk], 16, lane), bq = shx(w4[blk], 32, lane), c = shx(a, 32, lane);
                        Tt[blk] = (w4[blk] + a) + (bq + c); Ex[blk] = (fq == 0) ? (a + bq + c) : (fq == 1) ? (bq + c) : (fq == 2) ? a : 0.f; }
                    float bs = 0.f;
#pragma unroll
                    for (int blk = 3; blk >= 0; --blk) { float tail = R + bs + Ex[blk];
#pragma unroll
                        for (int i = 3; i >= 0; --i) { const float e = pv[blk][i] + tail; pv[blk][i] = (e > -80.f) ? fast_exp(e) : 0.f; tail += lm[blk][i]; }
                        bs += Tt[blk]; }
                    R += bs;
                } else {
                    float base;
                    if (kt == 2 * qt + 1) base = ttv; else if (kt == 2 * qt) base = 0.f; else { gacc += ttv; base = -gacc; }
                    float mx = -1.0e30f;
#pragma unroll
                    for (int blk = 0; blk < 4; ++blk) { const f32x4 ck = ckv[blk];
#pragma unroll
                        for (int i = 0; i < 4; ++i) { const bool valid = !need_mask || (kmin + 16 * blk + 4 * fq + i <= tq); const float lg = valid ? (s[blk][i] + cq - (ck[i] + base)) : -1.0e30f; pv[blk][i] = lg; mx = fmaxf(mx, lg); } }
                    mx = fmaxf(mx, shx(mx, 16, lane)); mx = fmaxf(mx, shx(mx, 32, lane));
                    const float mnew = fmaxf(mrun, mx), al = fast_exp(mrun - mnew); float ps = 0.f;
#pragma unroll
                    for (int blk = 0; blk < 4; ++blk)
#pragma unroll
                        for (int i = 0; i < 4; ++i) { const float e = pv[blk][i] - mnew; const float p = (e > -80.f) ? fast_exp(e) : 0.f; pv[blk][i] = p; ps += p; }
                    lsum = lsum * al + ps;
                    if (__any(mnew > mrun)) {
#pragma unroll
                        for (int d = 0; d < 16; ++d) o[d] = o[d] * al; }
                    mrun = mnew;
                }
                bf16x8 pf[2];
#pragma unroll
                for (int c = 0; c < 2; ++c) { u32x4 pw; pw.x = cvt_pk_bf16(pv[2 * c][0], pv[2 * c][1]); pw.y = cvt_pk_bf16(pv[2 * c][2], pv[2 * c][3]); pw.z = cvt_pk_bf16(pv[2 * c + 1][0], pv[2 * c + 1][1]); pw.w = cvt_pk_bf16(pv[2 * c + 1][2], pv[2 * c + 1][3]);
                    pf[c] = __builtin_bit_cast(bf16x8, pw); }
                const unsigned va = (unsigned)(size_t)(lds + vbuf) + vrd;
                s16x4 c0, c1, c2, c3, n0, n1, n2, n3;
                AT_TR4(c0, c1, c2, c3, va, 0, 512, 1024, 1536);
                n0 = c0; n1 = c1; n2 = c2; n3 = c3;
#define AT_PV(db) do { AT_WAIT4(c0, c1, c2, c3); \
                    if ((db) < 15) { AT_TR4(n0, n1, n2, n3, va, ((db) + 1) * AT_VPANEL, ((db) + 1) * AT_VPANEL + 512, ((db) + 1) * AT_VPANEL + 1024, ((db) + 1) * AT_VPANEL + 1536); } \
                    { const bf16x8 v0 = __builtin_shufflevector(c0, c1, 0, 1, 2, 3, 4, 5, 6, 7), v1 = __builtin_shufflevector(c2, c3, 0, 1, 2, 3, 4, 5, 6, 7); \
                      o[db] = __builtin_amdgcn_mfma_f32_16x16x32_bf16(v0, pf[0], o[db], 0, 0, 0); o[db] = __builtin_amdgcn_mfma_f32_16x16x32_bf16(v1, pf[1], o[db], 0, 0, 0); } \
                    c0 = n0; c1 = n1; c2 = n2; c3 = n3; } while (0)
                AT_PV(0); AT_PV(1); AT_PV(2); AT_PV(3); AT_PV(4); AT_PV(5); AT_PV(6); AT_PV(7); AT_PV(8); AT_PV(9); AT_PV(10); AT_PV(11); AT_PV(12); AT_PV(13); AT_PV(14); AT_PV(15);
#undef AT_PV
            } else if constexpr (FOX) { if (kt < 2 * qt) gacc += ttv; }
            { bool cont;
              if constexpr (!FOX) cont = (R >= SB_STOP);
              else cont = (qn * KN + cq + ((kt <= 2 * qt) ? gacc : 0.f) - mrun >= FOX_STOP) || (kt > 2 * qt);
              const bool anyc = !wdone && __any(cont); wdone = !anyc;
              if (lane == 0) flags[(it & 1) * 8 + w] = anyc ? 1u : 0u; }
            __syncthreads();
            if (kt == 0) break;
            --kt; ++it;
        }
#undef AT_LOAD
#undef AT_WRITE
        float inv = 1.f;
        if constexpr (FOX) { float lt = lsum; lt += shx(lt, 16, lane); lt += shx(lt, 32, lane); inv = 1.f / lt; }
        { GAS bf16_t* op = O + (rowbase + tq) * DM + h * HD + 4 * fq;
#pragma unroll
          for (int db = 0; db < 16; ++db) { u32x2 ow; ow.x = cvt_pk_bf16(o[db][0] * inv, o[db][1] * inv); ow.y = cvt_pk_bf16(o[db][2] * inv, o[db][3] * inv); *(GAS u32x2*)(op + 16 * db) = ow; } }
    }
}

constexpr int NPH = 41;
__host__ __device__ inline bool phase_nonempty(int k) { if (k == 0) return true; const int L = (k - 1) / 10, s = (k - 1) % 10; if (s == 1) return L == 2; if (s == 5) return (L & 1) != 0; return true; }
struct Args { const float* in[N_IN]; float* out; unsigned char* ws; int ph_lo, ph_hi, sub, pad; };

__global__ void __launch_bounds__(NTHREADS, 2) mk_fwd(Args args) {
    extern __shared__ __attribute__((aligned(16))) unsigned char lds_raw[];
    Frame F;
    F.lds = (LAS unsigned char*)lds_raw;
    F.wave = __builtin_amdgcn_readfirstlane((int)threadIdx.x >> 6);
    F.G = gridDim.x; { const int bx = blockIdx.x; F.vcu = (F.G % 8 == 0) ? (bx % 8) * (F.G / 8) + bx / 8 : bx; }
    F.ws = (GAS unsigned char*)args.ws; F.ctl = (GAS unsigned*)F.ws; F.res = (GAS float*)args.out;
    for (int u = (int)threadIdx.x; u < (LDS_BYTES - LDS_CTL) / 4; u += NTHREADS) ((LAS unsigned*)(F.lds + LDS_CTL))[u] = 0u;
    __syncthreads();
    const int lo = args.ph_lo, hi = args.ph_hi;
    XcdBarrier bar; bar.bar = F.ctl + CW_BAR; bar.x = 0; bar.st = nullptr;
    if (hi - lo > 1) bar = xcd_barrier_post(F.ctl + CW_BAR, (volatile LAS unsigned*)(F.lds + LDS_CTL) + 8);
#ifndef DUP_MASK
#define DUP_MASK 0
#endif
#define DUP(n) (1 + ((DUP_MASK >> (n)) & 1))
#ifndef SITE_MASK
#define SITE_MASK 0xFFFFF
#endif
#define SITE(n) ((SITE_MASK >> (n)) & 1)
#define IN(k) (lo <= (k) && (k) < hi)
#define SEAM(k) do { if ((k) + 1 < hi) xcd_barrier(bar); } while (0)
    const int c = (int)blockIdx.x;
#define WSB(name) GAS unsigned char* name = launder_ptr(F.ws)
#define XBP(ws_, which) ((GAS bf16_t*)((ws_) + ((which) ? WS_XB1 : WS_XB0)))

    if (SITE(0) && IN(0)) { for (int rep_ = 0; rep_ < DUP(0); ++rep_) prologue_phase(F); SEAM(0); }

    for (int L = 0; L < DEPTH; ++L) {
        const int pb = 1 + 10 * L;
        {
            F.wave = launder_int(F.wave); F.ws = launder_ptr(F.ws); F.res = launder_ptr(F.res); F.ctl = (GAS unsigned*)F.ws; F.G = launder_int(F.G); }
        for (int repa_ = 0; repa_ < DUP(20); ++repa_) {
        if (SITE(1) && IN(pb + 0)) {
            WSB(ws);
            const GAS bf16_t* Wqkv = (const GAS bf16_t*)(ws + (L < 2 ? WS_WDEAD : WS_WLIVE)) + (L == 0 ? WD_QKV0 : L == 1 ? WD_QKV1 : L == 2 ? WL_QKV2 : WL_Q3);
            g8::ProbPlain P{XBP(ws, (L + 1) & 1), Wqkv, 1024, 1024, 16, T / 256, (L == 3) ? 4 : 12, F.G, c};
            g8::EpiBf16Split E{(GAS bf16_t*)(ws + WS_QA), 1024, (L == 3) ? 0 : 1024, (size_t)(WS_KS - WS_QA) / 2};
            for (int rep_ = 0; rep_ < DUP(1); ++rep_) g8::gemm_phase<g8::ProbPlain, g8::EpiBf16Split>(F.lds, P, E, F.wave);
            if (SITE(2) && L == 2) forget_phase(F, XBP(ws, (L + 1) & 1));
            SEAM(pb + 0);
        }
        if (SITE(3) && IN(pb + 1) && L == 2) { WSB(ws); knorm_phase(F, (const GAS bf16_t*)(ws + WS_KS)); SEAM(pb + 1); }
        if (IN(pb + 2)) {
            WSB(ws); GAS bf16_t* QA = (GAS bf16_t*)(ws + WS_QA); const GAS bf16_t* KS = (const GAS bf16_t*)(ws + WS_KS); const GAS bf16_t* VS = (const GAS bf16_t*)(ws + WS_VS);
            if (L < 2) { if (SITE(4)) attn_phase<false>(F, QA, KS, VS, QA); } else { if (SITE(5)) attn_phase<true>(F, QA, KS, VS, QA); }
            SEAM(pb + 2);
        }
        }
        if (SITE(6) && IN(pb + 3)) {
            WSB(ws);
            const GAS bf16_t* Wo = (const GAS bf16_t*)(ws + (L < 2 ? WS_WDEAD : WS_WLIVE)) + (L == 0 ? WD_O0 : L == 1 ? WD_O1 : L == 2 ? WL_O2 : WL_O3);
            g8::ProbPlain P{(const GAS bf16_t*)(ws + WS_QA), Wo, 1024, 1024, 16, T / 256, 4, F.G, c};
            g8::EpiResidB E{XBP(ws, (L + 1) & 1)};
            g8::gemm_phase<g8::ProbPlain, g8::EpiResidB>(F.lds, P, E, F.wave);
            SEAM(pb + 3);
        }
        if (IN(pb + 4)) { WSB(ws); GAS bf16_t* xln1 = XBP(ws, (L + 1) & 1); if (L & 1) { if (SITE(7)) ln_phase<true, true>(F, L, 0, xln1); } else { if (SITE(8)) ln_phase<false, true>(F, L, 0, xln1); } SEAM(pb + 4); }
        if (SITE(9) && IN(pb + 5) && (L & 1)) { moe_lists_phase(F); SEAM(pb + 5); }
        if (IN(pb + 6)) {
            WSB(ws); const GAS bf16_t* xln1 = XBP(ws, (L + 1) & 1);
            if (L & 1) { if (SITE(10)) { load_tab(F);
                const GAS bf16_t* Wmgu = (const GAS bf16_t*)(ws + (L == 1 ? WS_WDEAD : WS_WLIVE)) + (L == 1 ? WD_MGU0 : WL_MGU1); const GAS i32x4* elist = (const GAS i32x4*)(ws + WS_MISC + MS_ELIST);
                g8::ProbMoeGU P{xln1, Wmgu, elist, (const LAS int*)(F.lds + LDS_TAB), 1024, 1024, 16, F.G, c}; g8::EpiMoeGU E{(GAS bf16_t*)(ws + (L == 1 ? WS_QA : WS_WDEAD)), elist, (const GAS float*)(ws + WS_MISC + MS_EGATE)};
                for (int rep_ = 0; rep_ < DUP(10); ++rep_) g8::gemm_phase<g8::ProbMoeGU, g8::EpiMoeGU>(F.lds, P, E, F.wave); } }
            else if (SITE(11)) { const GAS bf16_t* Wgu = (const GAS bf16_t*)(ws + (L == 0 ? WS_WDEAD : WS_WLIVE)) + (L == 0 ? WD_GU0 : WL_GU1);
                g8::ProbPlain P{xln1, Wgu, 1024, 1024, 16, T / 256, 22, F.G, c}; g8::EpiSwiglu E{(GAS bf16_t*)(ws + (L == 0 ? WS_QA : WS_XB0)), DFF};
                for (int rep_ = 0; rep_ < DUP(11); ++rep_) g8::gemm_phase<g8::ProbPlain, g8::EpiSwiglu>(F.lds, P, E, F.wave); }
            SEAM(pb + 6);
        }
        if (IN(pb + 7)) {
            WSB(ws);
            if (L & 1) { if (SITE(12)) { load_tab(F);
                const GAS bf16_t* Wmdn = (const GAS bf16_t*)(ws + (L == 1 ? WS_WDEAD : WS_WLIVE)) + (L == 1 ? WD_MDN0 : WL_MDN1);
                g8::ProbMoeDown P{(const GAS bf16_t*)(ws + (L == 1 ? WS_QA : WS_WDEAD)), Wmdn, (const LAS int*)(F.lds + LDS_TAB), 1408, 5632, 22, F.G, c}; g8::EpiMoeDownB E{XBP(ws, (L + 1) & 1), (const GAS int*)(ws + WS_MISC + MS_PLIST)};
                g8::gemm_phase<g8::ProbMoeDown, g8::EpiMoeDownB>(F.lds, P, E, F.wave); } }
            else if (SITE(13)) { const GAS bf16_t* Wdn = (const GAS bf16_t*)(ws + (L == 0 ? WS_WDEAD : WS_WLIVE)) + (L == 0 ? WD_DN0 : WL_DN1);
                g8::ProbPlain P{(const GAS bf16_t*)(ws + (L == 0 ? WS_QA : WS_XB0)), Wdn, DFF, DFF, 44, T / 256, 4, F.G, c}; g8::EpiResidB E{XBP(ws, (L + 1) & 1)};
                g8::gemm_phase<g8::ProbPlain, g8::EpiResidB>(F.lds, P, E, F.wave); }
            SEAM(pb + 7);
        }
        if (SITE(14) && IN(pb + 8)) { WSB(ws); ln_phase<false, false>(F, L, 1, XBP(ws, (L + 1) & 1)); SEAM(pb + 8); }
        if (IN(pb + 9)) {
            if (SITE(15) && args.sub != 2) { WSB(ws); const GAS bf16_t* Wpg = (const GAS bf16_t*)(ws + (L < 2 ? WS_WDEAD : WS_WLIVE)) + (L == 0 ? WD_PG0 : L == 1 ? WD_PG1 : L == 2 ? WL_PG2 : WL_PG3);
                g8::ProbPlain P{XBP(ws, (L + 1) & 1), Wpg, 1024, 1024, 16, T / 256, 4, F.G, c}; g8::EpiGate E{XBP(ws, L & 1)}; for (int rep_ = 0; rep_ < DUP(15); ++rep_) g8::gemm_phase<g8::ProbPlain, g8::EpiGate>(F.lds, P, E, F.wave); }
            if (SITE(16) && args.sub != 1) { WSB(ws); const GAS bf16_t* Wpp = (const GAS bf16_t*)(ws + (L < 2 ? WS_WDEAD : WS_WLIVE)) + (L == 0 ? WD_PP0 : L == 1 ? WD_PP1 : L == 2 ? WL_PP2 : WL_PP3);
                g8::ProbPlain P{(const GAS bf16_t*)(ws + WS_PB), Wpp, PLE, PLE, 4, T / 256, 4, F.G, c}; g8::EpiPleB E{XBP(ws, (L + 1) & 1), XBP(ws, L & 1), L == DEPTH - 1 ? F.res : (GAS float*)nullptr}; g8::gemm_phase<g8::ProbPlain, g8::EpiPleB>(F.lds, P, E, F.wave); }
            if (pb + 9 < NPH - 1) SEAM(pb + 9);
        }
    }
#undef WSB
#undef XBP
#undef IN
#undef SEAM
}

extern "C" void kernel_launch(void* const* d_in, const int* in_sizes, int n_in, void* d_out, int out_size, void* d_ws, size_t ws_size, hipStream_t stream) {
    static int grid = 0;
    if (grid == 0) {
        if (n_in != N_IN || out_size != T * DM || ws_size < WS_END) { fprintf(stderr, "kernel_launch: unexpected problem (n_in %d, out %d, ws %zu < %zu)\n", n_in, out_size, ws_size, (size_t)WS_END); grid = -1; return; }
        int dev = 0, cus = 0, per_cu = 0;
        if (hipGetDevice(&dev) != hipSuccess || hipDeviceGetAttribute(&cus, hipDeviceAttributeMultiprocessorCount, dev) != hipSuccess) { grid = -1; return; }
        if (hipFuncSetAttribute((const void*)mk_fwd, hipFuncAttributeMaxDynamicSharedMemorySize, LDS_BYTES) != hipSuccess) { fprintf(stderr, "kernel_launch: hipFuncSetAttribute failed\n"); grid = -1; return; }
        if (hipOccupancyMaxActiveBlocksPerMultiprocessor(&per_cu, (const void*)mk_fwd, NTHREADS, LDS_BYTES) != hipSuccess || per_cu < 1) { fprintf(stderr, "kernel_launch: occupancy query says %d blocks per CU\n", per_cu); }
        (void)hipGetLastError();
        grid = cus;
    }
    if (grid < 0) return;
    (void)hipMemsetAsync((char*)d_ws + WS_CTL, 0, CTL_ZERO_BYTES, stream);
    Args a{};
    for (int i = 0; i < N_IN; ++i) a.in[i] = (const float*)d_in[i];
    a.out = (float*)d_out; a.ws = (unsigned char*)d_ws;
    a.ph_lo = 0; a.ph_hi = NPH; a.sub = 0; a.pad = 0;
    hipLaunchKernelGGL(mk_fwd, dim3(grid), dim3(NTHREADS), LDS_BYTES, stream, a);
}
```

```cpp
#include <hip/hip_runtime.h>
#include <cstdio>
#include <cstdint>


#define LAS __attribute__((address_space(3)))
#define GAS __attribute__((address_space(1)))
typedef unsigned short bf16_t;
typedef short bf16x8 __attribute__((ext_vector_type(8)));
typedef short bf16x4 __attribute__((ext_vector_type(4)));
typedef float f32x4 __attribute__((ext_vector_type(4)));
typedef float f32x2 __attribute__((ext_vector_type(2)));
typedef unsigned u32x4 __attribute__((ext_vector_type(4)));
typedef unsigned u32x2 __attribute__((ext_vector_type(2)));
typedef int i32x4 __attribute__((ext_vector_type(4)));

constexpr int DM = 1024, NBATCH = 2, SEQ = 16384, T = NBATCH * SEQ, NH = 4, HD = 256, DFF = 2816, NE = 8, DFE = 704, PLE = 256, DEPTH = 4;
constexpr float ALPHA = 1.6817928305074292f;
constexpr float LN_EPS = 1e-5f;
constexpr int NWAVES = 8, NTHREADS = 512;
enum { IN_X = 0, IN_P, IN_AQKV, IN_AO, IN_KVF, IN_KVFB, IN_BQ, IN_BO, IN_FGU, IN_FDN, IN_MR, IN_MGU, IN_MDN, IN_PP, IN_PG, IN_LNG, IN_LNB, N_IN };

constexpr size_t MiB = 1u << 20;
constexpr size_t WS_CTL = 0, CTL_ZERO_BYTES = 1 * MiB;
constexpr size_t WS_MISC = 1 * MiB;
constexpr size_t WS_WLIVE = 8 * MiB;
constexpr size_t WS_PB = 77 * MiB;
constexpr size_t WS_XB1 = 93 * MiB, WS_XB0 = 157 * MiB;
constexpr size_t WS_WDEAD = 221 * MiB;
constexpr size_t WS_QA = 294 * MiB, WS_KS = 358 * MiB, WS_VS = 422 * MiB, WS_END = 486 * MiB;
constexpr size_t MS_REC = 0;
constexpr size_t MS_HIST = 512 * 1024;
constexpr size_t MS_ELIST = 576 * 1024;
constexpr int ELIST_CAP = 2 * T + NE * 256;
constexpr size_t MS_PLIST = MS_ELIST + (size_t)ELIST_CAP * 16;
constexpr int NPAIR = 28, PLIST_CAP = T + NPAIR * 256;
constexpr size_t MS_TAB = 2 * MiB;
constexpr size_t MS_CL = 2 * MiB + 64 * 1024;
constexpr size_t MS_TOT = MS_CL + (size_t)8 * SEQ * 4;
constexpr size_t MS_SNAP = 3 * MiB;
constexpr size_t MS_EGATE = 4 * MiB + 512 * 1024;
constexpr size_t MS_GATE = 4 * MiB;
static_assert(MS_PLIST + (size_t)PLIST_CAP * 4 <= MS_TAB && MS_TOT + 8 * 256 * 4 <= MS_SNAP, "misc map");
enum { TB_ECUM = 0  , TB_EOFF = 16  , TB_NRT = 32, TB_RT2P = 64  , TB_WORDS = 320 };
constexpr int CW_TMO = 0, CW_CODE = 1, CW_DBG = 64  , CW_KN2 = 192  , CW_BAR = 4096;

constexpr size_t WSZ_QKV = (size_t)3072 * 1024, WSZ_SQ = (size_t)1024 * 1024, WSZ_GU = (size_t)5632 * 1024, WSZ_DN = (size_t)1024 * 2816,
                 WSZ_MGU = (size_t)NE * 1536 * 1024, WSZ_MDN = (size_t)1024 * 5632, WSZ_PP = (size_t)1024 * 256;
constexpr size_t WD_QKV0 = 0, WD_O0 = WD_QKV0 + WSZ_QKV, WD_QKV1 = WD_O0 + WSZ_SQ, WD_O1 = WD_QKV1 + WSZ_QKV, WD_GU0 = WD_O1 + WSZ_SQ, WD_DN0 = WD_GU0 + WSZ_GU,
                 WD_MGU0 = WD_DN0 + WSZ_DN, WD_MDN0 = WD_MGU0 + WSZ_MGU, WD_PP0 = WD_MDN0 + WSZ_MDN, WD_PG0 = WD_PP0 + WSZ_PP, WD_PP1 = WD_PG0 + WSZ_SQ, WD_PG1 = WD_PP1 + WSZ_PP, WD_END = WD_PG1 + WSZ_SQ;
constexpr size_t WL_QKV2 = 0, WL_O2 = WL_QKV2 + WSZ_QKV, WL_Q3 = WL_O2 + WSZ_SQ, WL_O3 = WL_Q3 + WSZ_SQ, WL_GU1 = WL_O3 + WSZ_SQ, WL_DN1 = WL_GU1 + WSZ_GU,
                 WL_MGU1 = WL_DN1 + WSZ_DN, WL_MDN1 = WL_MGU1 + WSZ_MGU, WL_PP2 = WL_MDN1 + WSZ_MDN, WL_PG2 = WL_PP2 + WSZ_PP, WL_PP3 = WL_PG2 + WSZ_SQ, WL_PG3 = WL_PP3 + WSZ_PP, WL_END = WL_PG3 + WSZ_SQ;
static_assert(WD_END * 2 <= 73 * MiB && WL_END * 2 <= 69 * MiB, "weight regions");
static_assert((size_t)T * DFF * 2 <= WS_END - WS_QA && WS_XB0 + (size_t)T * DFF * 2 <= WS_KS && WS_WDEAD + (size_t)(T + NPAIR * 256) * 1408 * 2 <= WS_KS, "h overlays");

constexpr int RING_BYTES = 131072;
constexpr int LDS_CTL = 135168;
constexpr int LDS_TAB = LDS_CTL + 128;
constexpr int LDS_FLAGS = LDS_TAB + TB_WORDS * 4;
constexpr int LDS_BYTES = 147456;
static_assert(LDS_FLAGS + 64 <= LDS_BYTES, "LDS map");

#define RLX_AGENT __ATOMIC_RELAXED, __HIP_MEMORY_SCOPE_AGENT
__device__ __forceinline__ unsigned f2bf(float f) { unsigned u = __builtin_bit_cast(unsigned, f); return (u + 0x7fffu + ((u >> 16) & 1u)) >> 16; }
__device__ __forceinline__ unsigned pk2(float lo, float hi) { return f2bf(lo) | (f2bf(hi) << 16); }
__device__ __forceinline__ float bf2f(unsigned short b) { return __builtin_bit_cast(float, (unsigned)b << 16); }
typedef __bf16 bf16v2_t __attribute__((ext_vector_type(2)));
__device__ __forceinline__ unsigned cvt_pk_bf16(float lo, float hi) { bf16v2_t v; v[0] = (__bf16)lo; v[1] = (__bf16)hi; return __builtin_bit_cast(unsigned, v); }
__device__ __forceinline__ float shx(float v, int m, int lane) { return __builtin_bit_cast(float, __builtin_amdgcn_ds_bpermute((lane ^ m) << 2, __builtin_bit_cast(int, v))); }
__device__ __forceinline__ int shxi(int v, int m, int lane) { return __builtin_amdgcn_ds_bpermute((lane ^ m) << 2, v); }
__device__ __forceinline__ float shup(float v, int o, int lane) { return __builtin_bit_cast(float, __builtin_amdgcn_ds_bpermute(((lane - o) & 63) << 2, __builtin_bit_cast(int, v))); }
__device__ __forceinline__ float wave_sum(float v, int lane) {
#pragma unroll
    for (int o = 1; o < 64; o <<= 1) v += shx(v, o, lane);
    return v;
}
template <int CTRL> __device__ __forceinline__ float dpp_mov(float v) { return __builtin_bit_cast(float, __builtin_amdgcn_update_dpp(0, __builtin_bit_cast(int, v), CTRL, 0xF, 0xF, true)); }
__device__ __forceinline__ float wave_sum_dpp(float v) {
    v += dpp_mov<0xB1>(v); v += dpp_mov<0x4E>(v); v += dpp_mov<0x141>(v); v += dpp_mov<0x140>(v);
    const int b = __builtin_bit_cast(int, v);
    return (__builtin_bit_cast(float, __builtin_amdgcn_readlane(b, 0)) + __builtin_bit_cast(float, __builtin_amdgcn_readlane(b, 16))) + (__builtin_bit_cast(float, __builtin_amdgcn_readlane(b, 32)) + __builtin_bit_cast(float, __builtin_amdgcn_readlane(b, 48)));
}
__device__ __forceinline__ float fast_exp(float x) { return __builtin_amdgcn_exp2f(x * 1.4426950408889634f); }
__device__ __forceinline__ float fast_log(float x) { return __builtin_amdgcn_logf(x) * 0.6931471805599453f; }
__device__ __forceinline__ float softplus_f(float z) { return fmaxf(z, 0.f) + fast_log(1.f + fast_exp(-fabsf(z))); }
__device__ __forceinline__ float sigmoid_f(float z) { return __builtin_amdgcn_rcpf(1.f + fast_exp(-z)); }

typedef const GAS float* fptr_t;
__device__ __forceinline__ const GAS float* in_sel(int idx) { const __attribute__((address_space(4))) fptr_t* ka = (const __attribute__((address_space(4))) fptr_t*)__builtin_amdgcn_kernarg_segment_ptr(); return ka[idx]; }

template <class Tp> __device__ __forceinline__ GAS Tp* launder_ptr(GAS Tp* p) { unsigned lo = (unsigned)(unsigned long long)p, hi = (unsigned)((unsigned long long)p >> 32); asm volatile("" : "+v"(lo), "+v"(hi));
    lo = __builtin_amdgcn_readfirstlane(lo); hi = __builtin_amdgcn_readfirstlane(hi); return (GAS Tp*)(((unsigned long long)hi << 32) | lo); }
__device__ __forceinline__ int launder_int(int v) { asm volatile("" : "+v"(v)); return __builtin_amdgcn_readfirstlane(v); }

#define XB_TMO      128
#define XB_XCNT(j)  (256  + 64 * (j))
#define XB_XSUB(j)  (1280 + 64 * (j))
#define XB_XGEN(j)  (2304 + 64 * (j))
#define XB_TOP      3328
#define XB_TOPGEN   3392
#define XCD_BAR_WORDS 3456
#define XB_SPIN_CAP (1u << 18)
__device__ __forceinline__ unsigned xb_ld(GAS unsigned* p)              { return __hip_atomic_load(p, __ATOMIC_RELAXED, __HIP_MEMORY_SCOPE_AGENT); }
__device__ __forceinline__ unsigned xb_add(GAS unsigned* p, unsigned v) { return __hip_atomic_fetch_add(p, v, __ATOMIC_RELAXED, __HIP_MEMORY_SCOPE_AGENT); }
__device__ __forceinline__ unsigned xb_xcc_id() { return (unsigned)__builtin_amdgcn_s_getreg((3 << 11) | 20) & 0xFu; }
#define XB_SPIN(cond, bar) do { unsigned _sp = 0; while (cond) { __builtin_amdgcn_s_sleep(1); \
    if ((++_sp & 255u) == 0u) { if (xb_ld(&(bar)[XB_TMO])) break; if (_sp > XB_SPIN_CAP) { (void)xb_add(&(bar)[XB_TMO], 1u); break; } } } } while (0)
struct XcdBarrier { GAS unsigned* bar; unsigned x; volatile LAS unsigned* st; };
__device__ __forceinline__ XcdBarrier xcd_barrier_post(GAS unsigned* bar, volatile LAS unsigned* st) {
    XcdBarrier b; b.bar = bar; b.x = xb_xcc_id(); b.st = st;
    if (threadIdx.x == 0) (void)xb_add(&bar[XB_XCNT(b.x)], 1u);
    return b;
}
__device__ __forceinline__ void xcd_barrier_complete(GAS unsigned* bar, unsigned x, unsigned& nloc, unsigned& nx) {
    const unsigned G = gridDim.x * gridDim.y * gridDim.z;
    unsigned sum, cnt, mine, sp = 0u;
    for (;;) {
        sum = 0u; cnt = 0u; mine = 0u;
#pragma unroll
        for (unsigned j = 0; j < 16; ++j) { const unsigned c = xb_ld(&bar[XB_XCNT(j)]); sum += c; cnt += (c > 0u) ? 1u : 0u; mine = (j == x) ? c : mine; }
        if (sum == G) break;
        __builtin_amdgcn_s_sleep(1);
        if ((++sp & 255u) == 0u) { if (xb_ld(&bar[XB_TMO])) break; if (sp > XB_SPIN_CAP) { (void)xb_add(&bar[XB_TMO], 1u); break; } }
    }
    nloc = mine > 0u ? mine : 1u; nx = cnt > 0u ? cnt : 1u;
}
__device__ __forceinline__ void xcd_barrier(const XcdBarrier& b) {
    asm volatile("s_waitcnt vmcnt(0)" ::: "memory");
    __syncthreads();
    if (threadIdx.x == 0) {
        GAS unsigned* bar = b.bar;
        __builtin_amdgcn_s_waitcnt(0);
        unsigned nloc = b.st[0], nx = b.st[1];
        if (nloc == 0u) { xcd_barrier_complete(bar, b.x, nloc, nx); b.st[0] = nloc; b.st[1] = nx; }
        const unsigned old = xb_add(&bar[XB_XSUB(b.x)], 1u);
        const unsigned gen = old / nloc;
        if (old + 1u == (gen + 1u) * nloc) {
            __builtin_amdgcn_fence(__ATOMIC_RELEASE, "agent");
            asm volatile("s_waitcnt vmcnt(0)" ::: "memory");
            const unsigned og = xb_add(&bar[XB_TOP], 1u);
            const unsigned tg = og / nx;
            if (og + 1u == (tg + 1u) * nx) xb_add(&bar[XB_TOPGEN], 1u);
            else XB_SPIN(xb_ld(&bar[XB_TOPGEN]) == tg, bar);
            __builtin_amdgcn_fence(__ATOMIC_ACQUIRE, "agent");
            xb_add(&bar[XB_XGEN(b.x)], 1u);
            asm volatile("s_waitcnt vmcnt(0)" ::: "memory");
        } else {
            XB_SPIN(xb_ld(&bar[XB_XGEN(b.x)]) == gen, bar);
            __builtin_amdgcn_fence(__ATOMIC_ACQUIRE, "agent");
            asm volatile("s_waitcnt vmcnt(0)" ::: "memory");
        }
    }
    __syncthreads();
}

namespace g8 {
constexpr int BM = 256, BK = 64, HALF = 128, HTB = HALF * BK * 2, STAGE_BYTES = 8 * HTB, NXCD = 8, WGM = 8;
__host__ __device__ __forceinline__ int lds_byte(int r, int c) { const int st = (r >> 4) * 2 + (c >> 5), rr = r & 15, cc = c & 31, ob = rr * 64 + cc * 2; return st * 1024 + (ob ^ (((ob >> 9) & 1) << 5)); }
__host__ __device__ __forceinline__ void stage_rc(int b, int& R, int& C) { const int st = b / 1024, sb = b % 1024, swz = sb ^ (((sb >> 9) & 1) << 5); R = (st >> 1) * 16 + swz / 64; C = (st & 1) * 32 + (swz % 64) / 2; }
__host__ __device__ __forceinline__ int perm32(int rho) { const int n = rho >> 4, i = rho & 15; return 8 * (i >> 2) + 4 * n + (i & 3); }
struct Unit { int pm, pn, x0, x1; };
__device__ __forceinline__ bool static_order(int i, int G, int c, int nM, int nN, int& pm, int& pn) {
    const int nwg = nM * nN; const long L = (long)i * G + c; if (L >= nwg) return false;
    int wgid = (int)L; { const int q = nwg / NXCD, r = nwg % NXCD, xcd = wgid % NXCD, off = wgid / NXCD; wgid = (xcd < r ? xcd * (q + 1) : r * (q + 1) + (xcd - r) * q) + off; }
    const int nig = WGM * nN, gid = wgid / nig, fm = gid * WGM, gsz = (nM - fm) < WGM ? (nM - fm) : WGM;
    pm = fm + ((wgid % nig) % gsz); pn = (wgid % nig) / gsz; return true;
}

template <class Prob, class Epi, bool ALIGN_EPI = true>
__device__ __forceinline__ void gemm_phase(LAS unsigned char* lds, const Prob& P, const Epi& E, int wave_id) {
    int tid_; asm volatile("v_mbcnt_lo_u32_b32 %0, -1, 0\n\tv_mbcnt_hi_u32_b32 %0, -1, %0" : "=v"(tid_)); tid_ += wave_id * 64;
    const int tid = tid_, wid = __builtin_amdgcn_readfirstlane(tid >> 6), lane = tid & 63, wr = wid >> 2, wc = wid & 3, fr = lane & 15, fq = lane >> 4;
    const int nt = P.nt;
    unsigned voffA[2], voffB[2]; int Rr0 = 0; unsigned voffC = 0;
#pragma unroll
    for (int i = 0; i < 2; ++i) { int R, C; stage_rc(tid * 16 + i * 8192, R, C); const int Rb = Epi::PERM ? ((R & ~31) + perm32(R & 31)) : R;
        voffA[i] = (unsigned)(R * P.lda + C) * 2u; voffB[i] = (unsigned)(Rb * P.ldb + C) * 2u; if (i == 0) { Rr0 = R; voffC = (unsigned)C * 2u; } }
    const size_t kstep = (size_t)(BK * 2);
    const size_t hstepA = (size_t)HALF * P.lda * 2, hstepB = (size_t)HALF * P.ldb * 2;
    const unsigned ldsw = (unsigned)wid * 1024u;
    const int aoff = lds_byte(wr * 64 + fr, fq * 8), boff = lds_byte(wc * 32 + fr, fq * 8);
#define G8_SA(b, h) (((b) * 2 + (h)) * HTB)
#define G8_SB(b, h) ((4 + (b) * 2 + (h)) * HTB)
#define G8_STAGE(bufoff, gbase, voff) do { _Pragma("unroll") for (int _i = 0; _i < 2; ++_i) \
        __builtin_amdgcn_global_load_lds((const GAS unsigned*)((const GAS char*)(gbase) + (voff)[_i]), (LAS unsigned*)(lds + (bufoff) + ldsw + _i * 8192), 16, 0, 0); } while (0)
#define G8_STAGE_A(bufoff, h, kb, NX) do { if constexpr (Prob::GATHER) { const unsigned pk_ = (NX) ? gAn[h] : gAc[h]; const unsigned vo_[2] = {(pk_ & 0xffffu) * (unsigned)(P.lda * 2) + voffC, (pk_ >> 16) * (unsigned)(P.lda * 2) + voffC}; \
        G8_STAGE(bufoff, P.a_base() + (kb), vo_); } \
        else { G8_STAGE(bufoff, ((NX) ? nA : cA) + (h) * hstepA + (kb), voffA); } } while (0)
#define G8_LDA(dst, b, h) do { _Pragma("unroll") for (int m = 0; m < 4; ++m) _Pragma("unroll") for (int k = 0; k < 2; ++k) dst[m][k] = *(const LAS bf16x8*)(lds + G8_SA(b, h) + aoff + m * 2048 + k * 1024); } while (0)
#define G8_LDB(dst, b, h) do { _Pragma("unroll") for (int n = 0; n < 2; ++n) _Pragma("unroll") for (int k = 0; k < 2; ++k) dst[n][k] = *(const LAS bf16x8*)(lds + G8_SB(b, h) + boff + n * 2048 + k * 1024); } while (0)
#define G8_MMA(ai, bj, At, Bt) do { __builtin_amdgcn_s_setprio(1); _Pragma("unroll") for (int m = 0; m < 4; ++m) _Pragma("unroll") for (int n = 0; n < 2; ++n) _Pragma("unroll") for (int k = 0; k < 2; ++k) \
        acc[ai][bj][m][n] = __builtin_amdgcn_mfma_f32_16x16x32_bf16(Bt[n][k], At[m][k], acc[ai][bj][m][n], 0, 0, 0); __builtin_amdgcn_s_setprio(0); } while (0)
#define G8_WAIT_V(n) asm volatile("s_waitcnt vmcnt(" #n ")" ::: "memory")
#define G8_WAIT_L(n) asm volatile("s_waitcnt lgkmcnt(" #n ")" ::: "memory")
#define G8_BAR __builtin_amdgcn_s_barrier()
#define G8_SCHED __builtin_amdgcn_sched_barrier(0)
    Unit cur, nxt; int ui = 0;
    if (!P.next(0, cur)) return;
    f32x4 acc[2][2][4][2];
#pragma unroll
    for (int a = 0; a < 2; ++a)
#pragma unroll
        for (int b = 0; b < 2; ++b)
#pragma unroll
            for (int m = 0; m < 4; ++m)
#pragma unroll
                for (int n = 0; n < 2; ++n) acc[a][b][m][n] = (f32x4){0.f, 0.f, 0.f, 0.f};
    bf16x8 At[4][2], B0[2][2], B1[2][2];
    unsigned gAc[2], gAn[2];
    const GAS char* cA = nullptr; const GAS char* nA = nullptr;
    if constexpr (Prob::GATHER) { P.gather(cur, Rr0, gAc); } else { cA = P.a_tile(cur); }
    {
        const GAS char* b0 = P.b_ptr(cur, 0); const GAS char* b1 = P.b_ptr(cur, 1);
        G8_STAGE(G8_SB(0, 0), b0, voffB); G8_STAGE(G8_SB(0, 1), b0 + hstepB, voffB); G8_STAGE_A(G8_SA(0, 0), 0, 0, false); G8_STAGE_A(G8_SA(0, 1), 1, 0, false);
        if (wr == 1) G8_BAR;
        G8_WAIT_V(2); G8_BAR;
        G8_STAGE(G8_SB(1, 0), b1, voffB); G8_STAGE_A(G8_SA(1, 0), 0, kstep, false); G8_STAGE(G8_SB(1, 1), b1 + hstepB, voffB);
        G8_WAIT_V(6); G8_BAR;
    }
    for (;;) {
        const bool has_next = P.next(ui + 1, nxt);
        if (!has_next) nxt = cur;
        if constexpr (Prob::GATHER) { if (has_next) P.gather(nxt, Rr0, gAn); else { gAn[0] = gAc[0]; gAn[1] = gAc[1]; } }
        else { nA = P.a_tile(nxt); }
        for (int t = 0; t < nt; t += 2) {
            const bool last = (t == nt - 2);
            const size_t a1k = (size_t)(t + 1) * kstep;
            const size_t a2k = last ? 0 : (size_t)(t + 2) * kstep, a3k = last ? kstep : (size_t)(t + 3) * kstep;
            const GAS char* b2 = last ? P.b_ptr(nxt, 0) : P.b_ptr(cur, t + 2); const GAS char* b3 = last ? P.b_ptr(nxt, 1) : P.b_ptr(cur, t + 3);
            G8_LDB(B0, 0, 0); G8_LDB(B1, 0, 1); G8_SCHED; G8_LDA(At, 0, 0); G8_STAGE_A(G8_SA(1, 1), 1, a1k, false);
            G8_WAIT_V(8); G8_WAIT_L(0); G8_BAR; G8_MMA(0, 0, At, B0); G8_MMA(0, 1, At, B1); G8_BAR; G8_SCHED;
            G8_LDA(At, 0, 1); G8_STAGE(G8_SB(0, 0), b2, voffB); G8_STAGE(G8_SB(0, 1), b2 + hstepB, voffB);
            if (last) { G8_STAGE_A(G8_SA(0, 0), 0, a2k, true); } else { G8_STAGE_A(G8_SA(0, 0), 0, a2k, false); }
            G8_WAIT_V(8); G8_WAIT_L(0); G8_BAR; G8_MMA(1, 0, At, B0); G8_MMA(1, 1, At, B1); G8_BAR; G8_SCHED;
            G8_LDB(B0, 1, 0); G8_LDB(B1, 1, 1); G8_SCHED; G8_LDA(At, 1, 0);
            if (last) { G8_STAGE_A(G8_SA(0, 1), 1, a2k, true); } else { G8_STAGE_A(G8_SA(0, 1), 1, a2k, false); }
            G8_WAIT_V(8); G8_WAIT_L(0); G8_BAR; G8_MMA(0, 0, At, B0); G8_MMA(0, 1, At, B1); G8_BAR; G8_SCHED;
            G8_LDA(At, 1, 1); G8_STAGE(G8_SB(1, 0), b3, voffB); G8_STAGE(G8_SB(1, 1), b3 + hstepB, voffB);
            if (last) { G8_STAGE_A(G8_SA(1, 0), 0, a3k, true); } else { G8_STAGE_A(G8_SA(1, 0), 0, a3k, false); }
            G8_WAIT_V(8); G8_WAIT_L(0); G8_BAR; G8_MMA(1, 0, At, B0); G8_MMA(1, 1, At, B1); G8_BAR; G8_SCHED;
        }
        if constexpr (ALIGN_EPI) { if (wr == 0) G8_BAR; }
        { int l2_; asm volatile("v_mbcnt_lo_u32_b32 %0, -1, 0\n\tv_mbcnt_hi_u32_b32 %0, -1, %0" : "=v"(l2_)); E(acc, cur, wr, wc, l2_ & 15, l2_ >> 4); }
        if (!has_next) break;
#pragma unroll
        for (int a = 0; a < 2; ++a)
#pragma unroll
            for (int b = 0; b < 2; ++b)
#pragma unroll
                for (int m = 0; m < 4; ++m)
#pragma unroll
                    for (int n = 0; n < 2; ++n) acc[a][b][m][n] = (f32x4){0.f, 0.f, 0.f, 0.f};
        cur = nxt; ++ui;
        if constexpr (Prob::GATHER) { gAc[0] = gAn[0]; gAc[1] = gAn[1]; }
        else { cA = nA; }
        if constexpr (ALIGN_EPI) { if (wr == 1) G8_BAR; }
    }
    G8_WAIT_V(0);
    if constexpr (!ALIGN_EPI) { if (wr == 0) G8_BAR; }
    G8_BAR;
#undef G8_SA
#undef G8_SB
#undef G8_STAGE
#undef G8_STAGE_A
#undef G8_LDA
#undef G8_LDB
#undef G8_MMA
#undef G8_WAIT_V
#undef G8_WAIT_L
#undef G8_BAR
#undef G8_SCHED
}

struct ProbPlain {
    static constexpr bool GATHER = false;
    const GAS bf16_t* A; const GAS bf16_t* Bt; int lda, ldb, nt, nM, nN, G, c;
    __device__ __forceinline__ bool next(int i, Unit& u) const { u.x0 = 0; u.x1 = 0; return static_order(i, G, c, nM, nN, u.pm, u.pn); }
    __device__ __forceinline__ const GAS char* a_tile(const Unit& u) const { return (const GAS char*)A + (size_t)u.pm * BM * lda * 2; }
    __device__ __forceinline__ const GAS char* a_base() const { return (const GAS char*)A; }
    __device__ __forceinline__ void gather(const Unit&, int, unsigned (&)[2]) const {}
    __device__ __forceinline__ const GAS char* b_ptr(const Unit& u, int t) const { return (const GAS char*)Bt + ((size_t)u.pn * BM * ldb + (size_t)t * BK) * 2; }
};
struct ProbMoeGU {
    static constexpr bool GATHER = true;
    const GAS bf16_t* A; const GAS bf16_t* Bt; const GAS i32x4* elist; const LAS int* tab; int lda, ldb, nt, G, c;
    __device__ __forceinline__ bool next(int i, Unit& u) const {
        const int total = tab[TB_ECUM + NE]; const long L = (long)i * G + c; if (L >= total) return false;
        int wgid = (int)L; { const int q = total / NXCD, r = total % NXCD, xcd = wgid % NXCD, off = wgid / NXCD; wgid = (xcd < r ? xcd * (q + 1) : r * (q + 1) + (xcd - r) * q) + off; }
        int e = 0;
#pragma unroll
        for (int k = 1; k < NE; ++k) e += (wgid >= tab[TB_ECUM + k]) ? 1 : 0;
        const int loc = wgid - tab[TB_ECUM + e], nM = (tab[TB_ECUM + e + 1] - tab[TB_ECUM + e]) / 6;
        const int nig = WGM * 6, gid = loc / nig, fm = gid * WGM, gsz = (nM - fm) < WGM ? (nM - fm) : WGM;
        u.pm = fm + ((loc % nig) % gsz); u.pn = (loc % nig) / gsz; u.x0 = e; u.x1 = tab[TB_EOFF + e] + 256 * u.pm; return true;
    }
    __device__ __forceinline__ const GAS char* a_tile(const Unit&) const { return (const GAS char*)A; }
    __device__ __forceinline__ const GAS char* a_base() const { return (const GAS char*)A; }
    __device__ __forceinline__ void gather(const Unit& u, int R0, unsigned (&g)[2]) const {
#pragma unroll
        for (int h = 0; h < 2; ++h) { const int t0 = elist[u.x1 + h * HALF + R0].x, t1 = elist[u.x1 + h * HALF + R0 + 64].x; g[h] = (unsigned)t0 | ((unsigned)t1 << 16); }
    }
    __device__ __forceinline__ const GAS char* b_ptr(const Unit& u, int t) const { return (const GAS char*)Bt + ((size_t)(u.x0 * 1536 + u.pn * BM) * ldb + (size_t)t * BK) * 2; }
};
struct ProbMoeDown {
    static constexpr bool GATHER = false;
    const GAS bf16_t* A; const GAS bf16_t* Bt; const LAS int* tab; int lda, ldb, nt, G, c;
    __device__ __forceinline__ bool next(int i, Unit& u) const {
        const int nM = tab[TB_NRT]; if (!static_order(i, G, c, nM, 4, u.pm, u.pn)) return false;
        const int p = tab[TB_RT2P + u.pm]; u.x0 = (p & 0xff) * DFE; u.x1 = ((p >> 8) & 0xff) * DFE; return true;
    }
    __device__ __forceinline__ const GAS char* a_tile(const Unit& u) const { return (const GAS char*)A + (size_t)u.pm * BM * lda * 2; }
    __device__ __forceinline__ const GAS char* a_base() const { return (const GAS char*)A; }
    __device__ __forceinline__ void gather(const Unit&, int, unsigned (&)[2]) const {}
    __device__ __forceinline__ const GAS char* b_ptr(const Unit& u, int t) const { const int ko = (t < 11) ? (u.x0 + t * BK) : (u.x1 + (t - 11) * BK); return (const GAS char*)Bt + ((size_t)u.pn * BM * ldb + (size_t)ko) * 2; }
};

#define G8_ROWLOOP _Pragma("unroll") for (int ai = 0; ai < 2; ++ai) _Pragma("unroll") for (int m = 0; m < 4; ++m)
struct EpiBf16Split {
    static constexpr bool PERM = true;
    GAS bf16_t* O; int ldc; int split_cols; size_t split_stride;
    __device__ __forceinline__ void operator()(const f32x4 (&acc)[2][2][4][2], const Unit& u, int wr, int wc, int fr, int fq) const {
        const int row0 = u.pm * BM + wr * 64 + fr; int colt = u.pn * BM; GAS bf16_t* base = O;
        if (split_cols) { const int t = colt / split_cols; base += (size_t)t * split_stride; colt -= t * split_cols; }
        const int col0 = colt + wc * 32 + 8 * fq;
        G8_ROWLOOP { GAS bf16_t* rowp = base + (size_t)(row0 + ai * HALF + m * 16) * ldc + col0;
#pragma unroll
            for (int bj = 0; bj < 2; ++bj) { const f32x4 v0 = acc[ai][bj][m][0], v1 = acc[ai][bj][m][1];
                u32x4 w; w.x = cvt_pk_bf16(v0[0], v0[1]); w.y = cvt_pk_bf16(v0[2], v0[3]); w.z = cvt_pk_bf16(v1[0], v1[1]); w.w = cvt_pk_bf16(v1[2], v1[3]);
                *(GAS u32x4*)(rowp + bj * HALF) = w; } }
    }
};
struct EpiResid {
    static constexpr bool PERM = false;
    const GAS float* rin; GAS float* out;
    __device__ __forceinline__ void operator()(const f32x4 (&acc)[2][2][4][2], const Unit& u, int wr, int wc, int fr, int fq) const {
        const int row0 = u.pm * BM + wr * 64 + fr, col0 = u.pn * BM + wc * 32 + 4 * fq;
        G8_ROWLOOP { const size_t off = (size_t)(row0 + ai * HALF + m * 16) * DM + col0;
#pragma unroll
            for (int bj = 0; bj < 2; ++bj)
#pragma unroll
                for (int n = 0; n < 2; ++n) { const f32x4 r = *(const GAS f32x4*)(rin + off + bj * HALF + n * 16); *(GAS f32x4*)(out + off + bj * HALF + n * 16) = r * ALPHA + acc[ai][bj][m][n]; }
            asm volatile("" ::: "memory"); }
    }
};
struct EpiSwiglu {
    static constexpr bool PERM = true;
    GAS bf16_t* H; int ldh;
    __device__ __forceinline__ void operator()(const f32x4 (&acc)[2][2][4][2], const Unit& u, int wr, int wc, int fr, int fq) const {
        const int row0 = u.pm * BM + wr * 64 + fr, col0 = u.pn * HALF + wc * 32 + 8 * fq;
        G8_ROWLOOP { u32x4 w; unsigned ww[4];
#pragma unroll
            for (int n = 0; n < 2; ++n) { const f32x4 g = acc[ai][0][m][n], uu = acc[ai][1][m][n]; float hv[4];
#pragma unroll
                for (int i = 0; i < 4; ++i) hv[i] = g[i] * sigmoid_f(g[i]) * uu[i];
                ww[2 * n] = cvt_pk_bf16(hv[0], hv[1]); ww[2 * n + 1] = cvt_pk_bf16(hv[2], hv[3]); }
            w.x = ww[0]; w.y = ww[1]; w.z = ww[2]; w.w = ww[3];
            *(GAS u32x4*)(H + (size_t)(row0 + ai * HALF + m * 16) * ldh + col0) = w; }
    }
};
struct EpiGate {
    static constexpr bool PERM = true;
    GAS bf16_t* O;
    __device__ __forceinline__ void operator()(const f32x4 (&acc)[2][2][4][2], const Unit& u, int wr, int wc, int fr, int fq) const {
        const int row0 = u.pm * BM + wr * 64 + fr, col0 = u.pn * BM + wc * 32 + 8 * fq;
        G8_ROWLOOP { GAS bf16_t* rowp = O + (size_t)(row0 + ai * HALF + m * 16) * DM + col0;
#pragma unroll
            for (int bj = 0; bj < 2; ++bj) { const f32x4 v0 = acc[ai][bj][m][0], v1 = acc[ai][bj][m][1];
                u32x4 w; w.x = cvt_pk_bf16(sigmoid_f(v0[0]), sigmoid_f(v0[1])); w.y = cvt_pk_bf16(sigmoid_f(v0[2]), sigmoid_f(v0[3]));
                w.z = cvt_pk_bf16(sigmoid_f(v1[0]), sigmoid_f(v1[1])); w.w = cvt_pk_bf16(sigmoid_f(v1[2]), sigmoid_f(v1[3]));
                *(GAS u32x4*)(rowp + bj * HALF) = w; } }
    }
};
struct EpiPle {
    static constexpr bool PERM = true;
    GAS float* res; GAS bf16_t* XG;
    __device__ __forceinline__ void operator()(const f32x4 (&acc)[2][2][4][2], const Unit& u, int wr, int wc, int fr, int fq) const {
        const int row0 = u.pm * BM + wr * 64 + fr, col0 = u.pn * BM + wc * 32 + 8 * fq;
        G8_ROWLOOP { const size_t off = (size_t)(row0 + ai * HALF + m * 16) * DM + col0;
#pragma unroll
            for (int bj = 0; bj < 2; ++bj)
#pragma unroll
                for (int n = 0; n < 2; ++n) { const u32x2 gw = *(const GAS u32x2*)(XG + off + bj * HALF + 4 * n); const f32x4 r = *(const GAS f32x4*)(res + off + bj * HALF + 4 * n); const f32x4 a = acc[ai][bj][m][n]; f32x4 o;
                    o[0] = r[0] + a[0] * __builtin_bit_cast(float, gw.x << 16); o[1] = r[1] + a[1] * __builtin_bit_cast(float, gw.x & 0xffff0000u);
                    o[2] = r[2] + a[2] * __builtin_bit_cast(float, gw.y << 16); o[3] = r[3] + a[3] * __builtin_bit_cast(float, gw.y & 0xffff0000u);
                    *(GAS f32x4*)(res + off + bj * HALF + 4 * n) = o; u32x2 w; w.x = cvt_pk_bf16(o[0], o[1]); w.y = cvt_pk_bf16(o[2], o[3]); *(GAS u32x2*)(XG + off + bj * HALF + 4 * n) = w;
                    asm volatile("" ::: "memory"); } }
    }
};
struct EpiMoeGU {
    static constexpr bool PERM = true;
    GAS bf16_t* HS; const GAS i32x4* elist; const GAS float* egate;
    __device__ __forceinline__ void operator()(const f32x4 (&acc)[2][2][4][2], const Unit& u, int wr, int wc, int fr, int fq) const {
        const int j0 = u.pn * HALF + wc * 32 + 8 * fq; const bool colok = j0 < DFE;
        G8_ROWLOOP { const int sl = u.x1 + ai * HALF + wr * 64 + m * 16 + fr; const i32x4 en = elist[sl]; const float gate = egate[sl];
            if (colok && en.y >= 0) { u32x4 w; unsigned ww[4];
#pragma unroll
                for (int n = 0; n < 2; ++n) { const f32x4 g = acc[ai][0][m][n], uu = acc[ai][1][m][n]; float hv[4];
#pragma unroll
                    for (int i = 0; i < 4; ++i) hv[i] = gate * g[i] * sigmoid_f(g[i]) * uu[i];
                    ww[2 * n] = cvt_pk_bf16(hv[0], hv[1]); ww[2 * n + 1] = cvt_pk_bf16(hv[2], hv[3]); }
                w.x = ww[0]; w.y = ww[1]; w.z = ww[2]; w.w = ww[3];
                *(GAS u32x4*)(HS + (size_t)en.y + j0) = w; } }
    }
};
struct EpiMoeDown {
    static constexpr bool PERM = false;
    GAS float* res; const GAS int* plist;
    __device__ __forceinline__ void operator()(const f32x4 (&acc)[2][2][4][2], const Unit& u, int wr, int wc, int fr, int fq) const {
        const int col0 = u.pn * BM + wc * 32 + 4 * fq;
        G8_ROWLOOP { const int tok = plist[u.pm * BM + ai * HALF + wr * 64 + m * 16 + fr];
            if (tok >= 0) { const size_t off = (size_t)tok * DM + col0;
#pragma unroll
                for (int bj = 0; bj < 2; ++bj)
#pragma unroll
                    for (int n = 0; n < 2; ++n) { const f32x4 r = *(const GAS f32x4*)(res + off + bj * HALF + n * 16); *(GAS f32x4*)(res + off + bj * HALF + n * 16) = r * ALPHA + acc[ai][bj][m][n]; } }
            asm volatile("" ::: "memory"); }
    }
};
__device__ __forceinline__ void unpack8(const u32x4 w, float (&x)[8]) {
    x[0] = __builtin_bit_cast(float, w.x << 16); x[1] = __builtin_bit_cast(float, w.x & 0xffff0000u); x[2] = __builtin_bit_cast(float, w.y << 16); x[3] = __builtin_bit_cast(float, w.y & 0xffff0000u);
    x[4] = __builtin_bit_cast(float, w.z << 16); x[5] = __builtin_bit_cast(float, w.z & 0xffff0000u); x[6] = __builtin_bit_cast(float, w.w << 16); x[7] = __builtin_bit_cast(float, w.w & 0xffff0000u); }
struct EpiResidB {
    static constexpr bool PERM = true;
    GAS bf16_t* S;
    __device__ __forceinline__ void operator()(const f32x4 (&acc)[2][2][4][2], const Unit& u, int wr, int wc, int fr, int fq) const {
        const int row0 = u.pm * BM + wr * 64 + fr, col0 = u.pn * BM + wc * 32 + 8 * fq;
        G8_ROWLOOP { GAS bf16_t* rowp = S + (size_t)(row0 + ai * HALF + m * 16) * DM + col0;
#pragma unroll
            for (int bj = 0; bj < 2; ++bj) { float x[8]; unpack8(*(const GAS u32x4*)(rowp + bj * HALF), x); const f32x4 a0 = acc[ai][bj][m][0], a1 = acc[ai][bj][m][1];
                u32x4 w; w.x = cvt_pk_bf16(x[0] * ALPHA + a0[0], x[1] * ALPHA + a0[1]); w.y = cvt_pk_bf16(x[2] * ALPHA + a0[2], x[3] * ALPHA + a0[3]);
                w.z = cvt_pk_bf16(x[4] * ALPHA + a1[0], x[5] * ALPHA + a1[1]); w.w = cvt_pk_bf16(x[6] * ALPHA + a1[2], x[7] * ALPHA + a1[3]);
                *(GAS u32x4*)(rowp + bj * HALF) = w; }
            asm volatile("" ::: "memory"); }
    }
};
struct EpiMoeDownB {
    static constexpr bool PERM = true;
    GAS bf16_t* S; const GAS int* plist;
    __device__ __forceinline__ void operator()(const f32x4 (&acc)[2][2][4][2], const Unit& u, int wr, int wc, int fr, int fq) const {
        const int col0 = u.pn * BM + wc * 32 + 8 * fq;
        G8_ROWLOOP { const int tok = plist[u.pm * BM + ai * HALF + wr * 64 + m * 16 + fr];
            if (tok >= 0) { GAS bf16_t* rowp = S + (size_t)tok * DM + col0;
#pragma unroll
                for (int bj = 0; bj < 2; ++bj) { float x[8]; unpack8(*(const GAS u32x4*)(rowp + bj * HALF), x); const f32x4 a0 = acc[ai][bj][m][0], a1 = acc[ai][bj][m][1];
                    u32x4 w; w.x = cvt_pk_bf16(x[0] * ALPHA + a0[0], x[1] * ALPHA + a0[1]); w.y = cvt_pk_bf16(x[2] * ALPHA + a0[2], x[3] * ALPHA + a0[3]);
                    w.z = cvt_pk_bf16(x[4] * ALPHA + a1[0], x[5] * ALPHA + a1[1]); w.w = cvt_pk_bf16(x[6] * ALPHA + a1[2], x[7] * ALPHA + a1[3]);
                    *(GAS u32x4*)(rowp + bj * HALF) = w; } }
            asm volatile("" ::: "memory"); }
    }
};
struct EpiPleB {
    static constexpr bool PERM = true;
    const GAS bf16_t* S; GAS bf16_t* XG; GAS float* out32;
    __device__ __forceinline__ void operator()(const f32x4 (&acc)[2][2][4][2], const Unit& u, int wr, int wc, int fr, int fq) const {
        const int row0 = u.pm * BM + wr * 64 + fr, col0 = u.pn * BM + wc * 32 + 8 * fq;
        G8_ROWLOOP { const size_t off = (size_t)(row0 + ai * HALF + m * 16) * DM + col0;
#pragma unroll
            for (int bj = 0; bj < 2; ++bj) { float x[8], g[8]; unpack8(*(const GAS u32x4*)(S + off + bj * HALF), x); unpack8(*(const GAS u32x4*)(XG + off + bj * HALF), g);
                const f32x4 a0 = acc[ai][bj][m][0], a1 = acc[ai][bj][m][1]; f32x4 o0, o1;
#pragma unroll
                for (int i = 0; i < 4; ++i) { o0[i] = x[i] + a0[i] * g[i]; o1[i] = x[4 + i] + a1[i] * g[4 + i]; }
                u32x4 w; w.x = cvt_pk_bf16(o0[0], o0[1]); w.y = cvt_pk_bf16(o0[2], o0[3]); w.z = cvt_pk_bf16(o1[0], o1[1]); w.w = cvt_pk_bf16(o1[2], o1[3]);
                *(GAS u32x4*)(XG + off + bj * HALF) = w;
                if (out32) { *(GAS f32x4*)(out32 + off + bj * HALF) = o0; *(GAS f32x4*)(out32 + off + bj * HALF + 4) = o1; }
                asm volatile("" ::: "memory"); } }
    }
};
}

struct Frame {
    LAS unsigned char* lds; GAS unsigned* ctl; GAS unsigned char* ws; GAS float* res;
    int wave, vcu, G;
    __device__ __forceinline__ int lane_id() const { int l; asm volatile("v_mbcnt_lo_u32_b32 %0, -1, 0\n\tv_mbcnt_hi_u32_b32 %0, -1, %0" : "=v"(l)); return l; }
    __device__ __forceinline__ int tid_id() const { return wave * 64 + lane_id(); }
};
__device__ __forceinline__ GAS bf16_t* xb_ptr(const Frame& F, int which) { return (GAS bf16_t*)(F.ws + (which ? WS_XB1 : WS_XB0)); }

struct Job { int in_idx, Ns, nkb, n0, nblk, ldd, drow0, dk0, split, item0; float scale; long long src_off, dst_off; };
constexpr int NJOBS = 55;
struct JobTable { Job j[NJOBS]; int total; int njobs; };
constexpr JobTable make_jobs() {
    JobTable t{}; int n = 0, items = 0;
    auto add = [&](int in_idx, long long src_off, int Ns, int K, int n0, int ncols, long long dst_byte, int ldd, int drow0, int dk0, int split, float scale) {
        Job& j = t.j[n++]; j.in_idx = in_idx; j.src_off = src_off; j.Ns = Ns; j.nkb = K / 64; j.n0 = n0; j.nblk = ncols / 32; j.dst_off = dst_byte; j.ldd = ldd; j.drow0 = drow0; j.dk0 = dk0; j.split = split; j.scale = scale;
        j.item0 = items; items += j.nkb * j.nblk; };
    const long long WD = (long long)WS_WDEAD, WL = (long long)WS_WLIVE;
    const float QS = 0.0625f;
    for (int i = 0; i < 2; ++i) { const long long q = WD + 2 * (long long)(i ? WD_QKV1 : WD_QKV0), o = WD + 2 * (long long)(i ? WD_O1 : WD_O0);
        add(IN_AQKV, (long long)i * 1024 * 3072, 3072, 1024, 0, 1024, q, 1024, 0, 0, 0, QS);
        add(IN_AQKV, (long long)i * 1024 * 3072, 3072, 1024, 1024, 2048, q, 1024, 1024, 0, 0, 1.f);
        add(IN_AO, (long long)i * 1024 * 1024, 1024, 1024, 0, 1024, o, 1024, 0, 0, 0, 1.f); }
    add(IN_BQ, 0, 1024, 1024, 0, 1024, WL + 2 * (long long)WL_QKV2, 1024, 0, 0, 0, QS);
    add(IN_KVF, 0, 2052, 1024, 0, 2048, WL + 2 * (long long)WL_QKV2, 1024, 1024, 0, 0, 1.f);
    add(IN_BQ, (long long)1024 * 1024, 1024, 1024, 0, 1024, WL + 2 * (long long)WL_Q3, 1024, 0, 0, 0, QS);
    add(IN_BO, 0, 1024, 1024, 0, 1024, WL + 2 * (long long)WL_O2, 1024, 0, 0, 0, 1.f);
    add(IN_BO, (long long)1024 * 1024, 1024, 1024, 0, 1024, WL + 2 * (long long)WL_O3, 1024, 0, 0, 0, 1.f);
    for (int i = 0; i < 2; ++i) { const long long gu = i ? WL + 2 * (long long)WL_GU1 : WD + 2 * (long long)WD_GU0, dn = i ? WL + 2 * (long long)WL_DN1 : WD + 2 * (long long)WD_DN0;
        add(IN_FGU, (long long)i * 1024 * 5632, 5632, 1024, 0, 5632, gu, 1024, 0, 0, DFF, 1.f);
        add(IN_FDN, (long long)i * 2816 * 1024, 1024, 2816, 0, 1024, dn, 2816, 0, 0, 0, 1.f); }
    for (int i = 0; i < 2; ++i) for (int e = 0; e < NE; ++e) { const long long gu = i ? WL + 2 * (long long)WL_MGU1 : WD + 2 * (long long)WD_MGU0, dn = i ? WL + 2 * (long long)WL_MDN1 : WD + 2 * (long long)WD_MDN0;
        add(IN_MGU, (long long)(i * NE + e) * 1024 * 1408, 1408, 1024, 0, 1408, gu, 1024, e * 1536, 0, DFE, 1.f);
        add(IN_MDN, (long long)(i * NE + e) * 704 * 1024, 1024, 704, 0, 1024, dn, 5632, 0, e * DFE, 0, 1.f); }
    for (int i = 0; i < 4; ++i) { const long long pp = i == 0 ? WD + 2 * (long long)WD_PP0 : i == 1 ? WD + 2 * (long long)WD_PP1 : i == 2 ? WL + 2 * (long long)WL_PP2 : WL + 2 * (long long)WL_PP3;
        const long long pg = i == 0 ? WD + 2 * (long long)WD_PG0 : i == 1 ? WD + 2 * (long long)WD_PG1 : i == 2 ? WL + 2 * (long long)WL_PG2 : WL + 2 * (long long)WL_PG3;
        add(IN_PP, (long long)i * 256 * 1024, 1024, 256, 0, 1024, pp, 256, 0, 0, 0, 1.f);
        add(IN_PG, (long long)i * 1024 * 1024, 1024, 1024, 0, 1024, pg, 1024, 0, 0, 0, 1.f); }
    t.total = items; t.njobs = n; return t;
}
__device__ const JobTable g_jobs = make_jobs();
static_assert(make_jobs().njobs == NJOBS, "job count");

__device__ __forceinline__ void conv_item(const Frame& F, const Job& J, int it, LAS float* scr) {
    const int lane = F.lane_id(); const int kb = it / J.nblk, nb = it % J.nblk, k0 = 64 * kb, ncol = J.n0 + 32 * nb;
    const GAS float* W = in_sel(J.in_idx) + J.src_off;
    { f32x4 wv[8];
#pragma unroll
      for (int i = 0; i < 8; ++i) wv[i] = *(const GAS f32x4*)(W + (size_t)(k0 + (lane >> 3) + 8 * i) * J.Ns + ncol + (lane & 7) * 4);
#pragma unroll
      for (int i = 0; i < 8; ++i) { LAS float* d = scr + ((lane >> 3) + 8 * i) * 33 + (lane & 7) * 4; d[0] = wv[i][0] * J.scale; d[1] = wv[i][1] * J.scale; d[2] = wv[i][2] * J.scale; d[3] = wv[i][3] * J.scale; } }
    asm volatile("s_waitcnt lgkmcnt(0)" ::: "memory");
    int drow;
    if (J.split) { const int ty = ncol / J.split, jj = ncol % J.split; drow = J.drow0 + 256 * (jj >> 7) + 128 * ty + (jj & 127); } else drow = J.drow0 + (ncol - J.n0);
    GAS bf16_t* WT = (GAS bf16_t*)(F.ws + J.dst_off);
    const int c = lane & 7;
#pragma unroll
    for (int j = 0; j < 4; ++j) { const int n = (lane >> 3) + 8 * j; const LAS float* s = scr + (8 * c) * 33 + n;
        u32x4 o; o.x = pk2(s[0 * 33], s[1 * 33]); o.y = pk2(s[2 * 33], s[3 * 33]); o.z = pk2(s[4 * 33], s[5 * 33]); o.w = pk2(s[6 * 33], s[7 * 33]);
        *(GAS u32x4*)(WT + (size_t)(drow + n) * J.ldd + J.dk0 + k0 + 8 * c) = o; }
    asm volatile("s_waitcnt lgkmcnt(0)" ::: "memory");
}
__device__ __forceinline__ void prologue_phase(Frame& F) {
    LAS float* scr = (LAS float*)(F.lds + F.wave * 16384);
    const int gw = F.vcu * NWAVES + F.wave, NGW = F.G * NWAVES;
    const int total = g_jobs.total;
    for (int it = gw; it < total; it += NGW) {
        int jn = 0;
        for (int k = 1; k < NJOBS; ++k) jn += (it >= g_jobs.j[k].item0) ? 1 : 0;
        jn = __builtin_amdgcn_readfirstlane(jn);
        conv_item(F, g_jobs.j[jn], it - g_jobs.j[jn].item0, scr);
    }
    { const size_t gt = (size_t)blockIdx.x * NTHREADS + F.tid_id(), gs = (size_t)F.G * NTHREADS;
      for (size_t i = gt; i < (size_t)2 * NE * 2 * 64 * 128; i += gs) {
          const int ch = (int)(i & 127), row = (int)((i >> 7) & 63), gu = (int)((i >> 13) & 1), e = (int)((i >> 14) & 7), li = (int)(i >> 17);
          GAS bf16_t* base = (GAS bf16_t*)(F.ws + (li ? WS_WLIVE + 2 * WL_MGU1 : WS_WDEAD + 2 * WD_MGU0));
          *(GAS u32x4*)(base + (size_t)(e * 1536 + 1280 + 128 * gu + 64 + row) * 1024 + ch * 8) = (u32x4){0u, 0u, 0u, 0u}; } }
    GAS bf16_t* xb = xb_ptr(F, 1);
    { const int ln = F.lane_id();
      for (int m = gw; m < T; m += 2 * NGW) {
          const GAS f32x4* xa = (const GAS f32x4*)(in_sel(IN_X) + (size_t)m * DM) + ln; const GAS f32x4* xc = (const GAS f32x4*)(in_sel(IN_X) + (size_t)(m + NGW) * DM) + ln;
          GAS u32x2* oa = (GAS u32x2*)(xb + (size_t)m * DM) + ln; GAS u32x2* oc = (GAS u32x2*)(xb + (size_t)(m + NGW) * DM) + ln;
          f32x4 va[4], vc[4];
#pragma unroll
          for (int j = 0; j < 4; ++j) { va[j] = xa[64 * j]; vc[j] = xc[64 * j]; }
#pragma unroll
          for (int j = 0; j < 4; ++j) { u32x2 o; o.x = cvt_pk_bf16(va[j][0], va[j][1]); o.y = cvt_pk_bf16(va[j][2], va[j][3]); oa[64 * j] = o; o.x = cvt_pk_bf16(vc[j][0], vc[j][1]); o.y = cvt_pk_bf16(vc[j][2], vc[j][3]); oc[64 * j] = o; } } }
}

template <bool ROUTER, bool CVT_P>
__device__ __forceinline__ void ln_phase(Frame& F, int L, int which, GAS bf16_t* S) {
    int tid_ = F.tid_id(); asm volatile("" : "+v"(tid_));
    const int lane = tid_ & 63, w = __builtin_amdgcn_readfirstlane(tid_ >> 6);
    const GAS f32x4* gp = (const GAS f32x4*)(in_sel(IN_LNG) + (size_t)(L * 2 + which) * DM) + 4 * lane; const GAS f32x4* bp = (const GAS f32x4*)(in_sel(IN_LNB) + (size_t)(L * 2 + which) * DM) + 4 * lane;
    f32x4 gg[4], bb[4];
#pragma unroll
    for (int j = 0; j < 4; ++j) { gg[j] = gp[j]; bb[j] = bp[j]; }
    LAS f32x4* wrl = (LAS f32x4*)(F.lds + 1024);
    if constexpr (ROUTER) { const GAS float* Wr = in_sel(IN_MR) + (size_t)(L >> 1) * DM * NE;
        __syncthreads();
        for (int i = w; i < 16; i += NWAVES) { const int k = 16 * lane + i;
            wrl[(i * 2 + 0) * 64 + lane] = *(const GAS f32x4*)(Wr + (size_t)k * NE); wrl[(i * 2 + 1) * 64 + lane] = *(const GAS f32x4*)(Wr + (size_t)k * NE + 4); }
        __syncthreads(); }
    LAS int* hist = (LAS int*)F.lds;
    for (int ch = blockIdx.x; ch < T / 128; ch += F.G) {
        if constexpr (ROUTER) { __syncthreads(); if (tid_ < 40) hist[tid_] = 0; __syncthreads(); }
        u32x4 na, nb, ma, mb; f32x4 npv = (f32x4){0.f, 0.f, 0.f, 0.f}, np2 = npv;
        { const GAS u32x4* x0 = (const GAS u32x4*)(S + (size_t)(128 * ch + 16 * w) * DM) + 2 * lane; na = x0[0]; nb = x0[1]; ma = x0[128]; mb = x0[129];
          if constexpr (CVT_P) { const GAS f32x4* p0 = (const GAS f32x4*)(in_sel(IN_P) + ((size_t)L * T + 128 * ch + 16 * w) * PLE) + lane; npv = p0[0]; np2 = p0[64]; } }
        for (int k = 0; k < 16; ++k) {
            const int row = 128 * ch + 16 * w + k;
            GAS u32x4* xr = (GAS u32x4*)(S + (size_t)row * DM) + 2 * lane;
            float v[16]; { float t8[8]; g8::unpack8(na, t8);
#pragma unroll
                for (int i = 0; i < 8; ++i) v[i] = t8[i];
                g8::unpack8(nb, t8);
#pragma unroll
                for (int i = 0; i < 8; ++i) v[8 + i] = t8[i]; }
            const f32x4 pv = npv; na = ma; nb = mb; npv = np2;
            if (k < 14) { ma = xr[256]; mb = xr[257]; if constexpr (CVT_P) np2 = *((const GAS f32x4*)(in_sel(IN_P) + ((size_t)L * T + row + 2) * PLE) + lane); }
            float s = 0.f;
#pragma unroll
            for (int i = 0; i < 16; ++i) s += v[i];
            const float mean = wave_sum_dpp(s) * (1.f / DM); float s2 = 0.f;
#pragma unroll
            for (int i = 0; i < 16; ++i) { v[i] -= mean; s2 += v[i] * v[i]; }
            const float rstd = 1.f / sqrtf(wave_sum_dpp(s2) * (1.f / DM) + LN_EPS);
#pragma unroll
            for (int i = 0; i < 16; ++i) v[i] = v[i] * rstd * gg[i >> 2][i & 3] + bb[i >> 2][i & 3];
            { u32x4 o; o.x = cvt_pk_bf16(v[0], v[1]); o.y = cvt_pk_bf16(v[2], v[3]); o.z = cvt_pk_bf16(v[4], v[5]); o.w = cvt_pk_bf16(v[6], v[7]); xr[0] = o;
              o.x = cvt_pk_bf16(v[8], v[9]); o.y = cvt_pk_bf16(v[10], v[11]); o.z = cvt_pk_bf16(v[12], v[13]); o.w = cvt_pk_bf16(v[14], v[15]); xr[1] = o; }
            if constexpr (CVT_P) { u32x2 o; o.x = cvt_pk_bf16(pv[0], pv[1]); o.y = cvt_pk_bf16(pv[2], pv[3]);
                *((GAS u32x2*)((GAS bf16_t*)(F.ws + WS_PB) + (size_t)row * PLE) + lane) = o; }
            if constexpr (ROUTER) {
                float lg[NE];
#pragma unroll
                for (int e = 0; e < NE; ++e) lg[e] = 0.f;
#pragma unroll
                for (int i = 0; i < 16; ++i) { const float xv = v[i]; const f32x4 w0 = wrl[(i * 2 + 0) * 64 + lane], w1 = wrl[(i * 2 + 1) * 64 + lane];
#pragma unroll
                    for (int e = 0; e < 4; ++e) { lg[e] += xv * w0[e]; lg[4 + e] += xv * w1[e]; } }
#pragma unroll
                for (int e = 0; e < NE; ++e) lg[e] = wave_sum_dpp(lg[e]);
                int i1 = 0; float v1 = lg[0];
#pragma unroll
                for (int e = 1; e < NE; ++e) if (lg[e] > v1) { v1 = lg[e]; i1 = e; }
                int i2 = -1; float v2 = -3.0e38f;
#pragma unroll
                for (int e = 0; e < NE; ++e) if (e != i1 && lg[e] > v2) { v2 = lg[e]; i2 = e; }
                const float ex = fast_exp(v2 - v1), g1 = __builtin_amdgcn_rcpf(1.f + ex), g2 = 1.f - g1;
                const int ea = i1 < i2 ? i1 : i2, eb = i1 < i2 ? i2 : i1, pid = ea * (15 - ea) / 2 + eb - ea - 1;
                if (lane == 0) { GAS int* rp = (GAS int*)(F.ws + WS_MISC + MS_REC) + (size_t)row * 4; GAS float* gpp = (GAS float*)(F.ws + WS_MISC + MS_GATE);
                    rp[0] = i1 | (i2 << 8) | (pid << 16); rp[1] = 0; rp[2] = 0; rp[3] = row; gpp[row] = g1; gpp[T + row] = g2;
                    __hip_atomic_fetch_add(hist + i1, 1, __ATOMIC_RELAXED, __HIP_MEMORY_SCOPE_WORKGROUP); __hip_atomic_fetch_add(hist + i2, 1, __ATOMIC_RELAXED, __HIP_MEMORY_SCOPE_WORKGROUP);
                    __hip_atomic_fetch_add(hist + 8 + pid, 1, __ATOMIC_RELAXED, __HIP_MEMORY_SCOPE_WORKGROUP); }
            }
        }
        if constexpr (ROUTER) { __syncthreads(); if (tid_ < 40) ((GAS int*)(F.ws + WS_MISC + MS_HIST))[ch * 40 + tid_] = hist[tid_]; }
    }
}

__device__ __forceinline__ int pad256(int v) { return (v + 255) & ~255; }
__device__ __forceinline__ void moe_lists_phase(Frame& F) {
    LAS int* pre = (LAS int*)F.lds; LAS int* tot = pre + 40; LAS int* eoff = tot + 40; LAS int* poff = eoff + 16; LAS int* recs = poff + 32; LAS int* tabl = recs + 128;
    const GAS int* hist = (const GAS int*)(F.ws + WS_MISC + MS_HIST);
    const GAS i32x4* rec = (const GAS i32x4*)(F.ws + WS_MISC + MS_REC);
    GAS i32x4* elist = (GAS i32x4*)(F.ws + WS_MISC + MS_ELIST); GAS int* plist = (GAS int*)(F.ws + WS_MISC + MS_PLIST);
    int tid_ = F.tid_id(); asm volatile("" : "+v"(tid_));
    const int lane = tid_ & 63, w = F.wave, tid = tid_;
    bool first = true;
    for (int ch = blockIdx.x; ch < T / 128; ch += F.G) {
        __syncthreads();
        for (int col = w; col < 36; col += NWAVES) { int sp = 0, st = 0;
#pragma unroll
            for (int k = 0; k < 4; ++k) { const int c2 = lane + 64 * k; const int v = hist[c2 * 40 + col]; st += v; sp += (c2 < ch) ? v : 0; }
#pragma unroll
            for (int o = 1; o < 64; o <<= 1) { sp += shxi(sp, o, lane); st += shxi(st, o, lane); }
            if (lane == 0) { pre[col] = sp; tot[col] = st; } }
        __syncthreads();
        if (tid == 0) {
            int acc = 0, ucum = 0;
            for (int e = 0; e < NE; ++e) { eoff[e] = acc; tabl[TB_EOFF + e] = acc; tabl[TB_ECUM + e] = ucum; const int p = pad256(tot[e]); acc += p; ucum += 6 * (p >> 8); }
            eoff[NE] = acc; tabl[TB_EOFF + NE] = acc; tabl[TB_ECUM + NE] = ucum;
            int pacc = 0, pid = 0;
            for (int a = 0; a < NE - 1; ++a) for (int b = a + 1; b < NE; ++b) { poff[pid] = pacc; pacc += pad256(tot[8 + pid]); ++pid; }
            poff[NPAIR] = pacc; tabl[TB_NRT] = pacc >> 8;
        }
        __syncthreads();
        if (tid < 192) { const int r8 = tid << 8; int p = 0;
            for (int k = 1; k < NPAIR; ++k) p += (r8 >= poff[k]) ? 1 : 0;
            int a = 0, rem = p; while (rem >= NE - 1 - a) { rem -= NE - 1 - a; ++a; }
            tabl[TB_RT2P + tid] = a | ((a + 1 + rem) << 8); }
        __syncthreads();
        if (ch == 0) { for (int i = tid; i < TB_WORDS; i += NTHREADS) ((GAS int*)(F.ws + WS_MISC + MS_TAB))[i] = tabl[i]; }
        if (tid < 128) recs[tid] = rec[128 * ch + tid].x;
        __syncthreads();
        if (tid < 128) {
            const int token = 128 * ch + tid; const i32x4 r = rec[token]; const int e1 = r.x & 0xff, e2 = (r.x >> 8) & 0xff, pid = (r.x >> 16) & 0xff;
            int r1 = 0, r2 = 0, rp = 0;
            for (int j = 0; j < tid; ++j) { const int o = recs[j]; const int o1 = o & 0xff, o2 = (o >> 8) & 0xff, op = (o >> 16) & 0xff;
                r1 += ((o1 == e1) | (o2 == e1)) ? 1 : 0; r2 += ((o1 == e2) | (o2 == e2)) ? 1 : 0; rp += (op == pid) ? 1 : 0; }
            const int pslot = poff[pid] + pre[8 + pid] + rp; plist[pslot] = token;
            i32x4 en; en.x = token; en.w = 0;
            const GAS float* gp = (const GAS float*)(F.ws + WS_MISC + MS_GATE);
            GAS float* eg = (GAS float*)(F.ws + WS_MISC + MS_EGATE); en.z = 0;
            { const int sl = eoff[e1] + pre[e1] + r1; en.y = pslot * 1408 + (e1 < e2 ? 0 : DFE); elist[sl] = en; eg[sl] = gp[token]; }
            { const int sl = eoff[e2] + pre[e2] + r2; en.y = pslot * 1408 + (e2 < e1 ? 0 : DFE); elist[sl] = en; eg[sl] = gp[T + token]; }
        }
        if (first) {
            first = false; const int gt = blockIdx.x * NTHREADS + tid, gs = F.G * NTHREADS;
            for (int e = 0; e < NE; ++e) for (int i = eoff[e] + tot[e] + gt; i < eoff[e + 1]; i += gs) elist[i] = (i32x4){0, -1, 0, 0};
            for (int p = 0; p < NPAIR; ++p) for (int i = poff[p] + tot[8 + p] + gt; i < poff[p + 1]; i += gs) plist[i] = -1;
        }
    }
    __syncthreads();
}
__device__ __forceinline__ void load_tab(Frame& F) {
    __syncthreads();
    for (int i = F.tid_id(); i < TB_WORDS; i += NTHREADS) ((LAS int*)(F.lds + LDS_TAB))[i] = ((const GAS int*)(F.ws + WS_MISC + MS_TAB))[i];
    __syncthreads();
}

__device__ __forceinline__ void forget_phase(Frame& F, const GAS bf16_t* S) {
    int tid_ = F.tid_id(); asm volatile("" : "+v"(tid_));
    const int lane = tid_ & 63, w = __builtin_amdgcn_readfirstlane(tid_ >> 6);
    const GAS float* Wf = in_sel(IN_KVF);
    f32x4 wf[16];
#pragma unroll
    for (int i = 0; i < 16; ++i) wf[i] = *(const GAS f32x4*)(Wf + (size_t)(16 * lane + i) * 2052 + 2048);
    const f32x4 bias = *(const GAS f32x4*)in_sel(IN_KVFB);
    LAS float* lf = (LAS float*)F.lds;
    GAS float* cl = (GAS float*)(F.ws + WS_MISC + MS_CL); GAS float* tt = (GAS float*)(F.ws + WS_MISC + MS_TOT);
    for (int ch = blockIdx.x; ch < T / 128; ch += F.G) {
        __syncthreads();
        for (int k = 0; k < 16; ++k) {
            const int row = 128 * ch + 16 * w + k; const GAS u32x4* xr = (const GAS u32x4*)(S + (size_t)row * DM) + 2 * lane;
            float x[8]; f32x4 a = (f32x4){0.f, 0.f, 0.f, 0.f};
            g8::unpack8(xr[0], x);
#pragma unroll
            for (int i = 0; i < 8; ++i) a += wf[i] * x[i];
            g8::unpack8(xr[1], x);
#pragma unroll
            for (int i = 0; i < 8; ++i) a += wf[8 + i] * x[i];
#pragma unroll
            for (int hh = 0; hh < 4; ++hh) a[hh] = wave_sum_dpp(a[hh]);
            if (lane == 0) { f32x4 o;
#pragma unroll
                for (int hh = 0; hh < 4; ++hh) { const float z = a[hh] + bias[hh]; o[hh] = -(fmaxf(-z, 0.f) + log1pf(__expf(-fabsf(z)))); }
                *(LAS f32x4*)(lf + (16 * w + k) * 4) = o; }
        }
        __syncthreads();
        { const int tile = w >> 2, hh = w & 3; float x = lf[(tile * 64 + lane) * 4 + hh];
#pragma unroll
          for (int o = 1; o < 64; o <<= 1) { const float y = shup(x, o, lane); if (lane >= o) x += y; }
          const int row = 128 * ch + tile * 64 + lane, b = row / SEQ, s = row % SEQ;
          cl[(size_t)(b * NH + hh) * SEQ + s] = x; if (lane == 63) tt[(b * NH + hh) * 256 + (s >> 6)] = x; }
    }
    __syncthreads();
}
__device__ __forceinline__ void knorm_phase(Frame& F, const GAS bf16_t* KS) {
    const int lane = F.lane_id(), w = F.wave;
    for (int ch = blockIdx.x; ch < T / 128; ch += F.G) {
        float mx = 0.f;
        for (int k = 0; k < 16; ++k) { const int row = 128 * ch + 16 * w + k; const GAS u32x4* kr = (const GAS u32x4*)(KS + (size_t)row * DM) + 2 * lane; const u32x4 a = kr[0], b = kr[1];
            const unsigned u[8] = {a.x, a.y, a.z, a.w, b.x, b.y, b.z, b.w}; float s = 0.f;
#pragma unroll
            for (int i = 0; i < 8; ++i) { const float lo = __builtin_bit_cast(float, u[i] << 16), hi = __builtin_bit_cast(float, u[i] & 0xffff0000u); s += lo * lo + hi * hi; }
            s += shx(s, 1, lane); s += shx(s, 2, lane); s += shx(s, 4, lane); s += shx(s, 8, lane);
            mx = fmaxf(mx, s); }
        if ((lane & 15) == 0) { const int b = (128 * ch) / SEQ; (void)__hip_atomic_fetch_max(F.ctl + CW_KN2 + b * NH + (lane >> 4), __builtin_bit_cast(unsigned, mx), RLX_AGENT); }
    }
}

constexpr int AT_KB0 = 0, AT_VB0 = 32768, AT_KB1 = 66048, AT_VB1 = 98816, AT_VPANEL = 2080;
constexpr float SB_STOP = -24.f, FOX_STOP = -30.f;
typedef short s16x4 __attribute__((ext_vector_type(4)));
#define AT_TR4(r0, r1, r2, r3, addr, o0, o1, o2, o3) asm volatile("ds_read_b64_tr_b16 %0, %4 offset:%5\n\tds_read_b64_tr_b16 %1, %4 offset:%6\n\tds_read_b64_tr_b16 %2, %4 offset:%7\n\tds_read_b64_tr_b16 %3, %4 offset:%8" \
    : "=&v"(r0), "=&v"(r1), "=&v"(r2), "=&v"(r3) : "v"(addr), "i"(o0), "i"(o1), "i"(o2), "i"(o3) : "memory")
#define AT_WAIT4(r0, r1, r2, r3) asm volatile("s_waitcnt lgkmcnt(0)" : "+v"(r0), "+v"(r1), "+v"(r2), "+v"(r3) :: "memory")

template <bool FOX>
__device__ __forceinline__ void attn_phase(Frame& F, const GAS bf16_t* Q, const GAS bf16_t* Kb, const GAS bf16_t* Vb, GAS bf16_t* O) {
    LAS unsigned char* lds = F.lds;
    volatile LAS unsigned* flags = (volatile LAS unsigned*)(lds + LDS_FLAGS);
    int tid_ = F.tid_id(); asm volatile("" : "+v"(tid_));
    const int tid = tid_, w = __builtin_amdgcn_readfirstlane(tid >> 6), lane = tid & 63, fr = lane & 15, fq = lane >> 4;
    const int srow0 = tid >> 5, schunk = tid & 31;
    const unsigned kst = (unsigned)(srow0 * 512 + ((schunk ^ (srow0 & 15)) * 16));
    const unsigned vst = (unsigned)((schunk >> 1) * AT_VPANEL + srow0 * 32 + (schunk & 1) * 16);
    const unsigned vrd = (unsigned)((4 * fq + ((lane & 15) >> 2)) * 32 + 8 * (lane & 3));
    const GAS float* cl = (const GAS float*)(F.ws + WS_MISC + MS_CL); const GAS float* tt = (const GAS float*)(F.ws + WS_MISC + MS_TOT);
    for (int id = blockIdx.x; id < 8 * 128; id += F.G) {
        const int bh = id & 7, qt = id >> 3, b = bh >> 2, h = bh & 3, t0 = qt * 128;
        const size_t rowbase = (size_t)b * SEQ;
        const int tq = t0 + 16 * w + fr;
        bf16x8 qf[8];
        { const GAS bf16_t* qp = Q + (rowbase + tq) * DM + h * HD + 8 * fq;
#pragma unroll
          for (int s = 0; s < 8; ++s) qf[s] = *(const GAS bf16x8*)(qp + 32 * s); }
        f32x4 o[16];
#pragma unroll
        for (int d = 0; d < 16; ++d) o[d] = (f32x4){0.f, 0.f, 0.f, 0.f};
        float R = 0.f;
        float mrun = -1.0e30f, lsum = 0.f, cq = 0.f, qn = 0.f, KN = 0.f, gacc = 0.f;
        if constexpr (FOX) {
            float s2 = 0.f;
#pragma unroll
            for (int s = 0; s < 8; ++s)
#pragma unroll
                for (int j = 0; j < 8; ++j) { const float x = bf2f((unsigned short)qf[s][j]); s2 += x * x; }
            s2 += shx(s2, 16, lane); s2 += shx(s2, 32, lane); qn = sqrtf(s2);
            KN = sqrtf(__builtin_bit_cast(float, __hip_atomic_load(F.ctl + CW_KN2 + bh, RLX_AGENT))) * 1.002f;
            cq = cl[(size_t)bh * SEQ + tq] + ((tq >= t0 + 64) ? tt[bh * 256 + 2 * qt] : 0.f);
        }
        int kt = 2 * qt + 1, it = 0; bool wdone = false;
        u32x4 kr[4], vr[4];
#ifndef QK_NF
#define QK_NF 8
#endif
#ifndef QK_NF_SB
#define QK_NF_SB 8
#endif
#define AT_LOAD(KT) do { const GAS bf16_t* kp_ = Kb + (rowbase + (size_t)64 * (KT) + srow0) * DM + h * HD + schunk * 8; const GAS bf16_t* vp_ = Vb + (rowbase + (size_t)64 * (KT) + srow0) * DM + h * HD + schunk * 8; \
            _Pragma("unroll") for (int j = 0; j < 4; ++j) { kr[j] = *(const GAS u32x4*)(kp_ + (size_t)16 * j * DM); vr[j] = *(const GAS u32x4*)(vp_ + (size_t)16 * j * DM); } } while (0)
#define AT_WRITE(IT) do { const int kb_ = ((IT) & 1) ? AT_KB1 : AT_KB0, vb_ = ((IT) & 1) ? AT_VB1 : AT_VB0; \
            _Pragma("unroll") for (int j = 0; j < 4; ++j) { *(LAS u32x4*)(lds + kb_ + kst + j * 8192) = kr[j]; *(LAS u32x4*)(lds + vb_ + vst + j * 512) = vr[j]; } } while (0)
        AT_LOAD(kt); AT_WRITE(0); AT_LOAD(kt - 1);
        __syncthreads();
        for (;;) {
            const int kbuf = (it & 1) ? AT_KB1 : AT_KB0, vbuf = (it & 1) ? AT_VB1 : AT_VB0;
            if (it >= 2) { unsigned any = 0u; const int par = (it - 1) & 1;
#pragma unroll
                for (int k = 0; k < 8; ++k) any |= flags[par * 8 + k];
                if (any == 0u) break; }
            const int kmin = 64 * kt, wmax = t0 + 16 * w + 15, wmin = t0 + 16 * w;
            f32x4 ckv[4]; float ttv = 0.f;
            if constexpr (FOX) {
#pragma unroll
                for (int blk = 0; blk < 4; ++blk) ckv[blk] = *(const GAS f32x4*)(cl + (size_t)bh * SEQ + kmin + 16 * blk + 4 * fq);
                ttv = tt[bh * 256 + (kt > 2 * qt ? 2 * qt : kt)];
                asm volatile("" ::: "memory"); }
            if (kt > 0) { AT_WRITE(it + 1); if constexpr (!FOX) { if (kt > 1) AT_LOAD(kt - 2); } }
            const bool part = !wdone && (FOX ? (kmin <= wmax) : (kmin < wmax));
            if (part) {
                const bool need_mask = (kmin + 63 >= wmin);
                f32x4 s[4];
                {
                    constexpr int NF = FOX ? QK_NF : QK_NF_SB;
                    bf16x8 kf[NF];
#pragma unroll
                    for (int blk = 0; blk < 4; ++blk) s[blk] = (f32x4){0.f, 0.f, 0.f, 0.f};
#pragma unroll
                    for (int n = 0; n < NF - 1; ++n) kf[n] = *(const LAS bf16x8*)(lds + kbuf + (16 * (n & 3) + fr) * 512 + (((4 * (n >> 2) + fq) ^ fr) * 16));
                    __builtin_amdgcn_sched_barrier(0);
#pragma unroll
                    for (int n = 0; n < 32; ++n) {
                        if (n + NF - 1 < 32) { const int m = n + NF - 1; kf[m % NF] = *(const LAS bf16x8*)(lds + kbuf + (16 * (m & 3) + fr) * 512 + (((4 * (m >> 2) + fq) ^ fr) * 16)); }
                        s[n & 3] = __builtin_amdgcn_mfma_f32_16x16x32_bf16(kf[n % NF], qf[n >> 2], s[n & 3], 0, 0, 0);
                        __builtin_amdgcn_sched_barrier(0);
                    }
                }
                if constexpr (FOX) { if (kt > 1) AT_LOAD(kt - 2); }
                float pv[4][4];
                if constexpr (!FOX) {
                    float lm[4][4], w4[4], Tt[4], Ex[4];
#pragma unroll
                    for (int blk = 0; blk < 4; ++blk) { w4[blk] = 0.f;
#pragma unroll
                        for (int i = 0; i < 4; ++i) { const float z = s[blk][i]; const float sp = softplus_f(z); const bool valid = !need_mask || (kmin + 16 * blk + 4 * fq + i < tq);
                            lm[blk][i] = valid ? -sp : 0.f; pv[blk][i] = valid ? (z - sp) : -1.0e30f; w4[blk] += lm[blk][i]; } }
#pragma unroll
                    for (int blk = 0; blk < 4; ++blk) { const float a = shx(w4[blk], 16, lane), bq = shx(w4[blk], 32, lane), c = shx(a, 32, lane);
                        Tt[blk] = (w4[blk] + a) + (bq + c); Ex[blk] = (fq == 0) ? (a + bq + c) : (fq == 1) ? (bq + c) : (fq == 2) ? a : 0.f; }
                    float bs = 0.f;
#pragma unroll
                    for (int blk = 3; blk >= 0; --blk) { float tail = R + bs + Ex[blk];
#pragma unroll
                        for (int i = 3; i >= 0; --i) { const float e = pv[blk][i] + tail; pv[blk][i] = (e > -80.f) ? fast_exp(e) : 0.f; tail += lm[blk][i]; }
                        bs += Tt[blk]; }
                    R += bs;
                } else {
                    float base;
                    if (kt == 2 * qt + 1) base = ttv; else if (kt == 2 * qt) base = 0.f; else { gacc += ttv; base = -gacc; }
                    float mx = -1.0e30f;
#pragma unroll
                    for (int blk = 0; blk < 4; ++blk) { const f32x4 ck = ckv[blk];
#pragma unroll
                        for (int i = 0; i < 4; ++i) { const bool valid = !need_mask || (kmin + 16 * blk + 4 * fq + i <= tq); const float lg = valid ? (s[blk][i] + cq - (ck[i] + base)) : -1.0e30f; pv[blk][i] = lg; mx = fmaxf(mx, lg); } }
                    mx = fmaxf(mx, shx(mx, 16, lane)); mx = fmaxf(mx, shx(mx, 32, lane));
                    const float mnew = fmaxf(mrun, mx), al = fast_exp(mrun - mnew); float ps = 0.f;
#pragma unroll
                    for (int blk = 0; blk < 4; ++blk)
#pragma unroll
                        for (int i = 0; i < 4; ++i) { const float e = pv[blk][i] - mnew; const float p = (e > -80.f) ? fast_exp(e) : 0.f; pv[blk][i] = p; ps += p; }
                    lsum = lsum * al + ps;
                    if (__any(mnew > mrun)) {
#pragma unroll
                        for (int d = 0; d < 16; ++d) o[d] = o[d] * al; }
                    mrun = mnew;
                }
                bf16x8 pf[2];
#pragma unroll
                for (int c = 0; c < 2; ++c) { u32x4 pw; pw.x = cvt_pk_bf16(pv[2 * c][0], pv[2 * c][1]); pw.y = cvt_pk_bf16(pv[2 * c][2], pv[2 * c][3]); pw.z = cvt_pk_bf16(pv[2 * c + 1][0], pv[2 * c + 1][1]); pw.w = cvt_pk_bf16(pv[2 * c + 1][2], pv[2 * c + 1][3]);
                    pf[c] = __builtin_bit_cast(bf16x8, pw); }
                const unsigned va = (unsigned)(size_t)(lds + vbuf) + vrd;
                s16x4 c0, c1, c2, c3, n0, n1, n2, n3;
                AT_TR4(c0, c1, c2, c3, va, 0, 512, 1024, 1536);
                n0 = c0; n1 = c1; n2 = c2; n3 = c3;
#define AT_PV(db) do { AT_WAIT4(c0, c1, c2, c3); \
                    if ((db) < 15) { AT_TR4(n0, n1, n2, n3, va, ((db) + 1) * AT_VPANEL, ((db) + 1) * AT_VPANEL + 512, ((db) + 1) * AT_VPANEL + 1024, ((db) + 1) * AT_VPANEL + 1536); } \
                    { const bf16x8 v0 = __builtin_shufflevector(c0, c1, 0, 1, 2, 3, 4, 5, 6, 7), v1 = __builtin_shufflevector(c2, c3, 0, 1, 2, 3, 4, 5, 6, 7); \
                      o[db] = __builtin_amdgcn_mfma_f32_16x16x32_bf16(v0, pf[0], o[db], 0, 0, 0); o[db] = __builtin_amdgcn_mfma_f32_16x16x32_bf16(v1, pf[1], o[db], 0, 0, 0); } \
                    c0 = n0; c1 = n1; c2 = n2; c3 = n3; } while (0)
                AT_PV(0); AT_PV(1); AT_PV(2); AT_PV(3); AT_PV(4); AT_PV(5); AT_PV(6); AT_PV(7); AT_PV(8); AT_PV(9); AT_PV(10); AT_PV(11); AT_PV(12); AT_PV(13); AT_PV(14); AT_PV(15);
#undef AT_PV
            } else { if constexpr (FOX) { if (kt > 1) AT_LOAD(kt - 2); if (kt < 2 * qt) gacc += ttv; } }
            { bool cont;
              if constexpr (!FOX) cont = (R >= SB_STOP);
              else cont = (qn * KN + cq + ((kt <= 2 * qt) ? gacc : 0.f) - mrun >= FOX_STOP) || (kt > 2 * qt);
              const bool anyc = !wdone && __any(cont); wdone = !anyc;
              if (lane == 0) flags[(it & 1) * 8 + w] = anyc ? 1u : 0u; }
            __syncthreads();
            if (kt == 0) break;
            --kt; ++it;
        }
#undef AT_LOAD
#undef AT_WRITE
        float inv = 1.f;
        if constexpr (FOX) { float lt = lsum; lt += shx(lt, 16, lane); lt += shx(lt, 32, lane); inv = 1.f / lt; }
        { GAS bf16_t* op = O + (rowbase + tq) * DM + h * HD + 4 * fq;
#pragma unroll
          for (int db = 0; db < 16; ++db) { u32x2 ow; ow.x = cvt_pk_bf16(o[db][0] * inv, o[db][1] * inv); ow.y = cvt_pk_bf16(o[db][2] * inv, o[db][3] * inv); *(GAS u32x2*)(op + 16 * db) = ow; } }
    }
}

constexpr int NPH = 41;
__host__ __device__ inline bool phase_nonempty(int k) { if (k == 0) return true; const int L = (k - 1) / 10, s = (k - 1) % 10; if (s == 1) return L == 2; if (s == 5) return (L & 1) != 0; return true; }
struct Args { const float* in[N_IN]; float* out; unsigned char* ws; int ph_lo, ph_hi, sub, pad; };

__global__ void __launch_bounds__(NTHREADS, 2) mk_fwd(Args args) {
    extern __shared__ __attribute__((aligned(16))) unsigned char lds_raw[];
    Frame F;
    F.lds = (LAS unsigned char*)lds_raw;
    F.wave = __builtin_amdgcn_readfirstlane((int)threadIdx.x >> 6);
    F.G = gridDim.x; { const int bx = blockIdx.x; F.vcu = (F.G % 8 == 0) ? (bx % 8) * (F.G / 8) + bx / 8 : bx; }
    F.ws = (GAS unsigned char*)args.ws; F.ctl = (GAS unsigned*)F.ws; F.res = (GAS float*)args.out;
    for (int u = (int)threadIdx.x; u < (LDS_BYTES - LDS_CTL) / 4; u += NTHREADS) ((LAS unsigned*)(F.lds + LDS_CTL))[u] = 0u;
    __syncthreads();
    const int lo = args.ph_lo, hi = args.ph_hi;
    XcdBarrier bar; bar.bar = F.ctl + CW_BAR; bar.x = 0; bar.st = nullptr;
    if (hi - lo > 1) bar = xcd_barrier_post(F.ctl + CW_BAR, (volatile LAS unsigned*)(F.lds + LDS_CTL) + 8);
#ifndef DUP_MASK
#define DUP_MASK 0
#endif
#define DUP(n) (1 + ((DUP_MASK >> (n)) & 1))
#ifndef SITE_MASK
#define SITE_MASK 0xFFFFF
#endif
#define SITE(n) ((SITE_MASK >> (n)) & 1)
#define IN(k) (lo <= (k) && (k) < hi)
#define SEAM(k) do { if ((k) + 1 < hi) xcd_barrier(bar); } while (0)
    const int c = (int)blockIdx.x;
#define WSB(name) GAS unsigned char* name = launder_ptr(F.ws)
#define XBP(ws_, which) ((GAS bf16_t*)((ws_) + ((which) ? WS_XB1 : WS_XB0)))

    if (SITE(0) && IN(0)) { for (int rep_ = 0; rep_ < DUP(0); ++rep_) prologue_phase(F); SEAM(0); }

    for (int L = 0; L < DEPTH; ++L) {
        const int pb = 1 + 10 * L;
        {
            F.wave = launder_int(F.wave); F.ws = launder_ptr(F.ws); F.res = launder_ptr(F.res); F.ctl = (GAS unsigned*)F.ws; F.G = launder_int(F.G); }
        for (int repa_ = 0; repa_ < DUP(20); ++repa_) {
        if (SITE(1) && IN(pb + 0)) {
            WSB(ws);
            const GAS bf16_t* Wqkv = (const GAS bf16_t*)(ws + (L < 2 ? WS_WDEAD : WS_WLIVE)) + (L == 0 ? WD_QKV0 : L == 1 ? WD_QKV1 : L == 2 ? WL_QKV2 : WL_Q3);
            g8::ProbPlain P{XBP(ws, (L + 1) & 1), Wqkv, 1024, 1024, 16, T / 256, (L == 3) ? 4 : 12, F.G, c};
            g8::EpiBf16Split E{(GAS bf16_t*)(ws + WS_QA), 1024, (L == 3) ? 0 : 1024, (size_t)(WS_KS - WS_QA) / 2};
            for (int rep_ = 0; rep_ < DUP(1); ++rep_) g8::gemm_phase<g8::ProbPlain, g8::EpiBf16Split>(F.lds, P, E, F.wave);
            if (SITE(2) && L == 2) forget_phase(F, XBP(ws, (L + 1) & 1));
            SEAM(pb + 0);
        }
        if (SITE(3) && IN(pb + 1) && L == 2) { WSB(ws); knorm_phase(F, (const GAS bf16_t*)(ws + WS_KS)); SEAM(pb + 1); }
        if (IN(pb + 2)) {
            WSB(ws); GAS bf16_t* QA = (GAS bf16_t*)(ws + WS_QA); const GAS bf16_t* KS = (const GAS bf16_t*)(ws + WS_KS); const GAS bf16_t* VS = (const GAS bf16_t*)(ws + WS_VS);
            if (L < 2) { if (SITE(4)) attn_phase<false>(F, QA, KS, VS, QA); } else { if (SITE(5)) attn_phase<true>(F, QA, KS, VS, QA); }
            SEAM(pb + 2);
        }
        }
        if (SITE(6) && IN(pb + 3)) {
            WSB(ws);
            const GAS bf16_t* Wo = (const GAS bf16_t*)(ws + (L < 2 ? WS_WDEAD : WS_WLIVE)) + (L == 0 ? WD_O0 : L == 1 ? WD_O1 : L == 2 ? WL_O2 : WL_O3);
            g8::ProbPlain P{(const GAS bf16_t*)(ws + WS_QA), Wo, 1024, 1024, 16, T / 256, 4, F.G, c};
            g8::EpiResidB E{XBP(ws, (L + 1) & 1)};
            g8::gemm_phase<g8::ProbPlain, g8::EpiResidB>(F.lds, P, E, F.wave);
            SEAM(pb + 3);
        }
        if (IN(pb + 4)) { WSB(ws); GAS bf16_t* xln1 = XBP(ws, (L + 1) & 1); if (L & 1) { if (SITE(7)) ln_phase<true, true>(F, L, 0, xln1); } else { if (SITE(8)) ln_phase<false, true>(F, L, 0, xln1); } SEAM(pb + 4); }
        if (SITE(9) && IN(pb + 5) && (L & 1)) { moe_lists_phase(F); SEAM(pb + 5); }
        if (IN(pb + 6)) {
            WSB(ws); const GAS bf16_t* xln1 = XBP(ws, (L + 1) & 1);
            if (L & 1) { if (SITE(10)) { load_tab(F);
                const GAS bf16_t* Wmgu = (const GAS bf16_t*)(ws + (L == 1 ? WS_WDEAD : WS_WLIVE)) + (L == 1 ? WD_MGU0 : WL_MGU1); const GAS i32x4* elist = (const GAS i32x4*)(ws + WS_MISC + MS_ELIST);
                g8::ProbMoeGU P{xln1, Wmgu, elist, (const LAS int*)(F.lds + LDS_TAB), 1024, 1024, 16, F.G, c}; g8::EpiMoeGU E{(GAS bf16_t*)(ws + (L == 1 ? WS_QA : WS_WDEAD)), elist, (const GAS float*)(ws + WS_MISC + MS_EGATE)};
                for (int rep_ = 0; rep_ < DUP(10); ++rep_) g8::gemm_phase<g8::ProbMoeGU, g8::EpiMoeGU>(F.lds, P, E, F.wave); } }
            else if (SITE(11)) { const GAS bf16_t* Wgu = (const GAS bf16_t*)(ws + (L == 0 ? WS_WDEAD : WS_WLIVE)) + (L == 0 ? WD_GU0 : WL_GU1);
                g8::ProbPlain P{xln1, Wgu, 1024, 1024, 16, T / 256, 22, F.G, c}; g8::EpiSwiglu E{(GAS bf16_t*)(ws + (L == 0 ? WS_QA : WS_XB0)), DFF};
                for (int rep_ = 0; rep_ < DUP(11); ++rep_) g8::gemm_phase<g8::ProbPlain, g8::EpiSwiglu>(F.lds, P, E, F.wave); }
            SEAM(pb + 6);
        }
        if (IN(pb + 7)) {
            WSB(ws);
            if (L & 1) { if (SITE(12)) { load_tab(F);
                const GAS bf16_t* Wmdn = (const GAS bf16_t*)(ws + (L == 1 ? WS_WDEAD : WS_WLIVE)) + (L == 1 ? WD_MDN0 : WL_MDN1);
                g8::ProbMoeDown P{(const GAS bf16_t*)(ws + (L == 1 ? WS_QA : WS_WDEAD)), Wmdn, (const LAS int*)(F.lds + LDS_TAB), 1408, 5632, 22, F.G, c}; g8::EpiMoeDownB E{XBP(ws, (L + 1) & 1), (const GAS int*)(ws + WS_MISC + MS_PLIST)};
                g8::gemm_phase<g8::ProbMoeDown, g8::EpiMoeDownB>(F.lds, P, E, F.wave); } }
            else if (SITE(13)) { const GAS bf16_t* Wdn = (const GAS bf16_t*)(ws + (L == 0 ? WS_WDEAD : WS_WLIVE)) + (L == 0 ? WD_DN0 : WL_DN1);
                g8::ProbPlain P{(const GAS bf16_t*)(ws + (L == 0 ? WS_QA : WS_XB0)), Wdn, DFF, DFF, 44, T / 256, 4, F.G, c}; g8::EpiResidB E{XBP(ws, (L + 1) & 1)};
                g8::gemm_phase<g8::ProbPlain, g8::EpiResidB>(F.lds, P, E, F.wave); }
            SEAM(pb + 7);
        }
        if (SITE(14) && IN(pb + 8)) { WSB(ws); ln_phase<false, false>(F, L, 1, XBP(ws, (L + 1) & 1)); SEAM(pb + 8); }
        if (IN(pb + 9)) {
            if (SITE(15) && args.sub != 2) { WSB(ws); const GAS bf16_t* Wpg = (const GAS bf16_t*)(ws + (L < 2 ? WS_WDEAD : WS_WLIVE)) + (L == 0 ? WD_PG0 : L == 1 ? WD_PG1 : L == 2 ? WL_PG2 : WL_PG3);
                g8::ProbPlain P{XBP(ws, (L + 1) & 1), Wpg, 1024, 1024, 16, T / 256, 4, F.G, c}; g8::EpiGate E{XBP(ws, L & 1)}; for (int rep_ = 0; rep_ < DUP(15); ++rep_) g8::gemm_phase<g8::ProbPlain, g8::EpiGate>(F.lds, P, E, F.wave); }
            if (SITE(16) && args.sub != 1) { WSB(ws); const GAS bf16_t* Wpp = (const GAS bf16_t*)(ws + (L < 2 ? WS_WDEAD : WS_WLIVE)) + (L == 0 ? WD_PP0 : L == 1 ? WD_PP1 : L == 2 ? WL_PP2 : WL_PP3);
                g8::ProbPlain P{(const GAS bf16_t*)(ws + WS_PB), Wpp, PLE, PLE, 4, T / 256, 4, F.G, c}; g8::EpiPleB E{XBP(ws, (L + 1) & 1), XBP(ws, L & 1), L == DEPTH - 1 ? F.res : (GAS float*)nullptr}; g8::gemm_phase<g8::ProbPlain, g8::EpiPleB>(F.lds, P, E, F.wave); }
            if (pb + 9 < NPH - 1) SEAM(pb + 9);
        }
    }
#undef WSB
#undef XBP
#undef IN
#undef SEAM
}

extern "C" void kernel_launch(void* const* d_in, const int* in_sizes, int n_in, void* d_out, int out_size, void* d_ws, size_t ws_size, hipStream_t stream) {
    static int grid = 0;
    if (grid == 0) {
        if (n_in != N_IN || out_size != T * DM || ws_size < WS_END) { fprintf(stderr, "kernel_launch: unexpected problem (n_in %d, out %d, ws %zu < %zu)\n", n_in, out_size, ws_size, (size_t)WS_END); grid = -1; return; }
        int dev = 0, cus = 0, per_cu = 0;
        if (hipGetDevice(&dev) != hipSuccess || hipDeviceGetAttribute(&cus, hipDeviceAttributeMultiprocessorCount, dev) != hipSuccess) { grid = -1; return; }
        if (hipFuncSetAttribute((const void*)mk_fwd, hipFuncAttributeMaxDynamicSharedMemorySize, LDS_BYTES) != hipSuccess) { fprintf(stderr, "kernel_launch: hipFuncSetAttribute failed\n"); grid = -1; return; }
        if (hipOccupancyMaxActiveBlocksPerMultiprocessor(&per_cu, (const void*)mk_fwd, NTHREADS, LDS_BYTES) != hipSuccess || per_cu < 1) { fprintf(stderr, "kernel_launch: occupancy query says %d blocks per CU\n", per_cu); }
        (void)hipGetLastError();
        grid = cus;
    }
    if (grid < 0) return;
    (void)hipMemsetAsync((char*)d_ws + WS_CTL, 0, CTL_ZERO_BYTES, stream);
    Args a{};
    for (int i = 0; i < N_IN; ++i) a.in[i] = (const float*)d_in[i];
    a.out = (float*)d_out; a.ws = (unsigned char*)d_ws;
    a.ph_lo = 0; a.ph_hi = NPH; a.sub = 0; a.pad = 0;
    hipLaunchKernelGGL(mk_fwd, dim3(grid), dim3(NTHREADS), LDS_BYTES, stream, a);
}
```

```cpp
#include <hip/hip_runtime.h>
#include <cstdio>
#include <cstdint>


#define LAS __attribute__((address_space(3)))
#define GAS __attribute__((address_space(1)))
typedef unsigned short bf16_t;
typedef short bf16x8 __attribute__((ext_vector_type(8)));
typedef short bf16x4 __attribute__((ext_vector_type(4)));
typedef float f32x4 __attribute__((ext_vector_type(4)));
typedef float f32x2 __attribute__((ext_vector_type(2)));
typedef unsigned u32x4 __attribute__((ext_vector_type(4)));
typedef unsigned u32x2 __attribute__((ext_vector_type(2)));
typedef int i32x4 __attribute__((ext_vector_type(4)));

constexpr int DM = 1024, NBATCH = 2, SEQ = 16384, T = NBATCH * SEQ, NH = 4, HD = 256, DFF = 2816, NE = 8, DFE = 704, PLE = 256, DEPTH = 4;
constexpr float ALPHA = 1.6817928305074292f;
constexpr float LN_EPS = 1e-5f;
constexpr int NWAVES = 8, NTHREADS = 512;
enum { IN_X = 0, IN_P, IN_AQKV, IN_AO, IN_KVF, IN_KVFB, IN_BQ, IN_BO, IN_FGU, IN_FDN, IN_MR, IN_MGU, IN_MDN, IN_PP, IN_PG, IN_LNG, IN_LNB, N_IN };

constexpr size_t MiB = 1u << 20;
constexpr size_t WS_CTL = 0, CTL_ZERO_BYTES = 1 * MiB;
constexpr size_t WS_MISC = 1 * MiB;
constexpr size_t WS_WLIVE = 8 * MiB;
constexpr size_t WS_PB = 77 * MiB;
constexpr size_t WS_XB1 = 93 * MiB, WS_XB0 = 157 * MiB;
constexpr size_t WS_WDEAD = 221 * MiB;
constexpr size_t WS_QA = 294 * MiB, WS_KS = 358 * MiB, WS_VS = 422 * MiB, WS_END = 486 * MiB;
constexpr size_t MS_REC = 0;
constexpr size_t MS_HIST = 512 * 1024;
constexpr size_t MS_ELIST = 576 * 1024;
constexpr int ELIST_CAP = 2 * T + NE * 256;
constexpr size_t MS_PLIST = MS_ELIST + (size_t)ELIST_CAP * 16;
constexpr int NPAIR = 28, PLIST_CAP = T + NPAIR * 256;
constexpr size_t MS_TAB = 2 * MiB;
constexpr size_t MS_CL = 2 * MiB + 64 * 1024;
constexpr size_t MS_TOT = MS_CL + (size_t)8 * SEQ * 4;
constexpr size_t MS_SNAP = 3 * MiB;
constexpr size_t MS_EGATE = 4 * MiB + 512 * 1024;
constexpr size_t MS_GATE = 4 * MiB;
static_assert(MS_PLIST + (size_t)PLIST_CAP * 4 <= MS_TAB && MS_TOT + 8 * 256 * 4 <= MS_SNAP, "misc map");
enum { TB_ECUM = 0  , TB_EOFF = 16  , TB_NRT = 32, TB_RT2P = 64  , TB_WORDS = 320 };
constexpr int CW_TMO = 0, CW_CODE = 1, CW_DBG = 64  , CW_KN2 = 192  , CW_BAR = 4096;

constexpr size_t WSZ_QKV = (size_t)3072 * 1024, WSZ_SQ = (size_t)1024 * 1024, WSZ_GU = (size_t)5632 * 1024, WSZ_DN = (size_t)1024 * 2816,
                 WSZ_MGU = (size_t)NE * 1536 * 1024, WSZ_MDN = (size_t)1024 * 5632, WSZ_PP = (size_t)1024 * 256;
constexpr size_t WD_QKV0 = 0, WD_O0 = WD_QKV0 + WSZ_QKV, WD_QKV1 = WD_O0 + WSZ_SQ, WD_O1 = WD_QKV1 + WSZ_QKV, WD_GU0 = WD_O1 + WSZ_SQ, WD_DN0 = WD_GU0 + WSZ_GU,
                 WD_MGU0 = WD_DN0 + WSZ_DN, WD_MDN0 = WD_MGU0 + WSZ_MGU, WD_PP0 = WD_MDN0 + WSZ_MDN, WD_PG0 = WD_PP0 + WSZ_PP, WD_PP1 = WD_PG0 + WSZ_SQ, WD_PG1 = WD_PP1 + WSZ_PP, WD_END = WD_PG1 + WSZ_SQ;
constexpr size_t WL_QKV2 = 0, WL_O2 = WL_QKV2 + WSZ_QKV, WL_Q3 = WL_O2 + WSZ_SQ, WL_O3 = WL_Q3 + WSZ_SQ, WL_GU1 = WL_O3 + WSZ_SQ, WL_DN1 = WL_GU1 + WSZ_GU,
                 WL_MGU1 = WL_DN1 + WSZ_DN, WL_MDN1 = WL_MGU1 + WSZ_MGU, WL_PP2 = WL_MDN1 + WSZ_MDN, WL_PG2 = WL_PP2 + WSZ_PP, WL_PP3 = WL_PG2 + WSZ_SQ, WL_PG3 = WL_PP3 + WSZ_PP, WL_END = WL_PG3 + WSZ_SQ;
static_assert(WD_END * 2 <= 73 * MiB && WL_END * 2 <= 69 * MiB, "weight regions");
static_assert((size_t)T * DFF * 2 <= WS_END - WS_QA && WS_XB0 + (size_t)T * DFF * 2 <= WS_KS && WS_WDEAD + (size_t)(T + NPAIR * 256) * 1408 * 2 <= WS_KS, "h overlays");

constexpr int RING_BYTES = 131072;
constexpr int LDS_CTL = 135168;
constexpr int LDS_TAB = LDS_CTL + 128;
constexpr int LDS_FLAGS = LDS_TAB + TB_WORDS * 4;
constexpr int LDS_BYTES = 147456;
static_assert(LDS_FLAGS + 64 <= LDS_BYTES, "LDS map");

#define RLX_AGENT __ATOMIC_RELAXED, __HIP_MEMORY_SCOPE_AGENT
__device__ __forceinline__ unsigned f2bf(float f) { unsigned u = __builtin_bit_cast(unsigned, f); return (u + 0x7fffu + ((u >> 16) & 1u)) >> 16; }
__device__ __forceinline__ unsigned pk2(float lo, float hi) { return f2bf(lo) | (f2bf(hi) << 16); }
__device__ __forceinline__ float bf2f(unsigned short b) { return __builtin_bit_cast(float, (unsigned)b << 16); }
typedef __bf16 bf16v2_t __attribute__((ext_vector_type(2)));
__device__ __forceinline__ unsigned cvt_pk_bf16(float lo, float hi) { bf16v2_t v; v[0] = (__bf16)lo; v[1] = (__bf16)hi; return __builtin_bit_cast(unsigned, v); }
__device__ __forceinline__ float shx(float v, int m, int lane) { return __builtin_bit_cast(float, __builtin_amdgcn_ds_bpermute((lane ^ m) << 2, __builtin_bit_cast(int, v))); }
__device__ __forceinline__ int shxi(int v, int m, int lane) { return __builtin_amdgcn_ds_bpermute((lane ^ m) << 2, v); }
__device__ __forceinline__ float shup(float v, int o, int lane) { return __builtin_bit_cast(float, __builtin_amdgcn_ds_bpermute(((lane - o) & 63) << 2, __builtin_bit_cast(int, v))); }
__device__ __forceinline__ float wave_sum(float v, int lane) {
#pragma unroll
    for (int o = 1; o < 64; o <<= 1) v += shx(v, o, lane);
    return v;
}
template <int CTRL> __device__ __forceinline__ float dpp_mov(float v) { return __builtin_bit_cast(float, __builtin_amdgcn_update_dpp(0, __builtin_bit_cast(int, v), CTRL, 0xF, 0xF, true)); }
__device__ __forceinline__ float wave_sum_dpp(float v) {
    v += dpp_mov<0xB1>(v); v += dpp_mov<0x4E>(v); v += dpp_mov<0x141>(v); v += dpp_mov<0x140>(v);
    const int b = __builtin_bit_cast(int, v);
    return (__builtin_bit_cast(float, __builtin_amdgcn_readlane(b, 0)) + __builtin_bit_cast(float, __builtin_amdgcn_readlane(b, 16))) + (__builtin_bit_cast(float, __builtin_amdgcn_readlane(b, 32)) + __builtin_bit_cast(float, __builtin_amdgcn_readlane(b, 48)));
}
__device__ __forceinline__ float fast_exp(float x) { return __builtin_amdgcn_exp2f(x * 1.4426950408889634f); }
__device__ __forceinline__ float fast_log(float x) { return __builtin_amdgcn_logf(x) * 0.6931471805599453f; }
__device__ __forceinline__ float softplus_f(float z) { return fmaxf(z, 0.f) + fast_log(1.f + fast_exp(-fabsf(z))); }
__device__ __forceinline__ float sigmoid_f(float z) { return __builtin_amdgcn_rcpf(1.f + fast_exp(-z)); }

typedef const GAS float* fptr_t;
__device__ __forceinline__ const GAS float* in_sel(int idx) { const __attribute__((address_space(4))) fptr_t* ka = (const __attribute__((address_space(4))) fptr_t*)__builtin_amdgcn_kernarg_segment_ptr(); return ka[idx]; }

template <class Tp> __device__ __forceinline__ GAS Tp* launder_ptr(GAS Tp* p) { unsigned lo = (unsigned)(unsigned long long)p, hi = (unsigned)((unsigned long long)p >> 32); asm volatile("" : "+v"(lo), "+v"(hi));
    lo = __builtin_amdgcn_readfirstlane(lo); hi = __builtin_amdgcn_readfirstlane(hi); return (GAS Tp*)(((unsigned long long)hi << 32) | lo); }
__device__ __forceinline__ int launder_int(int v) { asm volatile("" : "+v"(v)); return __builtin_amdgcn_readfirstlane(v); }

#define XB_TMO      128
#define XB_XCNT(j)  (256  + 64 * (j))
#define XB_XSUB(j)  (1280 + 64 * (j))
#define XB_XGEN(j)  (2304 + 64 * (j))
#define XB_TOP      3328
#define XB_TOPGEN   3392
#define XCD_BAR_WORDS 3456
#define XB_SPIN_CAP (1u << 18)
__device__ __forceinline__ unsigned xb_ld(GAS unsigned* p)              { return __hip_atomic_load(p, __ATOMIC_RELAXED, __HIP_MEMORY_SCOPE_AGENT); }
__device__ __forceinline__ unsigned xb_add(GAS unsigned* p, unsigned v) { return __hip_atomic_fetch_add(p, v, __ATOMIC_RELAXED, __HIP_MEMORY_SCOPE_AGENT); }
__device__ __forceinline__ unsigned xb_xcc_id() { return (unsigned)__builtin_amdgcn_s_getreg((3 << 11) | 20) & 0xFu; }
#define XB_SPIN(cond, bar) do { unsigned _sp = 0; while (cond) { __builtin_amdgcn_s_sleep(1); \
    if ((++_sp & 255u) == 0u) { if (xb_ld(&(bar)[XB_TMO])) break; if (_sp > XB_SPIN_CAP) { (void)xb_add(&(bar)[XB_TMO], 1u); break; } } } } while (0)
struct XcdBarrier { GAS unsigned* bar; unsigned x; volatile LAS unsigned* st; };
__device__ __forceinline__ XcdBarrier xcd_barrier_post(GAS unsigned* bar, volatile LAS unsigned* st) {
    XcdBarrier b; b.bar = bar; b.x = xb_xcc_id(); b.st = st;
    if (threadIdx.x == 0) (void)xb_add(&bar[XB_XCNT(b.x)], 1u);
    return b;
}
__device__ __forceinline__ void xcd_barrier_complete(GAS unsigned* bar, unsigned x, unsigned& nloc, unsigned& nx) {
    const unsigned G = gridDim.x * gridDim.y * gridDim.z;
    unsigned sum, cnt, mine, sp = 0u;
    for (;;) {
        sum = 0u; cnt = 0u; mine = 0u;
#pragma unroll
        for (unsigned j = 0; j < 16; ++j) { const unsigned c = xb_ld(&bar[XB_XCNT(j)]); sum += c; cnt += (c > 0u) ? 1u : 0u; mine = (j == x) ? c : mine; }
        if (sum == G) break;
        __builtin_amdgcn_s_sleep(1);
        if ((++sp & 255u) == 0u) { if (xb_ld(&bar[XB_TMO])) break; if (sp > XB_SPIN_CAP) { (void)xb_add(&bar[XB_TMO], 1u); break; } }
    }
    nloc = mine > 0u ? mine : 1u; nx = cnt > 0u ? cnt : 1u;
}
__device__ __forceinline__ void xcd_barrier(const XcdBarrier& b) {
    asm volatile("s_waitcnt vmcnt(0)" ::: "memory");
    __syncthreads();
    if (threadIdx.x == 0) {
        GAS unsigned* bar = b.bar;
        __builtin_amdgcn_s_waitcnt(0);
        unsigned nloc = b.st[0], nx = b.st[1];
        if (nloc == 0u) { xcd_barrier_complete(bar, b.x, nloc, nx); b.st[0] = nloc; b.st[1] = nx; }
        const unsigned old = xb_add(&bar[XB_XSUB(b.x)], 1u);
        const unsigned gen = old / nloc;
        if (old + 1u == (gen + 1u) * nloc) {
            __builtin_amdgcn_fence(__ATOMIC_RELEASE, "agent");
            asm volatile("s_waitcnt vmcnt(0)" ::: "memory");
            const unsigned og = xb_add(&bar[XB_TOP], 1u);
            const unsigned tg = og / nx;
            if (og + 1u == (tg + 1u) * nx) xb_add(&bar[XB_TOPGEN], 1u);
            else XB_SPIN(xb_ld(&bar[XB_TOPGEN]) == tg, bar);
            __builtin_amdgcn_fence(__ATOMIC_ACQUIRE, "agent");
            xb_add(&bar[XB_XGEN(b.x)], 1u);
            asm volatile("s_waitcnt vmcnt(0)" ::: "memory");
        } else {
            XB_SPIN(xb_ld(&bar[XB_XGEN(b.x)]) == gen, bar);
            __builtin_amdgcn_fence(__ATOMIC_ACQUIRE, "agent");
            asm volatile("s_waitcnt vmcnt(0)" ::: "memory");
        }
    }
    __syncthreads();
}

namespace g8 {
constexpr int BM = 256, BK = 64, HALF = 128, HTB = HALF * BK * 2, STAGE_BYTES = 8 * HTB, NXCD = 8, WGM = 8;
__host__ __device__ __forceinline__ int lds_byte(int r, int c) { const int st = (r >> 4) * 2 + (c >> 5), rr = r & 15, cc = c & 31, ob = rr * 64 + cc * 2; return st * 1024 + (ob ^ (((ob >> 9) & 1) << 5)); }
__host__ __device__ __forceinline__ void stage_rc(int b, int& R, int& C) { const int st = b / 1024, sb = b % 1024, swz = sb ^ (((sb >> 9) & 1) << 5); R = (st >> 1) * 16 + swz / 64; C = (st & 1) * 32 + (swz % 64) / 2; }
__host__ __device__ __forceinline__ int perm32(int rho) { const int n = rho >> 4, i = rho & 15; return 8 * (i >> 2) + 4 * n + (i & 3); }
struct Unit { int pm, pn, x0, x1; };
__device__ __forceinline__ bool static_order(int i, int G, int c, int nM, int nN, int& pm, int& pn) {
    const int nwg = nM * nN; const long L = (long)i * G + c; if (L >= nwg) return false;
    int wgid = (int)L; { const int q = nwg / NXCD, r = nwg % NXCD, xcd = wgid % NXCD, off = wgid / NXCD; wgid = (xcd < r ? xcd * (q + 1) : r * (q + 1) + (xcd - r) * q) + off; }
    const int nig = WGM * nN, gid = wgid / nig, fm = gid * WGM, gsz = (nM - fm) < WGM ? (nM - fm) : WGM;
    pm = fm + ((wgid % nig) % gsz); pn = (wgid % nig) / gsz; return true;
}

template <class Prob, class Epi, bool ALIGN_EPI = true>
__device__ __forceinline__ void gemm_phase(LAS unsigned char* lds, const Prob& P, const Epi& E, int wave_id) {
    int tid_; asm volatile("v_mbcnt_lo_u32_b32 %0, -1, 0\n\tv_mbcnt_hi_u32_b32 %0, -1, %0" : "=v"(tid_)); tid_ += wave_id * 64;
    const int tid = tid_, wid = __builtin_amdgcn_readfirstlane(tid >> 6), lane = tid & 63, wr = wid >> 2, wc = wid & 3, fr = lane & 15, fq = lane >> 4;
    const int nt = P.nt;
    unsigned voffA[2], voffB[2]; int Rr0 = 0; unsigned voffC = 0;
#pragma unroll
    for (int i = 0; i < 2; ++i) { int R, C; stage_rc(tid * 16 + i * 8192, R, C); const int Rb = Epi::PERM ? ((R & ~31) + perm32(R & 31)) : R;
        voffA[i] = (unsigned)(R * P.lda + C) * 2u; voffB[i] = (unsigned)(Rb * P.ldb + C) * 2u; if (i == 0) { Rr0 = R; voffC = (unsigned)C * 2u; } }
    const size_t kstep = (size_t)(BK * 2);
    const size_t hstepA = (size_t)HALF * P.lda * 2, hstepB = (size_t)HALF * P.ldb * 2;
    const unsigned ldsw = (unsigned)wid * 1024u;
    const int aoff = lds_byte(wr * 64 + fr, fq * 8), boff = lds_byte(wc * 32 + fr, fq * 8);
#define G8_SA(b, h) (((b) * 2 + (h)) * HTB)
#define G8_SB(b, h) ((4 + (b) * 2 + (h)) * HTB)
#define G8_STAGE(bufoff, gbase, voff) do { _Pragma("unroll") for (int _i = 0; _i < 2; ++_i) \
        __builtin_amdgcn_global_load_lds((const GAS unsigned*)((const GAS char*)(gbase) + (voff)[_i]), (LAS unsigned*)(lds + (bufoff) + ldsw + _i * 8192), 16, 0, 0); } while (0)
#define G8_STAGE_A(bufoff, h, kb, NX) do { if constexpr (Prob::GATHER) { const unsigned pk_ = (NX) ? gAn[h] : gAc[h]; const unsigned vo_[2] = {(pk_ & 0xffffu) * (unsigned)(P.lda * 2) + voffC, (pk_ >> 16) * (unsigned)(P.lda * 2) + voffC}; \
        G8_STAGE(bufoff, P.a_base() + (kb), vo_); } \
        else { G8_STAGE(bufoff, ((NX) ? nA : cA) + (h) * hstepA + (kb), voffA); } } while (0)
#define G8_LDA(dst, b, h) do { _Pragma("unroll") for (int m = 0; m < 4; ++m) _Pragma("unroll") for (int k = 0; k < 2; ++k) dst[m][k] = *(const LAS bf16x8*)(lds + G8_SA(b, h) + aoff + m * 2048 + k * 1024); } while (0)
#define G8_LDB(dst, b, h) do { _Pragma("unroll") for (int n = 0; n < 2; ++n) _Pragma("unroll") for (int k = 0; k < 2; ++k) dst[n][k] = *(const LAS bf16x8*)(lds + G8_SB(b, h) + boff + n * 2048 + k * 1024); } while (0)
#define G8_MMA(ai, bj, At, Bt) do { __builtin_amdgcn_s_setprio(1); _Pragma("unroll") for (int m = 0; m < 4; ++m) _Pragma("unroll") for (int n = 0; n < 2; ++n) _Pragma("unroll") for (int k = 0; k < 2; ++k) \
        acc[ai][bj][m][n] = __builtin_amdgcn_mfma_f32_16x16x32_bf16(Bt[n][k], At[m][k], acc[ai][bj][m][n], 0, 0, 0); __builtin_amdgcn_s_setprio(0); } while (0)
#define G8_WAIT_V(n) asm volatile("s_waitcnt vmcnt(" #n ")" ::: "memory")
#define G8_WAIT_L(n) asm volatile("s_waitcnt lgkmcnt(" #n ")" ::: "memory")
#define G8_BAR __builtin_amdgcn_s_barrier()
#define G8_SCHED __builtin_amdgcn_sched_barrier(0)
    Unit cur, nxt; int ui = 0;
    if (!P.next(0, cur)) return;
    f32x4 acc[2][2][4][2];
#pragma unroll
    for (int a = 0; a < 2; ++a)
#pragma unroll
        for (int b = 0; b < 2; ++b)
#pragma unroll
            for (int m = 0; m < 4; ++m)
#pragma unroll
                for (int n = 0; n < 2; ++n) acc[a][b][m][n] = (f32x4){0.f, 0.f, 0.f, 0.f};
    bf16x8 At[4][2], B0[2][2], B1[2][2];
    unsigned gAc[2], gAn[2];
    const GAS char* cA = nullptr; const GAS char* nA = nullptr;
    if constexpr (Prob::GATHER) { P.gather(cur, Rr0, gAc); } else { cA = P.a_tile(cur); }
    {
        const GAS char* b0 = P.b_ptr(cur, 0); const GAS char* b1 = P.b_ptr(cur, 1);
        G8_STAGE(G8_SB(0, 0), b0, voffB); G8_STAGE(G8_SB(0, 1), b0 + hstepB, voffB); G8_STAGE_A(G8_SA(0, 0), 0, 0, false); G8_STAGE_A(G8_SA(0, 1), 1, 0, false);
        if (wr == 1) G8_BAR;
        G8_WAIT_V(2); G8_BAR;
        G8_STAGE(G8_SB(1, 0), b1, voffB); G8_STAGE_A(G8_SA(1, 0), 0, kstep, false); G8_STAGE(G8_SB(1, 1), b1 + hstepB, voffB);
        G8_WAIT_V(6); G8_BAR;
    }
    for (;;) {
        const bool has_next = P.next(ui + 1, nxt);
        if (!has_next) nxt = cur;
        if constexpr (Prob::GATHER) { if (has_next) P.gather(nxt, Rr0, gAn); else { gAn[0] = gAc[0]; gAn[1] = gAc[1]; } }
        else { nA = P.a_tile(nxt); }
        for (int t = 0; t < nt; t += 2) {
            const bool last = (t == nt - 2);
            const size_t a1k = (size_t)(t + 1) * kstep;
            const size_t a2k = last ? 0 : (size_t)(t + 2) * kstep, a3k = last ? kstep : (size_t)(t + 3) * kstep;
            const GAS char* b2 = last ? P.b_ptr(nxt, 0) : P.b_ptr(cur, t + 2); const GAS char* b3 = last ? P.b_ptr(nxt, 1) : P.b_ptr(cur, t + 3);
            G8_LDB(B0, 0, 0); G8_LDB(B1, 0, 1); G8_SCHED; G8_LDA(At, 0, 0); G8_STAGE_A(G8_SA(1, 1), 1, a1k, false);
            G8_WAIT_V(8); G8_WAIT_L(0); G8_BAR; G8_MMA(0, 0, At, B0); G8_MMA(0, 1, At, B1); G8_BAR; G8_SCHED;
            G8_LDA(At, 0, 1); G8_STAGE(G8_SB(0, 0), b2, voffB); G8_STAGE(G8_SB(0, 1), b2 + hstepB, voffB);
            if (last) { G8_STAGE_A(G8_SA(0, 0), 0, a2k, true); } else { G8_STAGE_A(G8_SA(0, 0), 0, a2k, false); }
            G8_WAIT_V(8); G8_WAIT_L(0); G8_BAR; G8_MMA(1, 0, At, B0); G8_MMA(1, 1, At, B1); G8_BAR; G8_SCHED;
            G8_LDB(B0, 1, 0); G8_LDB(B1, 1, 1); G8_SCHED; G8_LDA(At, 1, 0);
            if (last) { G8_STAGE_A(G8_SA(0, 1), 1, a2k, true); } else { G8_STAGE_A(G8_SA(0, 1), 1, a2k, false); }
            G8_WAIT_V(8); G8_WAIT_L(0); G8_BAR; G8_MMA(0, 0, At, B0); G8_MMA(0, 1, At, B1); G8_BAR; G8_SCHED;
            G8_LDA(At, 1, 1); G8_STAGE(G8_SB(1, 0), b3, voffB); G8_STAGE(G8_SB(1, 1), b3 + hstepB, voffB);
            if (last) { G8_STAGE_A(G8_SA(1, 0), 0, a3k, true); } else { G8_STAGE_A(G8_SA(1, 0), 0, a3k, false); }
            G8_WAIT_V(8); G8_WAIT_L(0); G8_BAR; G8_MMA(1, 0, At, B0); G8_MMA(1, 1, At, B1); G8_BAR; G8_SCHED;
        }
        if constexpr (ALIGN_EPI) { if (wr == 0) G8_BAR; }
        { int l2_; asm volatile("v_mbcnt_lo_u32_b32 %0, -1, 0\n\tv_mbcnt_hi_u32_b32 %0, -1, %0" : "=v"(l2_)); E(acc, cur, wr, wc, l2_ & 15, l2_ >> 4); }
        if (!has_next) break;
#pragma unroll
        for (int a = 0; a < 2; ++a)
#pragma unroll
            for (int b = 0; b < 2; ++b)
#pragma unroll
                for (int m = 0; m < 4; ++m)
#pragma unroll
                    for (int n = 0; n < 2; ++n) acc[a][b][m][n] = (f32x4){0.f, 0.f, 0.f, 0.f};
        cur = nxt; ++ui;
        if constexpr (Prob::GATHER) { gAc[0] = gAn[0]; gAc[1] = gAn[1]; }
        else { cA = nA; }
        if constexpr (ALIGN_EPI) { if (wr == 1) G8_BAR; }
    }
    G8_WAIT_V(0);
    if constexpr (!ALIGN_EPI) { if (wr == 0) G8_BAR; }
    G8_BAR;
#undef G8_SA
#undef G8_SB
#undef G8_STAGE
#undef G8_STAGE_A
#undef G8_LDA
#undef G8_LDB
#undef G8_MMA
#undef G8_WAIT_V
#undef G8_WAIT_L
#undef G8_BAR
#undef G8_SCHED
}

struct ProbPlain {
    static constexpr bool GATHER = false;
    const GAS bf16_t* A; const GAS bf16_t* Bt; int lda, ldb, nt, nM, nN, G, c;
    __device__ __forceinline__ bool next(int i, Unit& u) const { u.x0 = 0; u.x1 = 0; return static_order(i, G, c, nM, nN, u.pm, u.pn); }
    __device__ __forceinline__ const GAS char* a_tile(const Unit& u) const { return (const GAS char*)A + (size_t)u.pm * BM * lda * 2; }
    __device__ __forceinline__ const GAS char* a_base() const { return (const GAS char*)A; }
    __device__ __forceinline__ void gather(const Unit&, int, unsigned (&)[2]) const {}
    __device__ __forceinline__ const GAS char* b_ptr(const Unit& u, int t) const { return (const GAS char*)Bt + ((size_t)u.pn * BM * ldb + (size_t)t * BK) * 2; }
};
struct ProbMoeGU {
    static constexpr bool GATHER = true;
    const GAS bf16_t* A; const GAS bf16_t* Bt; const GAS i32x4* elist; const LAS int* tab; int lda, ldb, nt, G, c;
    __device__ __forceinline__ bool next(int i, Unit& u) const {
        const int total = tab[TB_ECUM + NE]; const long L = (long)i * G + c; if (L >= total) return false;
        int wgid = (int)L; { const int q = total / NXCD, r = total % NXCD, xcd = wgid % NXCD, off = wgid / NXCD; wgid = (xcd < r ? xcd * (q + 1) : r * (q + 1) + (xcd - r) * q) + off; }
        int e = 0;
#pragma unroll
        for (int k = 1; k < NE; ++k) e += (wgid >= tab[TB_ECUM + k]) ? 1 : 0;
        const int loc = wgid - tab[TB_ECUM + e], nM = (tab[TB_ECUM + e + 1] - tab[TB_ECUM + e]) / 6;
        const int nig = WGM * 6, gid = loc / nig, fm = gid * WGM, gsz = (nM - fm) < WGM ? (nM - fm) : WGM;
        u.pm = fm + ((loc % nig) % gsz); u.pn = (loc % nig) / gsz; u.x0 = e; u.x1 = tab[TB_EOFF + e] + 256 * u.pm; return true;
    }
    __device__ __forceinline__ const GAS char* a_tile(const Unit&) const { return (const GAS char*)A; }
    __device__ __forceinline__ const GAS char* a_base() const { return (const GAS char*)A; }
    __device__ __forceinline__ void gather(const Unit& u, int R0, unsigned (&g)[2]) const {
#pragma unroll
        for (int h = 0; h < 2; ++h) { const int t0 = elist[u.x1 + h * HALF + R0].x, t1 = elist[u.x1 + h * HALF + R0 + 64].x; g[h] = (unsigned)t0 | ((unsigned)t1 << 16); }
    }
    __device__ __forceinline__ const GAS char* b_ptr(const Unit& u, int t) const { return (const GAS char*)Bt + ((size_t)(u.x0 * 1536 + u.pn * BM) * ldb + (size_t)t * BK) * 2; }
};
struct ProbMoeDown {
    static constexpr bool GATHER = false;
    const GAS bf16_t* A; const GAS bf16_t* Bt; const LAS int* tab; int lda, ldb, nt, G, c;
    __device__ __forceinline__ bool next(int i, Unit& u) const {
        const int nM = tab[TB_NRT]; if (!static_order(i, G, c, nM, 4, u.pm, u.pn)) return false;
        const int p = tab[TB_RT2P + u.pm]; u.x0 = (p & 0xff) * DFE; u.x1 = ((p >> 8) & 0xff) * DFE; return true;
    }
    __device__ __forceinline__ const GAS char* a_tile(const Unit& u) const { return (const GAS char*)A + (size_t)u.pm * BM * lda * 2; }
    __device__ __forceinline__ const GAS char* a_base() const { return (const GAS char*)A; }
    __device__ __forceinline__ void gather(const Unit&, int, unsigned (&)[2]) const {}
    __device__ __forceinline__ const GAS char* b_ptr(const Unit& u, int t) const { const int ko = (t < 11) ? (u.x0 + t * BK) : (u.x1 + (t - 11) * BK); return (const GAS char*)Bt + ((size_t)u.pn * BM * ldb + (size_t)ko) * 2; }
};

#define G8_ROWLOOP _Pragma("unroll") for (int ai = 0; ai < 2; ++ai) _Pragma("unroll") for (int m = 0; m < 4; ++m)
struct EpiBf16Split {
    static constexpr bool PERM = true;
    GAS bf16_t* O; int ldc; int split_cols; size_t split_stride;
    __device__ __forceinline__ void operator()(const f32x4 (&acc)[2][2][4][2], const Unit& u, int wr, int wc, int fr, int fq) const {
        const int row0 = u.pm * BM + wr * 64 + fr; int colt = u.pn * BM; GAS bf16_t* base = O;
        if (split_cols) { const int t = colt / split_cols; base += (size_t)t * split_stride; colt -= t * split_cols; }
        const int col0 = colt + wc * 32 + 8 * fq;
        G8_ROWLOOP { GAS bf16_t* rowp = base + (size_t)(row0 + ai * HALF + m * 16) * ldc + col0;
#pragma unroll
            for (int bj = 0; bj < 2; ++bj) { const f32x4 v0 = acc[ai][bj][m][0], v1 = acc[ai][bj][m][1];
                u32x4 w; w.x = cvt_pk_bf16(v0[0], v0[1]); w.y = cvt_pk_bf16(v0[2], v0[3]); w.z = cvt_pk_bf16(v1[0], v1[1]); w.w = cvt_pk_bf16(v1[2], v1[3]);
                *(GAS u32x4*)(rowp + bj * HALF) = w; } }
    }
};
struct EpiResid {
    static constexpr bool PERM = false;
    const GAS float* rin; GAS float* out;
    __device__ __forceinline__ void operator()(const f32x4 (&acc)[2][2][4][2], const Unit& u, int wr, int wc, int fr, int fq) const {
        const int row0 = u.pm * BM + wr * 64 + fr, col0 = u.pn * BM + wc * 32 + 4 * fq;
        G8_ROWLOOP { const size_t off = (size_t)(row0 + ai * HALF + m * 16) * DM + col0;
#pragma unroll
            for (int bj = 0; bj < 2; ++bj)
#pragma unroll
                for (int n = 0; n < 2; ++n) { const f32x4 r = *(const GAS f32x4*)(rin + off + bj * HALF + n * 16); *(GAS f32x4*)(out + off + bj * HALF + n * 16) = r * ALPHA + acc[ai][bj][m][n]; }
            asm volatile("" ::: "memory"); }
    }
};
struct EpiSwiglu {
    static constexpr bool PERM = true;
    GAS bf16_t* H; int ldh;
    __device__ __forceinline__ void operator()(const f32x4 (&acc)[2][2][4][2], const Unit& u, int wr, int wc, int fr, int fq) const {
        const int row0 = u.pm * BM + wr * 64 + fr, col0 = u.pn * HALF + wc * 32 + 8 * fq;
        G8_ROWLOOP { u32x4 w; unsigned ww[4];
#pragma unroll
            for (int n = 0; n < 2; ++n) { const f32x4 g = acc[ai][0][m][n], uu = acc[ai][1][m][n]; float hv[4];
#pragma unroll
                for (int i = 0; i < 4; ++i) hv[i] = g[i] * sigmoid_f(g[i]) * uu[i];
                ww[2 * n] = cvt_pk_bf16(hv[0], hv[1]); ww[2 * n + 1] = cvt_pk_bf16(hv[2], hv[3]); }
            w.x = ww[0]; w.y = ww[1]; w.z = ww[2]; w.w = ww[3];
            *(GAS u32x4*)(H + (size_t)(row0 + ai * HALF + m * 16) * ldh + col0) = w; }
    }
};
struct EpiGate {
    static constexpr bool PERM = true;
    GAS bf16_t* O;
    __device__ __forceinline__ void operator()(const f32x4 (&acc)[2][2][4][2], const Unit& u, int wr, int wc, int fr, int fq) const {
        const int row0 = u.pm * BM + wr * 64 + fr, col0 = u.pn * BM + wc * 32 + 8 * fq;
        G8_ROWLOOP { GAS bf16_t* rowp = O + (size_t)(row0 + ai * HALF + m * 16) * DM + col0;
#pragma unroll
            for (int bj = 0; bj < 2; ++bj) { const f32x4 v0 = acc[ai][bj][m][0], v1 = acc[ai][bj][m][1];
                u32x4 w; w.x = cvt_pk_bf16(sigmoid_f(v0[0]), sigmoid_f(v0[1])); w.y = cvt_pk_bf16(sigmoid_f(v0[2]), sigmoid_f(v0[3]));
                w.z = cvt_pk_bf16(sigmoid_f(v1[0]), sigmoid_f(v1[1])); w.w = cvt_pk_bf16(sigmoid_f(v1[2]), sigmoid_f(v1[3]));
                *(GAS u32x4*)(rowp + bj * HALF) = w; } }
    }
};
struct EpiPle {
    static constexpr bool PERM = true;
    GAS float* res; GAS bf16_t* XG;
    __device__ __forceinline__ void operator()(const f32x4 (&acc)[2][2][4][2], const Unit& u, int wr, int wc, int fr, int fq) const {
        const int row0 = u.pm * BM + wr * 64 + fr, col0 = u.pn * BM + wc * 32 + 8 * fq;
        G8_ROWLOOP { const size_t off = (size_t)(row0 + ai * HALF + m * 16) * DM + col0;
#pragma unroll
            for (int bj = 0; bj < 2; ++bj)
#pragma unroll
                for (int n = 0; n < 2; ++n) { const u32x2 gw = *(const GAS u32x2*)(XG + off + bj * HALF + 4 * n); const f32x4 r = *(const GAS f32x4*)(res + off + bj * HALF + 4 * n); const f32x4 a = acc[ai][bj][m][n]; f32x4 o;
                    o[0] = r[0] + a[0] * __builtin_bit_cast(float, gw.x << 16); o[1] = r[1] + a[1] * __builtin_bit_cast(float, gw.x & 0xffff0000u);
                    o[2] = r[2] + a[2] * __builtin_bit_cast(float, gw.y << 16); o[3] = r[3] + a[3] * __builtin_bit_cast(float, gw.y & 0xffff0000u);
                    *(GAS f32x4*)(res + off + bj * HALF + 4 * n) = o; u32x2 w; w.x = cvt_pk_bf16(o[0], o[1]); w.y = cvt_pk_bf16(o[2], o[3]); *(GAS u32x2*)(XG + off + bj * HALF + 4 * n) = w;
                    asm volatile("" ::: "memory"); } }
    }
};
struct EpiMoeGU {
    static constexpr bool PERM = true;
    GAS bf16_t* HS; const GAS i32x4* elist; const GAS float* egate;
    __device__ __forceinline__ void operator()(const f32x4 (&acc)[2][2][4][2], const Unit& u, int wr, int wc, int fr, int fq) const {
        const int j0 = u.pn * HALF + wc * 32 + 8 * fq; const bool colok = j0 < DFE;
        G8_ROWLOOP { const int sl = u.x1 + ai * HALF + wr * 64 + m * 16 + fr; const i32x4 en = elist[sl]; const float gate = egate[sl];
            if (colok && en.y >= 0) { u32x4 w; unsigned ww[4];
#pragma unroll
                for (int n = 0; n < 2; ++n) { const f32x4 g = acc[ai][0][m][n], uu = acc[ai][1][m][n]; float hv[4];
#pragma unroll
                    for (int i = 0; i < 4; ++i) hv[i] = gate * g[i] * sigmoid_f(g[i]) * uu[i];
                    ww[2 * n] = cvt_pk_bf16(hv[0], hv[1]); ww[2 * n + 1] = cvt_pk_bf16(hv[2], hv[3]); }
                w.x = ww[0]; w.y = ww[1]; w.z = ww[2]; w.w = ww[3];
                *(GAS u32x4*)(HS + (size_t)en.y + j0) = w; } }
    }
};
struct EpiMoeDown {
    static constexpr bool PERM = false;
    GAS float* res; const GAS int* plist;
    __device__ __forceinline__ void operator()(const f32x4 (&acc)[2][2][4][2], const Unit& u, int wr, int wc, int fr, int fq) const {
        const int col0 = u.pn * BM + wc * 32 + 4 * fq;
        G8_ROWLOOP { const int tok = plist[u.pm * BM + ai * HALF + wr * 64 + m * 16 + fr];
            if (tok >= 0) { const size_t off = (size_t)tok * DM + col0;
#pragma unroll
                for (int bj = 0; bj < 2; ++bj)
#pragma unroll
                    for (int n = 0; n < 2; ++n) { const f32x4 r = *(const GAS f32x4*)(res + off + bj * HALF + n * 16); *(GAS f32x4*)(res + off + bj * HALF + n * 16) = r * ALPHA + acc[ai][bj][m][n]; } }
            asm volatile("" ::: "memory"); }
    }
};
__device__ __forceinline__ void unpack8(const u32x4 w, float (&x)[8]) {
    x[0] = __builtin_bit_cast(float, w.x << 16); x[1] = __builtin_bit_cast(float, w.x & 0xffff0000u); x[2] = __builtin_bit_cast(float, w.y << 16); x[3] = __builtin_bit_cast(float, w.y & 0xffff0000u);
    x[4] = __builtin_bit_cast(float, w.z << 16); x[5] = __builtin_bit_cast(float, w.z & 0xffff0000u); x[6] = __builtin_bit_cast(float, w.w << 16); x[7] = __builtin_bit_cast(float, w.w & 0xffff0000u); }
struct EpiResidB {
    static constexpr bool PERM = true;
    GAS bf16_t* S;
    __device__ __forceinline__ void operator()(const f32x4 (&acc)[2][2][4][2], const Unit& u, int wr, int wc, int fr, int fq) const {
        const int row0 = u.pm * BM + wr * 64 + fr, col0 = u.pn * BM + wc * 32 + 8 * fq;
        G8_ROWLOOP { GAS bf16_t* rowp = S + (size_t)(row0 + ai * HALF + m * 16) * DM + col0;
#pragma unroll
            for (int bj = 0; bj < 2; ++bj) { float x[8]; unpack8(*(const GAS u32x4*)(rowp + bj * HALF), x); const f32x4 a0 = acc[ai][bj][m][0], a1 = acc[ai][bj][m][1];
                u32x4 w; w.x = cvt_pk_bf16(x[0] * ALPHA + a0[0], x[1] * ALPHA + a0[1]); w.y = cvt_pk_bf16(x[2] * ALPHA + a0[2], x[3] * ALPHA + a0[3]);
                w.z = cvt_pk_bf16(x[4] * ALPHA + a1[0], x[5] * ALPHA + a1[1]); w.w = cvt_pk_bf16(x[6] * ALPHA + a1[2], x[7] * ALPHA + a1[3]);
                *(GAS u32x4*)(rowp + bj * HALF) = w; }
            asm volatile("" ::: "memory"); }
    }
};
struct EpiMoeDownB {
    static constexpr bool PERM = true;
    GAS bf16_t* S; const GAS int* plist;
    __device__ __forceinline__ void operator()(const f32x4 (&acc)[2][2][4][2], const Unit& u, int wr, int wc, int fr, int fq) const {
        const int col0 = u.pn * BM + wc * 32 + 8 * fq;
        G8_ROWLOOP { const int tok = plist[u.pm * BM + ai * HALF + wr * 64 + m * 16 + fr];
            if (tok >= 0) { GAS bf16_t* rowp = S + (size_t)tok * DM + col0;
#pragma unroll
                for (int bj = 0; bj < 2; ++bj) { float x[8]; unpack8(*(const GAS u32x4*)(rowp + bj * HALF), x); const f32x4 a0 = acc[ai][bj][m][0], a1 = acc[ai][bj][m][1];
                    u32x4 w; w.x = cvt_pk_bf16(x[0] * ALPHA + a0[0], x[1] * ALPHA + a0[1]); w.y = cvt_pk_bf16(x[2] * ALPHA + a0[2], x[3] * ALPHA + a0[3]);
                    w.z = cvt_pk_bf16(x[4] * ALPHA + a1[0], x[5] * ALPHA + a1[1]); w.w = cvt_pk_bf16(x[6] * ALPHA + a1[2], x[7] * ALPHA + a1[3]);
                    *(GAS u32x4*)(rowp + bj * HALF) = w; } }
            asm volatile("" ::: "memory"); }
    }
};
struct EpiPleB {
    static constexpr bool PERM = true;
    const GAS bf16_t* S; GAS bf16_t* XG; GAS float* out32;
    __device__ __forceinline__ void operator()(const f32x4 (&acc)[2][2][4][2], const Unit& u, int wr, int wc, int fr, int fq) const {
        const int row0 = u.pm * BM + wr * 64 + fr, col0 = u.pn * BM + wc * 32 + 8 * fq;
        G8_ROWLOOP { const size_t off = (size_t)(row0 + ai * HALF + m * 16) * DM + col0;
#pragma unroll
            for (int bj = 0; bj < 2; ++bj) { float x[8], g[8]; unpack8(*(const GAS u32x4*)(S + off + bj * HALF), x); unpack8(*(const GAS u32x4*)(XG + off + bj * HALF), g);
                const f32x4 a0 = acc[ai][bj][m][0], a1 = acc[ai][bj][m][1]; f32x4 o0, o1;
#pragma unroll
                for (int i = 0; i < 4; ++i) { o0[i] = x[i] + a0[i] * g[i]; o1[i] = x[4 + i] + a1[i] * g[4 + i]; }
                u32x4 w; w.x = cvt_pk_bf16(o0[0], o0[1]); w.y = cvt_pk_bf16(o0[2], o0[3]); w.z = cvt_pk_bf16(o1[0], o1[1]); w.w = cvt_pk_bf16(o1[2], o1[3]);
                *(GAS u32x4*)(XG + off + bj * HALF) = w;
                if (out32) { *(GAS f32x4*)(out32 + off + bj * HALF) = o0; *(GAS f32x4*)(out32 + off + bj * HALF + 4) = o1; }
                asm volatile("" ::: "memory"); } }
    }
};
}

struct Frame {
    LAS unsigned char* lds; GAS unsigned* ctl; GAS unsigned char* ws; GAS float* res;
    int wave, vcu, G;
    __device__ __forceinline__ int lane_id() const { int l; asm volatile("v_mbcnt_lo_u32_b32 %0, -1, 0\n\tv_mbcnt_hi_u32_b32 %0, -1, %0" : "=v"(l)); return l; }
    __device__ __forceinline__ int tid_id() const { return wave * 64 + lane_id(); }
};
__device__ __forceinline__ GAS bf16_t* xb_ptr(const Frame& F, int which) { return (GAS bf16_t*)(F.ws + (which ? WS_XB1 : WS_XB0)); }

struct Job { int in_idx, Ns, nkb, n0, nblk, ldd, drow0, dk0, split, item0; float scale; long long src_off, dst_off; };
constexpr int NJOBS = 55;
struct JobTable { Job j[NJOBS]; int total; int njobs; };
constexpr JobTable make_jobs() {
    JobTable t{}; int n = 0, items = 0;
    auto add = [&](int in_idx, long long src_off, int Ns, int K, int n0, int ncols, long long dst_byte, int ldd, int drow0, int dk0, int split, float scale) {
        Job& j = t.j[n++]; j.in_idx = in_idx; j.src_off = src_off; j.Ns = Ns; j.nkb = K / 64; j.n0 = n0; j.nblk = ncols / 32; j.dst_off = dst_byte; j.ldd = ldd; j.drow0 = drow0; j.dk0 = dk0; j.split = split; j.scale = scale;
        j.item0 = items; items += j.nkb * j.nblk; };
    const long long WD = (long long)WS_WDEAD, WL = (long long)WS_WLIVE;
    const float QS = 0.0625f;
    for (int i = 0; i < 2; ++i) { const long long q = WD + 2 * (long long)(i ? WD_QKV1 : WD_QKV0), o = WD + 2 * (long long)(i ? WD_O1 : WD_O0);
        add(IN_AQKV, (long long)i * 1024 * 3072, 3072, 1024, 0, 1024, q, 1024, 0, 0, 0, QS);
        add(IN_AQKV, (long long)i * 1024 * 3072, 3072, 1024, 1024, 2048, q, 1024, 1024, 0, 0, 1.f);
        add(IN_AO, (long long)i * 1024 * 1024, 1024, 1024, 0, 1024, o, 1024, 0, 0, 0, 1.f); }
    add(IN_BQ, 0, 1024, 1024, 0, 1024, WL + 2 * (long long)WL_QKV2, 1024, 0, 0, 0, QS);
    add(IN_KVF, 0, 2052, 1024, 0, 2048, WL + 2 * (long long)WL_QKV2, 1024, 1024, 0, 0, 1.f);
    add(IN_BQ, (long long)1024 * 1024, 1024, 1024, 0, 1024, WL + 2 * (long long)WL_Q3, 1024, 0, 0, 0, QS);
    add(IN_BO, 0, 1024, 1024, 0, 1024, WL + 2 * (long long)WL_O2, 1024, 0, 0, 0, 1.f);
    add(IN_BO, (long long)1024 * 1024, 1024, 1024, 0, 1024, WL + 2 * (long long)WL_O3, 1024, 0, 0, 0, 1.f);
    for (int i = 0; i < 2; ++i) { const long long gu = i ? WL + 2 * (long long)WL_GU1 : WD + 2 * (long long)WD_GU0, dn = i ? WL + 2 * (long long)WL_DN1 : WD + 2 * (long long)WD_DN0;
        add(IN_FGU, (long long)i * 1024 * 5632, 5632, 1024, 0, 5632, gu, 1024, 0, 0, DFF, 1.f);
        add(IN_FDN, (long long)i * 2816 * 1024, 1024, 2816, 0, 1024, dn, 2816, 0, 0, 0, 1.f); }
    for (int i = 0; i < 2; ++i) for (int e = 0; e < NE; ++e) { const long long gu = i ? WL + 2 * (long long)WL_MGU1 : WD + 2 * (long long)WD_MGU0, dn = i ? WL + 2 * (long long)WL_MDN1 : WD + 2 * (long long)WD_MDN0;
        add(IN_MGU, (long long)(i * NE + e) * 1024 * 1408, 1408, 1024, 0, 1408, gu, 1024, e * 1536, 0, DFE, 1.f);
        add(IN_MDN, (long long)(i * NE + e) * 704 * 1024, 1024, 704, 0, 1024, dn, 5632, 0, e * DFE, 0, 1.f); }
    for (int i = 0; i < 4; ++i) { const long long pp = i == 0 ? WD + 2 * (long long)WD_PP0 : i == 1 ? WD + 2 * (long long)WD_PP1 : i == 2 ? WL + 2 * (long long)WL_PP2 : WL + 2 * (long long)WL_PP3;
        const long long pg = i == 0 ? WD + 2 * (long long)WD_PG0 : i == 1 ? WD + 2 * (long long)WD_PG1 : i == 2 ? WL + 2 * (long long)WL_PG2 : WL + 2 * (long long)WL_PG3;
        add(IN_PP, (long long)i * 256 * 1024, 1024, 256, 0, 1024, pp, 256, 0, 0, 0, 1.f);
        add(IN_PG, (long long)i * 1024 * 1024, 1024, 1024, 0, 1024, pg, 1024, 0, 0, 0, 1.f); }
    t.total = items; t.njobs = n; return t;
}
__device__ const JobTable g_jobs = make_jobs();
static_assert(make_jobs().njobs == NJOBS, "job count");

__device__ __forceinline__ void conv_item(const Frame& F, const Job& J, int it, LAS float* scr) {
    const int lane = F.lane_id(); const int kb = it / J.nblk, nb = it % J.nblk, k0 = 64 * kb, ncol = J.n0 + 32 * nb;
    const GAS float* W = in_sel(J.in_idx) + J.src_off;
    { f32x4 wv[8];
#pragma unroll
      for (int i = 0; i < 8; ++i) wv[i] = *(const GAS f32x4*)(W + (size_t)(k0 + (lane >> 3) + 8 * i) * J.Ns + ncol + (lane & 7) * 4);
#pragma unroll
      for (int i = 0; i < 8; ++i) { LAS float* d = scr + ((lane >> 3) + 8 * i) * 33 + (lane & 7) * 4; d[0] = wv[i][0] * J.scale; d[1] = wv[i][1] * J.scale; d[2] = wv[i][2] * J.scale; d[3] = wv[i][3] * J.scale; } }
    asm volatile("s_waitcnt lgkmcnt(0)" ::: "memory");
    int drow;
    if (J.split) { const int ty = ncol / J.split, jj = ncol % J.split; drow = J.drow0 + 256 * (jj >> 7) + 128 * ty + (jj & 127); } else drow = J.drow0 + (ncol - J.n0);
    GAS bf16_t* WT = (GAS bf16_t*)(F.ws + J.dst_off);
    const int c = lane & 7;
#pragma unroll
    for (int j = 0; j < 4; ++j) { const int n = (lane >> 3) + 8 * j; const LAS float* s = scr + (8 * c) * 33 + n;
        u32x4 o; o.x = pk2(s[0 * 33], s[1 * 33]); o.y = pk2(s[2 * 33], s[3 * 33]); o.z = pk2(s[4 * 33], s[5 * 33]); o.w = pk2(s[6 * 33], s[7 * 33]);
        *(GAS u32x4*)(WT + (size_t)(drow + n) * J.ldd + J.dk0 + k0 + 8 * c) = o; }
    asm volatile("s_waitcnt lgkmcnt(0)" ::: "memory");
}
__device__ __forceinline__ void prologue_phase(Frame& F) {
    LAS float* scr = (LAS float*)(F.lds + F.wave * 16384);
    const int gw = F.vcu * NWAVES + F.wave, NGW = F.G * NWAVES;
    const int total = g_jobs.total;
    for (int it = gw; it < total; it += NGW) {
        int jn = 0;
        for (int k = 1; k < NJOBS; ++k) jn += (it >= g_jobs.j[k].item0) ? 1 : 0;
        jn = __builtin_amdgcn_readfirstlane(jn);
        conv_item(F, g_jobs.j[jn], it - g_jobs.j[jn].item0, scr);
    }
    { const size_t gt = (size_t)blockIdx.x * NTHREADS + F.tid_id(), gs = (size_t)F.G * NTHREADS;
      for (size_t i = gt; i < (size_t)2 * NE * 2 * 64 * 128; i += gs) {
          const int ch = (int)(i & 127), row = (int)((i >> 7) & 63), gu = (int)((i >> 13) & 1), e = (int)((i >> 14) & 7), li = (int)(i >> 17);
          GAS bf16_t* base = (GAS bf16_t*)(F.ws + (li ? WS_WLIVE + 2 * WL_MGU1 : WS_WDEAD + 2 * WD_MGU0));
          *(GAS u32x4*)(base + (size_t)(e * 1536 + 1280 + 128 * gu + 64 + row) * 1024 + ch * 8) = (u32x4){0u, 0u, 0u, 0u}; } }
    GAS bf16_t* xb = xb_ptr(F, 1);
    { const int ln = F.lane_id();
      for (int m = gw; m < T; m += 2 * NGW) {
          const GAS f32x4* xa = (const GAS f32x4*)(in_sel(IN_X) + (size_t)m * DM) + ln; const GAS f32x4* xc = (const GAS f32x4*)(in_sel(IN_X) + (size_t)(m + NGW) * DM) + ln;
          GAS u32x2* oa = (GAS u32x2*)(xb + (size_t)m * DM) + ln; GAS u32x2* oc = (GAS u32x2*)(xb + (size_t)(m + NGW) * DM) + ln;
          f32x4 va[4], vc[4];
#pragma unroll
          for (int j = 0; j < 4; ++j) { va[j] = xa[64 * j]; vc[j] = xc[64 * j]; }
#pragma unroll
          for (int j = 0; j < 4; ++j) { u32x2 o; o.x = cvt_pk_bf16(va[j][0], va[j][1]); o.y = cvt_pk_bf16(va[j][2], va[j][3]); oa[64 * j] = o; o.x = cvt_pk_bf16(vc[j][0], vc[j][1]); o.y = cvt_pk_bf16(vc[j][2], vc[j][3]); oc[64 * j] = o; } } }
}

template <bool ROUTER, bool CVT_P>
__device__ __forceinline__ void ln_phase(Frame& F, int L, int which, GAS bf16_t* S) {
    int tid_ = F.tid_id(); asm volatile("" : "+v"(tid_));
    const int lane = tid_ & 63, w = __builtin_amdgcn_readfirstlane(tid_ >> 6);
    const GAS f32x4* gp = (const GAS f32x4*)(in_sel(IN_LNG) + (size_t)(L * 2 + which) * DM) + 4 * lane; const GAS f32x4* bp = (const GAS f32x4*)(in_sel(IN_LNB) + (size_t)(L * 2 + which) * DM) + 4 * lane;
    f32x4 gg[4], bb[4];
#pragma unroll
    for (int j = 0; j < 4; ++j) { gg[j] = gp[j]; bb[j] = bp[j]; }
    LAS f32x4* wrl = (LAS f32x4*)(F.lds + 1024);
    if constexpr (ROUTER) { const GAS float* Wr = in_sel(IN_MR) + (size_t)(L >> 1) * DM * NE;
        __syncthreads();
        for (int i = w; i < 16; i += NWAVES) { const int k = 16 * lane + i;
            wrl[(i * 2 + 0) * 64 + lane] = *(const GAS f32x4*)(Wr + (size_t)k * NE); wrl[(i * 2 + 1) * 64 + lane] = *(const GAS f32x4*)(Wr + (size_t)k * NE + 4); }
        __syncthreads(); }
    LAS int* hist = (LAS int*)F.lds;
    for (int ch = blockIdx.x; ch < T / 128; ch += F.G) {
        if constexpr (ROUTER) { __syncthreads(); if (tid_ < 40) hist[tid_] = 0; __syncthreads(); }
        u32x4 na, nb, ma, mb; f32x4 npv = (f32x4){0.f, 0.f, 0.f, 0.f}, np2 = npv;
        { const GAS u32x4* x0 = (const GAS u32x4*)(S + (size_t)(128 * ch + 16 * w) * DM) + 2 * lane; na = x0[0]; nb = x0[1]; ma = x0[128]; mb = x0[129];
          if constexpr (CVT_P) { const GAS f32x4* p0 = (const GAS f32x4*)(in_sel(IN_P) + ((size_t)L * T + 128 * ch + 16 * w) * PLE) + lane; npv = p0[0]; np2 = p0[64]; } }
        for (int k = 0; k < 16; ++k) {
            const int row = 128 * ch + 16 * w + k;
            GAS u32x4* xr = (GAS u32x4*)(S + (size_t)row * DM) + 2 * lane;
            float v[16]; { float t8[8]; g8::unpack8(na, t8);
#pragma unroll
                for (int i = 0; i < 8; ++i) v[i] = t8[i];
                g8::unpack8(nb, t8);
#pragma unroll
                for (int i = 0; i < 8; ++i) v[8 + i] = t8[i]; }
            const f32x4 pv = npv; na = ma; nb = mb; npv = np2;
            if (k < 14) { ma = xr[256]; mb = xr[257]; if constexpr (CVT_P) np2 = *((const GAS f32x4*)(in_sel(IN_P) + ((size_t)L * T + row + 2) * PLE) + lane); }
            float s = 0.f;
#pragma unroll
            for (int i = 0; i < 16; ++i) s += v[i];
            const float mean = wave_sum_dpp(s) * (1.f / DM); float s2 = 0.f;
#pragma unroll
            for (int i = 0; i < 16; ++i) { v[i] -= mean; s2 += v[i] * v[i]; }
            const float rstd = 1.f / sqrtf(wave_sum_dpp(s2) * (1.f / DM) + LN_EPS);
#pragma unroll
            for (int i = 0; i < 16; ++i) v[i] = v[i] * rstd * gg[i >> 2][i & 3] + bb[i >> 2][i & 3];
            { u32x4 o; o.x = cvt_pk_bf16(v[0], v[1]); o.y = cvt_pk_bf16(v[2], v[3]); o.z = cvt_pk_bf16(v[4], v[5]); o.w = cvt_pk_bf16(v[6], v[7]); xr[0] = o;
              o.x = cvt_pk_bf16(v[8], v[9]); o.y = cvt_pk_bf16(v[10], v[11]); o.z = cvt_pk_bf16(v[12], v[13]); o.w = cvt_pk_bf16(v[14], v[15]); xr[1] = o; }
            if constexpr (CVT_P) { u32x2 o; o.x = cvt_pk_bf16(pv[0], pv[1]); o.y = cvt_pk_bf16(pv[2], pv[3]);
                *((GAS u32x2*)((GAS bf16_t*)(F.ws + WS_PB) + (size_t)row * PLE) + lane) = o; }
            if constexpr (ROUTER) {
                float lg[NE];
#pragma unroll
                for (int e = 0; e < NE; ++e) lg[e] = 0.f;
#pragma unroll
                for (int i = 0; i < 16; ++i) { const float xv = v[i]; const f32x4 w0 = wrl[(i * 2 + 0) * 64 + lane], w1 = wrl[(i * 2 + 1) * 64 + lane];
#pragma unroll
                    for (int e = 0; e < 4; ++e) { lg[e] += xv * w0[e]; lg[4 + e] += xv * w1[e]; } }
#pragma unroll
                for (int e = 0; e < NE; ++e) lg[e] = wave_sum_dpp(lg[e]);
                int i1 = 0; float v1 = lg[0];
#pragma unroll
                for (int e = 1; e < NE; ++e) if (lg[e] > v1) { v1 = lg[e]; i1 = e; }
                int i2 = -1; float v2 = -3.0e38f;
#pragma unroll
                for (int e = 0; e < NE; ++e) if (e != i1 && lg[e] > v2) { v2 = lg[e]; i2 = e; }
                const float ex = fast_exp(v2 - v1), g1 = __builtin_amdgcn_rcpf(1.f + ex), g2 = 1.f - g1;
                const int ea = i1 < i2 ? i1 : i2, eb = i1 < i2 ? i2 : i1, pid = ea * (15 - ea) / 2 + eb - ea - 1;
                if (lane == 0) { GAS int* rp = (GAS int*)(F.ws + WS_MISC + MS_REC) + (size_t)row * 4; GAS float* gpp = (GAS float*)(F.ws + WS_MISC + MS_GATE);
                    rp[0] = i1 | (i2 << 8) | (pid << 16); rp[1] = 0; rp[2] = 0; rp[3] = row; gpp[row] = g1; gpp[T + row] = g2;
                    __hip_atomic_fetch_add(hist + i1, 1, __ATOMIC_RELAXED, __HIP_MEMORY_SCOPE_WORKGROUP); __hip_atomic_fetch_add(hist + i2, 1, __ATOMIC_RELAXED, __HIP_MEMORY_SCOPE_WORKGROUP);
                    __hip_atomic_fetch_add(hist + 8 + pid, 1, __ATOMIC_RELAXED, __HIP_MEMORY_SCOPE_WORKGROUP); }
            }
        }
        if constexpr (ROUTER) { __syncthreads(); if (tid_ < 40) ((GAS int*)(F.ws + WS_MISC + MS_HIST))[ch * 40 + tid_] = hist[tid_]; }
    }
}

__device__ __forceinline__ int pad256(int v) { return (v + 255) & ~255; }
__device__ __forceinline__ void moe_lists_phase(Frame& F) {
    LAS int* pre = (LAS int*)F.lds; LAS int* tot = pre + 40; LAS int* eoff = tot + 40; LAS int* poff = eoff + 16; LAS int* recs = poff + 32; LAS int* tabl = recs + 128;
    const GAS int* hist = (const GAS int*)(F.ws + WS_MISC + MS_HIST);
    const GAS i32x4* rec = (const GAS i32x4*)(F.ws + WS_MISC + MS_REC);
    GAS i32x4* elist = (GAS i32x4*)(F.ws + WS_MISC + MS_ELIST); GAS int* plist = (GAS int*)(F.ws + WS_MISC + MS_PLIST);
    int tid_ = F.tid_id(); asm volatile("" : "+v"(tid_));
    const int lane = tid_ & 63, w = F.wave, tid = tid_;
    bool first = true;
    for (int ch = blockIdx.x; ch < T / 128; ch += F.G) {
        __syncthreads();
        for (int col = w; col < 36; col += NWAVES) { int sp = 0, st = 0;
#pragma unroll
            for (int k = 0; k < 4; ++k) { const int c2 = lane + 64 * k; const int v = hist[c2 * 40 + col]; st += v; sp += (c2 < ch) ? v : 0; }
#pragma unroll
            for (int o = 1; o < 64; o <<= 1) { sp += shxi(sp, o, lane); st += shxi(st, o, lane); }
            if (lane == 0) { pre[col] = sp; tot[col] = st; } }
        __syncthreads();
        if (tid == 0) {
            int acc = 0, ucum = 0;
            for (int e = 0; e < NE; ++e) { eoff[e] = acc; tabl[TB_EOFF + e] = acc; tabl[TB_ECUM + e] = ucum; const int p = pad256(tot[e]); acc += p; ucum += 6 * (p >> 8); }
            eoff[NE] = acc; tabl[TB_EOFF + NE] = acc; tabl[TB_ECUM + NE] = ucum;
            int pacc = 0, pid = 0;
            for (int a = 0; a < NE - 1; ++a) for (int b = a + 1; b < NE; ++b) { poff[pid] = pacc; pacc += pad256(tot[8 + pid]); ++pid; }
            poff[NPAIR] = pacc; tabl[TB_NRT] = pacc >> 8;
        }
        __syncthreads();
        if (tid < 192) { const int r8 = tid << 8; int p = 0;
            for (int k = 1; k < NPAIR; ++k) p += (r8 >= poff[k]) ? 1 : 0;
            int a = 0, rem = p; while (rem >= NE - 1 - a) { rem -= NE - 1 - a; ++a; }
            tabl[TB_RT2P + tid] = a | ((a + 1 + rem) << 8); }
        __syncthreads();
        if (ch == 0) { for (int i = tid; i < TB_WORDS; i += NTHREADS) ((GAS int*)(F.ws + WS_MISC + MS_TAB))[i] = tabl[i]; }
        if (tid < 128) recs[tid] = rec[128 * ch + tid].x;
        __syncthreads();
        if (tid < 128) {
            const int token = 128 * ch + tid; const i32x4 r = rec[token]; const int e1 = r.x & 0xff, e2 = (r.x >> 8) & 0xff, pid = (r.x >> 16) & 0xff;
            int r1 = 0, r2 = 0, rp = 0;
            for (int j = 0; j < tid; ++j) { const int o = recs[j]; const int o1 = o & 0xff, o2 = (o >> 8) & 0xff, op = (o >> 16) & 0xff;
                r1 += ((o1 == e1) | (o2 == e1)) ? 1 : 0; r2 += ((o1 == e2) | (o2 == e2)) ? 1 : 0; rp += (op == pid) ? 1 : 0; }
            const int pslot = poff[pid] + pre[8 + pid] + rp; plist[pslot] = token;
            i32x4 en; en.x = token; en.w = 0;
            const GAS float* gp = (const GAS float*)(F.ws + WS_MISC + MS_GATE);
            GAS float* eg = (GAS float*)(F.ws + WS_MISC + MS_EGATE); en.z = 0;
            { const int sl = eoff[e1] + pre[e1] + r1; en.y = pslot * 1408 + (e1 < e2 ? 0 : DFE); elist[sl] = en; eg[sl] = gp[token]; }
            { const int sl = eoff[e2] + pre[e2] + r2; en.y = pslot * 1408 + (e2 < e1 ? 0 : DFE); elist[sl] = en; eg[sl] = gp[T + token]; }
        }
        if (first) {
            first = false; const int gt = blockIdx.x * NTHREADS + tid, gs = F.G * NTHREADS;
            for (int e = 0; e < NE; ++e) for (int i = eoff[e] + tot[e] + gt; i < eoff[e + 1]; i += gs) elist[i] = (i32x4){0, -1, 0, 0};
            for (int p = 0; p < NPAIR; ++p) for (int i = poff[p] + tot[8 + p] + gt; i < poff[p + 1]; i += gs) plist[i] = -1;
        }
    }
    __syncthreads();
}
__device__ __forceinline__ void load_tab(Frame& F) {
    __syncthreads();
    for (int i = F.tid_id(); i < TB_WORDS; i += NTHREADS) ((LAS int*)(F.lds + LDS_TAB))[i] = ((const GAS int*)(F.ws + WS_MISC + MS_TAB))[i];
    __syncthreads();
}

__device__ __forceinline__ void forget_phase(Frame& F, const GAS bf16_t* S) {
    int tid_ = F.tid_id(); asm volatile("" : "+v"(tid_));
    const int lane = tid_ & 63, w = __builtin_amdgcn_readfirstlane(tid_ >> 6);
    const GAS float* Wf = in_sel(IN_KVF);
    f32x4 wf[16];
#pragma unroll
    for (int i = 0; i < 16; ++i) wf[i] = *(const GAS f32x4*)(Wf + (size_t)(16 * lane + i) * 2052 + 2048);
    const f32x4 bias = *(const GAS f32x4*)in_sel(IN_KVFB);
    LAS float* lf = (LAS float*)F.lds;
    GAS float* cl = (GAS float*)(F.ws + WS_MISC + MS_CL); GAS float* tt = (GAS float*)(F.ws + WS_MISC + MS_TOT);
    for (int ch = blockIdx.x; ch < T / 128; ch += F.G) {
        __syncthreads();
        for (int k = 0; k < 16; ++k) {
            const int row = 128 * ch + 16 * w + k; const GAS u32x4* xr = (const GAS u32x4*)(S + (size_t)row * DM) + 2 * lane;
            float x[8]; f32x4 a = (f32x4){0.f, 0.f, 0.f, 0.f};
            g8::unpack8(xr[0], x);
#pragma unroll
            for (int i = 0; i < 8; ++i) a += wf[i] * x[i];
            g8::unpack8(xr[1], x);
#pragma unroll
            for (int i = 0; i < 8; ++i) a += wf[8 + i] * x[i];
#pragma unroll
            for (int hh = 0; hh < 4; ++hh) a[hh] = wave_sum_dpp(a[hh]);
            if (lane == 0) { f32x4 o;
#pragma unroll
                for (int hh = 0; hh < 4; ++hh) { const float z = a[hh] + bias[hh]; o[hh] = -(fmaxf(-z, 0.f) + log1pf(__expf(-fabsf(z)))); }
                *(LAS f32x4*)(lf + (16 * w + k) * 4) = o; }
        }
        __syncthreads();
        { const int tile = w >> 2, hh = w & 3; float x = lf[(tile * 64 + lane) * 4 + hh];
#pragma unroll
          for (int o = 1; o < 64; o <<= 1) { const float y = shup(x, o, lane); if (lane >= o) x += y; }
          const int row = 128 * ch + tile * 64 + lane, b = row / SEQ, s = row % SEQ;
          cl[(size_t)(b * NH + hh) * SEQ + s] = x; if (lane == 63) tt[(b * NH + hh) * 256 + (s >> 6)] = x; }
    }
    __syncthreads();
}
__device__ __forceinline__ void knorm_phase(Frame& F, const GAS bf16_t* KS) {
    const int lane = F.lane_id(), w = F.wave;
    for (int ch = blockIdx.x; ch < T / 128; ch += F.G) {
        float mx = 0.f;
        for (int k = 0; k < 16; ++k) { const int row = 128 * ch + 16 * w + k; const GAS u32x4* kr = (const GAS u32x4*)(KS + (size_t)row * DM) + 2 * lane; const u32x4 a = kr[0], b = kr[1];
            const unsigned u[8] = {a.x, a.y, a.z, a.w, b.x, b.y, b.z, b.w}; float s = 0.f;
#pragma unroll
            for (int i = 0; i < 8; ++i) { const float lo = __builtin_bit_cast(float, u[i] << 16), hi = __builtin_bit_cast(float, u[i] & 0xffff0000u); s += lo * lo + hi * hi; }
            s += shx(s, 1, lane); s += shx(s, 2, lane); s += shx(s, 4, lane); s += shx(s, 8, lane);
            mx = fmaxf(mx, s); }
        if ((lane & 15) == 0) { const int b = (128 * ch) / SEQ; (void)__hip_atomic_fetch_max(F.ctl + CW_KN2 + b * NH + (lane >> 4), __builtin_bit_cast(unsigned, mx), RLX_AGENT); }
    }
}

constexpr int AT_KB0 = 0, AT_VB0 = 32768, AT_KB1 = 66048, AT_VB1 = 98816, AT_VPANEL = 2080;
constexpr float SB_STOP = -14.f, FOX_STOP = -20.f;
typedef short s16x4 __attribute__((ext_vector_type(4)));
#define AT_TR4(r0, r1, r2, r3, addr, o0, o1, o2, o3) asm volatile("ds_read_b64_tr_b16 %0, %4 offset:%5\n\tds_read_b64_tr_b16 %1, %4 offset:%6\n\tds_read_b64_tr_b16 %2, %4 offset:%7\n\tds_read_b64_tr_b16 %3, %4 offset:%8" \
    : "=&v"(r0), "=&v"(r1), "=&v"(r2), "=&v"(r3) : "v"(addr), "i"(o0), "i"(o1), "i"(o2), "i"(o3) : "memory")
#define AT_WAIT4(r0, r1, r2, r3) asm volatile("s_waitcnt lgkmcnt(0)" : "+v"(r0), "+v"(r1), "+v"(r2), "+v"(r3) :: "memory")

template <bool FOX>
__device__ __forceinline__ void attn_phase(Frame& F, const GAS bf16_t* Q, const GAS bf16_t* Kb, const GAS bf16_t* Vb, GAS bf16_t* O) {
    LAS unsigned char* lds = F.lds;
    volatile LAS unsigned* flags = (volatile LAS unsigned*)(lds + LDS_FLAGS);
    int tid_ = F.tid_id(); asm volatile("" : "+v"(tid_));
    const int tid = tid_, w = __builtin_amdgcn_readfirstlane(tid >> 6), lane = tid & 63, fr = lane & 15, fq = lane >> 4;
    const int srow0 = tid >> 5, schunk = tid & 31;
    const unsigned kst = (unsigned)(srow0 * 512 + ((schunk ^ (srow0 & 15)) * 16));
    const unsigned vst = (unsigned)((schunk >> 1) * AT_VPANEL + srow0 * 32 + (schunk & 1) * 16);
    const unsigned vrd = (unsigned)((4 * fq + ((lane & 15) >> 2)) * 32 + 8 * (lane & 3));
    const GAS float* cl = (const GAS float*)(F.ws + WS_MISC + MS_CL); const GAS float* tt = (const GAS float*)(F.ws + WS_MISC + MS_TOT);
    for (int id = blockIdx.x; id < 8 * 128; id += F.G) {
        const int bh = id & 7, qt = id >> 3, b = bh >> 2, h = bh & 3, t0 = qt * 128;
        const size_t rowbase = (size_t)b * SEQ;
        const int tq = t0 + 16 * w + fr;
        bf16x8 qf[8];
        { const GAS bf16_t* qp = Q + (rowbase + tq) * DM + h * HD + 8 * fq;
#pragma unroll
          for (int s = 0; s < 8; ++s) qf[s] = *(const GAS bf16x8*)(qp + 32 * s); }
        f32x4 o[16];
#pragma unroll
        for (int d = 0; d < 16; ++d) o[d] = (f32x4){0.f, 0.f, 0.f, 0.f};
        float R = 0.f;
        float mrun = -1.0e30f, lsum = 0.f, cq = 0.f, qn = 0.f, KN = 0.f, gacc = 0.f;
        if constexpr (FOX) {
            float s2 = 0.f;
#pragma unroll
            for (int s = 0; s < 8; ++s)
#pragma unroll
                for (int j = 0; j < 8; ++j) { const float x = bf2f((unsigned short)qf[s][j]); s2 += x * x; }
            s2 += shx(s2, 16, lane); s2 += shx(s2, 32, lane); qn = sqrtf(s2);
            KN = sqrtf(__builtin_bit_cast(float, __hip_atomic_load(F.ctl + CW_KN2 + bh, RLX_AGENT))) * 1.002f;
            cq = cl[(size_t)bh * SEQ + tq] + ((tq >= t0 + 64) ? tt[bh * 256 + 2 * qt] : 0.f);
        }
        int kt = 2 * qt + 1, it = 0; bool wdone = false;
        u32x4 kr[4], vr[4];
#ifndef QK_NF
#define QK_NF 8
#endif
#ifndef QK_NF_SB
#define QK_NF_SB 8
#endif
#define AT_LOAD(KT) do { const GAS bf16_t* kp_ = Kb + (rowbase + (size_t)64 * (KT) + srow0) * DM + h * HD + schunk * 8; const GAS bf16_t* vp_ = Vb + (rowbase + (size_t)64 * (KT) + srow0) * DM + h * HD + schunk * 8; \
            _Pragma("unroll") for (int j = 0; j < 4; ++j) { kr[j] = *(const GAS u32x4*)(kp_ + (size_t)16 * j * DM); vr[j] = *(const GAS u32x4*)(vp_ + (size_t)16 * j * DM); } } while (0)
#define AT_WRITE(IT) do { const int kb_ = ((IT) & 1) ? AT_KB1 : AT_KB0, vb_ = ((IT) & 1) ? AT_VB1 : AT_VB0; \
            _Pragma("unroll") for (int j = 0; j < 4; ++j) { *(LAS u32x4*)(lds + kb_ + kst + j * 8192) = kr[j]; *(LAS u32x4*)(lds + vb_ + vst + j * 512) = vr[j]; } } while (0)
        AT_LOAD(kt); AT_WRITE(0); AT_LOAD(kt - 1);
        __syncthreads();
        for (;;) {
            const int kbuf = (it & 1) ? AT_KB1 : AT_KB0, vbuf = (it & 1) ? AT_VB1 : AT_VB0;
            if (it >= 2) { unsigned any = 0u; const int par = (it - 1) & 1;
#pragma unroll
                for (int k = 0; k < 8; ++k) any |= flags[par * 8 + k];
                if (any == 0u) break; }
            const int kmin = 64 * kt, wmax = t0 + 16 * w + 15, wmin = t0 + 16 * w;
            f32x4 ckv[4]; float ttv = 0.f;
            if constexpr (FOX) {
#pragma unroll
                for (int blk = 0; blk < 4; ++blk) ckv[blk] = *(const GAS f32x4*)(cl + (size_t)bh * SEQ + kmin + 16 * blk + 4 * fq);
                ttv = tt[bh * 256 + (kt > 2 * qt ? 2 * qt : kt)];
                asm volatile("" ::: "memory"); }
            if (kt > 0) { AT_WRITE(it + 1); if constexpr (!FOX) { if (kt > 1) AT_LOAD(kt - 2); } }
            const bool part = !wdone && (FOX ? (kmin <= wmax) : (kmin < wmax));
            if (part) {
                const bool need_mask = (kmin + 63 >= wmin);
                f32x4 s[4];
                {
                    constexpr int NF = FOX ? QK_NF : QK_NF_SB;
                    bf16x8 kf[NF];
#pragma unroll
                    for (int blk = 0; blk < 4; ++blk) s[blk] = (f32x4){0.f, 0.f, 0.f, 0.f};
#pragma unroll
                    for (int n = 0; n < NF - 1; ++n) kf[n] = *(const LAS bf16x8*)(lds + kbuf + (16 * (n & 3) + fr) * 512 + (((4 * (n >> 2) + fq) ^ fr) * 16));
                    __builtin_amdgcn_sched_barrier(0);
#pragma unroll
                    for (int n = 0; n < 32; ++n) {
                        if (n + NF - 1 < 32) { const int m = n + NF - 1; kf[m % NF] = *(const LAS bf16x8*)(lds + kbuf + (16 * (m & 3) + fr) * 512 + (((4 * (m >> 2) + fq) ^ fr) * 16)); }
                        s[n & 3] = __builtin_amdgcn_mfma_f32_16x16x32_bf16(kf[n % NF], qf[n >> 2], s[n & 3], 0, 0, 0);
                        __builtin_amdgcn_sched_barrier(0);
                    }
                }
                if constexpr (FOX) { if (kt > 1) AT_LOAD(kt - 2); }
                float pv[4][4];
                if constexpr (!FOX) {
                    float lm[4][4], w4[4], Tt[4], Ex[4];
#pragma unroll
                    for (int blk = 0; blk < 4; ++blk) { w4[blk] = 0.f;
#pragma unroll
                        for (int i = 0; i < 4; ++i) { const float z = s[blk][i]; const float sp = softplus_f(z); const bool valid = !need_mask || (kmin + 16 * blk + 4 * fq + i < tq);
                            lm[blk][i] = valid ? -sp : 0.f; pv[blk][i] = valid ? (z - sp) : -1.0e30f; w4[blk] += lm[blk][i]; } }
#pragma unroll
                    for (int blk = 0; blk < 4; ++blk) { const float a = shx(w4[blk], 16, lane), bq = shx(w4[blk], 32, lane), c = shx(a, 32, lane);
                        Tt[blk] = (w4[blk] + a) + (bq + c); Ex[blk] = (fq == 0) ? (a + bq + c) : (fq == 1) ? (bq + c) : (fq == 2) ? a : 0.f; }
                    float bs = 0.f;
#pragma unroll
                    for (int blk = 3; blk >= 0; --blk) { float tail = R + bs + Ex[blk];
#pragma unroll
                        for (int i = 3; i >= 0; --i) { const float e = pv[blk][i] + tail; pv[blk][i] = (e > -80.f) ? fast_exp(e) : 0.f; tail += lm[blk][i]; }
                        bs += Tt[blk]; }
                    R += bs;
                } else {
                    float base;
                    if (kt == 2 * qt + 1) base = ttv; else if (kt == 2 * qt) base = 0.f; else { gacc += ttv; base = -gacc; }
                    float mx = -1.0e30f;
#pragma unroll
                    for (int blk = 0; blk < 4; ++blk) { const f32x4 ck = ckv[blk];
#pragma unroll
                        for (int i = 0; i < 4; ++i) { const bool valid = !need_mask || (kmin + 16 * blk + 4 * fq + i <= tq); const float lg = valid ? (s[blk][i] + cq - (ck[i] + base)) : -1.0e30f; pv[blk][i] = lg; mx = fmaxf(mx, lg); } }
                    mx = fmaxf(mx, shx(mx, 16, lane)); mx = fmaxf(mx, shx(mx, 32, lane));
                    const float mnew = fmaxf(mrun, mx), al = fast_exp(mrun - mnew); float ps = 0.f;
#pragma unroll
                    for (int blk = 0; blk < 4; ++blk)
#pragma unroll
                        for (int i = 0; i < 4; ++i) { const float e = pv[blk][i] - mnew; const float p = (e > -80.f) ? fast_exp(e) : 0.f; pv[blk][i] = p; ps += p; }
                    lsum = lsum * al + ps;
                    if (__any(mnew > mrun)) {
#pragma unroll
                        for (int d = 0; d < 16; ++d) o[d] = o[d] * al; }
                    mrun = mnew;
                }
                bf16x8 pf[2];
#pragma unroll
                for (int c = 0; c < 2; ++c) { u32x4 pw; pw.x = cvt_pk_bf16(pv[2 * c][0], pv[2 * c][1]); pw.y = cvt_pk_bf16(pv[2 * c][2], pv[2 * c][3]); pw.z = cvt_pk_bf16(pv[2 * c + 1][0], pv[2 * c + 1][1]); pw.w = cvt_pk_bf16(pv[2 * c + 1][2], pv[2 * c + 1][3]);
                    pf[c] = __builtin_bit_cast(bf16x8, pw); }
                const unsigned va = (unsigned)(size_t)(lds + vbuf) + vrd;
                s16x4 c0, c1, c2, c3, n0, n1, n2, n3;
                AT_TR4(c0, c1, c2, c3, va, 0, 512, 1024, 1536);
                n0 = c0; n1 = c1; n2 = c2; n3 = c3;
#define AT_PV(db) do { AT_WAIT4(c0, c1, c2, c3); \
                    if ((db) < 15) { AT_TR4(n0, n1, n2, n3, va, ((db) + 1) * AT_VPANEL, ((db) + 1) * AT_VPANEL + 512, ((db) + 1) * AT_VPANEL + 1024, ((db) + 1) * AT_VPANEL + 1536); } \
                    { const bf16x8 v0 = __builtin_shufflevector(c0, c1, 0, 1, 2, 3, 4, 5, 6, 7), v1 = __builtin_shufflevector(c2, c3, 0, 1, 2, 3, 4, 5, 6, 7); \
                      o[db] = __builtin_amdgcn_mfma_f32_16x16x32_bf16(v0, pf[0], o[db], 0, 0, 0); o[db] = __builtin_amdgcn_mfma_f32_16x16x32_bf16(v1, pf[1], o[db], 0, 0, 0); } \
                    c0 = n0; c1 = n1; c2 = n2; c3 = n3; } while (0)
                AT_PV(0); AT_PV(1); AT_PV(2); AT_PV(3); AT_PV(4); AT_PV(5); AT_PV(6); AT_PV(7); AT_PV(8); AT_PV(9); AT_PV(10); AT_PV(11); AT_PV(12); AT_PV(13); AT_PV(14); AT_PV(15);
#undef AT_PV
            } else { if constexpr (FOX) { if (kt > 1) AT_LOAD(kt - 2); if (kt < 2 * qt) gacc += ttv; } }
            { bool cont;
              if constexpr (!FOX) cont = (R >= SB_STOP);
              else cont = (qn * KN + cq + ((kt <= 2 * qt) ? gacc : 0.f) - mrun >= FOX_STOP) || (kt > 2 * qt);
              const bool anyc = !wdone && __any(cont); wdone = !anyc;
              if (lane == 0) flags[(it & 1) * 8 + w] = anyc ? 1u : 0u; }
            __syncthreads();
            if (kt == 0) break;
            --kt; ++it;
        }
#undef AT_LOAD
#undef AT_WRITE
        float inv = 1.f;
        if constexpr (FOX) { float lt = lsum; lt += shx(lt, 16, lane); lt += shx(lt, 32, lane); inv = 1.f / lt; }
        { GAS bf16_t* op = O + (rowbase + tq) * DM + h * HD + 4 * fq;
#pragma unroll
          for (int db = 0; db < 16; ++db) { u32x2 ow; ow.x = cvt_pk_bf16(o[db][0] * inv, o[db][1] * inv); ow.y = cvt_pk_bf16(o[db][2] * inv, o[db][3] * inv); *(GAS u32x2*)(op + 16 * db) = ow; } }
    }
}

constexpr int NPH = 41;
__host__ __device__ inline bool phase_nonempty(int k) { if (k == 0) return true; const int L = (k - 1) / 10, s = (k - 1) % 10; if (s == 1) return L == 2; if (s == 5) return (L & 1) != 0; return true; }
struct Args { const float* in[N_IN]; float* out; unsigned char* ws; int ph_lo, ph_hi, sub, pad; };

__global__ void __launch_bounds__(NTHREADS, 2) mk_fwd(Args args) {
    extern __shared__ __attribute__((aligned(16))) unsigned char lds_raw[];
    Frame F;
    F.lds = (LAS unsigned char*)lds_raw;
    F.wave = __builtin_amdgcn_readfirstlane((int)threadIdx.x >> 6);
    F.G = gridDim.x; { const int bx = blockIdx.x; F.vcu = (F.G % 8 == 0) ? (bx % 8) * (F.G / 8) + bx / 8 : bx; }
    F.ws = (GAS unsigned char*)args.ws; F.ctl = (GAS unsigned*)F.ws; F.res = (GAS float*)args.out;
    for (int u = (int)threadIdx.x; u < (LDS_BYTES - LDS_CTL) / 4; u += NTHREADS) ((LAS unsigned*)(F.lds + LDS_CTL))[u] = 0u;
    __syncthreads();
    const int lo = args.ph_lo, hi = args.ph_hi;
    XcdBarrier bar; bar.bar = F.ctl + CW_BAR; bar.x = 0; bar.st = nullptr;
    if (hi - lo > 1) bar = xcd_barrier_post(F.ctl + CW_BAR, (volatile LAS unsigned*)(F.lds + LDS_CTL) + 8);
#ifndef DUP_MASK
#define DUP_MASK 0
#endif
#define DUP(n) (1 + ((DUP_MASK >> (n)) & 1))
#ifndef SITE_MASK
#define SITE_MASK 0xFFFFF
#endif
#define SITE(n) ((SITE_MASK >> (n)) & 1)
#define IN(k) (lo <= (k) && (k) < hi)
#define SEAM(k) do { if ((k) + 1 < hi) xcd_barrier(bar); } while (0)
    const int c = (int)blockIdx.x;
#define WSB(name) GAS unsigned char* name = launder_ptr(F.ws)
#define XBP(ws_, which) ((GAS bf16_t*)((ws_) + ((which) ? WS_XB1 : WS_XB0)))

    if (SITE(0) && IN(0)) { for (int rep_ = 0; rep_ < DUP(0); ++rep_) prologue_phase(F); SEAM(0); }

    for (int L = 0; L < DEPTH; ++L) {
        const int pb = 1 + 10 * L;
        {
            F.wave = launder_int(F.wave); F.ws = launder_ptr(F.ws); F.res = launder_ptr(F.res); F.ctl = (GAS unsigned*)F.ws; F.G = launder_int(F.G); }
        for (int repa_ = 0; repa_ < DUP(20); ++repa_) {
        if (SITE(1) && IN(pb + 0)) {
            WSB(ws);
            const GAS bf16_t* Wqkv = (const GAS bf16_t*)(ws + (L < 2 ? WS_WDEAD : WS_WLIVE)) + (L == 0 ? WD_QKV0 : L == 1 ? WD_QKV1 : L == 2 ? WL_QKV2 : WL_Q3);
            g8::ProbPlain P{XBP(ws, (L + 1) & 1), Wqkv, 1024, 1024, 16, T / 256, (L == 3) ? 4 : 12, F.G, c};
            g8::EpiBf16Split E{(GAS bf16_t*)(ws + WS_QA), 1024, (L == 3) ? 0 : 1024, (size_t)(WS_KS - WS_QA) / 2};
            for (int rep_ = 0; rep_ < DUP(1); ++rep_) g8::gemm_phase<g8::ProbPlain, g8::EpiBf16Split>(F.lds, P, E, F.wave);
            if (SITE(2) && L == 2) forget_phase(F, XBP(ws, (L + 1) & 1));
            SEAM(pb + 0);
        }
        if (SITE(3) && IN(pb + 1) && L == 2) { WSB(ws); knorm_phase(F, (const GAS bf16_t*)(ws + WS_KS)); SEAM(pb + 1); }
        if (IN(pb + 2)) {
            WSB(ws); GAS bf16_t* QA = (GAS bf16_t*)(ws + WS_QA); const GAS bf16_t* KS = (const GAS bf16_t*)(ws + WS_KS); const GAS bf16_t* VS = (const GAS bf16_t*)(ws + WS_VS);
            if (L < 2) { if (SITE(4)) attn_phase<false>(F, QA, KS, VS, QA); } else { if (SITE(5)) attn_phase<true>(F, QA, KS, VS, QA); }
            SEAM(pb + 2);
        }
        }
        if (SITE(6) && IN(pb + 3)) {
            WSB(ws);
            const GAS bf16_t* Wo = (const GAS bf16_t*)(ws + (L < 2 ? WS_WDEAD : WS_WLIVE)) + (L == 0 ? WD_O0 : L == 1 ? WD_O1 : L == 2 ? WL_O2 : WL_O3);
            g8::ProbPlain P{(const GAS bf16_t*)(ws + WS_QA), Wo, 1024, 1024, 16, T / 256, 4, F.G, c};
            g8::EpiResidB E{XBP(ws, (L + 1) & 1)};
            g8::gemm_phase<g8::ProbPlain, g8::EpiResidB>(F.lds, P, E, F.wave);
            SEAM(pb + 3);
        }
        if (IN(pb + 4)) { WSB(ws); GAS bf16_t* xln1 = XBP(ws, (L + 1) & 1); if (L & 1) { if (SITE(7)) ln_phase<true, true>(F, L, 0, xln1); } else { if (SITE(8)) ln_phase<false, true>(F, L, 0, xln1); } SEAM(pb + 4); }
        if (SITE(9) && IN(pb + 5) && (L & 1)) { moe_lists_phase(F); SEAM(pb + 5); }
        if (IN(pb + 6)) {
            WSB(ws); const GAS bf16_t* xln1 = XBP(ws, (L + 1) & 1);
            if (L & 1) { if (SITE(10)) { load_tab(F);
                const GAS bf16_t* Wmgu = (const GAS bf16_t*)(ws + (L == 1 ? WS_WDEAD : WS_WLIVE)) + (L == 1 ? WD_MGU0 : WL_MGU1); const GAS i32x4* elist = (const GAS i32x4*)(ws + WS_MISC + MS_ELIST);
                g8::ProbMoeGU P{xln1, Wmgu, elist, (const LAS int*)(F.lds + LDS_TAB), 1024, 1024, 16, F.G, c}; g8::EpiMoeGU E{(GAS bf16_t*)(ws + (L == 1 ? WS_QA : WS_WDEAD)), elist, (const GAS float*)(ws + WS_MISC + MS_EGATE)};
                for (int rep_ = 0; rep_ < DUP(10); ++rep_) g8::gemm_phase<g8::ProbMoeGU, g8::EpiMoeGU>(F.lds, P, E, F.wave); } }
            else if (SITE(11)) { const GAS bf16_t* Wgu = (const GAS bf16_t*)(ws + (L == 0 ? WS_WDEAD : WS_WLIVE)) + (L == 0 ? WD_GU0 : WL_GU1);
                g8::ProbPlain P{xln1, Wgu, 1024, 1024, 16, T / 256, 22, F.G, c}; g8::EpiSwiglu E{(GAS bf16_t*)(ws + (L == 0 ? WS_QA : WS_XB0)), DFF};
                for (int rep_ = 0; rep_ < DUP(11); ++rep_) g8::gemm_phase<g8::ProbPlain, g8::EpiSwiglu>(F.lds, P, E, F.wave); }
            SEAM(pb + 6);
        }
        if (IN(pb + 7)) {
            WSB(ws);
            if (L & 1) { if (SITE(12)) { load_tab(F);
                const GAS bf16_t* Wmdn = (const GAS bf16_t*)(ws + (L == 1 ? WS_WDEAD : WS_WLIVE)) + (L == 1 ? WD_MDN0 : WL_MDN1);
                g8::ProbMoeDown P{(const GAS bf16_t*)(ws + (L == 1 ? WS_QA : WS_WDEAD)), Wmdn, (const LAS int*)(F.lds + LDS_TAB), 1408, 5632, 22, F.G, c}; g8::EpiMoeDownB E{XBP(ws, (L + 1) & 1), (const GAS int*)(ws + WS_MISC + MS_PLIST)};
                g8::gemm_phase<g8::ProbMoeDown, g8::EpiMoeDownB>(F.lds, P, E, F.wave); } }
            else if (SITE(13)) { const GAS bf16_t* Wdn = (const GAS bf16_t*)(ws + (L == 0 ? WS_WDEAD : WS_WLIVE)) + (L == 0 ? WD_DN0 : WL_DN1);
                g8::ProbPlain P{(const GAS bf16_t*)(ws + (L == 0 ? WS_QA : WS_XB0)), Wdn, DFF, DFF, 44, T / 256, 4, F.G, c}; g8::EpiResidB E{XBP(ws, (L + 1) & 1)};
                g8::gemm_phase<g8::ProbPlain, g8::EpiResidB>(F.lds, P, E, F.wave); }
            SEAM(pb + 7);
        }
        if (SITE(14) && IN(pb + 8)) { WSB(ws); ln_phase<false, false>(F, L, 1, XBP(ws, (L + 1) & 1)); SEAM(pb + 8); }
        if (IN(pb + 9)) {
            if (SITE(15) && args.sub != 2) { WSB(ws); const GAS bf16_t* Wpg = (const GAS bf16_t*)(ws + (L < 2 ? WS_WDEAD : WS_WLIVE)) + (L == 0 ? WD_PG0 : L == 1 ? WD_PG1 : L == 2 ? WL_PG2 : WL_PG3);
                g8::ProbPlain P{XBP(ws, (L + 1) & 1), Wpg, 1024, 1024, 16, T / 256, 4, F.G, c}; g8::EpiGate E{XBP(ws, L & 1)}; for (int rep_ = 0; rep_ < DUP(15); ++rep_) g8::gemm_phase<g8::ProbPlain, g8::EpiGate>(F.lds, P, E, F.wave); }
            if (SITE(16) && args.sub != 1) { WSB(ws); const GAS bf16_t* Wpp = (const GAS bf16_t*)(ws + (L < 2 ? WS_WDEAD : WS_WLIVE)) + (L == 0 ? WD_PP0 : L == 1 ? WD_PP1 : L == 2 ? WL_PP2 : WL_PP3);
                g8::ProbPlain P{(const GAS bf16_t*)(ws + WS_PB), Wpp, PLE, PLE, 4, T / 256, 4, F.G, c}; g8::EpiPleB E{XBP(ws, (L + 1) & 1), XBP(ws, L & 1), L == DEPTH - 1 ? F.res : (GAS float*)nullptr}; g8::gemm_phase<g8::ProbPlain, g8::EpiPleB>(F.lds, P, E, F.wave); }
            if (pb + 9 < NPH - 1) SEAM(pb + 9);
        }
    }
#undef WSB
#undef XBP
#undef IN
#undef SEAM
}

extern "C" void kernel_launch(void* const* d_in, const int* in_sizes, int n_in, void* d_out, int out_size, void* d_ws, size_t ws_size, hipStream_t stream) {
    static int grid = 0;
    if (grid == 0) {
        if (n_in != N_IN || out_size != T * DM || ws_size < WS_END) { fprintf(stderr, "kernel_launch: unexpected problem (n_in %d, out %d, ws %zu < %zu)\n", n_in, out_size, ws_size, (size_t)WS_END); grid = -1; return; }
        int dev = 0, cus = 0, per_cu = 0;
        if (hipGetDevice(&dev) != hipSuccess || hipDeviceGetAttribute(&cus, hipDeviceAttributeMultiprocessorCount, dev) != hipSuccess) { grid = -1; return; }
        if (hipFuncSetAttribute((const void*)mk_fwd, hipFuncAttributeMaxDynamicSharedMemorySize, LDS_BYTES) != hipSuccess) { fprintf(stderr, "kernel_launch: hipFuncSetAttribute failed\n"); grid = -1; return; }
        if (hipOccupancyMaxActiveBlocksPerMultiprocessor(&per_cu, (const void*)mk_fwd, NTHREADS, LDS_BYTES) != hipSuccess || per_cu < 1) { fprintf(stderr, "kernel_launch: occupancy query says %d blocks per CU\n", per_cu); }
        (void)hipGetLastError();
        grid = cus;
    }
    if (grid < 0) return;
    (void)hipMemsetAsync((char*)d_ws + WS_CTL, 0, CTL_ZERO_BYTES, stream);
    Args a{};
    for (int i = 0; i < N_IN; ++i) a.in[i] = (const float*)d_in[i];
    a.out = (float*)d_out; a.ws = (unsigned char*)d_ws;
    a.ph_lo = 0; a.ph_hi = NPH; a.sub = 0; a.pad = 0;
    hipLaunchKernelGGL(mk_fwd, dim3(grid), dim3(NTHREADS), LDS_BYTES, stream, a);
}
```

```cpp
#include <hip/hip_runtime.h>
#include <cstdio>
#include <cstdint>


#define LAS __attribute__((address_space(3)))
#define GAS __attribute__((address_space(1)))
typedef unsigned short bf16_t;
typedef short bf16x8 __attribute__((ext_vector_type(8)));
typedef short bf16x4 __attribute__((ext_vector_type(4)));
typedef float f32x4 __attribute__((ext_vector_type(4)));
typedef float f32x2 __attribute__((ext_vector_type(2)));
typedef unsigned u32x4 __attribute__((ext_vector_type(4)));
typedef unsigned u32x2 __attribute__((ext_vector_type(2)));
typedef int i32x4 __attribute__((ext_vector_type(4)));

constexpr int DM = 1024, NBATCH = 2, SEQ = 16384, T = NBATCH * SEQ, NH = 4, HD = 256, DFF = 2816, NE = 8, DFE = 704, PLE = 256, DEPTH = 4;
constexpr float ALPHA = 1.6817928305074292f;
constexpr float LN_EPS = 1e-5f;
constexpr int NWAVES = 8, NTHREADS = 512;
enum { IN_X = 0, IN_P, IN_AQKV, IN_AO, IN_KVF, IN_KVFB, IN_BQ, IN_BO, IN_FGU, IN_FDN, IN_MR, IN_MGU, IN_MDN, IN_PP, IN_PG, IN_LNG, IN_LNB, N_IN };

constexpr size_t MiB = 1u << 20;
constexpr size_t WS_CTL = 0, CTL_ZERO_BYTES = 1 * MiB;
constexpr size_t WS_MISC = 1 * MiB;
constexpr size_t WS_WLIVE = 8 * MiB;
constexpr size_t WS_PB = 77 * MiB;
constexpr size_t WS_XB1 = 93 * MiB, WS_XB0 = 157 * MiB;
constexpr size_t WS_WDEAD = 221 * MiB;
constexpr size_t WS_QA = 294 * MiB, WS_KS = 358 * MiB, WS_VS = 422 * MiB, WS_END = 486 * MiB;
constexpr size_t MS_REC = 0;
constexpr size_t MS_HIST = 512 * 1024;
constexpr size_t MS_ELIST = 576 * 1024;
constexpr int ELIST_CAP = 2 * T + NE * 256;
constexpr size_t MS_PLIST = MS_ELIST + (size_t)ELIST_CAP * 16;
constexpr int NPAIR = 28, PLIST_CAP = T + NPAIR * 256;
constexpr size_t MS_TAB = 2 * MiB;
constexpr size_t MS_CL = 2 * MiB + 64 * 1024;
constexpr size_t MS_TOT = MS_CL + (size_t)8 * SEQ * 4;
constexpr size_t MS_SNAP = 3 * MiB;
constexpr size_t MS_EGATE = 4 * MiB + 512 * 1024;
constexpr size_t MS_CS = 3 * MiB;
constexpr size_t MS_ST2 = 5 * MiB, MS_ST1 = 6 * MiB;
constexpr int CS_PG0 = 0, CS_GU0 = 4096, CS_MGU0 = CS_GU0 + 2 * 5632, CS_TOTAL = CS_MGU0 + 2 * 8 * 1536;
constexpr size_t MS_GATE = 4 * MiB;
static_assert(MS_PLIST + (size_t)PLIST_CAP * 4 <= MS_TAB && MS_TOT + 8 * 256 * 4 <= MS_SNAP, "misc map");
enum { TB_ECUM = 0  , TB_EOFF = 16  , TB_NRT = 32, TB_RT2P = 64  , TB_WORDS = 320 };
constexpr int CW_TMO = 0, CW_CODE = 1, CW_DBG = 64  , CW_KN2 = 192  , CW_BAR = 4096;

constexpr size_t WSZ_QKV = (size_t)3072 * 1024, WSZ_SQ = (size_t)1024 * 1024, WSZ_GU = (size_t)5632 * 1024, WSZ_DN = (size_t)1024 * 2816,
                 WSZ_MGU = (size_t)NE * 1536 * 1024, WSZ_MDN = (size_t)1024 * 5632, WSZ_PP = (size_t)1024 * 256;
constexpr size_t WD_QKV0 = 0, WD_O0 = WD_QKV0 + WSZ_QKV, WD_QKV1 = WD_O0 + WSZ_SQ, WD_O1 = WD_QKV1 + WSZ_QKV, WD_GU0 = WD_O1 + WSZ_SQ, WD_DN0 = WD_GU0 + WSZ_GU,
                 WD_MGU0 = WD_DN0 + WSZ_DN, WD_MDN0 = WD_MGU0 + WSZ_MGU, WD_PP0 = WD_MDN0 + WSZ_MDN, WD_PG0 = WD_PP0 + WSZ_PP, WD_PP1 = WD_PG0 + WSZ_SQ, WD_PG1 = WD_PP1 + WSZ_PP, WD_END = WD_PG1 + WSZ_SQ;
constexpr size_t WL_QKV2 = 0, WL_O2 = WL_QKV2 + WSZ_QKV, WL_Q3 = WL_O2 + WSZ_SQ, WL_O3 = WL_Q3 + WSZ_SQ, WL_GU1 = WL_O3 + WSZ_SQ, WL_DN1 = WL_GU1 + WSZ_GU,
                 WL_MGU1 = WL_DN1 + WSZ_DN, WL_MDN1 = WL_MGU1 + WSZ_MGU, WL_PP2 = WL_MDN1 + WSZ_MDN, WL_PG2 = WL_PP2 + WSZ_PP, WL_PP3 = WL_PG2 + WSZ_SQ, WL_PG3 = WL_PP3 + WSZ_PP, WL_END = WL_PG3 + WSZ_SQ;
static_assert(WD_END * 2 <= 73 * MiB && WL_END * 2 <= 69 * MiB, "weight regions");
static_assert((size_t)T * DFF * 2 <= WS_END - WS_QA && WS_XB0 + (size_t)T * DFF * 2 <= WS_KS && WS_WDEAD + (size_t)(T + NPAIR * 256) * 1408 * 2 <= WS_KS, "h overlays");

constexpr int RING_BYTES = 131072;
constexpr int LDS_CTL = 135168;
constexpr int LDS_TAB = LDS_CTL + 128;
constexpr int LDS_FLAGS = LDS_TAB + TB_WORDS * 4;
constexpr int LDS_BYTES = 147456;
constexpr int LDS_XCH = 137216;
static_assert(LDS_FLAGS + 64 <= LDS_XCH && LDS_XCH + 8192 <= LDS_BYTES, "LDS map");

#define RLX_AGENT __ATOMIC_RELAXED, __HIP_MEMORY_SCOPE_AGENT
__device__ __forceinline__ unsigned f2bf(float f) { unsigned u = __builtin_bit_cast(unsigned, f); return (u + 0x7fffu + ((u >> 16) & 1u)) >> 16; }
__device__ __forceinline__ unsigned pk2(float lo, float hi) { return f2bf(lo) | (f2bf(hi) << 16); }
__device__ __forceinline__ float bf2f(unsigned short b) { return __builtin_bit_cast(float, (unsigned)b << 16); }
typedef __bf16 bf16v2_t __attribute__((ext_vector_type(2)));
__device__ __forceinline__ unsigned cvt_pk_bf16(float lo, float hi) { bf16v2_t v; v[0] = (__bf16)lo; v[1] = (__bf16)hi; return __builtin_bit_cast(unsigned, v); }
__device__ __forceinline__ float shx(float v, int m, int lane) { return __builtin_bit_cast(float, __builtin_amdgcn_ds_bpermute((lane ^ m) << 2, __builtin_bit_cast(int, v))); }
__device__ __forceinline__ void xswap32(float& a, float& b) { asm volatile("s_nop 1\n\tv_permlane32_swap_b32 %0, %1" : "+v"(a), "+v"(b)); }
__device__ __forceinline__ void xswap16(float& a, float& b) { asm volatile("s_nop 1\n\tv_permlane16_swap_b32 %0, %1" : "+v"(a), "+v"(b)); }
__device__ __forceinline__ float xsum16(float v) { float a = v, b = v; xswap16(a, b); return a + b; }
__device__ __forceinline__ float xsum32(float v) { float a = v, b = v; xswap32(a, b); return a + b; }
__device__ __forceinline__ float xmax16(float v) { float a = v, b = v; xswap16(a, b); return fmaxf(a, b); }
__device__ __forceinline__ float xmax32(float v) { float a = v, b = v; xswap32(a, b); return fmaxf(a, b); }
__device__ __forceinline__ float xget16(float v, int fq) { float a = v, b = v; xswap16(a, b); return (fq & 1) ? a : b; }
__device__ __forceinline__ float xget32(float v, int fq) { float a = v, b = v; xswap32(a, b); return (fq & 2) ? a : b; }
__device__ __forceinline__ int shxi(int v, int m, int lane) { return __builtin_amdgcn_ds_bpermute((lane ^ m) << 2, v); }
__device__ __forceinline__ float shup(float v, int o, int lane) { return __builtin_bit_cast(float, __builtin_amdgcn_ds_bpermute(((lane - o) & 63) << 2, __builtin_bit_cast(int, v))); }
__device__ __forceinline__ float wave_sum(float v, int lane) {
#pragma unroll
    for (int o = 1; o < 64; o <<= 1) v += shx(v, o, lane);
    return v;
}
template <int CTRL> __device__ __forceinline__ float dpp_mov(float v) { return __builtin_bit_cast(float, __builtin_amdgcn_update_dpp(0, __builtin_bit_cast(int, v), CTRL, 0xF, 0xF, true)); }
__device__ __forceinline__ float wave_sum_dpp(float v) {
    v += dpp_mov<0xB1>(v); v += dpp_mov<0x4E>(v); v += dpp_mov<0x141>(v); v += dpp_mov<0x140>(v);
    const int b = __builtin_bit_cast(int, v);
    return (__builtin_bit_cast(float, __builtin_amdgcn_readlane(b, 0)) + __builtin_bit_cast(float, __builtin_amdgcn_readlane(b, 16))) + (__builtin_bit_cast(float, __builtin_amdgcn_readlane(b, 32)) + __builtin_bit_cast(float, __builtin_amdgcn_readlane(b, 48)));
}
__device__ __forceinline__ float fast_exp(float x) { return __builtin_amdgcn_exp2f(x * 1.4426950408889634f); }
__device__ __forceinline__ float fast_log(float x) { return __builtin_amdgcn_logf(x) * 0.6931471805599453f; }
__device__ __forceinline__ float softplus_f(float z) { return fmaxf(z, 0.f) + fast_log(1.f + fast_exp(-fabsf(z))); }
__device__ __forceinline__ float sigmoid_f(float z) { return __builtin_amdgcn_rcpf(1.f + fast_exp(-z)); }

typedef const GAS float* fptr_t;
__device__ __forceinline__ const GAS float* in_sel(int idx) { const __attribute__((address_space(4))) fptr_t* ka = (const __attribute__((address_space(4))) fptr_t*)__builtin_amdgcn_kernarg_segment_ptr(); return ka[idx]; }

template <class Tp> __device__ __forceinline__ GAS Tp* launder_ptr(GAS Tp* p) { unsigned lo = (unsigned)(unsigned long long)p, hi = (unsigned)((unsigned long long)p >> 32); asm volatile("" : "+v"(lo), "+v"(hi));
    lo = __builtin_amdgcn_readfirstlane(lo); hi = __builtin_amdgcn_readfirstlane(hi); return (GAS Tp*)(((unsigned long long)hi << 32) | lo); }
__device__ __forceinline__ int launder_int(int v) { asm volatile("" : "+v"(v)); return __builtin_amdgcn_readfirstlane(v); }

#define XB_TMO      128
#define XB_XCNT(j)  (256  + 64 * (j))
#define XB_XSUB(j)  (1280 + 64 * (j))
#define XB_XGEN(j)  (2304 + 64 * (j))
#define XB_TOP      3328
#define XB_TOPGEN   3392
#define XCD_BAR_WORDS 3456
#define XB_SPIN_CAP (1u << 18)
__device__ __forceinline__ unsigned xb_ld(GAS unsigned* p)              { return __hip_atomic_load(p, __ATOMIC_RELAXED, __HIP_MEMORY_SCOPE_AGENT); }
__device__ __forceinline__ unsigned xb_add(GAS unsigned* p, unsigned v) { return __hip_atomic_fetch_add(p, v, __ATOMIC_RELAXED, __HIP_MEMORY_SCOPE_AGENT); }
__device__ __forceinline__ unsigned xb_xcc_id() { return (unsigned)__builtin_amdgcn_s_getreg((3 << 11) | 20) & 0xFu; }
#define XB_SPIN(cond, bar) do { unsigned _sp = 0; while (cond) { __builtin_amdgcn_s_sleep(1); \
    if ((++_sp & 255u) == 0u) { if (xb_ld(&(bar)[XB_TMO])) break; if (_sp > XB_SPIN_CAP) { (void)xb_add(&(bar)[XB_TMO], 1u); break; } } } } while (0)
struct XcdBarrier { GAS unsigned* bar; unsigned x; volatile LAS unsigned* st; };
__device__ __forceinline__ XcdBarrier xcd_barrier_post(GAS unsigned* bar, volatile LAS unsigned* st) {
    XcdBarrier b; b.bar = bar; b.x = xb_xcc_id(); b.st = st;
    if (threadIdx.x == 0) (void)xb_add(&bar[XB_XCNT(b.x)], 1u);
    return b;
}
__device__ __forceinline__ void xcd_barrier_complete(GAS unsigned* bar, unsigned x, unsigned& nloc, unsigned& nx) {
    const unsigned G = gridDim.x * gridDim.y * gridDim.z;
    unsigned sum, cnt, mine, sp = 0u;
    for (;;) {
        sum = 0u; cnt = 0u; mine = 0u;
#pragma unroll
        for (unsigned j = 0; j < 16; ++j) { const unsigned c = xb_ld(&bar[XB_XCNT(j)]); sum += c; cnt += (c > 0u) ? 1u : 0u; mine = (j == x) ? c : mine; }
        if (sum == G) break;
        __builtin_amdgcn_s_sleep(1);
        if ((++sp & 255u) == 0u) { if (xb_ld(&bar[XB_TMO])) break; if (sp > XB_SPIN_CAP) { (void)xb_add(&bar[XB_TMO], 1u); break; } }
    }
    nloc = mine > 0u ? mine : 1u; nx = cnt > 0u ? cnt : 1u;
}
__device__ __forceinline__ void xcd_barrier(const XcdBarrier& b) {
    asm volatile("s_waitcnt vmcnt(0)" ::: "memory");
    __syncthreads();
    if (threadIdx.x == 0) {
        GAS unsigned* bar = b.bar;
        __builtin_amdgcn_s_waitcnt(0);
        unsigned nloc = b.st[0], nx = b.st[1];
        if (nloc == 0u) { xcd_barrier_complete(bar, b.x, nloc, nx); b.st[0] = nloc; b.st[1] = nx; }
        const unsigned old = xb_add(&bar[XB_XSUB(b.x)], 1u);
        const unsigned gen = old / nloc;
        if (old + 1u == (gen + 1u) * nloc) {
            __builtin_amdgcn_fence(__ATOMIC_RELEASE, "agent");
            asm volatile("s_waitcnt vmcnt(0)" ::: "memory");
            const unsigned og = xb_add(&bar[XB_TOP], 1u);
            const unsigned tg = og / nx;
            if (og + 1u == (tg + 1u) * nx) xb_add(&bar[XB_TOPGEN], 1u);
            else XB_SPIN(xb_ld(&bar[XB_TOPGEN]) == tg, bar);
            __builtin_amdgcn_fence(__ATOMIC_ACQUIRE, "agent");
            xb_add(&bar[XB_XGEN(b.x)], 1u);
            asm volatile("s_waitcnt vmcnt(0)" ::: "memory");
        } else {
            XB_SPIN(xb_ld(&bar[XB_XGEN(b.x)]) == gen, bar);
            __builtin_amdgcn_fence(__ATOMIC_ACQUIRE, "agent");
            asm volatile("s_waitcnt vmcnt(0)" ::: "memory");
        }
    }
    __syncthreads();
}

__device__ __forceinline__ size_t sblk(int r, int c) { return ((size_t)(r >> 4) * 32 + (c >> 5)) * 512 + (r & 15) * 32 + (c & 31); }
namespace g8 {
constexpr int BM = 256, BK = 64, HALF = 128, HTB = HALF * BK * 2, STAGE_BYTES = 8 * HTB, NXCD = 8, WGM = 8;
__host__ __device__ __forceinline__ int lds_byte(int r, int c) { const int st = (r >> 4) * 2 + (c >> 5), rr = r & 15, cc = c & 31, ob = rr * 64 + cc * 2; return st * 1024 + (ob ^ (((ob >> 9) & 1) << 5)); }
__host__ __device__ __forceinline__ void stage_rc(int b, int& R, int& C) { const int st = b / 1024, sb = b % 1024, swz = sb ^ (((sb >> 9) & 1) << 5); R = (st >> 1) * 16 + swz / 64; C = (st & 1) * 32 + (swz % 64) / 2; }
__host__ __device__ __forceinline__ int perm32(int rho) { const int n = rho >> 4, i = rho & 15; return 8 * (i >> 2) + 4 * n + (i & 3); }
struct Unit { int pm, pn, x0, x1; };
template <class E, class = void> struct has_pre { static constexpr bool value = false; };
template <class E> struct has_pre<E, decltype((void)E::PRE)> { static constexpr bool value = true; };
__device__ __forceinline__ bool static_order(int i, int G, int c, int nM, int nN, int& pm, int& pn) {
    const int nwg = nM * nN; const long L = (long)i * G + c; if (L >= nwg) return false;
    int wgid = (int)L; { const int q = nwg / NXCD, r = nwg % NXCD, xcd = wgid % NXCD, off = wgid / NXCD; wgid = (xcd < r ? xcd * (q + 1) : r * (q + 1) + (xcd - r) * q) + off; }
    const int nig = WGM * nN, gid = wgid / nig, fm = gid * WGM, gsz = (nM - fm) < WGM ? (nM - fm) : WGM;
    pm = fm + ((wgid % nig) % gsz); pn = (wgid % nig) / gsz; return true;
}

template <class Prob, class Epi, bool ALIGN_EPI = true>
__device__ __forceinline__ void gemm_phase(LAS unsigned char* lds, const Prob& P, const Epi& E, int wave_id) {
    int tid_; asm volatile("v_mbcnt_lo_u32_b32 %0, -1, 0\n\tv_mbcnt_hi_u32_b32 %0, -1, %0" : "=v"(tid_)); tid_ += wave_id * 64;
    const int tid = tid_, wid = __builtin_amdgcn_readfirstlane(tid >> 6), lane = tid & 63, wr = wid >> 2, wc = wid & 3, fr = lane & 15, fq = lane >> 4;
    const int nt = P.nt;
    unsigned voffA[2], voffB[2]; int Rr0 = 0; unsigned voffC = 0;
#pragma unroll
    for (int i = 0; i < 2; ++i) { int R, C; stage_rc(tid * 16 + i * 8192, R, C); const int Rb = R; static_assert(Epi::PERM, "the stored weight order assumes the permuted (8 consecutive columns per lane) accumulator layout");
        voffA[i] = P.ablk ? (unsigned)(((R >> 4) * (P.lda >> 5) + (C >> 5)) * 1024 + ((R & 15) * 32 + (C & 31)) * 2) : (unsigned)(R * P.lda + C) * 2u;
        voffB[i] = (unsigned)(((Rb >> 4) * (P.ldb >> 5) + (C >> 5)) * 1024 + ((Rb & 15) * 32 + (C & 31)) * 2);
        if (i == 0) { Rr0 = R; voffC = (unsigned)((C >> 5) * 1024 + (C & 31) * 2); } }
    const size_t kstep = (P.ablk || Prob::GATHER) ? (size_t)2048 : (size_t)(BK * 2);
    const size_t hstepA = (size_t)HALF * P.lda * 2, hstepB = (size_t)HALF * P.ldb * 2;
    const unsigned ldsw = (unsigned)wid * 1024u;
    const int aoff = lds_byte(wr * 64 + fr, fq * 8), boff = lds_byte(wc * 32 + fr, fq * 8);
#define G8_SA(b, h) (((b) * 2 + (h)) * HTB)
#define G8_SB(b, h) ((4 + (b) * 2 + (h)) * HTB)
#define G8_STAGE(bufoff, gbase, voff) do { _Pragma("unroll") for (int _i = 0; _i < 2; ++_i) \
        __builtin_amdgcn_global_load_lds((const GAS unsigned*)((const GAS char*)(gbase) + (voff)[_i]), (LAS unsigned*)(lds + (bufoff) + ldsw + _i * 8192), 16, 0, 0); } while (0)
#define G8_STAGE_A(bufoff, h, kb, NX) do { if constexpr (Prob::GATHER) { const unsigned pk_ = (NX) ? gAn[h] : gAc[h]; const unsigned t0_ = pk_ & 0xffffu, t1_ = pk_ >> 16; const unsigned vo_[2] = {(t0_ >> 4) * 32768u + (t0_ & 15u) * 64u + voffC, (t1_ >> 4) * 32768u + (t1_ & 15u) * 64u + voffC};     \
        G8_STAGE(bufoff, P.a_base() + (kb), vo_); } \
        else { G8_STAGE(bufoff, ((NX) ? nA : cA) + (h) * hstepA + (kb), voffA); } } while (0)
#define G8_LDA(dst, b, h) do { _Pragma("unroll") for (int m = 0; m < 4; ++m) _Pragma("unroll") for (int k = 0; k < 2; ++k) dst[m][k] = *(const LAS bf16x8*)(lds + G8_SA(b, h) + aoff + m * 2048 + k * 1024); } while (0)
#define G8_LDB(dst, b, h) do { _Pragma("unroll") for (int n = 0; n < 2; ++n) _Pragma("unroll") for (int k = 0; k < 2; ++k) dst[n][k] = *(const LAS bf16x8*)(lds + G8_SB(b, h) + boff + n * 2048 + k * 1024); } while (0)
#define G8_MMA(ai, bj, At, Bt) do { __builtin_amdgcn_s_setprio(1); _Pragma("unroll") for (int m = 0; m < 4; ++m) _Pragma("unroll") for (int n = 0; n < 2; ++n) _Pragma("unroll") for (int k = 0; k < 2; ++k) \
        acc[ai][bj][m][n] = __builtin_amdgcn_mfma_f32_16x16x32_bf16(Bt[n][k], At[m][k], acc[ai][bj][m][n], 0, 0, 0); __builtin_amdgcn_s_setprio(0); } while (0)
#define G8_WAIT_V(n) asm volatile("s_waitcnt vmcnt(" #n ")" ::: "memory")
#define G8_WAIT_L(n) asm volatile("s_waitcnt lgkmcnt(" #n ")" ::: "memory")
#define G8_BAR __builtin_amdgcn_s_barrier()
#define G8_SCHED __builtin_amdgcn_sched_barrier(0)
    Unit cur, nxt; int ui = 0;
    if (!P.next(0, cur)) return;
    f32x4 acc[2][2][4][2];
#pragma unroll
    for (int a = 0; a < 2; ++a)
#pragma unroll
        for (int b = 0; b < 2; ++b)
#pragma unroll
            for (int m = 0; m < 4; ++m)
#pragma unroll
                for (int n = 0; n < 2; ++n) acc[a][b][m][n] = (f32x4){0.f, 0.f, 0.f, 0.f};
    bf16x8 At[4][2], B0[2][2], B1[2][2];
    unsigned gAc[2], gAn[2];
    const GAS char* cA = nullptr; const GAS char* nA = nullptr;
    if constexpr (Prob::GATHER) { P.gather(cur, Rr0, gAc); } else { cA = P.a_tile(cur); }
    if constexpr (has_pre<Epi>::value) E.first(cur, tid);
    {
        const GAS char* b0 = P.b_ptr(cur, 0); const GAS char* b1 = P.b_ptr(cur, 1);
        G8_STAGE(G8_SB(0, 0), b0, voffB); G8_STAGE(G8_SB(0, 1), b0 + hstepB, voffB); G8_STAGE_A(G8_SA(0, 0), 0, 0, false); G8_STAGE_A(G8_SA(0, 1), 1, 0, false);
        if (wr == 1) G8_BAR;
        G8_WAIT_V(2); G8_BAR;
        G8_STAGE(G8_SB(1, 0), b1, voffB); G8_STAGE_A(G8_SA(1, 0), 0, kstep, false); G8_STAGE(G8_SB(1, 1), b1 + hstepB, voffB);
        G8_WAIT_V(6); G8_BAR;
    }
    for (;;) {
        const bool has_next = P.next(ui + 1, nxt);
        if (!has_next) nxt = cur;
        if constexpr (Prob::GATHER) { if (has_next) P.gather(nxt, Rr0, gAn); else { gAn[0] = gAc[0]; gAn[1] = gAc[1]; } }
        else { nA = P.a_tile(nxt); }
        for (int t = 0; t < nt; t += 2) {
            const bool last = (t == nt - 2);
            const size_t a1k = (size_t)(t + 1) * kstep;
            const size_t a2k = last ? 0 : (size_t)(t + 2) * kstep, a3k = last ? kstep : (size_t)(t + 3) * kstep;
            const GAS char* b2 = last ? P.b_ptr(nxt, 0) : P.b_ptr(cur, t + 2); const GAS char* b3 = last ? P.b_ptr(nxt, 1) : P.b_ptr(cur, t + 3);
            G8_LDB(B0, 0, 0); G8_LDB(B1, 0, 1); G8_SCHED; G8_LDA(At, 0, 0); G8_STAGE_A(G8_SA(1, 1), 1, a1k, false);
            G8_WAIT_V(8); G8_WAIT_L(0); G8_BAR; G8_MMA(0, 0, At, B0); G8_MMA(0, 1, At, B1); G8_BAR; G8_SCHED;
            G8_LDA(At, 0, 1); G8_STAGE(G8_SB(0, 0), b2, voffB); G8_STAGE(G8_SB(0, 1), b2 + hstepB, voffB);
            if (last) { G8_STAGE_A(G8_SA(0, 0), 0, a2k, true); } else { G8_STAGE_A(G8_SA(0, 0), 0, a2k, false); }
            G8_WAIT_V(8); G8_WAIT_L(0); G8_BAR; G8_MMA(1, 0, At, B0); G8_MMA(1, 1, At, B1); G8_BAR; G8_SCHED;
            G8_LDB(B0, 1, 0); G8_LDB(B1, 1, 1); G8_SCHED; G8_LDA(At, 1, 0);
            if (last) { G8_STAGE_A(G8_SA(0, 1), 1, a2k, true); } else { G8_STAGE_A(G8_SA(0, 1), 1, a2k, false); }
            G8_WAIT_V(8); G8_WAIT_L(0); G8_BAR; G8_MMA(0, 0, At, B0); G8_MMA(0, 1, At, B1); G8_BAR; G8_SCHED;
            G8_LDA(At, 1, 1); G8_STAGE(G8_SB(1, 0), b3, voffB); G8_STAGE(G8_SB(1, 1), b3 + hstepB, voffB);
            if (last) { G8_STAGE_A(G8_SA(1, 0), 0, a3k, true); } else { G8_STAGE_A(G8_SA(1, 0), 0, a3k, false); }
            G8_WAIT_V(8); G8_WAIT_L(0); G8_BAR; G8_MMA(1, 0, At, B0); G8_MMA(1, 1, At, B1); G8_BAR; G8_SCHED;
        }
        if constexpr (ALIGN_EPI) { if (wr == 0) G8_BAR; }
        { int l2_; asm volatile("v_mbcnt_lo_u32_b32 %0, -1, 0\n\tv_mbcnt_hi_u32_b32 %0, -1, %0" : "=v"(l2_)); if constexpr (has_pre<Epi>::value) E(acc, cur, nxt, has_next, ui, wr, wc, l2_ & 15, l2_ >> 4); else E(acc, cur, wr, wc, l2_ & 15, l2_ >> 4); }
        if (!has_next) break;
#pragma unroll
        for (int a = 0; a < 2; ++a)
#pragma unroll
            for (int b = 0; b < 2; ++b)
#pragma unroll
                for (int m = 0; m < 4; ++m)
#pragma unroll
                    for (int n = 0; n < 2; ++n) acc[a][b][m][n] = (f32x4){0.f, 0.f, 0.f, 0.f};
        cur = nxt; ++ui;
        if constexpr (Prob::GATHER) { gAc[0] = gAn[0]; gAc[1] = gAn[1]; }
        else { cA = nA; }
        if constexpr (ALIGN_EPI) { if (wr == 1) G8_BAR; }
    }
    G8_WAIT_V(0);
    if constexpr (!ALIGN_EPI) { if (wr == 0) G8_BAR; }
    G8_BAR;
#undef G8_SA
#undef G8_SB
#undef G8_STAGE
#undef G8_STAGE_A
#undef G8_LDA
#undef G8_LDB
#undef G8_MMA
#undef G8_WAIT_V
#undef G8_WAIT_L
#undef G8_BAR
#undef G8_SCHED
}

struct ProbPlain {
    static constexpr bool GATHER = false;
    const GAS bf16_t* A; const GAS bf16_t* Bt; int lda, ldb, nt, nM, nN, G, c; int ablk = 0;
    __device__ __forceinline__ bool next(int i, Unit& u) const { u.x0 = 0; u.x1 = 0; return static_order(i, G, c, nM, nN, u.pm, u.pn); }
    __device__ __forceinline__ const GAS char* a_tile(const Unit& u) const { return (const GAS char*)A + (size_t)u.pm * BM * lda * 2; }
    __device__ __forceinline__ const GAS char* a_base() const { return (const GAS char*)A; }
    __device__ __forceinline__ void gather(const Unit&, int, unsigned (&)[2]) const {}
    __device__ __forceinline__ const GAS char* b_ptr(const Unit& u, int t) const { return (const GAS char*)Bt + (size_t)u.pn * BM * ldb * 2 + (size_t)t * 2048; }
};
struct ProbMoeGU {
    static constexpr bool GATHER = true;
    const GAS bf16_t* A; const GAS bf16_t* Bt; const GAS i32x4* elist; const LAS int* tab; int lda, ldb, nt, G, c; static constexpr int ablk = 0;
    __device__ __forceinline__ bool next(int i, Unit& u) const {
        const int total = tab[TB_ECUM + NE]; const long L = (long)i * G + c; if (L >= total) return false;
        int wgid = (int)L; { const int q = total / NXCD, r = total % NXCD, xcd = wgid % NXCD, off = wgid / NXCD; wgid = (xcd < r ? xcd * (q + 1) : r * (q + 1) + (xcd - r) * q) + off; }
        int e = 0;
#pragma unroll
        for (int k = 1; k < NE; ++k) e += (wgid >= tab[TB_ECUM + k]) ? 1 : 0;
        const int loc = wgid - tab[TB_ECUM + e], nM = (tab[TB_ECUM + e + 1] - tab[TB_ECUM + e]) / 6;
        const int nig = WGM * 6, gid = loc / nig, fm = gid * WGM, gsz = (nM - fm) < WGM ? (nM - fm) : WGM;
        u.pm = fm + ((loc % nig) % gsz); u.pn = (loc % nig) / gsz; u.x0 = e; u.x1 = tab[TB_EOFF + e] + 256 * u.pm; return true;
    }
    __device__ __forceinline__ const GAS char* a_tile(const Unit&) const { return (const GAS char*)A; }
    __device__ __forceinline__ const GAS char* a_base() const { return (const GAS char*)A; }
    __device__ __forceinline__ void gather(const Unit& u, int R0, unsigned (&g)[2]) const {
#pragma unroll
        for (int h = 0; h < 2; ++h) { const int t0 = elist[u.x1 + h * HALF + R0].x, t1 = elist[u.x1 + h * HALF + R0 + 64].x; g[h] = (unsigned)t0 | ((unsigned)t1 << 16); }
    }
    __device__ __forceinline__ const GAS char* b_ptr(const Unit& u, int t) const { return (const GAS char*)Bt + (size_t)(u.x0 * 1536 + u.pn * BM) * ldb * 2 + (size_t)t * 2048; }
};
struct ProbMoeDown {
    static constexpr bool GATHER = false;
    const GAS bf16_t* A; const GAS bf16_t* Bt; const LAS int* tab; int lda, ldb, nt, G, c; static constexpr int ablk = 0;
    __device__ __forceinline__ bool next(int i, Unit& u) const {
        const int nM = tab[TB_NRT]; if (!static_order(i, G, c, nM, 4, u.pm, u.pn)) return false;
        const int p = tab[TB_RT2P + u.pm]; u.x0 = (p & 0xff) * DFE; u.x1 = ((p >> 8) & 0xff) * DFE; return true;
    }
    __device__ __forceinline__ const GAS char* a_tile(const Unit& u) const { return (const GAS char*)A + (size_t)u.pm * BM * lda * 2; }
    __device__ __forceinline__ const GAS char* a_base() const { return (const GAS char*)A; }
    __device__ __forceinline__ void gather(const Unit&, int, unsigned (&)[2]) const {}
    __device__ __forceinline__ const GAS char* b_ptr(const Unit& u, int t) const { const int ko = (t < 11) ? (u.x0 + t * BK) : (u.x1 + (t - 11) * BK); return (const GAS char*)Bt + (size_t)u.pn * BM * ldb * 2 + (size_t)(ko >> 5) * 1024; }
};

#define G8_ROWLOOP _Pragma("unroll") for (int ai = 0; ai < 2; ++ai) _Pragma("unroll") for (int m = 0; m < 4; ++m)
struct EpiBf16Split {
    static constexpr bool PERM = true;
    GAS bf16_t* O; int ldc; int split_cols; size_t split_stride;
    __device__ __forceinline__ void operator()(const f32x4 (&acc)[2][2][4][2], const Unit& u, int wr, int wc, int fr, int fq) const {
        const int row0 = u.pm * BM + wr * 64 + fr; int colt = u.pn * BM; GAS bf16_t* base = O;
        if (split_cols) { const int t = colt / split_cols; base += (size_t)t * split_stride; colt -= t * split_cols; }
        const int col0 = colt + wc * 32 + 8 * fq;
        G8_ROWLOOP { GAS bf16_t* blk = base + ((size_t)(u.pm * 16 + ai * 8 + wr * 4 + m) * (ldc >> 5) + (colt >> 5) + wc) * 512 + fr * 32 + 8 * fq;
#pragma unroll
            for (int bj = 0; bj < 2; ++bj) { const f32x4 v0 = acc[ai][bj][m][0], v1 = acc[ai][bj][m][1];
                u32x4 w; w.x = cvt_pk_bf16(v0[0], v0[1]); w.y = cvt_pk_bf16(v0[2], v0[3]); w.z = cvt_pk_bf16(v1[0], v1[1]); w.w = cvt_pk_bf16(v1[2], v1[3]);
                *(GAS u32x4*)(blk + bj * 4 * 512) = w; } }
        (void)row0; (void)col0;
    }
};
struct EpiResid {
    static constexpr bool PERM = false;
    const GAS float* rin; GAS float* out;
    __device__ __forceinline__ void operator()(const f32x4 (&acc)[2][2][4][2], const Unit& u, int wr, int wc, int fr, int fq) const {
        const int row0 = u.pm * BM + wr * 64 + fr, col0 = u.pn * BM + wc * 32 + 4 * fq;
        G8_ROWLOOP { const size_t off = (size_t)(row0 + ai * HALF + m * 16) * DM + col0;
#pragma unroll
            for (int bj = 0; bj < 2; ++bj)
#pragma unroll
                for (int n = 0; n < 2; ++n) { const f32x4 r = *(const GAS f32x4*)(rin + off + bj * HALF + n * 16); *(GAS f32x4*)(out + off + bj * HALF + n * 16) = r * ALPHA + acc[ai][bj][m][n]; }
            asm volatile("" ::: "memory"); }
    }
};
struct EpiSwiglu {
    static constexpr bool PERM = true;
    GAS bf16_t* H; int ldh;
    __device__ __forceinline__ void operator()(const f32x4 (&acc)[2][2][4][2], const Unit& u, int wr, int wc, int fr, int fq) const {
        const int row0 = u.pm * BM + wr * 64 + fr, col0 = u.pn * HALF + wc * 32 + 8 * fq;
        G8_ROWLOOP { u32x4 w; unsigned ww[4];
#pragma unroll
            for (int n = 0; n < 2; ++n) { const f32x4 g = acc[ai][0][m][n], uu = acc[ai][1][m][n]; float hv[4];
#pragma unroll
                for (int i = 0; i < 4; ++i) hv[i] = g[i] * sigmoid_f(g[i]) * uu[i];
                ww[2 * n] = cvt_pk_bf16(hv[0], hv[1]); ww[2 * n + 1] = cvt_pk_bf16(hv[2], hv[3]); }
            w.x = ww[0]; w.y = ww[1]; w.z = ww[2]; w.w = ww[3];
            *(GAS u32x4*)(H + ((size_t)(u.pm * 16 + ai * 8 + wr * 4 + m) * (ldh >> 5) + (u.pn * 4 + wc)) * 512 + fr * 32 + 8 * fq) = w; }
    }
};
struct EpiGate {
    static constexpr bool PERM = true;
    GAS bf16_t* O;
    __device__ __forceinline__ void operator()(const f32x4 (&acc)[2][2][4][2], const Unit& u, int wr, int wc, int fr, int fq) const {
        const int row0 = u.pm * BM + wr * 64 + fr, col0 = u.pn * BM + wc * 32 + 8 * fq;
        G8_ROWLOOP { GAS bf16_t* rowp = O + (size_t)(row0 + ai * HALF + m * 16) * DM + col0;
#pragma unroll
            for (int bj = 0; bj < 2; ++bj) { const f32x4 v0 = acc[ai][bj][m][0], v1 = acc[ai][bj][m][1];
                u32x4 w; w.x = cvt_pk_bf16(sigmoid_f(v0[0]), sigmoid_f(v0[1])); w.y = cvt_pk_bf16(sigmoid_f(v0[2]), sigmoid_f(v0[3]));
                w.z = cvt_pk_bf16(sigmoid_f(v1[0]), sigmoid_f(v1[1])); w.w = cvt_pk_bf16(sigmoid_f(v1[2]), sigmoid_f(v1[3]));
                *(GAS u32x4*)(rowp + bj * HALF) = w; } }
    }
};
struct EpiPle {
    static constexpr bool PERM = true;
    GAS float* res; GAS bf16_t* XG;
    __device__ __forceinline__ void operator()(const f32x4 (&acc)[2][2][4][2], const Unit& u, int wr, int wc, int fr, int fq) const {
        const int row0 = u.pm * BM + wr * 64 + fr, col0 = u.pn * BM + wc * 32 + 8 * fq;
        G8_ROWLOOP { const size_t off = (size_t)(row0 + ai * HALF + m * 16) * DM + col0;
#pragma unroll
            for (int bj = 0; bj < 2; ++bj)
#pragma unroll
                for (int n = 0; n < 2; ++n) { const u32x2 gw = *(const GAS u32x2*)(XG + off + bj * HALF + 4 * n); const f32x4 r = *(const GAS f32x4*)(res + off + bj * HALF + 4 * n); const f32x4 a = acc[ai][bj][m][n]; f32x4 o;
                    o[0] = r[0] + a[0] * __builtin_bit_cast(float, gw.x << 16); o[1] = r[1] + a[1] * __builtin_bit_cast(float, gw.x & 0xffff0000u);
                    o[2] = r[2] + a[2] * __builtin_bit_cast(float, gw.y << 16); o[3] = r[3] + a[3] * __builtin_bit_cast(float, gw.y & 0xffff0000u);
                    *(GAS f32x4*)(res + off + bj * HALF + 4 * n) = o; u32x2 w; w.x = cvt_pk_bf16(o[0], o[1]); w.y = cvt_pk_bf16(o[2], o[3]); *(GAS u32x2*)(XG + off + bj * HALF + 4 * n) = w;
                    asm volatile("" ::: "memory"); } }
    }
};
struct EpiMoeGU {
    static constexpr bool PERM = true;
    static constexpr bool PRE = true;
    GAS bf16_t* HS; const GAS i32x4* elist; const GAS float* egate; LAS float* tbl;
    __device__ __forceinline__ void fetch(const Unit& u, int t, int& d, float& g) const { d = ((const GAS int*)(elist + u.x1 + t))[1]; g = egate[u.x1 + t]; }
    __device__ __forceinline__ void park(int buf, int t, int d, float g) const { LAS float* p = tbl + (buf * 256 + t) * 2; p[0] = __builtin_bit_cast(float, d); p[1] = g; }
    __device__ __forceinline__ void first(const Unit& u, int tid) const { if (tid < 256) { int d; float g; fetch(u, tid, d, g); park(0, tid, d, g); } }
    __device__ __forceinline__ void operator()(const f32x4 (&acc)[2][2][4][2], const Unit& u, const Unit& nx, bool has_next, int ui, int wr, int wc, int fr, int fq) const {
        const int j0 = u.pn * HALF + wc * 32 + 8 * fq; const bool colok = j0 < DFE;
        const int tid = (wr * 4 + wc) * 64 + fr + 16 * fq; int nd = 0; float ng = 0.f;
        if (has_next && tid < 256) fetch(nx, tid, nd, ng);
        const LAS float* cur = tbl + (ui & 1) * 512;
        G8_ROWLOOP { const f32x2 mg = *(const LAS f32x2*)(cur + (ai * HALF + wr * 64 + m * 16 + fr) * 2); const int dy = __builtin_bit_cast(int, mg[0]); const float gate = mg[1];
            if (colok && dy >= 0) { u32x4 w; unsigned ww[4];
#pragma unroll
                for (int n = 0; n < 2; ++n) { const f32x4 g = acc[ai][0][m][n], uu = acc[ai][1][m][n]; float hv[4];
#pragma unroll
                    for (int i = 0; i < 4; ++i) hv[i] = gate * g[i] * sigmoid_f(g[i]) * uu[i];
                    ww[2 * n] = cvt_pk_bf16(hv[0], hv[1]); ww[2 * n + 1] = cvt_pk_bf16(hv[2], hv[3]); }
                w.x = ww[0]; w.y = ww[1]; w.z = ww[2]; w.w = ww[3];
                *(GAS u32x4*)(HS + (size_t)dy + j0) = w; } }
        if (has_next && tid < 256) park((ui + 1) & 1, tid, nd, ng);
    }
};
struct EpiMoeDown {
    static constexpr bool PERM = false;
    GAS float* res; const GAS int* plist;
    __device__ __forceinline__ void operator()(const f32x4 (&acc)[2][2][4][2], const Unit& u, int wr, int wc, int fr, int fq) const {
        const int col0 = u.pn * BM + wc * 32 + 4 * fq;
        G8_ROWLOOP { const int tok = plist[u.pm * BM + ai * HALF + wr * 64 + m * 16 + fr];
            if (tok >= 0) { const size_t off = (size_t)tok * DM + col0;
#pragma unroll
                for (int bj = 0; bj < 2; ++bj)
#pragma unroll
                    for (int n = 0; n < 2; ++n) { const f32x4 r = *(const GAS f32x4*)(res + off + bj * HALF + n * 16); *(GAS f32x4*)(res + off + bj * HALF + n * 16) = r * ALPHA + acc[ai][bj][m][n]; } }
            asm volatile("" ::: "memory"); }
    }
};
__device__ __forceinline__ void unpack8(const u32x4 w, float (&x)[8]) {
    x[0] = __builtin_bit_cast(float, w.x << 16); x[1] = __builtin_bit_cast(float, w.x & 0xffff0000u); x[2] = __builtin_bit_cast(float, w.y << 16); x[3] = __builtin_bit_cast(float, w.y & 0xffff0000u);
    x[4] = __builtin_bit_cast(float, w.z << 16); x[5] = __builtin_bit_cast(float, w.z & 0xffff0000u); x[6] = __builtin_bit_cast(float, w.w << 16); x[7] = __builtin_bit_cast(float, w.w & 0xffff0000u); }
__device__ __forceinline__ void ln_row(const GAS float* st, size_t row, float& rs, float& rm) {
    const f32x4 p0 = *(const GAS f32x4*)(st + row * 8), p1 = *(const GAS f32x4*)(st + row * 8 + 4);
    const float mean = ((p0[0] + p0[2]) + (p1[0] + p1[2])) * (1.f / DM), ex2 = ((p0[1] + p0[3]) + (p1[1] + p1[3])) * (1.f / DM);
    rs = __builtin_amdgcn_rsqf(fmaxf(ex2 - mean * mean, 0.f) + LN_EPS); rm = rs * mean; }
__device__ __forceinline__ void stats_row(float s_, float q_, LAS float* xch, int rl, int wc, int fr, int fq) {
    const int lane = fr + 16 * fq;
    s_ = xsum32(xsum16(s_)); q_ = xsum32(xsum16(q_)); (void)lane;
    if (fq == 0) *(LAS f32x2*)(xch + (rl * 4 + wc) * 2) = (f32x2){s_, q_}; }
__device__ __forceinline__ void stats_flush(LAS float* xch, GAS float* st, const GAS int* plist, int rowbase, int pn, int wr, int wc, int fr, int fq) {
    asm volatile("s_waitcnt lgkmcnt(0)" ::: "memory"); __builtin_amdgcn_s_barrier();
    if (wc < 2) { const int rl = wc * HALF + wr * 64 + fr + 16 * fq; const f32x4 p0 = *(const LAS f32x4*)(xch + rl * 8), p1 = *(const LAS f32x4*)(xch + rl * 8 + 4);
        int grow = rowbase + rl; if (plist) grow = plist[grow];
        if (grow >= 0) *(GAS f32x2*)(st + ((size_t)grow * 4 + pn) * 2) = (f32x2){(p0[0] + p0[2]) + (p1[0] + p1[2]), (p0[1] + p0[3]) + (p1[1] + p1[3])}; }
}
template <bool STATS>
__device__ __forceinline__ u32x4 resid8(const u32x4 xin, const f32x4 a0, const f32x4 a1, f32x2& s2, f32x2& q2) {
    u32x4 w; f32x2 y;
#define G8_R2(word, lo, hi) y = (f32x2){__builtin_bit_cast(float, xin.word << 16), __builtin_bit_cast(float, xin.word & 0xffff0000u)} * ALPHA + (f32x2){lo, hi}; \
        if constexpr (STATS) { s2 += y; q2 += y * y; } w.word = cvt_pk_bf16(y[0], y[1]);
    G8_R2(x, a0[0], a0[1]) G8_R2(y, a0[2], a0[3]) G8_R2(z, a1[0], a1[1]) G8_R2(w, a1[2], a1[3])
#undef G8_R2
    return w; }
template <bool STATS>
struct EpiResidB {
    static constexpr bool PERM = true;
    GAS bf16_t* S; GAS float* st; LAS float* xch;
    __device__ __forceinline__ void operator()(const f32x4 (&acc)[2][2][4][2], const Unit& u, int wr, int wc, int fr, int fq) const {
        const int row0 = u.pm * BM + wr * 64 + fr, col0 = u.pn * BM + wc * 32 + 8 * fq;
        GAS bf16_t* base = S + sblk(row0, col0);
        u32x4 n0 = *(const GAS u32x4*)(base), n1 = *(const GAS u32x4*)(base + 4 * 512);
#pragma unroll
        for (int r = 0; r < 8; ++r) { const int ai = r >> 2, m = r & 3; GAS bf16_t* rowp = base + (size_t)(ai * 8 + m) * 32 * 512; const u32x4 c0 = n0, c1 = n1;
            if (r < 7) { GAS bf16_t* nxp = base + (size_t)(((r + 1) >> 2) * 8 + ((r + 1) & 3)) * 32 * 512; n0 = *(const GAS u32x4*)(nxp); n1 = *(const GAS u32x4*)(nxp + 4 * 512); }
            asm volatile("" ::: "memory");
            f32x2 s2 = (f32x2){0.f, 0.f}, q2 = s2;
            *(GAS u32x4*)(rowp) = resid8<STATS>(c0, acc[ai][0][m][0], acc[ai][0][m][1], s2, q2); *(GAS u32x4*)(rowp + 4 * 512) = resid8<STATS>(c1, acc[ai][1][m][0], acc[ai][1][m][1], s2, q2);
            if constexpr (STATS) stats_row(s2[0] + s2[1], q2[0] + q2[1], xch, ai * HALF + wr * 64 + m * 16 + fr, wc, fr, fq);
            asm volatile("" ::: "memory"); }
        if constexpr (STATS) stats_flush(xch, st, (const GAS int*)nullptr, u.pm * BM, u.pn, wr, wc, fr, fq);
    }
};
struct EpiMoeDownB {
    static constexpr bool PERM = true;
    GAS bf16_t* S; const GAS int* plist; GAS float* st; LAS float* xch;
    __device__ __forceinline__ void operator()(const f32x4 (&acc)[2][2][4][2], const Unit& u, int wr, int wc, int fr, int fq) const {
        const int col0 = u.pn * BM + wc * 32 + 8 * fq;
        int tok[8];
#pragma unroll
        for (int r = 0; r < 8; ++r) tok[r] = plist[u.pm * BM + (r >> 2) * HALF + wr * 64 + (r & 3) * 16 + fr];
        u32x4 n0 = (u32x4){0u, 0u, 0u, 0u}, n1 = n0;
        if (tok[0] >= 0) { const GAS bf16_t* p = S + sblk(tok[0], col0); n0 = *(const GAS u32x4*)(p); n1 = *(const GAS u32x4*)(p + 4 * 512); }
#pragma unroll
        for (int r = 0; r < 8; ++r) { const int ai = r >> 2, m = r & 3; const u32x4 c0 = n0, c1 = n1;
            if (r < 7) { if (tok[r + 1] >= 0) { const GAS bf16_t* p = S + sblk(tok[r + 1], col0); n0 = *(const GAS u32x4*)(p); n1 = *(const GAS u32x4*)(p + 4 * 512); } }
            asm volatile("" ::: "memory");
            f32x2 s2 = (f32x2){0.f, 0.f}, q2 = s2;
            if (tok[r] >= 0) { GAS bf16_t* rowp = S + sblk(tok[r], col0);
                *(GAS u32x4*)(rowp) = resid8<true>(c0, acc[ai][0][m][0], acc[ai][0][m][1], s2, q2); *(GAS u32x4*)(rowp + 4 * 512) = resid8<true>(c1, acc[ai][1][m][0], acc[ai][1][m][1], s2, q2); }
            stats_row(s2[0] + s2[1], q2[0] + q2[1], xch, ai * HALF + wr * 64 + m * 16 + fr, wc, fr, fq);
            asm volatile("" ::: "memory"); }
        stats_flush(xch, st, plist, u.pm * BM, u.pn, wr, wc, fr, fq);
    }
};
struct EpiStoreB {
    static constexpr bool PERM = true;
    GAS bf16_t* O;
    __device__ __forceinline__ void operator()(const f32x4 (&acc)[2][2][4][2], const Unit& u, int wr, int wc, int fr, int fq) const {
        const int row0 = u.pm * BM + wr * 64 + fr, col0 = u.pn * BM + wc * 32 + 8 * fq;
        G8_ROWLOOP { GAS bf16_t* blk = O + ((size_t)(u.pm * 16 + ai * 8 + wr * 4 + m) * 32 + u.pn * 8 + wc) * 512 + fr * 32 + 8 * fq;
#pragma unroll
            for (int bj = 0; bj < 2; ++bj) { const f32x4 v0 = acc[ai][bj][m][0], v1 = acc[ai][bj][m][1];
                u32x4 w; w.x = cvt_pk_bf16(v0[0], v0[1]); w.y = cvt_pk_bf16(v0[2], v0[3]); w.z = cvt_pk_bf16(v1[0], v1[1]); w.w = cvt_pk_bf16(v1[2], v1[3]);
                *(GAS u32x4*)(blk + bj * 4 * 512) = w; }
            asm volatile("" ::: "memory"); }
        (void)row0; (void)col0;
    }
};
struct EpiGatePleLN {
    static constexpr bool PERM = true;
    const GAS bf16_t* S; GAS bf16_t* XG; GAS float* out32; const GAS float* st; const GAS float* cs; const GAS float* bw; const GAS float* lg; const GAS float* lb; LAS float* xch; const GAS bf16_t* PP;
    __device__ __forceinline__ void operator()(const f32x4 (&acc)[2][2][4][2], const Unit& u, int wr, int wc, int fr, int fq) const {
        const int row0 = u.pm * BM + wr * 64 + fr, col0 = u.pn * BM + wc * 32 + 8 * fq;
        const size_t base = (size_t)row0 * DM + col0;
        const size_t pbase = ((size_t)(u.pm * 16 + wr * 4) * 32 + u.pn * 8 + wc) * 512 + fr * 32 + 8 * fq;
        u32x4 nx = *(const GAS u32x4*)(S + pbase), np = *(const GAS u32x4*)(PP + pbase);
        if (wr == 0) { const int rl = wc * 64 + fr + 16 * fq; float rs, rm; ln_row(st, (size_t)u.pm * BM + rl, rs, rm); *(LAS f32x2*)(xch + rl * 2) = (f32x2){rs, rm}; }
        asm volatile("s_waitcnt lgkmcnt(0)" ::: "memory"); __builtin_amdgcn_s_barrier();
#pragma unroll
        for (int bj = 0; bj < 2; ++bj) {
            f32x4 c_[2], b_[2], g_[2], l_[2];
#pragma unroll
            for (int n = 0; n < 2; ++n) { const int cc = col0 + bj * HALF + 4 * n; c_[n] = *(const GAS f32x4*)(cs + cc); b_[n] = *(const GAS f32x4*)(bw + cc); g_[n] = *(const GAS f32x4*)(lg + cc); l_[n] = *(const GAS f32x4*)(lb + cc); }
#pragma unroll
            for (int r = 0; r < 8; ++r) { const int ai = r >> 2, m = r & 3, step = bj * 8 + r; const size_t off = base + (size_t)(ai * HALF + m * 16) * DM + bj * HALF;
                const u32x4 cx = nx, cp = np;
                if (step < 15) { const int s1 = step + 1; const size_t o1 = base + (size_t)(((s1 >> 2) & 1) * HALF + (s1 & 3) * 16) * DM + (s1 >> 3) * HALF; const size_t b1 = pbase + ((size_t)((((s1 >> 2) & 1) * 8 + (s1 & 3)) * 32 + (s1 >> 3) * 4)) * 512; nx = *(const GAS u32x4*)(S + b1); np = *(const GAS u32x4*)(PP + b1); (void)o1; }
                asm volatile("" ::: "memory");
                const f32x2 rr = *(const LAS f32x2*)(xch + (ai * HALF + wr * 64 + m * 16 + fr) * 2); const float rs = rr[0], rm = rr[1];
                float x[8], p[8]; unpack8(cx, x); unpack8(cp, p);
                f32x4 o[2];
#pragma unroll
                for (int n = 0; n < 2; ++n)
#pragma unroll
                    for (int i = 0; i < 4; ++i) { const float z = sigmoid_f(rs * acc[ai][bj][m][n][i] - rm * c_[n][i] + b_[n][i]); const float gm = g_[n][i];
                        o[n][i] = (x[4 * n + i] * (rs * gm) + (l_[n][i] - rm * gm)) + p[4 * n + i] * z; }
                u32x4 w; w.x = cvt_pk_bf16(o[0][0], o[0][1]); w.y = cvt_pk_bf16(o[0][2], o[0][3]); w.z = cvt_pk_bf16(o[1][0], o[1][1]); w.w = cvt_pk_bf16(o[1][2], o[1][3]);
                if (out32) { *(GAS f32x4*)(out32 + off) = o[0]; *(GAS f32x4*)(out32 + off + 4) = o[1]; }
                else *(GAS u32x4*)(XG + pbase + ((size_t)((ai * 8 + m) * 32 + bj * 4)) * 512) = w;
                asm volatile("" ::: "memory"); } }
    }
};
struct EpiPleB {
    static constexpr bool PERM = true;
    const GAS bf16_t* S; GAS bf16_t* XG; GAS float* out32;
    __device__ __forceinline__ void operator()(const f32x4 (&acc)[2][2][4][2], const Unit& u, int wr, int wc, int fr, int fq) const {
        const int row0 = u.pm * BM + wr * 64 + fr, col0 = u.pn * BM + wc * 32 + 8 * fq;
        G8_ROWLOOP { const size_t off = (size_t)(row0 + ai * HALF + m * 16) * DM + col0;
#pragma unroll
            for (int bj = 0; bj < 2; ++bj) { float x[8], g[8]; unpack8(*(const GAS u32x4*)(S + off + bj * HALF), x); unpack8(*(const GAS u32x4*)(XG + off + bj * HALF), g);
                const f32x4 a0 = acc[ai][bj][m][0], a1 = acc[ai][bj][m][1]; f32x4 o0, o1;
#pragma unroll
                for (int i = 0; i < 4; ++i) { o0[i] = x[i] + a0[i] * g[i]; o1[i] = x[4 + i] + a1[i] * g[4 + i]; }
                u32x4 w; w.x = cvt_pk_bf16(o0[0], o0[1]); w.y = cvt_pk_bf16(o0[2], o0[3]); w.z = cvt_pk_bf16(o1[0], o1[1]); w.w = cvt_pk_bf16(o1[2], o1[3]);
                *(GAS u32x4*)(XG + off + bj * HALF) = w;
                if (out32) { *(GAS f32x4*)(out32 + off + bj * HALF) = o0; *(GAS f32x4*)(out32 + off + bj * HALF + 4) = o1; }
                asm volatile("" ::: "memory"); } }
    }
};
}

struct Frame {
    LAS unsigned char* lds; GAS unsigned* ctl; GAS unsigned char* ws; GAS float* res;
    int wave, vcu, G;
    __device__ __forceinline__ int lane_id() const { int l; asm volatile("v_mbcnt_lo_u32_b32 %0, -1, 0\n\tv_mbcnt_hi_u32_b32 %0, -1, %0" : "=v"(l)); return l; }
    __device__ __forceinline__ int tid_id() const { return wave * 64 + lane_id(); }
};
__device__ __forceinline__ GAS bf16_t* xb_ptr(const Frame& F, int which) { return (GAS bf16_t*)(F.ws + (which ? WS_XB1 : WS_XB0)); }

struct Job { int in_idx, Ns, nkb, n0, nblk, ldd, drow0, dk0, split, item0, ln, cs, vperm; float scale; long long src_off, dst_off; };
constexpr int NJOBS = 58;
struct JobTable { Job j[NJOBS]; int total; int njobs; };
constexpr JobTable make_jobs() {
    JobTable t{}; int n = 0, items = 0;
    auto add = [&](int in_idx, long long src_off, int Ns, int K, int n0, int ncols, long long dst_byte, int ldd, int drow0, int dk0, int split, float scale, int ln = -1, int cs = 0, int vperm = 0) {
        Job& j = t.j[n++]; j.ln = ln; j.cs = cs; j.vperm = vperm; j.in_idx = in_idx; j.src_off = src_off; j.Ns = Ns; j.nkb = K / 64; j.n0 = n0; j.nblk = ncols / 32; j.dst_off = dst_byte; j.ldd = ldd; j.drow0 = drow0; j.dk0 = dk0; j.split = split; j.scale = scale;
        j.item0 = items; items += j.nkb * j.nblk; };
    const long long WD = (long long)WS_WDEAD, WL = (long long)WS_WLIVE;
    const float QS = 0.0625f;
    for (int i = 0; i < 2; ++i) { const long long q = WD + 2 * (long long)(i ? WD_QKV1 : WD_QKV0), o = WD + 2 * (long long)(i ? WD_O1 : WD_O0);
        add(IN_AQKV, (long long)i * 1024 * 3072, 3072, 1024, 0, 1024, q, 1024, 0, 0, 0, QS);
        add(IN_AQKV, (long long)i * 1024 * 3072, 3072, 1024, 1024, 1024, q, 1024, 1024, 0, 0, 1.f);
        add(IN_AQKV, (long long)i * 1024 * 3072, 3072, 1024, 2048, 1024, q, 1024, 2048, 0, 0, 1.f, -1, 0, 1);
        add(IN_AO, (long long)i * 1024 * 1024, 1024, 1024, 0, 1024, o, 1024, 0, 0, 0, 1.f); }
    add(IN_BQ, 0, 1024, 1024, 0, 1024, WL + 2 * (long long)WL_QKV2, 1024, 0, 0, 0, QS);
    add(IN_KVF, 0, 2052, 1024, 0, 1024, WL + 2 * (long long)WL_QKV2, 1024, 1024, 0, 0, 1.f);
    add(IN_KVF, 0, 2052, 1024, 1024, 1024, WL + 2 * (long long)WL_QKV2, 1024, 2048, 0, 0, 1.f, -1, 0, 1);
    add(IN_BQ, (long long)1024 * 1024, 1024, 1024, 0, 1024, WL + 2 * (long long)WL_Q3, 1024, 0, 0, 0, QS);
    add(IN_BO, 0, 1024, 1024, 0, 1024, WL + 2 * (long long)WL_O2, 1024, 0, 0, 0, 1.f);
    add(IN_BO, (long long)1024 * 1024, 1024, 1024, 0, 1024, WL + 2 * (long long)WL_O3, 1024, 0, 0, 0, 1.f);
    for (int i = 0; i < 2; ++i) { const long long gu = i ? WL + 2 * (long long)WL_GU1 : WD + 2 * (long long)WD_GU0, dn = i ? WL + 2 * (long long)WL_DN1 : WD + 2 * (long long)WD_DN0;
        add(IN_FGU, (long long)i * 1024 * 5632, 5632, 1024, 0, 5632, gu, 1024, 0, 0, DFF, 1.f);
        add(IN_FDN, (long long)i * 2816 * 1024, 1024, 2816, 0, 1024, dn, 2816, 0, 0, 0, 1.f); }
    for (int i = 0; i < 2; ++i) for (int e = 0; e < NE; ++e) { const long long gu = i ? WL + 2 * (long long)WL_MGU1 : WD + 2 * (long long)WD_MGU0, dn = i ? WL + 2 * (long long)WL_MDN1 : WD + 2 * (long long)WD_MDN0;
        add(IN_MGU, (long long)(i * NE + e) * 1024 * 1408, 1408, 1024, 0, 1408, gu, 1024, e * 1536, 0, DFE, 1.f);
        add(IN_MDN, (long long)(i * NE + e) * 704 * 1024, 1024, 704, 0, 1024, dn, 5632, 0, e * DFE, 0, 1.f); }
    for (int i = 0; i < 4; ++i) { const long long pp = i == 0 ? WD + 2 * (long long)WD_PP0 : i == 1 ? WD + 2 * (long long)WD_PP1 : i == 2 ? WL + 2 * (long long)WL_PP2 : WL + 2 * (long long)WL_PP3;
        const long long pg = i == 0 ? WD + 2 * (long long)WD_PG0 : i == 1 ? WD + 2 * (long long)WD_PG1 : i == 2 ? WL + 2 * (long long)WL_PG2 : WL + 2 * (long long)WL_PG3;
        add(IN_PP, (long long)i * 256 * 1024, 1024, 256, 0, 1024, pp, 256, 0, 0, 0, 1.f);
        add(IN_PG, (long long)i * 1024 * 1024, 1024, 1024, 0, 1024, pg, 1024, 0, 0, 0, 1.f, 2 * i + 1, CS_PG0 + 1024 * i); }
    t.total = items; t.njobs = n; return t;
}
__device__ const JobTable g_jobs = make_jobs();
static_assert(make_jobs().njobs == NJOBS, "job count");

__device__ __forceinline__ void conv_item(const Frame& F, const Job& J, int it, LAS float* scr) {
    const int lane = F.lane_id(); const int kb = it / J.nblk, nb = it % J.nblk, k0 = 64 * kb, ncol = J.n0 + 32 * nb;
    const GAS float* W = in_sel(J.in_idx) + J.src_off;
    int drow;
    if (J.split) { const int ty = ncol / J.split, jj = ncol % J.split; drow = J.drow0 + 256 * (jj >> 7) + 128 * ty + (jj & 127); } else drow = J.drow0 + (ncol - J.n0);
    GAS float* part = (GAS float*)(F.ws + WS_XB0);
    { f32x4 wv[8];
#pragma unroll
      for (int i = 0; i < 8; ++i) wv[i] = *(const GAS f32x4*)(W + (size_t)(k0 + (lane >> 3) + 8 * i) * J.Ns + ncol + (lane & 7) * 4);
      if (J.ln >= 0) {
          const GAS float* lg = in_sel(IN_LNG) + (size_t)J.ln * DM + k0 + (lane >> 3); const GAS float* lb = in_sel(IN_LNB) + (size_t)J.ln * DM + k0 + (lane >> 3);
          f32x4 bp = (f32x4){0.f, 0.f, 0.f, 0.f};
#pragma unroll
          for (int i = 0; i < 8; ++i) { const float g = lg[8 * i], b = lb[8 * i]; bp += wv[i] * b; wv[i] *= g; }
#pragma unroll
          for (int c = 0; c < 4; ++c) { float v = bp[c]; v += shx(v, 8, lane); v += shx(v, 16, lane); v += shx(v, 32, lane); bp[c] = v; }
          if (lane < 8) *(GAS f32x4*)(part + (size_t)(16 + kb) * CS_TOTAL + J.cs + drow + 4 * lane) = bp; }
#pragma unroll
      for (int i = 0; i < 8; ++i) { LAS float* d = scr + ((lane >> 3) + 8 * i) * 33 + (lane & 7) * 4; d[0] = wv[i][0] * J.scale; d[1] = wv[i][1] * J.scale; d[2] = wv[i][2] * J.scale; d[3] = wv[i][3] * J.scale; } }
    asm volatile("s_waitcnt lgkmcnt(0)" ::: "memory");
    GAS bf16_t* WT = (GAS bf16_t*)(F.ws + J.dst_off);
    const int r = lane >> 2, q = lane & 3;
#pragma unroll
    for (int rb = 0; rb < 2; ++rb) { const int m_ = 8 * (r >> 2) + 4 * rb + (r & 3);
        const int n = J.vperm ? (8 * ((m_ & 15) >> 2) + 4 * (m_ >> 4) + (m_ & 3)) : m_;
        float cv = 0.f;
#pragma unroll
        for (int cb = 0; cb < 2; ++cb) { const LAS float* s = scr + (32 * cb + 8 * q) * 33 + n;
            u32x4 o; o.x = pk2(s[0 * 33], s[1 * 33]); o.y = pk2(s[2 * 33], s[3 * 33]); o.z = pk2(s[4 * 33], s[5 * 33]); o.w = pk2(s[6 * 33], s[7 * 33]);
            const int srow = drow + 16 * rb, kcol = J.dk0 + k0 + 32 * cb;
            *(GAS u32x4*)(WT + ((size_t)(srow >> 4) * (J.ldd >> 5) + (kcol >> 5)) * 512 + lane * 8) = o;
            if (J.ln >= 0) { float x[8]; g8::unpack8(o, x); cv += ((x[0] + x[1]) + (x[2] + x[3])) + ((x[4] + x[5]) + (x[6] + x[7])); } }
        if (J.ln >= 0) {
            cv += shx(cv, 1, lane); cv += shx(cv, 2, lane);
            if (q == 0) part[(size_t)kb * CS_TOTAL + J.cs + drow + n] = cv; } }
    asm volatile("s_waitcnt lgkmcnt(0)" ::: "memory");
}
__device__ __forceinline__ void cs_finalize(Frame& F) {
    const GAS float* part = (const GAS float*)(F.ws + WS_XB0); GAS float* cs = (GAS float*)(F.ws + WS_MISC + MS_CS);
    const int gt = (int)blockIdx.x * NTHREADS + F.tid_id(), gs = F.G * NTHREADS;
    for (int i = gt; i < 2 * 4096; i += gs) { const int a = i >> 12, idx = CS_PG0 + (i & 4095); float v = 0.f;
#pragma unroll
        for (int kb = 0; kb < 16; ++kb) v += part[(size_t)(a * 16 + kb) * CS_TOTAL + idx];
        cs[a * CS_TOTAL + idx] = v; }
}
__device__ __forceinline__ void prologue_phase(Frame& F) {
    LAS float* scr = (LAS float*)(F.lds + F.wave * 16384);
    const int gw = F.vcu * NWAVES + F.wave, NGW = F.G * NWAVES;
    const int total = g_jobs.total;
    for (int it = gw; it < total; it += NGW) {
        int jn = 0;
        for (int k = 1; k < NJOBS; ++k) jn += (it >= g_jobs.j[k].item0) ? 1 : 0;
        jn = __builtin_amdgcn_readfirstlane(jn);
        conv_item(F, g_jobs.j[jn], it - g_jobs.j[jn].item0, scr);
    }
    { const size_t gt = (size_t)blockIdx.x * NTHREADS + F.tid_id(), gs = (size_t)F.G * NTHREADS;
      for (size_t i = gt; i < (size_t)2 * NE * 2 * 64 * 128; i += gs) {
          const int ch = (int)(i & 127), row = (int)((i >> 7) & 63), gu = (int)((i >> 13) & 1), e = (int)((i >> 14) & 7), li = (int)(i >> 17);
          GAS bf16_t* base = (GAS bf16_t*)(F.ws + (li ? WS_WLIVE + 2 * WL_MGU1 : WS_WDEAD + 2 * WD_MGU0));
          { const int prow = e * 1536 + 1280 + 128 * gu + 64 + row, kc = ch * 8;
            *(GAS u32x4*)(base + ((size_t)(prow >> 4) * 32 + (kc >> 5)) * 512 + (prow & 15) * 32 + (kc & 31)) = (u32x4){0u, 0u, 0u, 0u}; } } }
    GAS bf16_t* xb = xb_ptr(F, 1);
    { const int ln = F.lane_id();
      for (int m = gw; m < T; m += 2 * NGW) {
          const GAS f32x4* xa = (const GAS f32x4*)(in_sel(IN_X) + (size_t)m * DM) + 2 * ln; const GAS f32x4* xc = (const GAS f32x4*)(in_sel(IN_X) + (size_t)(m + NGW) * DM) + 2 * ln;
          GAS u32x4* oa = (GAS u32x4*)(xb + sblk(m, 8 * ln)); GAS u32x4* oc = (GAS u32x4*)(xb + sblk(m + NGW, 8 * ln));
          f32x4 va[4], vc[4];
#pragma unroll
          for (int j = 0; j < 2; ++j) { va[2 * j] = xa[128 * j]; va[2 * j + 1] = xa[128 * j + 1]; vc[2 * j] = xc[128 * j]; vc[2 * j + 1] = xc[128 * j + 1]; }
#pragma unroll
          for (int j = 0; j < 2; ++j) { u32x4 o; o.x = cvt_pk_bf16(va[2 * j][0], va[2 * j][1]); o.y = cvt_pk_bf16(va[2 * j][2], va[2 * j][3]); o.z = cvt_pk_bf16(va[2 * j + 1][0], va[2 * j + 1][1]); o.w = cvt_pk_bf16(va[2 * j + 1][2], va[2 * j + 1][3]); oa[1024 * j] = o;
              o.x = cvt_pk_bf16(vc[2 * j][0], vc[2 * j][1]); o.y = cvt_pk_bf16(vc[2 * j][2], vc[2 * j][3]); o.z = cvt_pk_bf16(vc[2 * j + 1][0], vc[2 * j + 1][1]); o.w = cvt_pk_bf16(vc[2 * j + 1][2], vc[2 * j + 1][3]); oc[1024 * j] = o; } } }
}

template <bool ROUTER, bool CVT_P>
__device__ __forceinline__ void ln_phase(Frame& F, int L, int which, GAS bf16_t* S) {
    int tid_ = F.tid_id(); asm volatile("" : "+v"(tid_));
    const int w = __builtin_amdgcn_readfirstlane(tid_ >> 6);
    LAS f32x4* gl = (LAS f32x4*)F.lds; LAS f32x4* bl = gl + 256;
    LAS f32x4* wrl = gl + 512;
    LAS int* hist = (LAS int*)(gl + 512 + 2048);
    __syncthreads();
    if (tid_ < 256) { gl[tid_] = ((const GAS f32x4*)(in_sel(IN_LNG) + (size_t)(L * 2 + which) * DM))[tid_]; bl[tid_] = ((const GAS f32x4*)(in_sel(IN_LNB) + (size_t)(L * 2 + which) * DM))[tid_]; }
    if constexpr (ROUTER) { const GAS f32x4* Wr = (const GAS f32x4*)(in_sel(IN_MR) + (size_t)(L >> 1) * DM * NE);
#pragma unroll
        for (int i = 0; i < 4; ++i) wrl[tid_ + 512 * i] = Wr[tid_ + 512 * i]; }
    __syncthreads();
    for (int ch = blockIdx.x; ch < T / 128; ch += F.G) {
        if constexpr (ROUTER) { __syncthreads(); if (tid_ < 40) hist[tid_] = 0; __syncthreads(); }
        const int r0 = 128 * ch + 16 * w;
        const int lane = F.lane_id(), q = lane & 3;
        GAS u32x4* sp = (GAS u32x4*)(S + (size_t)(r0 >> 4) * 32 * 512) + lane;
        u32x4 d[32];
#pragma unroll
        for (int cb = 0; cb < 32; ++cb) d[cb] = sp[64 * cb];
        if constexpr (CVT_P) {
            const GAS f32x4* pp = (const GAS f32x4*)(in_sel(IN_P) + ((size_t)L * T + r0 + (lane >> 5)) * PLE) + 2 * (lane & 31);
            GAS u32x4* po = (GAS u32x4*)((GAS bf16_t*)(F.ws + WS_PB) + (size_t)(r0 + (lane >> 5)) * PLE) + (lane & 31);
#pragma unroll
            for (int h = 0; h < 2; ++h) { f32x4 pa[4], pb[4];
#pragma unroll
                for (int j = 0; j < 4; ++j) { pa[j] = pp[(size_t)(4 * h + j) * 128]; pb[j] = pp[(size_t)(4 * h + j) * 128 + 1]; }
#pragma unroll
                for (int j = 0; j < 4; ++j) { u32x4 o; o.x = cvt_pk_bf16(pa[j][0], pa[j][1]); o.y = cvt_pk_bf16(pa[j][2], pa[j][3]); o.z = cvt_pk_bf16(pb[j][0], pb[j][1]); o.w = cvt_pk_bf16(pb[j][2], pb[j][3]);
                    po[(size_t)(4 * h + j) * 64] = o; } } }
        float sm = 0.f;
#pragma unroll
        for (int cb = 0; cb < 32; ++cb) { float x[8]; g8::unpack8(d[cb], x); sm += ((x[0] + x[1]) + (x[2] + x[3])) + ((x[4] + x[5]) + (x[6] + x[7])); }
        sm += shx(sm, 1, lane); sm += shx(sm, 2, lane);
        const float mean = sm * (1.f / DM); float s2 = 0.f;
#pragma unroll
        for (int cb = 0; cb < 32; ++cb) asm volatile("" : "+v"(d[cb]));
#pragma unroll
        for (int cb = 0; cb < 32; ++cb) { float x[8]; g8::unpack8(d[cb], x);
#pragma unroll
            for (int i = 0; i < 8; ++i) { const float c = x[i] - mean; s2 += c * c; } }
        s2 += shx(s2, 1, lane); s2 += shx(s2, 2, lane);
        const float rstd = 1.f / sqrtf(s2 * (1.f / DM) + LN_EPS);
#pragma unroll
        for (int cb = 0; cb < 32; ++cb) asm volatile("" : "+v"(d[cb]));
        float lg[NE];
#pragma unroll
        for (int e = 0; e < NE; ++e) lg[e] = 0.f;
#pragma unroll
        for (int cb = 0; cb < 32; ++cb) { float x[8]; g8::unpack8(d[cb], x); const int c0 = 32 * cb + 8 * q;
            const f32x4 ga = gl[c0 >> 2], gb = gl[(c0 >> 2) + 1], ba = bl[c0 >> 2], bb = bl[(c0 >> 2) + 1];
#pragma unroll
            for (int i = 0; i < 4; ++i) { x[i] = (x[i] - mean) * rstd * ga[i] + ba[i]; x[4 + i] = (x[4 + i] - mean) * rstd * gb[i] + bb[i]; }
            if constexpr (ROUTER) {
#pragma unroll
                for (int i = 0; i < 8; ++i) { const f32x4 w0 = wrl[2 * (c0 + i)], w1 = wrl[2 * (c0 + i) + 1];
#pragma unroll
                    for (int e = 0; e < 4; ++e) { lg[e] += x[i] * w0[e]; lg[4 + e] += x[i] * w1[e]; }
                    if ((i & 1) == 1) asm volatile("" ::: "memory"); } }
            u32x4 o; o.x = cvt_pk_bf16(x[0], x[1]); o.y = cvt_pk_bf16(x[2], x[3]); o.z = cvt_pk_bf16(x[4], x[5]); o.w = cvt_pk_bf16(x[6], x[7]);
            sp[64 * cb] = o; asm volatile("" ::: "memory"); }
        if constexpr (ROUTER) {
#pragma unroll
            for (int e = 0; e < NE; ++e) { lg[e] += shx(lg[e], 1, lane); lg[e] += shx(lg[e], 2, lane); }
            int i1 = 0; float v1 = lg[0];
#pragma unroll
            for (int e = 1; e < NE; ++e) if (lg[e] > v1) { v1 = lg[e]; i1 = e; }
            int i2 = -1; float v2 = -3.0e38f;
#pragma unroll
            for (int e = 0; e < NE; ++e) if (e != i1 && lg[e] > v2) { v2 = lg[e]; i2 = e; }
            const float ex = fast_exp(v2 - v1), g1 = __builtin_amdgcn_rcpf(1.f + ex), g2 = 1.f - g1;
            const int ea = i1 < i2 ? i1 : i2, eb = i1 < i2 ? i2 : i1, pid = ea * (15 - ea) / 2 + eb - ea - 1;
            if (q == 0) { const int row = r0 + (lane >> 2); GAS float* gpp = (GAS float*)(F.ws + WS_MISC + MS_GATE);
                *((GAS i32x4*)(F.ws + WS_MISC + MS_REC) + row) = (i32x4){i1 | (i2 << 8) | (pid << 16), 0, 0, row}; gpp[row] = g1; gpp[T + row] = g2;
                __hip_atomic_fetch_add(hist + i1, 1, __ATOMIC_RELAXED, __HIP_MEMORY_SCOPE_WORKGROUP); __hip_atomic_fetch_add(hist + i2, 1, __ATOMIC_RELAXED, __HIP_MEMORY_SCOPE_WORKGROUP);
                __hip_atomic_fetch_add(hist + 8 + pid, 1, __ATOMIC_RELAXED, __HIP_MEMORY_SCOPE_WORKGROUP); }
            __syncthreads(); if (tid_ < 40) ((GAS int*)(F.ws + WS_MISC + MS_HIST))[ch * 40 + tid_] = hist[tid_]; }
    }
}

__device__ __forceinline__ int pad256(int v) { return (v + 255) & ~255; }
__device__ __forceinline__ void moe_lists_phase(Frame& F) {
    LAS int* pre = (LAS int*)F.lds; LAS int* tot = pre + 40; LAS int* eoff = tot + 40; LAS int* poff = eoff + 16; LAS int* recs = poff + 32; LAS int* tabl = recs + 128;
    const GAS int* hist = (const GAS int*)(F.ws + WS_MISC + MS_HIST);
    const GAS i32x4* rec = (const GAS i32x4*)(F.ws + WS_MISC + MS_REC);
    GAS i32x4* elist = (GAS i32x4*)(F.ws + WS_MISC + MS_ELIST); GAS int* plist = (GAS int*)(F.ws + WS_MISC + MS_PLIST);
    int tid_ = F.tid_id(); asm volatile("" : "+v"(tid_));
    const int lane = tid_ & 63, w = F.wave, tid = tid_;
    bool first = true;
    for (int ch = blockIdx.x; ch < T / 128; ch += F.G) {
        __syncthreads();
        { int hv[5][4];
#pragma unroll
          for (int q = 0; q < 5; ++q) { const int col = w + NWAVES * q;
#pragma unroll
              for (int k = 0; k < 4; ++k) hv[q][k] = (col < 36) ? hist[(lane + 64 * k) * 40 + col] : 0; }
#pragma unroll
          for (int q = 0; q < 5; ++q) { const int col = w + NWAVES * q; int sp = 0, st = 0;
#pragma unroll
              for (int k = 0; k < 4; ++k) { const int c2 = lane + 64 * k; st += hv[q][k]; sp += (c2 < ch) ? hv[q][k] : 0; }
#pragma unroll
              for (int o = 1; o < 64; o <<= 1) { sp += shxi(sp, o, lane); st += shxi(st, o, lane); }
              if (lane == 0 && col < 36) { pre[col] = sp; tot[col] = st; } } }
        __syncthreads();
        if (tid == 0) {
            int acc = 0, ucum = 0;
            for (int e = 0; e < NE; ++e) { eoff[e] = acc; tabl[TB_EOFF + e] = acc; tabl[TB_ECUM + e] = ucum; const int p = pad256(tot[e]); acc += p; ucum += 6 * (p >> 8); }
            eoff[NE] = acc; tabl[TB_EOFF + NE] = acc; tabl[TB_ECUM + NE] = ucum;
            int pacc = 0, pid = 0;
            for (int a = 0; a < NE - 1; ++a) for (int b = a + 1; b < NE; ++b) { poff[pid] = pacc; pacc += pad256(tot[8 + pid]); ++pid; }
            poff[NPAIR] = pacc; tabl[TB_NRT] = pacc >> 8;
        }
        __syncthreads();
        if (tid < 192) { const int r8 = tid << 8; int p = 0;
            for (int k = 1; k < NPAIR; ++k) p += (r8 >= poff[k]) ? 1 : 0;
            int a = 0, rem = p; while (rem >= NE - 1 - a) { rem -= NE - 1 - a; ++a; }
            tabl[TB_RT2P + tid] = a | ((a + 1 + rem) << 8); }
        __syncthreads();
        if (ch == 0) { for (int i = tid; i < TB_WORDS; i += NTHREADS) ((GAS int*)(F.ws + WS_MISC + MS_TAB))[i] = tabl[i]; }
        if (tid < 128) recs[tid] = rec[128 * ch + tid].x;
        __syncthreads();
        if (tid < 128) {
            const int token = 128 * ch + tid; const i32x4 r = rec[token]; const int e1 = r.x & 0xff, e2 = (r.x >> 8) & 0xff, pid = (r.x >> 16) & 0xff;
            int r1 = 0, r2 = 0, rp = 0;
            for (int j = 0; j < tid; ++j) { const int o = recs[j]; const int o1 = o & 0xff, o2 = (o >> 8) & 0xff, op = (o >> 16) & 0xff;
                r1 += ((o1 == e1) | (o2 == e1)) ? 1 : 0; r2 += ((o1 == e2) | (o2 == e2)) ? 1 : 0; rp += (op == pid) ? 1 : 0; }
            const int pslot = poff[pid] + pre[8 + pid] + rp; plist[pslot] = token;
            i32x4 en; en.x = token; en.w = 0;
            const GAS float* gp = (const GAS float*)(F.ws + WS_MISC + MS_GATE);
            GAS float* eg = (GAS float*)(F.ws + WS_MISC + MS_EGATE); en.z = 0;
            { const int sl = eoff[e1] + pre[e1] + r1; en.y = pslot * 1408 + (e1 < e2 ? 0 : DFE); elist[sl] = en; eg[sl] = gp[token]; }
            { const int sl = eoff[e2] + pre[e2] + r2; en.y = pslot * 1408 + (e2 < e1 ? 0 : DFE); elist[sl] = en; eg[sl] = gp[T + token]; }
        }
        if (first) {
            first = false; const int gt = blockIdx.x * NTHREADS + tid, gs = F.G * NTHREADS;
            for (int e = 0; e < NE; ++e) for (int i = eoff[e] + tot[e] + gt; i < eoff[e + 1]; i += gs) elist[i] = (i32x4){0, -1, 0, 0};
            for (int p = 0; p < NPAIR; ++p) for (int i = poff[p] + tot[8 + p] + gt; i < poff[p + 1]; i += gs) plist[i] = -1;
        }
    }
    __syncthreads();
}
__device__ __forceinline__ void load_tab(Frame& F) {
    __syncthreads();
    for (int i = F.tid_id(); i < TB_WORDS; i += NTHREADS) ((LAS int*)(F.lds + LDS_TAB))[i] = ((const GAS int*)(F.ws + WS_MISC + MS_TAB))[i];
    __syncthreads();
}

__device__ __forceinline__ void forget_phase(Frame& F, const GAS bf16_t* S) {
    int tid_ = F.tid_id(); asm volatile("" : "+v"(tid_));
    const int lane = tid_ & 63, w = __builtin_amdgcn_readfirstlane(tid_ >> 6);
    const GAS float* Wf = in_sel(IN_KVF);
    f32x4 wf[16];
#pragma unroll
    for (int i = 0; i < 16; ++i) wf[i] = *(const GAS f32x4*)(Wf + (size_t)(16 * lane + i) * 2052 + 2048);
    const f32x4 bias = *(const GAS f32x4*)in_sel(IN_KVFB);
    LAS float* lf = (LAS float*)F.lds;
    GAS float* cl = (GAS float*)(F.ws + WS_MISC + MS_CL); GAS float* tt = (GAS float*)(F.ws + WS_MISC + MS_TOT);
    for (int ch = blockIdx.x; ch < T / 128; ch += F.G) {
        __syncthreads();
#pragma unroll
        for (int h = 0; h < 2; ++h) { u32x4 ra[8], rb[8];
#pragma unroll
          for (int k8 = 0; k8 < 8; ++k8) { const GAS u32x4* xr = (const GAS u32x4*)(S + sblk(128 * ch + 16 * w + 8 * h + k8, 16 * lane)); ra[k8] = xr[0]; rb[k8] = xr[1]; }
#pragma unroll
          for (int k8 = 0; k8 < 8; ++k8) { const int k = 8 * h + k8;
            float x[8]; f32x4 a = (f32x4){0.f, 0.f, 0.f, 0.f};
            g8::unpack8(ra[k8], x);
#pragma unroll
            for (int i = 0; i < 8; ++i) a += wf[i] * x[i];
            g8::unpack8(rb[k8], x);
#pragma unroll
            for (int i = 0; i < 8; ++i) a += wf[8 + i] * x[i];
#pragma unroll
            for (int hh = 0; hh < 4; ++hh) a[hh] = wave_sum_dpp(a[hh]);
            if (lane == 0) { f32x4 o;
#pragma unroll
                for (int hh = 0; hh < 4; ++hh) { const float z = a[hh] + bias[hh]; o[hh] = -(fmaxf(-z, 0.f) + log1pf(__expf(-fabsf(z)))); }
                *(LAS f32x4*)(lf + (16 * w + k) * 4) = o; }
          } }
        __syncthreads();
        { const int tile = w >> 2, hh = w & 3; float x = lf[(tile * 64 + lane) * 4 + hh];
#pragma unroll
          for (int o = 1; o < 64; o <<= 1) { const float y = shup(x, o, lane); if (lane >= o) x += y; }
          const int row = 128 * ch + tile * 64 + lane, b = row / SEQ, s = row % SEQ;
          cl[(size_t)(b * NH + hh) * SEQ + s] = x; if (lane == 63) tt[(b * NH + hh) * 256 + (s >> 6)] = x; }
    }
    __syncthreads();
}
__device__ __forceinline__ void knorm_phase(Frame& F, const GAS bf16_t* KS) {
    const int lane = F.lane_id(), w = F.wave;
    for (int ch = blockIdx.x; ch < T / 128; ch += F.G) {
        float mx = 0.f;
#pragma unroll
        for (int h = 0; h < 2; ++h) { u32x4 ra[8], rb[8];
#pragma unroll
            for (int k = 0; k < 8; ++k) { const int row = 128 * ch + 16 * w + 8 * h + k;
                const GAS u32x4* kr = (const GAS u32x4*)(KS + ((size_t)(row >> 4) * 32 + (lane >> 1)) * 512 + (row & 15) * 32 + 16 * (lane & 1)); ra[k] = kr[0]; rb[k] = kr[1]; }
#pragma unroll
            for (int k = 0; k < 8; ++k) { const unsigned u[8] = {ra[k].x, ra[k].y, ra[k].z, ra[k].w, rb[k].x, rb[k].y, rb[k].z, rb[k].w}; float s = 0.f;
#pragma unroll
                for (int i = 0; i < 8; ++i) { const float lo = __builtin_bit_cast(float, u[i] << 16), hi = __builtin_bit_cast(float, u[i] & 0xffff0000u); s += lo * lo + hi * hi; }
                s += shx(s, 1, lane); s += shx(s, 2, lane); s += shx(s, 4, lane); s += shx(s, 8, lane);
                mx = fmaxf(mx, s); } }
        if ((lane & 15) == 0) { const int b = (128 * ch) / SEQ; (void)__hip_atomic_fetch_max(F.ctl + CW_KN2 + b * NH + (lane >> 4), __builtin_bit_cast(unsigned, mx), RLX_AGENT); }
    }
}

constexpr int AT_KB0 = 0, AT_VB0 = 32768, AT_KB1 = 66048, AT_VB1 = 98816, AT_VPANEL = 2080, AT_CL0 = 132096, AT_CL1 = 132352, AT_TT0 = 132608, AT_TT1 = 132864;
constexpr float SB_STOP = -14.f, FOX_STOP = -20.f;
typedef short s16x4 __attribute__((ext_vector_type(4)));
#define AT_TR4(r0, r1, r2, r3, addr, o0, o1, o2, o3) asm volatile("ds_read_b64_tr_b16 %0, %4 offset:%5\n\tds_read_b64_tr_b16 %1, %4 offset:%6\n\tds_read_b64_tr_b16 %2, %4 offset:%7\n\tds_read_b64_tr_b16 %3, %4 offset:%8" \
    : "=&v"(r0), "=&v"(r1), "=&v"(r2), "=&v"(r3) : "v"(addr), "i"(o0), "i"(o1), "i"(o2), "i"(o3) : "memory")
#define AT_WAIT4(r0, r1, r2, r3) asm volatile("s_waitcnt lgkmcnt(0)" : "+v"(r0), "+v"(r1), "+v"(r2), "+v"(r3) :: "memory")

template <bool FOX>
__device__ __forceinline__ void attn_phase(Frame& F, const GAS bf16_t* Q, const GAS bf16_t* Kb, const GAS bf16_t* Vb, GAS bf16_t* O) {
    LAS unsigned char* lds = F.lds;
    volatile LAS unsigned* flags = (volatile LAS unsigned*)(lds + LDS_FLAGS);
    int tid_ = F.tid_id(); asm volatile("" : "+v"(tid_));
    const int tid = tid_, w = __builtin_amdgcn_readfirstlane(tid >> 6), lane = tid & 63, fr = lane & 15, fq = lane >> 4;
    const unsigned vrd = (unsigned)((4 * fq + ((lane & 15) >> 2)) * 32 + 8 * (lane & 3));
    const GAS float* cl = (const GAS float*)(F.ws + WS_MISC + MS_CL); const GAS float* tt = (const GAS float*)(F.ws + WS_MISC + MS_TOT);
    for (int id = blockIdx.x; id < 8 * 128; id += F.G) {
        const int bh = id & 7, qt = id >> 3, b = bh >> 2, h = bh & 3, t0 = qt * 128;
        const size_t rowbase = (size_t)b * SEQ;
        const int tq = t0 + 16 * w + fr;
        int kt = 2 * qt + 1, it = 0; bool wdone = false;
#ifndef QK_NF
#define QK_NF 8
#endif
#ifndef QK_NF_SB
#define QK_NF_SB 8
#endif
#define AT_DMA(KT, IT) do { const int ln_ = F.lane_id();     \
            const int kb_ = ((IT) & 1) ? AT_KB1 : AT_KB0, vb_ = ((IT) & 1) ? AT_VB1 : AT_VB0; \
            _Pragma("unroll") for (int j = 0; j < 4; ++j) { const int pc_ = w + 8 * j; const int r_ = 2 * pc_ + (ln_ >> 5); \
                __builtin_amdgcn_global_load_lds((const GAS unsigned*)(Kb + ((size_t)((rowbase + (size_t)64 * (KT) + r_) >> 4) * 32 + h * 8 + ((((ln_ & 31) ^ (r_ & 15))) >> 2)) * 512 + (r_ & 15) * 32 + ((((ln_ & 31) ^ (r_ & 15))) & 3) * 8), (LAS unsigned*)(lds + kb_ + pc_ * 1024), 16, 0, 0); } \
            _Pragma("unroll") for (int j = 0; j < 4; ++j) { const int pc_ = w + 8 * j; \
                __builtin_amdgcn_global_load_lds((const GAS unsigned*)(Vb + ((size_t)((rowbase + (size_t)64 * (KT) + 32 * (pc_ & 1) + (ln_ >> 1)) >> 4) * 32 + h * 8 + (pc_ >> 2)) * 512 + ((ln_ >> 1) & 15) * 32 + ((pc_ >> 1) & 1) * 16 + 8 * (ln_ & 1)), (LAS unsigned*)(lds + vb_ + (pc_ >> 1) * AT_VPANEL + (pc_ & 1) * 1024), 16, 0, 0); } \
            if constexpr (FOX) { if (w == 0) __builtin_amdgcn_global_load_lds((const GAS unsigned*)(cl + (size_t)bh * SEQ + 64 * (KT) + ln_), (LAS unsigned*)(lds + (((IT) & 1) ? AT_CL1 : AT_CL0)), 4, 0, 0); \
                                 if (w == 1) __builtin_amdgcn_global_load_lds((const GAS unsigned*)(tt + bh * 256 + ((KT) > 2 * qt ? 2 * qt : (KT))), (LAS unsigned*)(lds + (((IT) & 1) ? AT_TT1 : AT_TT0)), 4, 0, 0); } } while (0)
        if (id == (int)blockIdx.x) AT_DMA(kt, 0);
        bf16x8 qf[8];
        { const GAS bf16_t* qp = Q + ((size_t)((rowbase + t0 + 16 * w) >> 4) * 32 + h * 8) * 512 + fr * 32 + 8 * fq;
#pragma unroll
          for (int s = 0; s < 8; ++s) qf[s] = *(const GAS bf16x8*)(qp + 512 * s); }
        f32x4 o[16];
#pragma unroll
        for (int d = 0; d < 16; ++d) o[d] = (f32x4){0.f, 0.f, 0.f, 0.f};
        float R = 0.f;
        float mrun = -1.0e30f, lsum = 0.f, cq = 0.f, qn = 0.f, KN = 0.f, gacc = 0.f;
        if constexpr (FOX) {
            float s2 = 0.f;
#pragma unroll
            for (int s = 0; s < 8; ++s)
#pragma unroll
                for (int j = 0; j < 8; ++j) { const float x = bf2f((unsigned short)qf[s][j]); s2 += x * x; }
            s2 = xsum32(xsum16(s2)); qn = sqrtf(s2);
            KN = sqrtf(__builtin_bit_cast(float, __hip_atomic_load(F.ctl + CW_KN2 + bh, RLX_AGENT))) * 1.002f;
            cq = cl[(size_t)bh * SEQ + tq] + ((tq >= t0 + 64) ? tt[bh * 256 + 2 * qt] : 0.f);
        }
        asm volatile("s_waitcnt vmcnt(0) lgkmcnt(0)" ::: "memory"); __builtin_amdgcn_s_barrier();
        for (;;) {
            const int kbuf = (it & 1) ? AT_KB1 : AT_KB0, vbuf = (it & 1) ? AT_VB1 : AT_VB0;
            if (it >= 2) { const int par = (it - 1) & 1; const u32x4 f0 = *(const LAS u32x4*)(lds + LDS_FLAGS + par * 32), f1 = *(const LAS u32x4*)(lds + LDS_FLAGS + par * 32 + 16);
                if (((f0.x | f0.y) | (f0.z | f0.w) | (f1.x | f1.y) | (f1.z | f1.w)) == 0u) break; }
            const int kmin = 64 * kt, wmax = t0 + 16 * w + 15, wmin = t0 + 16 * w;
            if (kt > 0) AT_DMA(kt - 1, it + 1);
            const bool part = !wdone && (FOX ? (kmin <= wmax) : (kmin < wmax));
            if (part) {
                const bool need_mask = (kmin + 63 >= wmin);
                f32x4 s[4];
                {
                    constexpr int NF = FOX ? QK_NF : QK_NF_SB;
                    bf16x8 kf[NF];
#pragma unroll
                    for (int blk = 0; blk < 4; ++blk) s[blk] = (f32x4){0.f, 0.f, 0.f, 0.f};
#pragma unroll
                    for (int n = 0; n < NF - 1; ++n) kf[n] = *(const LAS bf16x8*)(lds + kbuf + (16 * (n & 3) + fr) * 512 + (((4 * (n >> 2) + fq) ^ fr) * 16));
                    __builtin_amdgcn_sched_barrier(0);
#pragma unroll
                    for (int n = 0; n < 32; ++n) {
                        if (n + NF - 1 < 32) { const int m = n + NF - 1; kf[m % NF] = *(const LAS bf16x8*)(lds + kbuf + (16 * (m & 3) + fr) * 512 + (((4 * (m >> 2) + fq) ^ fr) * 16)); }
                        s[n & 3] = __builtin_amdgcn_mfma_f32_16x16x32_bf16(kf[n % NF], qf[n >> 2], s[n & 3], 0, 0, 0);
                        __builtin_amdgcn_sched_barrier(0);
                    }
                }
                f32x4 ckv[4]; float ttv = 0.f;
                if constexpr (FOX) { const int cb_ = (it & 1) ? AT_CL1 : AT_CL0;
#pragma unroll
                    for (int blk = 0; blk < 4; ++blk) ckv[blk] = *(const LAS f32x4*)(lds + cb_ + (16 * blk + 4 * fq) * 4);
                    ttv = *(const LAS float*)(lds + ((it & 1) ? AT_TT1 : AT_TT0)); }
                float pv[4][4];
                if constexpr (!FOX) {
                    float lm[4][4], w4[4], Tt[4], Ex[4];
#pragma unroll
                    for (int blk = 0; blk < 4; ++blk) { w4[blk] = 0.f;
#pragma unroll
                        for (int i = 0; i < 4; ++i) { const float z = s[blk][i]; const float sp = softplus_f(z); const bool valid = !need_mask || (kmin + 16 * blk + 4 * fq + i < tq);
                            lm[blk][i] = valid ? -sp : 0.f; pv[blk][i] = valid ? (z - sp) : -1.0e30f; w4[blk] += lm[blk][i]; } }
#pragma unroll
                    for (int blk = 0; blk < 4; ++blk) { const float a = xget16(w4[blk], fq), bq = xget32(w4[blk], fq), c = xget32(a, fq);
                        Tt[blk] = (w4[blk] + a) + (bq + c); Ex[blk] = (fq == 0) ? (a + bq + c) : (fq == 1) ? (bq + c) : (fq == 2) ? a : 0.f; }
                    float bs = 0.f;
#pragma unroll
                    for (int blk = 3; blk >= 0; --blk) { float tail = R + bs + Ex[blk];
#pragma unroll
                        for (int i = 3; i >= 0; --i) { const float e = pv[blk][i] + tail; pv[blk][i] = (e > -80.f) ? fast_exp(e) : 0.f; tail += lm[blk][i]; }
                        bs += Tt[blk]; }
                    R += bs;
                } else {
                    float base;
                    if (kt == 2 * qt + 1) base = ttv; else if (kt == 2 * qt) base = 0.f; else { gacc += ttv; base = -gacc; }
                    float mx = -1.0e30f;
#pragma unroll
                    for (int blk = 0; blk < 4; ++blk) { const f32x4 ck = ckv[blk];
#pragma unroll
                        for (int i = 0; i < 4; ++i) { const bool valid = !need_mask || (kmin + 16 * blk + 4 * fq + i <= tq); const float lg = valid ? (s[blk][i] + cq - (ck[i] + base)) : -1.0e30f; pv[blk][i] = lg; mx = fmaxf(mx, lg); } }
                    mx = xmax32(xmax16(mx));
                    const float mnew = fmaxf(mrun, mx), al = fast_exp(mrun - mnew); float ps = 0.f;
#pragma unroll
                    for (int blk = 0; blk < 4; ++blk)
#pragma unroll
                        for (int i = 0; i < 4; ++i) { const float e = pv[blk][i] - mnew; const float p = (e > -80.f) ? fast_exp(e) : 0.f; pv[blk][i] = p; ps += p; }
                    lsum = lsum * al + ps;
                    if (__any(mnew > mrun)) {
#pragma unroll
                        for (int d = 0; d < 16; ++d) o[d] = o[d] * al; }
                    mrun = mnew;
                }
                bf16x8 pf[2];
#pragma unroll
                for (int c = 0; c < 2; ++c) { u32x4 pw; pw.x = cvt_pk_bf16(pv[2 * c][0], pv[2 * c][1]); pw.y = cvt_pk_bf16(pv[2 * c][2], pv[2 * c][3]); pw.z = cvt_pk_bf16(pv[2 * c + 1][0], pv[2 * c + 1][1]); pw.w = cvt_pk_bf16(pv[2 * c + 1][2], pv[2 * c + 1][3]);
                    pf[c] = __builtin_bit_cast(bf16x8, pw); }
                const unsigned va = (unsigned)(size_t)(lds + vbuf) + vrd;
                s16x4 x0, x1, x2, x3, y0, y1, y2, y3, z0, z1, z2, z3;
                AT_TR4(x0, x1, x2, x3, va, 0, 512, 1024, 1536);
                AT_TR4(y0, y1, y2, y3, va, AT_VPANEL, AT_VPANEL + 512, AT_VPANEL + 1024, AT_VPANEL + 1536);
                z0 = x0; z1 = x1; z2 = x2; z3 = x3;
#define AT_PV(db, A0, A1, A2, A3, F0, F1, F2, F3) do { \
                    if ((db) < 15) asm volatile("s_waitcnt lgkmcnt(4)" : "+v"(A0), "+v"(A1), "+v"(A2), "+v"(A3) :: "memory"); else asm volatile("s_waitcnt lgkmcnt(0)" : "+v"(A0), "+v"(A1), "+v"(A2), "+v"(A3) :: "memory"); \
                    if ((db) < 14) { AT_TR4(F0, F1, F2, F3, va, ((db) + 2) * AT_VPANEL, ((db) + 2) * AT_VPANEL + 512, ((db) + 2) * AT_VPANEL + 1024, ((db) + 2) * AT_VPANEL + 1536); } \
                    { const bf16x8 v0 = __builtin_shufflevector(A0, A1, 0, 1, 2, 3, 4, 5, 6, 7), v1 = __builtin_shufflevector(A2, A3, 0, 1, 2, 3, 4, 5, 6, 7); \
                      o[db] = __builtin_amdgcn_mfma_f32_16x16x32_bf16(v0, pf[0], o[db], 0, 0, 0); o[db] = __builtin_amdgcn_mfma_f32_16x16x32_bf16(v1, pf[1], o[db], 0, 0, 0); } } while (0)
#define AT_PVX(db) AT_PV(db, x0, x1, x2, x3, z0, z1, z2, z3)
#define AT_PVY(db) AT_PV(db, y0, y1, y2, y3, x0, x1, x2, x3)
#define AT_PVZ(db) AT_PV(db, z0, z1, z2, z3, y0, y1, y2, y3)
                AT_PVX(0); AT_PVY(1); AT_PVZ(2); AT_PVX(3); AT_PVY(4); AT_PVZ(5); AT_PVX(6); AT_PVY(7); AT_PVZ(8); AT_PVX(9); AT_PVY(10); AT_PVZ(11); AT_PVX(12); AT_PVY(13); AT_PVZ(14); AT_PVX(15);
#undef AT_PVX
#undef AT_PVY
#undef AT_PVZ
#undef AT_PV
            } else { if constexpr (FOX) { if (kt < 2 * qt) gacc += *(const LAS float*)(lds + ((it & 1) ? AT_TT1 : AT_TT0)); } }
            { bool cont;
              if constexpr (!FOX) cont = (R >= SB_STOP);
              else cont = (qn * KN + cq + ((kt <= 2 * qt) ? gacc : 0.f) - mrun >= FOX_STOP) || (kt > 2 * qt);
              const bool anyc = !wdone && __any(cont); wdone = !anyc;
              if (lane == 0) flags[(it & 1) * 8 + w] = anyc ? 1u : 0u; }
            asm volatile("s_waitcnt vmcnt(0) lgkmcnt(0)" ::: "memory"); __builtin_amdgcn_s_barrier();
            if (kt == 0) break;
            --kt; ++it;
        }
        if (id + F.G < 8 * 128) { const int id2 = id + F.G; const int bh = id2 & 7, qt = id2 >> 3, b = bh >> 2, h = bh & 3; const size_t rowbase = (size_t)b * SEQ; (void)b;
            AT_DMA(2 * qt + 1, 0); }
#undef AT_DMA
        float inv = 1.f;
        if constexpr (FOX) { const float lt = xsum32(xsum16(lsum)); inv = 1.f / lt; }
        { GAS bf16_t* op = O + ((size_t)((rowbase + t0 + 16 * w) >> 4) * 32 + h * 8) * 512 + fr * 32 + 8 * fq;
#pragma unroll
          for (int k2 = 0; k2 < 8; ++k2) { u32x4 ow;
              ow.x = cvt_pk_bf16(o[2 * k2][0] * inv, o[2 * k2][1] * inv); ow.y = cvt_pk_bf16(o[2 * k2][2] * inv, o[2 * k2][3] * inv); ow.z = cvt_pk_bf16(o[2 * k2 + 1][0] * inv, o[2 * k2 + 1][1] * inv); ow.w = cvt_pk_bf16(o[2 * k2 + 1][2] * inv, o[2 * k2 + 1][3] * inv);
              *(GAS u32x4*)(op + 512 * k2) = ow; } }
    }
}

constexpr int NPH = 41;
__host__ __device__ inline bool phase_nonempty(int k) { if (k == 0) return true; const int L = (k - 1) / 10, s = (k - 1) % 10; if (s == 1) return L == 2; if (s == 5) return (L & 1) != 0; if (s == 8) return false; return true; }
struct Args { const float* in[N_IN]; float* out; unsigned char* ws; int ph_lo, ph_hi, sub, pad; };

__global__ void __launch_bounds__(NTHREADS, 2) mk_fwd(Args args) {
    extern __shared__ __attribute__((aligned(16))) unsigned char lds_raw[];
    Frame F;
    F.lds = (LAS unsigned char*)lds_raw;
    F.wave = __builtin_amdgcn_readfirstlane((int)threadIdx.x >> 6);
    F.G = gridDim.x; { const int bx = blockIdx.x; F.vcu = (F.G % 8 == 0) ? (bx % 8) * (F.G / 8) + bx / 8 : bx; }
    F.ws = (GAS unsigned char*)args.ws; F.ctl = (GAS unsigned*)F.ws; F.res = (GAS float*)args.out;
    for (int u = (int)threadIdx.x; u < (LDS_BYTES - LDS_CTL) / 4; u += NTHREADS) ((LAS unsigned*)(F.lds + LDS_CTL))[u] = 0u;
    __syncthreads();
    const int lo = args.ph_lo, hi = args.ph_hi;
    XcdBarrier bar; bar.bar = F.ctl + CW_BAR; bar.x = 0; bar.st = nullptr;
    if (hi - lo > 1) bar = xcd_barrier_post(F.ctl + CW_BAR, (volatile LAS unsigned*)(F.lds + LDS_CTL) + 8);
#ifndef UNALIGNED_EPI
#define UNALIGNED_EPI 1
#endif
#ifndef DUP_MASK
#define DUP_MASK 0
#endif
#define DUP(n) (1 + ((DUP_MASK >> (n)) & 1))
#ifndef SITE_MASK
#define SITE_MASK 0xFFFFF
#endif
#define SITE(n) ((SITE_MASK >> (n)) & 1)
#define IN(k) (lo <= (k) && (k) < hi)
#define SEAM(k) do { if ((k) + 1 < hi) xcd_barrier(bar); } while (0)
    const int c = (int)blockIdx.x;
#define WSB(name) GAS unsigned char* name = launder_ptr(F.ws)
#define XBP(ws_, which) ((GAS bf16_t*)((ws_) + ((which) ? WS_XB1 : WS_XB0)))

    if (SITE(0) && IN(0)) { for (int rep_ = 0; rep_ < DUP(0); ++rep_) prologue_phase(F); SEAM(0); }

    for (int L = 0; L < DEPTH; ++L) {
        const int pb = 1 + 10 * L;
        {
            F.wave = launder_int(F.wave); F.ws = launder_ptr(F.ws); F.res = launder_ptr(F.res); F.ctl = (GAS unsigned*)F.ws; F.G = launder_int(F.G); }
        for (int repa_ = 0; repa_ < DUP(20); ++repa_) {
        if (SITE(1) && IN(pb + 0)) {
            WSB(ws);
            const GAS bf16_t* Wqkv = (const GAS bf16_t*)(ws + (L < 2 ? WS_WDEAD : WS_WLIVE)) + (L == 0 ? WD_QKV0 : L == 1 ? WD_QKV1 : L == 2 ? WL_QKV2 : WL_Q3);
            g8::ProbPlain P{XBP(ws, (L + 1) & 1), Wqkv, 1024, 1024, 16, T / 256, (L == 3) ? 4 : 12, F.G, c, 1};
            g8::EpiBf16Split E{(GAS bf16_t*)(ws + WS_QA), 1024, (L == 3) ? 0 : 1024, (size_t)(WS_KS - WS_QA) / 2};
            if (L == 0) cs_finalize(F);
            for (int rep_ = 0; rep_ < DUP(1); ++rep_) g8::gemm_phase<g8::ProbPlain, g8::EpiBf16Split, UNALIGNED_EPI == 0>(F.lds, P, E, F.wave);
            if (SITE(2) && L == 2) forget_phase(F, XBP(ws, (L + 1) & 1));
            SEAM(pb + 0);
        }
        if (SITE(3) && IN(pb + 1) && L == 2) { WSB(ws); knorm_phase(F, (const GAS bf16_t*)(ws + WS_KS)); SEAM(pb + 1); }
        if (IN(pb + 2)) {
            WSB(ws); GAS bf16_t* QA = (GAS bf16_t*)(ws + WS_QA); const GAS bf16_t* KS = (const GAS bf16_t*)(ws + WS_KS); const GAS bf16_t* VS = (const GAS bf16_t*)(ws + WS_VS);
            if (L < 2) { if (SITE(4)) attn_phase<false>(F, QA, KS, VS, QA); } else { if (SITE(5)) attn_phase<true>(F, QA, KS, VS, QA); }
            SEAM(pb + 2);
        }
        }
        if (SITE(6) && IN(pb + 3)) {
            WSB(ws);
            const GAS bf16_t* Wo = (const GAS bf16_t*)(ws + (L < 2 ? WS_WDEAD : WS_WLIVE)) + (L == 0 ? WD_O0 : L == 1 ? WD_O1 : L == 2 ? WL_O2 : WL_O3);
            g8::ProbPlain P{(const GAS bf16_t*)(ws + WS_QA), Wo, 1024, 1024, 16, T / 256, 4, F.G, c, 1};
            g8::EpiResidB<false> E{XBP(ws, (L + 1) & 1), (GAS float*)nullptr, (LAS float*)nullptr};
            g8::gemm_phase<g8::ProbPlain, g8::EpiResidB<false>>(F.lds, P, E, F.wave);
            SEAM(pb + 3);
        }
        if (IN(pb + 4)) { WSB(ws); GAS bf16_t* xln1 = XBP(ws, (L + 1) & 1); if (L & 1) { if (SITE(7)) ln_phase<true, true>(F, L, 0, xln1); } else { if (SITE(8)) ln_phase<false, true>(F, L, 0, xln1); } SEAM(pb + 4); }
        if (SITE(9) && IN(pb + 5) && (L & 1)) { moe_lists_phase(F); SEAM(pb + 5); }
        if (IN(pb + 6)) {
            WSB(ws); const GAS bf16_t* xln1 = XBP(ws, (L + 1) & 1);
            if (L & 1) { if (SITE(10)) { load_tab(F);
                const GAS bf16_t* Wmgu = (const GAS bf16_t*)(ws + (L == 1 ? WS_WDEAD : WS_WLIVE)) + (L == 1 ? WD_MGU0 : WL_MGU1); const GAS i32x4* elist = (const GAS i32x4*)(ws + WS_MISC + MS_ELIST);
                g8::ProbMoeGU P{xln1, Wmgu, elist, (const LAS int*)(F.lds + LDS_TAB), 1024, 1024, 16, F.G, c}; g8::EpiMoeGU E{(GAS bf16_t*)(ws + (L == 1 ? WS_QA : WS_WDEAD)), elist, (const GAS float*)(ws + WS_MISC + MS_EGATE), (LAS float*)(F.lds + LDS_XCH)};
                for (int rep_ = 0; rep_ < DUP(10); ++rep_) g8::gemm_phase<g8::ProbMoeGU, g8::EpiMoeGU, UNALIGNED_EPI == 0>(F.lds, P, E, F.wave);
                if (SITE(17)) {
                    const int rem = ((const LAS int*)(F.lds + LDS_TAB))[TB_ECUM + NE] % F.G;
                    if (c >= rem) { const GAS bf16_t* Wpp = (const GAS bf16_t*)(ws + (L == 1 ? WS_WDEAD : WS_WLIVE)) + (L == 1 ? WD_PP1 : WL_PP3);
                        g8::ProbPlain P2{(const GAS bf16_t*)(ws + WS_PB), Wpp, PLE, PLE, launder_int(4), T / 256, 4, F.G - rem, c - rem}; g8::EpiStoreB E2{(GAS bf16_t*)(ws + WS_VS)};
                        g8::gemm_phase<g8::ProbPlain, g8::EpiStoreB, UNALIGNED_EPI == 0>(F.lds, P2, E2, F.wave); } } } }
            else if (SITE(11)) { const GAS bf16_t* Wgu = (const GAS bf16_t*)(ws + (L == 0 ? WS_WDEAD : WS_WLIVE)) + (L == 0 ? WD_GU0 : WL_GU1);
                g8::ProbPlain P{xln1, Wgu, 1024, 1024, 16, T / 256, 22, F.G, c, 1}; g8::EpiSwiglu E{(GAS bf16_t*)(ws + (L == 0 ? WS_QA : WS_XB0)), DFF};
                for (int rep_ = 0; rep_ < DUP(11); ++rep_) g8::gemm_phase<g8::ProbPlain, g8::EpiSwiglu, UNALIGNED_EPI == 0>(F.lds, P, E, F.wave); }
            SEAM(pb + 6);
        }
        if (IN(pb + 7)) {
            WSB(ws);
            if (L & 1) { if (SITE(12)) { load_tab(F);
                const GAS bf16_t* Wmdn = (const GAS bf16_t*)(ws + (L == 1 ? WS_WDEAD : WS_WLIVE)) + (L == 1 ? WD_MDN0 : WL_MDN1);
                g8::ProbMoeDown P{(const GAS bf16_t*)(ws + (L == 1 ? WS_QA : WS_WDEAD)), Wmdn, (const LAS int*)(F.lds + LDS_TAB), 1408, 5632, 22, F.G, c}; g8::EpiMoeDownB E{XBP(ws, (L + 1) & 1), (const GAS int*)(ws + WS_MISC + MS_PLIST), (GAS float*)(ws + WS_MISC + MS_ST2), (LAS float*)(F.lds + LDS_XCH)};
                g8::gemm_phase<g8::ProbMoeDown, g8::EpiMoeDownB>(F.lds, P, E, F.wave); } }
            else if (SITE(13)) { const GAS bf16_t* Wdn = (const GAS bf16_t*)(ws + (L == 0 ? WS_WDEAD : WS_WLIVE)) + (L == 0 ? WD_DN0 : WL_DN1);
                g8::ProbPlain P{(const GAS bf16_t*)(ws + (L == 0 ? WS_QA : WS_XB0)), Wdn, DFF, DFF, 44, T / 256, 4, F.G, c, 1}; g8::EpiResidB<true> E{XBP(ws, (L + 1) & 1), (GAS float*)(ws + WS_MISC + MS_ST2), (LAS float*)(F.lds + LDS_XCH)};
                g8::gemm_phase<g8::ProbPlain, g8::EpiResidB<true>>(F.lds, P, E, F.wave); }
            SEAM(pb + 7);
        }
        if (IN(pb + 9)) {
            if (SITE(16) && !(L & 1)) { WSB(ws); const GAS bf16_t* Wpp = (const GAS bf16_t*)(ws + (L < 2 ? WS_WDEAD : WS_WLIVE)) + (L == 0 ? WD_PP0 : WL_PP2);
                g8::ProbPlain P{(const GAS bf16_t*)(ws + WS_PB), Wpp, PLE, PLE, launder_int(4), T / 256, 4, F.G, c}; g8::EpiStoreB E{(GAS bf16_t*)(ws + WS_QA)};
                g8::gemm_phase<g8::ProbPlain, g8::EpiStoreB, UNALIGNED_EPI == 0>(F.lds, P, E, F.wave); }
            if (SITE(15)) { WSB(ws); const GAS bf16_t* Wpg = (const GAS bf16_t*)(ws + (L < 2 ? WS_WDEAD : WS_WLIVE)) + (L == 0 ? WD_PG0 : L == 1 ? WD_PG1 : L == 2 ? WL_PG2 : WL_PG3);
                g8::ProbPlain P{XBP(ws, (L + 1) & 1), Wpg, 1024, 1024, 16, T / 256, 4, F.G, c, 1};
                g8::EpiGatePleLN E{XBP(ws, (L + 1) & 1), XBP(ws, L & 1), L == DEPTH - 1 ? F.res : (GAS float*)nullptr, (const GAS float*)(ws + WS_MISC + MS_ST2), (const GAS float*)(ws + WS_MISC + MS_CS) + CS_PG0 + 1024 * L, (const GAS float*)(ws + WS_MISC + MS_CS) + CS_TOTAL + CS_PG0 + 1024 * L, in_sel(IN_LNG) + (size_t)(2 * L + 1) * DM, in_sel(IN_LNB) + (size_t)(2 * L + 1) * DM, (LAS float*)(F.lds + LDS_XCH), (const GAS bf16_t*)(ws + ((L & 1) ? WS_VS : WS_QA))};
                for (int rep_ = 0; rep_ < DUP(15); ++rep_) g8::gemm_phase<g8::ProbPlain, g8::EpiGatePleLN>(F.lds, P, E, F.wave); }
            if (pb + 9 < NPH - 1) SEAM(pb + 9);
        }
    }
#undef WSB
#undef XBP
#undef IN
#undef SEAM
}

extern "C" void kernel_launch(void* const* d_in, const int* in_sizes, int n_in, void* d_out, int out_size, void* d_ws, size_t ws_size, hipStream_t stream) {
    static int grid = 0;
    if (grid == 0) {
        if (n_in != N_IN || out_size != T * DM || ws_size < WS_END) { fprintf(stderr, "kernel_launch: unexpected problem (n_in %d, out %d, ws %zu < %zu)\n", n_in, out_size, ws_size, (size_t)WS_END); grid = -1; return; }
        int dev = 0, cus = 0, per_cu = 0;
        if (hipGetDevice(&dev) != hipSuccess || hipDeviceGetAttribute(&cus, hipDeviceAttributeMultiprocessorCount, dev) != hipSuccess) { grid = -1; return; }
        if (hipFuncSetAttribute((const void*)mk_fwd, hipFuncAttributeMaxDynamicSharedMemorySize, LDS_BYTES) != hipSuccess) { fprintf(stderr, "kernel_launch: hipFuncSetAttribute failed\n"); grid = -1; return; }
        if (hipOccupancyMaxActiveBlocksPerMultiprocessor(&per_cu, (const void*)mk_fwd, NTHREADS, LDS_BYTES) != hipSuccess || per_cu < 1) { fprintf(stderr, "kernel_launch: occupancy query says %d blocks per CU\n", per_cu); }
        (void)hipGetLastError();
        grid = cus;
    }
    if (grid < 0) return;
    (void)hipMemsetAsync((char*)d_ws + WS_CTL, 0, CTL_ZERO_BYTES, stream);
    Args a{};
    for (int i = 0; i < N_IN; ++i) a.in[i] = (const float*)d_in[i];
    a.out = (float*)d_out; a.ws = (unsigned char*)d_ws;
    a.ph_lo = 0; a.ph_hi = NPH; a.sub = 0; a.pad = 0;
    hipLaunchKernelGGL(mk_fwd, dim3(grid), dim3(NTHREADS), LDS_BYTES, stream, a);
}
```

```cpp
#include <hip/hip_runtime.h>
#include <cstdio>
#include <cstdint>


#define LAS __attribute__((address_space(3)))
#define GAS __attribute__((address_space(1)))
typedef unsigned short bf16_t;
typedef short bf16x8 __attribute__((ext_vector_type(8)));
typedef short bf16x4 __attribute__((ext_vector_type(4)));
typedef float f32x4 __attribute__((ext_vector_type(4)));
typedef float f32x2 __attribute__((ext_vector_type(2)));
typedef unsigned u32x4 __attribute__((ext_vector_type(4)));
typedef unsigned u32x2 __attribute__((ext_vector_type(2)));
typedef int i32x4 __attribute__((ext_vector_type(4)));

constexpr int DM = 1024, NBATCH = 2, SEQ = 16384, T = NBATCH * SEQ, NH = 4, HD = 256, DFF = 2816, NE = 8, DFE = 704, PLE = 256, DEPTH = 4;
constexpr float ALPHA = 1.6817928305074292f;
constexpr float LN_EPS = 1e-5f;
constexpr int NWAVES = 8, NTHREADS = 512;
enum { IN_X = 0, IN_P, IN_AQKV, IN_AO, IN_KVF, IN_KVFB, IN_BQ, IN_BO, IN_FGU, IN_FDN, IN_MR, IN_MGU, IN_MDN, IN_PP, IN_PG, IN_LNG, IN_LNB, N_IN };

constexpr size_t MiB = 1u << 20;
constexpr size_t WS_CTL = 0, CTL_ZERO_BYTES = 1 * MiB;
constexpr size_t WS_MISC = 1 * MiB;
constexpr size_t WS_WLIVE = 8 * MiB;
constexpr size_t WS_PB = 77 * MiB;
constexpr size_t WS_XB1 = 93 * MiB, WS_XB0 = 157 * MiB;
constexpr size_t WS_WDEAD = 221 * MiB;
constexpr size_t WS_QA = 294 * MiB, WS_KS = 358 * MiB, WS_VS = 422 * MiB, WS_END = 486 * MiB;
constexpr size_t MS_REC = 0;
constexpr size_t MS_HIST = 512 * 1024;
constexpr size_t MS_ELIST = 576 * 1024;
constexpr int ELIST_CAP = 2 * T + NE * 256;
constexpr size_t MS_PLIST = MS_ELIST + (size_t)ELIST_CAP * 16;
constexpr int NPAIR = 28, PLIST_CAP = T + NPAIR * 256;
constexpr size_t MS_TAB = 2 * MiB;
constexpr size_t MS_CL = 2 * MiB + 64 * 1024;
constexpr size_t MS_TOT = MS_CL + (size_t)8 * SEQ * 4;
constexpr size_t MS_SNAP = 3 * MiB;
constexpr size_t MS_EGATE = 4 * MiB + 512 * 1024;
constexpr size_t MS_CS = 3 * MiB;
constexpr size_t MS_ST2 = 5 * MiB, MS_ST1 = 6 * MiB;
constexpr int CS_PG0 = 0, CS_GU0 = 4096, CS_MGU0 = CS_GU0 + 2 * 5632, CS_TOTAL = CS_MGU0 + 2 * 8 * 1536;
constexpr size_t MS_GATE = 4 * MiB;
static_assert(MS_PLIST + (size_t)PLIST_CAP * 4 <= MS_TAB && MS_TOT + 8 * 256 * 4 <= MS_SNAP, "misc map");
enum { TB_ECUM = 0  , TB_EOFF = 16  , TB_NRT = 32, TB_RT2P = 64  , TB_WORDS = 320 };
constexpr int CW_TMO = 0, CW_CODE = 1, CW_DBG = 64  , CW_KN2 = 192  , CW_BAR = 4096;

constexpr size_t WSZ_QKV = (size_t)3072 * 1024, WSZ_SQ = (size_t)1024 * 1024, WSZ_GU = (size_t)5632 * 1024, WSZ_DN = (size_t)1024 * 2816,
                 WSZ_MGU = (size_t)NE * 1536 * 1024, WSZ_MDN = (size_t)1024 * 5632, WSZ_PP = (size_t)1024 * 256;
constexpr size_t WD_QKV0 = 0, WD_O0 = WD_QKV0 + WSZ_QKV, WD_QKV1 = WD_O0 + WSZ_SQ, WD_O1 = WD_QKV1 + WSZ_QKV, WD_GU0 = WD_O1 + WSZ_SQ, WD_DN0 = WD_GU0 + WSZ_GU,
                 WD_MGU0 = WD_DN0 + WSZ_DN, WD_MDN0 = WD_MGU0 + WSZ_MGU, WD_PP0 = WD_MDN0 + WSZ_MDN, WD_PG0 = WD_PP0 + WSZ_PP, WD_PP1 = WD_PG0 + WSZ_SQ, WD_PG1 = WD_PP1 + WSZ_PP, WD_END = WD_PG1 + WSZ_SQ;
constexpr size_t WL_QKV2 = 0, WL_O2 = WL_QKV2 + WSZ_QKV, WL_Q3 = WL_O2 + WSZ_SQ, WL_O3 = WL_Q3 + WSZ_SQ, WL_GU1 = WL_O3 + WSZ_SQ, WL_DN1 = WL_GU1 + WSZ_GU,
                 WL_MGU1 = WL_DN1 + WSZ_DN, WL_MDN1 = WL_MGU1 + WSZ_MGU, WL_PP2 = WL_MDN1 + WSZ_MDN, WL_PG2 = WL_PP2 + WSZ_PP, WL_PP3 = WL_PG2 + WSZ_SQ, WL_PG3 = WL_PP3 + WSZ_PP, WL_END = WL_PG3 + WSZ_SQ;
static_assert(WD_END * 2 <= 73 * MiB && WL_END * 2 <= 69 * MiB, "weight regions");
static_assert((size_t)T * DFF * 2 <= WS_END - WS_QA && WS_XB0 + (size_t)T * DFF * 2 <= WS_KS && WS_WDEAD + (size_t)(T + NPAIR * 256) * 1408 * 2 <= WS_KS, "h overlays");

constexpr int RING_BYTES = 131072;
constexpr int LDS_CTL = 135168;
constexpr int LDS_TAB = LDS_CTL + 128;
constexpr int LDS_FLAGS = LDS_TAB + TB_WORDS * 4;
constexpr int LDS_BYTES = 147456;
constexpr int LDS_XCH = 137216;
static_assert(LDS_FLAGS + 64 <= LDS_XCH && LDS_XCH + 8192 <= LDS_BYTES, "LDS map");

#define RLX_AGENT __ATOMIC_RELAXED, __HIP_MEMORY_SCOPE_AGENT
__device__ __forceinline__ unsigned f2bf(float f) { unsigned u = __builtin_bit_cast(unsigned, f); return (u + 0x7fffu + ((u >> 16) & 1u)) >> 16; }
__device__ __forceinline__ unsigned pk2(float lo, float hi) { return f2bf(lo) | (f2bf(hi) << 16); }
__device__ __forceinline__ float bf2f(unsigned short b) { return __builtin_bit_cast(float, (unsigned)b << 16); }
typedef __bf16 bf16v2_t __attribute__((ext_vector_type(2)));
__device__ __forceinline__ unsigned cvt_pk_bf16(float lo, float hi) { bf16v2_t v; v[0] = (__bf16)lo; v[1] = (__bf16)hi; return __builtin_bit_cast(unsigned, v); }
__device__ __forceinline__ float shx(float v, int m, int lane) { return __builtin_bit_cast(float, __builtin_amdgcn_ds_bpermute((lane ^ m) << 2, __builtin_bit_cast(int, v))); }
__device__ __forceinline__ void xswap32(float& a, float& b) { asm volatile("s_nop 1\n\tv_permlane32_swap_b32 %0, %1" : "+v"(a), "+v"(b)); }
__device__ __forceinline__ void xswap16(float& a, float& b) { asm volatile("s_nop 1\n\tv_permlane16_swap_b32 %0, %1" : "+v"(a), "+v"(b)); }
__device__ __forceinline__ float xsum16(float v) { float a = v, b = v; xswap16(a, b); return a + b; }
__device__ __forceinline__ float xsum32(float v) { float a = v, b = v; xswap32(a, b); return a + b; }
__device__ __forceinline__ float xmax16(float v) { float a = v, b = v; xswap16(a, b); return fmaxf(a, b); }
__device__ __forceinline__ float xmax32(float v) { float a = v, b = v; xswap32(a, b); return fmaxf(a, b); }
__device__ __forceinline__ float xget16(float v, int fq) { float a = v, b = v; xswap16(a, b); return (fq & 1) ? a : b; }
__device__ __forceinline__ float xget32(float v, int fq) { float a = v, b = v; xswap32(a, b); return (fq & 2) ? a : b; }
__device__ __forceinline__ int shxi(int v, int m, int lane) { return __builtin_amdgcn_ds_bpermute((lane ^ m) << 2, v); }
__device__ __forceinline__ float shup(float v, int o, int lane) { return __builtin_bit_cast(float, __builtin_amdgcn_ds_bpermute(((lane - o) & 63) << 2, __builtin_bit_cast(int, v))); }
__device__ __forceinline__ float wave_sum(float v, int lane) {
#pragma unroll
    for (int o = 1; o < 64; o <<= 1) v += shx(v, o, lane);
    return v;
}
template <int CTRL> __device__ __forceinline__ float dpp_mov(float v) { return __builtin_bit_cast(float, __builtin_amdgcn_update_dpp(0, __builtin_bit_cast(int, v), CTRL, 0xF, 0xF, true)); }
__device__ __forceinline__ float wave_sum_dpp(float v) {
    v += dpp_mov<0xB1>(v); v += dpp_mov<0x4E>(v); v += dpp_mov<0x141>(v); v += dpp_mov<0x140>(v);
    const int b = __builtin_bit_cast(int, v);
    return (__builtin_bit_cast(float, __builtin_amdgcn_readlane(b, 0)) + __builtin_bit_cast(float, __builtin_amdgcn_readlane(b, 16))) + (__builtin_bit_cast(float, __builtin_amdgcn_readlane(b, 32)) + __builtin_bit_cast(float, __builtin_amdgcn_readlane(b, 48)));
}
__device__ __forceinline__ float fast_exp(float x) { return __builtin_amdgcn_exp2f(x * 1.4426950408889634f); }
__device__ __forceinline__ float fast_log(float x) { return __builtin_amdgcn_logf(x) * 0.6931471805599453f; }
__device__ __forceinline__ float softplus_f(float z) { return fmaxf(z, 0.f) + fast_log(1.f + fast_exp(-fabsf(z))); }
__device__ __forceinline__ float sigmoid_f(float z) { return __builtin_amdgcn_rcpf(1.f + fast_exp(-z)); }

typedef const GAS float* fptr_t;
__device__ __forceinline__ const GAS float* in_sel(int idx) { const __attribute__((address_space(4))) fptr_t* ka = (const __attribute__((address_space(4))) fptr_t*)__builtin_amdgcn_kernarg_segment_ptr(); return ka[idx]; }

template <class Tp> __device__ __forceinline__ GAS Tp* launder_ptr(GAS Tp* p) { unsigned lo = (unsigned)(unsigned long long)p, hi = (unsigned)((unsigned long long)p >> 32); asm volatile("" : "+v"(lo), "+v"(hi));
    lo = __builtin_amdgcn_readfirstlane(lo); hi = __builtin_amdgcn_readfirstlane(hi); return (GAS Tp*)(((unsigned long long)hi << 32) | lo); }
__device__ __forceinline__ int launder_int(int v) { asm volatile("" : "+v"(v)); return __builtin_amdgcn_readfirstlane(v); }

#define XB_TMO      128
#define XB_XCNT(j)  (256  + 64 * (j))
#define XB_XSUB(j)  (1280 + 64 * (j))
#define XB_XGEN(j)  (2304 + 64 * (j))
#define XB_TOP      3328
#define XB_TOPGEN   3392
#define XCD_BAR_WORDS 3456
#define XB_SPIN_CAP (1u << 18)
__device__ __forceinline__ unsigned xb_ld(GAS unsigned* p)              { return __hip_atomic_load(p, __ATOMIC_RELAXED, __HIP_MEMORY_SCOPE_AGENT); }
__device__ __forceinline__ unsigned xb_add(GAS unsigned* p, unsigned v) { return __hip_atomic_fetch_add(p, v, __ATOMIC_RELAXED, __HIP_MEMORY_SCOPE_AGENT); }
__device__ __forceinline__ unsigned xb_xcc_id() { return (unsigned)__builtin_amdgcn_s_getreg((3 << 11) | 20) & 0xFu; }
#define XB_SPIN(cond, bar) do { unsigned _sp = 0; while (cond) { __builtin_amdgcn_s_sleep(1); \
    if ((++_sp & 255u) == 0u) { if (xb_ld(&(bar)[XB_TMO])) break; if (_sp > XB_SPIN_CAP) { (void)xb_add(&(bar)[XB_TMO], 1u); break; } } } } while (0)
struct XcdBarrier { GAS unsigned* bar; unsigned x; volatile LAS unsigned* st; };
__device__ __forceinline__ XcdBarrier xcd_barrier_post(GAS unsigned* bar, volatile LAS unsigned* st) {
    XcdBarrier b; b.bar = bar; b.x = xb_xcc_id(); b.st = st;
    if (threadIdx.x == 0) (void)xb_add(&bar[XB_XCNT(b.x)], 1u);
    return b;
}
__device__ __forceinline__ void xcd_barrier_complete(GAS unsigned* bar, unsigned x, unsigned& nloc, unsigned& nx) {
    const unsigned G = gridDim.x * gridDim.y * gridDim.z;
    unsigned sum, cnt, mine, sp = 0u;
    for (;;) {
        sum = 0u; cnt = 0u; mine = 0u;
#pragma unroll
        for (unsigned j = 0; j < 16; ++j) { const unsigned c = xb_ld(&bar[XB_XCNT(j)]); sum += c; cnt += (c > 0u) ? 1u : 0u; mine = (j == x) ? c : mine; }
        if (sum == G) break;
        __builtin_amdgcn_s_sleep(1);
        if ((++sp & 255u) == 0u) { if (xb_ld(&bar[XB_TMO])) break; if (sp > XB_SPIN_CAP) { (void)xb_add(&bar[XB_TMO], 1u); break; } }
    }
    nloc = mine > 0u ? mine : 1u; nx = cnt > 0u ? cnt : 1u;
}
__device__ __forceinline__ void xcd_barrier(const XcdBarrier& b) {
    asm volatile("s_waitcnt vmcnt(0)" ::: "memory");
    __syncthreads();
    if (threadIdx.x == 0) {
        GAS unsigned* bar = b.bar;
        __builtin_amdgcn_s_waitcnt(0);
        unsigned nloc = b.st[0], nx = b.st[1];
        if (nloc == 0u) { xcd_barrier_complete(bar, b.x, nloc, nx); b.st[0] = nloc; b.st[1] = nx; }
        const unsigned old = xb_add(&bar[XB_XSUB(b.x)], 1u);
        const unsigned gen = old / nloc;
        if (old + 1u == (gen + 1u) * nloc) {
            __builtin_amdgcn_fence(__ATOMIC_RELEASE, "agent");
            asm volatile("s_waitcnt vmcnt(0)" ::: "memory");
            const unsigned og = xb_add(&bar[XB_TOP], 1u);
            const unsigned tg = og / nx;
            if (og + 1u == (tg + 1u) * nx) xb_add(&bar[XB_TOPGEN], 1u);
            else XB_SPIN(xb_ld(&bar[XB_TOPGEN]) == tg, bar);
            xb_add(&bar[XB_XGEN(b.x)], 1u);
            __builtin_amdgcn_fence(__ATOMIC_ACQUIRE, "agent");
            asm volatile("s_waitcnt vmcnt(0)" ::: "memory");
        } else {
            XB_SPIN(xb_ld(&bar[XB_XGEN(b.x)]) == gen, bar);
            __builtin_amdgcn_fence(__ATOMIC_ACQUIRE, "agent");
            asm volatile("s_waitcnt vmcnt(0)" ::: "memory");
        }
    }
    __syncthreads();
}

__device__ __forceinline__ size_t sblk(int r, int c) { return ((size_t)(r >> 4) * 32 + (c >> 5)) * 512 + (r & 15) * 32 + (c & 31); }
namespace g8 {
constexpr int BM = 256, BK = 64, HALF = 128, HTB = HALF * BK * 2, STAGE_BYTES = 8 * HTB, NXCD = 8, WGM = 8;
__host__ __device__ __forceinline__ int lds_byte(int r, int c) { const int st = (r >> 4) * 2 + (c >> 5), rr = r & 15, cc = c & 31, ob = rr * 64 + cc * 2; return st * 1024 + (ob ^ (((ob >> 9) & 1) << 5)); }
__host__ __device__ __forceinline__ void stage_rc(int b, int& R, int& C) { const int st = b / 1024, sb = b % 1024, swz = sb ^ (((sb >> 9) & 1) << 5); R = (st >> 1) * 16 + swz / 64; C = (st & 1) * 32 + (swz % 64) / 2; }
__host__ __device__ __forceinline__ int perm32(int rho) { const int n = rho >> 4, i = rho & 15; return 8 * (i >> 2) + 4 * n + (i & 3); }
struct Unit { int pm, pn, x0, x1; };
template <class E, class = void> struct has_pre { static constexpr bool value = false; };
template <class E> struct has_pre<E, decltype((void)E::PRE)> { static constexpr bool value = true; };
__device__ __forceinline__ bool static_order(int i, int G, int c, int nM, int nN, int& pm, int& pn) {
    const int nwg = nM * nN; const long L = (long)i * G + c; if (L >= nwg) return false;
    int wgid = (int)L; { const int q = nwg / NXCD, r = nwg % NXCD, xcd = wgid % NXCD, off = wgid / NXCD; wgid = (xcd < r ? xcd * (q + 1) : r * (q + 1) + (xcd - r) * q) + off; }
    const int nig = WGM * nN, gid = wgid / nig, fm = gid * WGM, gsz = (nM - fm) < WGM ? (nM - fm) : WGM;
    pm = fm + ((wgid % nig) % gsz); pn = (wgid % nig) / gsz; return true;
}

template <class Prob, class Epi, bool ALIGN_EPI = true>
__device__ __forceinline__ void gemm_phase(LAS unsigned char* lds, const Prob& P, const Epi& E, int wave_id) {
    int tid_; asm volatile("v_mbcnt_lo_u32_b32 %0, -1, 0\n\tv_mbcnt_hi_u32_b32 %0, -1, %0" : "=v"(tid_)); tid_ += wave_id * 64;
    const int tid = tid_, wid = __builtin_amdgcn_readfirstlane(tid >> 6), lane = tid & 63, wr = wid >> 2, wc = wid & 3, fr = lane & 15, fq = lane >> 4;
    const int nt = P.nt;
    unsigned voffA[2], voffB[2]; int Rr0 = 0; unsigned voffC = 0;
#pragma unroll
    for (int i = 0; i < 2; ++i) { int R, C; stage_rc(tid * 16 + i * 8192, R, C); const int Rb = R; static_assert(Epi::PERM, "the stored weight order assumes the permuted (8 consecutive columns per lane) accumulator layout");
        voffA[i] = P.ablk ? (unsigned)(((R >> 4) * (P.lda >> 5) + (C >> 5)) * 1024 + ((R & 15) * 32 + (C & 31)) * 2) : (unsigned)(R * P.lda + C) * 2u;
        voffB[i] = (unsigned)(((Rb >> 4) * (P.ldb >> 5) + (C >> 5)) * 1024 + ((Rb & 15) * 32 + (C & 31)) * 2);
        if (i == 0) { Rr0 = R; voffC = (unsigned)((C >> 5) * 1024 + (C & 31) * 2); } }
    const size_t kstep = (P.ablk || Prob::GATHER) ? (size_t)2048 : (size_t)(BK * 2);
    const size_t hstepA = (size_t)HALF * P.lda * 2, hstepB = (size_t)HALF * P.ldb * 2;
    const unsigned ldsw = (unsigned)wid * 1024u;
    const int aoff = lds_byte(wr * 64 + fr, fq * 8), boff = lds_byte(wc * 32 + fr, fq * 8);
#define G8_SA(b, h) (((b) * 2 + (h)) * HTB)
#define G8_SB(b, h) ((4 + (b) * 2 + (h)) * HTB)
#define G8_STAGE(bufoff, gbase, voff) do { _Pragma("unroll") for (int _i = 0; _i < 2; ++_i) \
        __builtin_amdgcn_global_load_lds((const GAS unsigned*)((const GAS char*)(gbase) + (voff)[_i]), (LAS unsigned*)(lds + (bufoff) + ldsw + _i * 8192), 16, 0, 0); } while (0)
#define G8_STAGE_A(bufoff, h, kb, NX) do { if constexpr (Prob::GATHER) { const unsigned pk_ = (NX) ? gAn[h] : gAc[h]; const unsigned t0_ = pk_ & 0xffffu, t1_ = pk_ >> 16; const unsigned vo_[2] = {(t0_ >> 4) * 32768u + (t0_ & 15u) * 64u + voffC, (t1_ >> 4) * 32768u + (t1_ & 15u) * 64u + voffC};     \
        G8_STAGE(bufoff, P.a_base() + (kb), vo_); } \
        else { G8_STAGE(bufoff, ((NX) ? nA : cA) + (h) * hstepA + (kb), voffA); } } while (0)
#define G8_LDA(dst, b, h) do { _Pragma("unroll") for (int m = 0; m < 4; ++m) _Pragma("unroll") for (int k = 0; k < 2; ++k) dst[m][k] = *(const LAS bf16x8*)(lds + G8_SA(b, h) + aoff + m * 2048 + k * 1024); } while (0)
#define G8_LDB(dst, b, h) do { _Pragma("unroll") for (int n = 0; n < 2; ++n) _Pragma("unroll") for (int k = 0; k < 2; ++k) dst[n][k] = *(const LAS bf16x8*)(lds + G8_SB(b, h) + boff + n * 2048 + k * 1024); } while (0)
#define G8_MMA(ai, bj, At, Bt) do { __builtin_amdgcn_s_setprio(1); _Pragma("unroll") for (int m = 0; m < 4; ++m) _Pragma("unroll") for (int n = 0; n < 2; ++n) _Pragma("unroll") for (int k = 0; k < 2; ++k) \
        acc[ai][bj][m][n] = __builtin_amdgcn_mfma_f32_16x16x32_bf16(Bt[n][k], At[m][k], acc[ai][bj][m][n], 0, 0, 0); __builtin_amdgcn_s_setprio(0); } while (0)
#define G8_WAIT_V(n) asm volatile("s_waitcnt vmcnt(" #n ")" ::: "memory")
#define G8_WAIT_L(n) asm volatile("s_waitcnt lgkmcnt(" #n ")" ::: "memory")
#define G8_BAR __builtin_amdgcn_s_barrier()
#define G8_SCHED __builtin_amdgcn_sched_barrier(0)
    Unit cur, nxt; int ui = 0;
    if (!P.next(0, cur)) return;
    f32x4 acc[2][2][4][2];
#pragma unroll
    for (int a = 0; a < 2; ++a)
#pragma unroll
        for (int b = 0; b < 2; ++b)
#pragma unroll
            for (int m = 0; m < 4; ++m)
#pragma unroll
                for (int n = 0; n < 2; ++n) acc[a][b][m][n] = (f32x4){0.f, 0.f, 0.f, 0.f};
    bf16x8 At[4][2], B0[2][2], B1[2][2];
    unsigned gAc[2], gAn[2];
    const GAS char* cA = nullptr; const GAS char* nA = nullptr;
    if constexpr (Prob::GATHER) { P.gather(cur, Rr0, gAc); } else { cA = P.a_tile(cur); }
    if constexpr (has_pre<Epi>::value) E.first(cur, tid);
    {
        const GAS char* b0 = P.b_ptr(cur, 0); const GAS char* b1 = P.b_ptr(cur, 1);
        G8_STAGE(G8_SB(0, 0), b0, voffB); G8_STAGE(G8_SB(0, 1), b0 + hstepB, voffB); G8_STAGE_A(G8_SA(0, 0), 0, 0, false); G8_STAGE_A(G8_SA(0, 1), 1, 0, false);
        if (wr == 1) G8_BAR;
        G8_WAIT_V(2); G8_BAR;
        G8_STAGE(G8_SB(1, 0), b1, voffB); G8_STAGE_A(G8_SA(1, 0), 0, kstep, false); G8_STAGE(G8_SB(1, 1), b1 + hstepB, voffB);
        G8_WAIT_V(6); G8_BAR;
    }
    for (;;) {
        const bool has_next = P.next(ui + 1, nxt);
        if (!has_next) nxt = cur;
        if constexpr (Prob::GATHER) { if (has_next) P.gather(nxt, Rr0, gAn); else { gAn[0] = gAc[0]; gAn[1] = gAc[1]; } }
        else { nA = P.a_tile(nxt); }
        for (int t = 0; t < nt; t += 2) {
            const bool last = (t == nt - 2);
            const size_t a1k = (size_t)(t + 1) * kstep;
            const size_t a2k = last ? 0 : (size_t)(t + 2) * kstep, a3k = last ? kstep : (size_t)(t + 3) * kstep;
            const GAS char* b2 = last ? P.b_ptr(nxt, 0) : P.b_ptr(cur, t + 2); const GAS char* b3 = last ? P.b_ptr(nxt, 1) : P.b_ptr(cur, t + 3);
            G8_LDB(B0, 0, 0); G8_LDB(B1, 0, 1); G8_SCHED; G8_LDA(At, 0, 0); G8_STAGE_A(G8_SA(1, 1), 1, a1k, false);
            G8_WAIT_V(8); G8_WAIT_L(0); G8_BAR; G8_MMA(0, 0, At, B0); G8_MMA(0, 1, At, B1); G8_BAR; G8_SCHED;
            G8_LDA(At, 0, 1); G8_STAGE(G8_SB(0, 0), b2, voffB); G8_STAGE(G8_SB(0, 1), b2 + hstepB, voffB);
            if (last) { G8_STAGE_A(G8_SA(0, 0), 0, a2k, true); } else { G8_STAGE_A(G8_SA(0, 0), 0, a2k, false); }
            G8_WAIT_V(8); G8_WAIT_L(0); G8_BAR; G8_MMA(1, 0, At, B0); G8_MMA(1, 1, At, B1); G8_BAR; G8_SCHED;
            G8_LDB(B0, 1, 0); G8_LDB(B1, 1, 1); G8_SCHED; G8_LDA(At, 1, 0);
            if (last) { G8_STAGE_A(G8_SA(0, 1), 1, a2k, true); } else { G8_STAGE_A(G8_SA(0, 1), 1, a2k, false); }
            G8_WAIT_V(8); G8_WAIT_L(0); G8_BAR; G8_MMA(0, 0, At, B0); G8_MMA(0, 1, At, B1); G8_BAR; G8_SCHED;
            G8_LDA(At, 1, 1); G8_STAGE(G8_SB(1, 0), b3, voffB); G8_STAGE(G8_SB(1, 1), b3 + hstepB, voffB);
            if (last) { G8_STAGE_A(G8_SA(1, 0), 0, a3k, true); } else { G8_STAGE_A(G8_SA(1, 0), 0, a3k, false); }
            G8_WAIT_V(8); G8_WAIT_L(0); G8_BAR; G8_MMA(1, 0, At, B0); G8_MMA(1, 1, At, B1); G8_BAR; G8_SCHED;
        }
        if constexpr (ALIGN_EPI) { if (wr == 0) G8_BAR; }
        { int l2_; asm volatile("v_mbcnt_lo_u32_b32 %0, -1, 0\n\tv_mbcnt_hi_u32_b32 %0, -1, %0" : "=v"(l2_)); if constexpr (has_pre<Epi>::value) E(acc, cur, nxt, has_next, ui, wr, wc, l2_ & 15, l2_ >> 4); else E(acc, cur, wr, wc, l2_ & 15, l2_ >> 4); }
        if (!has_next) break;
#pragma unroll
        for (int a = 0; a < 2; ++a)
#pragma unroll
            for (int b = 0; b < 2; ++b)
#pragma unroll
                for (int m = 0; m < 4; ++m)
#pragma unroll
                    for (int n = 0; n < 2; ++n) acc[a][b][m][n] = (f32x4){0.f, 0.f, 0.f, 0.f};
        cur = nxt; ++ui;
        if constexpr (Prob::GATHER) { gAc[0] = gAn[0]; gAc[1] = gAn[1]; }
        else { cA = nA; }
        if constexpr (ALIGN_EPI) { if (wr == 1) G8_BAR; }
    }
    G8_WAIT_V(0);
    if constexpr (!ALIGN_EPI) { if (wr == 0) G8_BAR; }
    G8_BAR;
#undef G8_SA
#undef G8_SB
#undef G8_STAGE
#undef G8_STAGE_A
#undef G8_LDA
#undef G8_LDB
#undef G8_MMA
#undef G8_WAIT_V
#undef G8_WAIT_L
#undef G8_BAR
#undef G8_SCHED
}

struct ProbPlain {
    static constexpr bool GATHER = false;
    const GAS bf16_t* A; const GAS bf16_t* Bt; int lda, ldb, nt, nM, nN, G, c; int ablk = 0;
    __device__ __forceinline__ bool next(int i, Unit& u) const { u.x0 = 0; u.x1 = 0; return static_order(i, G, c, nM, nN, u.pm, u.pn); }
    __device__ __forceinline__ const GAS char* a_tile(const Unit& u) const { return (const GAS char*)A + (size_t)u.pm * BM * lda * 2; }
    __device__ __forceinline__ const GAS char* a_base() const { return (const GAS char*)A; }
    __device__ __forceinline__ void gather(const Unit&, int, unsigned (&)[2]) const {}
    __device__ __forceinline__ const GAS char* b_ptr(const Unit& u, int t) const { return (const GAS char*)Bt + (size_t)u.pn * BM * ldb * 2 + (size_t)t * 2048; }
};
struct ProbMoeGU {
    static constexpr bool GATHER = true;
    const GAS bf16_t* A; const GAS bf16_t* Bt; const GAS i32x4* elist; const LAS int* tab; int lda, ldb, nt, G, c; static constexpr int ablk = 0;
    __device__ __forceinline__ bool next(int i, Unit& u) const {
        const int total = tab[TB_ECUM + NE]; const long L = (long)i * G + c; if (L >= total) return false;
        int wgid = (int)L; { const int q = total / NXCD, r = total % NXCD, xcd = wgid % NXCD, off = wgid / NXCD; wgid = (xcd < r ? xcd * (q + 1) : r * (q + 1) + (xcd - r) * q) + off; }
        int e = 0;
#pragma unroll
        for (int k = 1; k < NE; ++k) e += (wgid >= tab[TB_ECUM + k]) ? 1 : 0;
        const int loc = wgid - tab[TB_ECUM + e], nM = (tab[TB_ECUM + e + 1] - tab[TB_ECUM + e]) / 6;
        const int nig = WGM * 6, gid = loc / nig, fm = gid * WGM, gsz = (nM - fm) < WGM ? (nM - fm) : WGM;
        u.pm = fm + ((loc % nig) % gsz); u.pn = (loc % nig) / gsz; u.x0 = e; u.x1 = tab[TB_EOFF + e] + 256 * u.pm; return true;
    }
    __device__ __forceinline__ const GAS char* a_tile(const Unit&) const { return (const GAS char*)A; }
    __device__ __forceinline__ const GAS char* a_base() const { return (const GAS char*)A; }
    __device__ __forceinline__ void gather(const Unit& u, int R0, unsigned (&g)[2]) const {
#pragma unroll
        for (int h = 0; h < 2; ++h) { const int t0 = elist[u.x1 + h * HALF + R0].x, t1 = elist[u.x1 + h * HALF + R0 + 64].x; g[h] = (unsigned)t0 | ((unsigned)t1 << 16); }
    }
    __device__ __forceinline__ const GAS char* b_ptr(const Unit& u, int t) const { return (const GAS char*)Bt + (size_t)(u.x0 * 1536 + u.pn * BM) * ldb * 2 + (size_t)t * 2048; }
};
struct ProbMoeDown {
    static constexpr bool GATHER = false;
    const GAS bf16_t* A; const GAS bf16_t* Bt; const LAS int* tab; int lda, ldb, nt, G, c; static constexpr int ablk = 0;
    __device__ __forceinline__ bool next(int i, Unit& u) const {
        const int nM = tab[TB_NRT]; if (!static_order(i, G, c, nM, 4, u.pm, u.pn)) return false;
        const int p = tab[TB_RT2P + u.pm]; u.x0 = (p & 0xff) * DFE; u.x1 = ((p >> 8) & 0xff) * DFE; return true;
    }
    __device__ __forceinline__ const GAS char* a_tile(const Unit& u) const { return (const GAS char*)A + (size_t)u.pm * BM * lda * 2; }
    __device__ __forceinline__ const GAS char* a_base() const { return (const GAS char*)A; }
    __device__ __forceinline__ void gather(const Unit&, int, unsigned (&)[2]) const {}
    __device__ __forceinline__ const GAS char* b_ptr(const Unit& u, int t) const { const int ko = (t < 11) ? (u.x0 + t * BK) : (u.x1 + (t - 11) * BK); return (const GAS char*)Bt + (size_t)u.pn * BM * ldb * 2 + (size_t)(ko >> 5) * 1024; }
};

#define G8_ROWLOOP _Pragma("unroll") for (int ai = 0; ai < 2; ++ai) _Pragma("unroll") for (int m = 0; m < 4; ++m)
struct EpiBf16Split {
    static constexpr bool PERM = true;
    GAS bf16_t* O; int ldc; int split_cols; size_t split_stride;
    __device__ __forceinline__ void operator()(const f32x4 (&acc)[2][2][4][2], const Unit& u, int wr, int wc, int fr, int fq) const {
        const int row0 = u.pm * BM + wr * 64 + fr; int colt = u.pn * BM; GAS bf16_t* base = O;
        if (split_cols) { const int t = colt / split_cols; base += (size_t)t * split_stride; colt -= t * split_cols; }
        const int col0 = colt + wc * 32 + 8 * fq;
        G8_ROWLOOP { GAS bf16_t* blk = base + ((size_t)(u.pm * 16 + ai * 8 + wr * 4 + m) * (ldc >> 5) + (colt >> 5) + wc) * 512 + fr * 32 + 8 * fq;
#pragma unroll
            for (int bj = 0; bj < 2; ++bj) { const f32x4 v0 = acc[ai][bj][m][0], v1 = acc[ai][bj][m][1];
                u32x4 w; w.x = cvt_pk_bf16(v0[0], v0[1]); w.y = cvt_pk_bf16(v0[2], v0[3]); w.z = cvt_pk_bf16(v1[0], v1[1]); w.w = cvt_pk_bf16(v1[2], v1[3]);
                *(GAS u32x4*)(blk + bj * 4 * 512) = w; } }
        (void)row0; (void)col0;
    }
};
struct EpiResid {
    static constexpr bool PERM = false;
    const GAS float* rin; GAS float* out;
    __device__ __forceinline__ void operator()(const f32x4 (&acc)[2][2][4][2], const Unit& u, int wr, int wc, int fr, int fq) const {
        const int row0 = u.pm * BM + wr * 64 + fr, col0 = u.pn * BM + wc * 32 + 4 * fq;
        G8_ROWLOOP { const size_t off = (size_t)(row0 + ai * HALF + m * 16) * DM + col0;
#pragma unroll
            for (int bj = 0; bj < 2; ++bj)
#pragma unroll
                for (int n = 0; n < 2; ++n) { const f32x4 r = *(const GAS f32x4*)(rin + off + bj * HALF + n * 16); *(GAS f32x4*)(out + off + bj * HALF + n * 16) = r * ALPHA + acc[ai][bj][m][n]; }
            asm volatile("" ::: "memory"); }
    }
};
struct EpiSwiglu {
    static constexpr bool PERM = true;
    GAS bf16_t* H; int ldh;
    __device__ __forceinline__ void operator()(const f32x4 (&acc)[2][2][4][2], const Unit& u, int wr, int wc, int fr, int fq) const {
        const int row0 = u.pm * BM + wr * 64 + fr, col0 = u.pn * HALF + wc * 32 + 8 * fq;
        G8_ROWLOOP { u32x4 w; unsigned ww[4];
#pragma unroll
            for (int n = 0; n < 2; ++n) { const f32x4 g = acc[ai][0][m][n], uu = acc[ai][1][m][n]; float hv[4];
#pragma unroll
                for (int i = 0; i < 4; ++i) hv[i] = g[i] * sigmoid_f(g[i]) * uu[i];
                ww[2 * n] = cvt_pk_bf16(hv[0], hv[1]); ww[2 * n + 1] = cvt_pk_bf16(hv[2], hv[3]); }
            w.x = ww[0]; w.y = ww[1]; w.z = ww[2]; w.w = ww[3];
            *(GAS u32x4*)(H + ((size_t)(u.pm * 16 + ai * 8 + wr * 4 + m) * (ldh >> 5) + (u.pn * 4 + wc)) * 512 + fr * 32 + 8 * fq) = w; }
    }
};
struct EpiGate {
    static constexpr bool PERM = true;
    GAS bf16_t* O;
    __device__ __forceinline__ void operator()(const f32x4 (&acc)[2][2][4][2], const Unit& u, int wr, int wc, int fr, int fq) const {
        const int row0 = u.pm * BM + wr * 64 + fr, col0 = u.pn * BM + wc * 32 + 8 * fq;
        G8_ROWLOOP { GAS bf16_t* rowp = O + (size_t)(row0 + ai * HALF + m * 16) * DM + col0;
#pragma unroll
            for (int bj = 0; bj < 2; ++bj) { const f32x4 v0 = acc[ai][bj][m][0], v1 = acc[ai][bj][m][1];
                u32x4 w; w.x = cvt_pk_bf16(sigmoid_f(v0[0]), sigmoid_f(v0[1])); w.y = cvt_pk_bf16(sigmoid_f(v0[2]), sigmoid_f(v0[3]));
                w.z = cvt_pk_bf16(sigmoid_f(v1[0]), sigmoid_f(v1[1])); w.w = cvt_pk_bf16(sigmoid_f(v1[2]), sigmoid_f(v1[3]));
                *(GAS u32x4*)(rowp + bj * HALF) = w; } }
    }
};
struct EpiPle {
    static constexpr bool PERM = true;
    GAS float* res; GAS bf16_t* XG;
    __device__ __forceinline__ void operator()(const f32x4 (&acc)[2][2][4][2], const Unit& u, int wr, int wc, int fr, int fq) const {
        const int row0 = u.pm * BM + wr * 64 + fr, col0 = u.pn * BM + wc * 32 + 8 * fq;
        G8_ROWLOOP { const size_t off = (size_t)(row0 + ai * HALF + m * 16) * DM + col0;
#pragma unroll
            for (int bj = 0; bj < 2; ++bj)
#pragma unroll
                for (int n = 0; n < 2; ++n) { const u32x2 gw = *(const GAS u32x2*)(XG + off + bj * HALF + 4 * n); const f32x4 r = *(const GAS f32x4*)(res + off + bj * HALF + 4 * n); const f32x4 a = acc[ai][bj][m][n]; f32x4 o;
                    o[0] = r[0] + a[0] * __builtin_bit_cast(float, gw.x << 16); o[1] = r[1] + a[1] * __builtin_bit_cast(float, gw.x & 0xffff0000u);
                    o[2] = r[2] + a[2] * __builtin_bit_cast(float, gw.y << 16); o[3] = r[3] + a[3] * __builtin_bit_cast(float, gw.y & 0xffff0000u);
                    *(GAS f32x4*)(res + off + bj * HALF + 4 * n) = o; u32x2 w; w.x = cvt_pk_bf16(o[0], o[1]); w.y = cvt_pk_bf16(o[2], o[3]); *(GAS u32x2*)(XG + off + bj * HALF + 4 * n) = w;
                    asm volatile("" ::: "memory"); } }
    }
};
struct EpiMoeGU {
    static constexpr bool PERM = true;
    static constexpr bool PRE = true;
    GAS bf16_t* HS; const GAS i32x4* elist; const GAS float* egate; LAS float* tbl;
    __device__ __forceinline__ void fetch(const Unit& u, int t, int& d, float& g) const { d = ((const GAS int*)(elist + u.x1 + t))[1]; g = egate[u.x1 + t]; }
    __device__ __forceinline__ void park(int buf, int t, int d, float g) const { LAS float* p = tbl + (buf * 256 + t) * 2; p[0] = __builtin_bit_cast(float, d); p[1] = g; }
    __device__ __forceinline__ void first(const Unit& u, int tid) const { if (tid < 256) { int d; float g; fetch(u, tid, d, g); park(0, tid, d, g); } }
    __device__ __forceinline__ void operator()(const f32x4 (&acc)[2][2][4][2], const Unit& u, const Unit& nx, bool has_next, int ui, int wr, int wc, int fr, int fq) const {
        const int j0 = u.pn * HALF + wc * 32 + 8 * fq; const bool colok = j0 < DFE;
        const int tid = (wr * 4 + wc) * 64 + fr + 16 * fq; int nd = 0; float ng = 0.f;
        if (has_next && tid < 256) fetch(nx, tid, nd, ng);
        const LAS float* cur = tbl + (ui & 1) * 512;
        G8_ROWLOOP { const f32x2 mg = *(const LAS f32x2*)(cur + (ai * HALF + wr * 64 + m * 16 + fr) * 2); const int dy = __builtin_bit_cast(int, mg[0]); const float gate = mg[1];
            if (colok && dy >= 0) { u32x4 w; unsigned ww[4];
#pragma unroll
                for (int n = 0; n < 2; ++n) { const f32x4 g = acc[ai][0][m][n], uu = acc[ai][1][m][n]; float hv[4];
#pragma unroll
                    for (int i = 0; i < 4; ++i) hv[i] = gate * g[i] * sigmoid_f(g[i]) * uu[i];
                    ww[2 * n] = cvt_pk_bf16(hv[0], hv[1]); ww[2 * n + 1] = cvt_pk_bf16(hv[2], hv[3]); }
                w.x = ww[0]; w.y = ww[1]; w.z = ww[2]; w.w = ww[3];
                *(GAS u32x4*)(HS + (size_t)dy + j0) = w; } }
        if (has_next && tid < 256) park((ui + 1) & 1, tid, nd, ng);
    }
};
struct EpiMoeDown {
    static constexpr bool PERM = false;
    GAS float* res; const GAS int* plist;
    __device__ __forceinline__ void operator()(const f32x4 (&acc)[2][2][4][2], const Unit& u, int wr, int wc, int fr, int fq) const {
        const int col0 = u.pn * BM + wc * 32 + 4 * fq;
        G8_ROWLOOP { const int tok = plist[u.pm * BM + ai * HALF + wr * 64 + m * 16 + fr];
            if (tok >= 0) { const size_t off = (size_t)tok * DM + col0;
#pragma unroll
                for (int bj = 0; bj < 2; ++bj)
#pragma unroll
                    for (int n = 0; n < 2; ++n) { const f32x4 r = *(const GAS f32x4*)(res + off + bj * HALF + n * 16); *(GAS f32x4*)(res + off + bj * HALF + n * 16) = r * ALPHA + acc[ai][bj][m][n]; } }
            asm volatile("" ::: "memory"); }
    }
};
__device__ __forceinline__ void unpack8(const u32x4 w, float (&x)[8]) {
    x[0] = __builtin_bit_cast(float, w.x << 16); x[1] = __builtin_bit_cast(float, w.x & 0xffff0000u); x[2] = __builtin_bit_cast(float, w.y << 16); x[3] = __builtin_bit_cast(float, w.y & 0xffff0000u);
    x[4] = __builtin_bit_cast(float, w.z << 16); x[5] = __builtin_bit_cast(float, w.z & 0xffff0000u); x[6] = __builtin_bit_cast(float, w.w << 16); x[7] = __builtin_bit_cast(float, w.w & 0xffff0000u); }
__device__ __forceinline__ void ln_row(const GAS float* st, size_t row, float& rs, float& rm) {
    const f32x4 p0 = *(const GAS f32x4*)(st + row * 8), p1 = *(const GAS f32x4*)(st + row * 8 + 4);
    const float mean = ((p0[0] + p0[2]) + (p1[0] + p1[2])) * (1.f / DM), ex2 = ((p0[1] + p0[3]) + (p1[1] + p1[3])) * (1.f / DM);
    rs = __builtin_amdgcn_rsqf(fmaxf(ex2 - mean * mean, 0.f) + LN_EPS); rm = rs * mean; }
__device__ __forceinline__ void stats_row(float s_, float q_, LAS float* xch, int rl, int wc, int fr, int fq) {
    const int lane = fr + 16 * fq;
    s_ = xsum32(xsum16(s_)); q_ = xsum32(xsum16(q_)); (void)lane;
    if (fq == 0) *(LAS f32x2*)(xch + (rl * 4 + wc) * 2) = (f32x2){s_, q_}; }
__device__ __forceinline__ void stats_flush(LAS float* xch, GAS float* st, const GAS int* plist, int rowbase, int pn, int wr, int wc, int fr, int fq) {
    asm volatile("s_waitcnt lgkmcnt(0)" ::: "memory"); __builtin_amdgcn_s_barrier();
    if (wc < 2) { const int rl = wc * HALF + wr * 64 + fr + 16 * fq; const f32x4 p0 = *(const LAS f32x4*)(xch + rl * 8), p1 = *(const LAS f32x4*)(xch + rl * 8 + 4);
        int grow = rowbase + rl; if (plist) grow = plist[grow];
        if (grow >= 0) *(GAS f32x2*)(st + ((size_t)grow * 4 + pn) * 2) = (f32x2){(p0[0] + p0[2]) + (p1[0] + p1[2]), (p0[1] + p0[3]) + (p1[1] + p1[3])}; }
}
template <bool STATS>
__device__ __forceinline__ u32x4 resid8(const u32x4 xin, const f32x4 a0, const f32x4 a1, f32x2& s2, f32x2& q2) {
    u32x4 w; f32x2 y;
#define G8_R2(word, lo, hi) y = (f32x2){__builtin_bit_cast(float, xin.word << 16), __builtin_bit_cast(float, xin.word & 0xffff0000u)} * ALPHA + (f32x2){lo, hi}; \
        if constexpr (STATS) { s2 += y; q2 += y * y; } w.word = cvt_pk_bf16(y[0], y[1]);
    G8_R2(x, a0[0], a0[1]) G8_R2(y, a0[2], a0[3]) G8_R2(z, a1[0], a1[1]) G8_R2(w, a1[2], a1[3])
#undef G8_R2
    return w; }
template <bool STATS>
struct EpiResidB {
    static constexpr bool PERM = true;
    GAS bf16_t* S; GAS float* st; LAS float* xch;
    __device__ __forceinline__ void operator()(const f32x4 (&acc)[2][2][4][2], const Unit& u, int wr, int wc, int fr, int fq) const {
        const int row0 = u.pm * BM + wr * 64 + fr, col0 = u.pn * BM + wc * 32 + 8 * fq;
        GAS bf16_t* base = S + sblk(row0, col0);
        u32x4 n0 = *(const GAS u32x4*)(base), n1 = *(const GAS u32x4*)(base + 4 * 512);
#pragma unroll
        for (int r = 0; r < 8; ++r) { const int ai = r >> 2, m = r & 3; GAS bf16_t* rowp = base + (size_t)(ai * 8 + m) * 32 * 512; const u32x4 c0 = n0, c1 = n1;
            if (r < 7) { GAS bf16_t* nxp = base + (size_t)(((r + 1) >> 2) * 8 + ((r + 1) & 3)) * 32 * 512; n0 = *(const GAS u32x4*)(nxp); n1 = *(const GAS u32x4*)(nxp + 4 * 512); }
            asm volatile("" ::: "memory");
            f32x2 s2 = (f32x2){0.f, 0.f}, q2 = s2;
            *(GAS u32x4*)(rowp) = resid8<STATS>(c0, acc[ai][0][m][0], acc[ai][0][m][1], s2, q2); *(GAS u32x4*)(rowp + 4 * 512) = resid8<STATS>(c1, acc[ai][1][m][0], acc[ai][1][m][1], s2, q2);
            if constexpr (STATS) stats_row(s2[0] + s2[1], q2[0] + q2[1], xch, ai * HALF + wr * 64 + m * 16 + fr, wc, fr, fq);
            asm volatile("" ::: "memory"); }
        if constexpr (STATS) stats_flush(xch, st, (const GAS int*)nullptr, u.pm * BM, u.pn, wr, wc, fr, fq);
    }
};
struct EpiMoeDownB {
    static constexpr bool PERM = true;
    GAS bf16_t* S; const GAS int* plist; GAS float* st; LAS float* xch;
    __device__ __forceinline__ void operator()(const f32x4 (&acc)[2][2][4][2], const Unit& u, int wr, int wc, int fr, int fq) const {
        const int col0 = u.pn * BM + wc * 32 + 8 * fq;
        int tok[8];
#pragma unroll
        for (int r = 0; r < 8; ++r) tok[r] = plist[u.pm * BM + (r >> 2) * HALF + wr * 64 + (r & 3) * 16 + fr];
        u32x4 n0 = (u32x4){0u, 0u, 0u, 0u}, n1 = n0;
        if (tok[0] >= 0) { const GAS bf16_t* p = S + sblk(tok[0], col0); n0 = *(const GAS u32x4*)(p); n1 = *(const GAS u32x4*)(p + 4 * 512); }
#pragma unroll
        for (int r = 0; r < 8; ++r) { const int ai = r >> 2, m = r & 3; const u32x4 c0 = n0, c1 = n1;
            if (r < 7) { if (tok[r + 1] >= 0) { const GAS bf16_t* p = S + sblk(tok[r + 1], col0); n0 = *(const GAS u32x4*)(p); n1 = *(const GAS u32x4*)(p + 4 * 512); } }
            asm volatile("" ::: "memory");
            f32x2 s2 = (f32x2){0.f, 0.f}, q2 = s2;
            if (tok[r] >= 0) { GAS bf16_t* rowp = S + sblk(tok[r], col0);
                *(GAS u32x4*)(rowp) = resid8<true>(c0, acc[ai][0][m][0], acc[ai][0][m][1], s2, q2); *(GAS u32x4*)(rowp + 4 * 512) = resid8<true>(c1, acc[ai][1][m][0], acc[ai][1][m][1], s2, q2); }
            stats_row(s2[0] + s2[1], q2[0] + q2[1], xch, ai * HALF + wr * 64 + m * 16 + fr, wc, fr, fq);
            asm volatile("" ::: "memory"); }
        stats_flush(xch, st, plist, u.pm * BM, u.pn, wr, wc, fr, fq);
    }
};
struct EpiStoreB {
    static constexpr bool PERM = true;
    GAS bf16_t* O;
    __device__ __forceinline__ void operator()(const f32x4 (&acc)[2][2][4][2], const Unit& u, int wr, int wc, int fr, int fq) const {
        const int row0 = u.pm * BM + wr * 64 + fr, col0 = u.pn * BM + wc * 32 + 8 * fq;
        G8_ROWLOOP { GAS bf16_t* blk = O + ((size_t)(u.pm * 16 + ai * 8 + wr * 4 + m) * 32 + u.pn * 8 + wc) * 512 + fr * 32 + 8 * fq;
#pragma unroll
            for (int bj = 0; bj < 2; ++bj) { const f32x4 v0 = acc[ai][bj][m][0], v1 = acc[ai][bj][m][1];
                u32x4 w; w.x = cvt_pk_bf16(v0[0], v0[1]); w.y = cvt_pk_bf16(v0[2], v0[3]); w.z = cvt_pk_bf16(v1[0], v1[1]); w.w = cvt_pk_bf16(v1[2], v1[3]);
                *(GAS u32x4*)(blk + bj * 4 * 512) = w; }
            asm volatile("" ::: "memory"); }
        (void)row0; (void)col0;
    }
};
struct EpiGatePleLN {
    static constexpr bool PERM = true;
    const GAS bf16_t* S; GAS bf16_t* XG; GAS float* out32; const GAS float* st; const GAS float* cs; const GAS float* bw; const GAS float* lg; const GAS float* lb; LAS float* xch; const GAS bf16_t* PP;
    __device__ __forceinline__ void operator()(const f32x4 (&acc)[2][2][4][2], const Unit& u, int wr, int wc, int fr, int fq) const {
        const int row0 = u.pm * BM + wr * 64 + fr, col0 = u.pn * BM + wc * 32 + 8 * fq;
        const size_t base = (size_t)row0 * DM + col0;
        const size_t pbase = ((size_t)(u.pm * 16 + wr * 4) * 32 + u.pn * 8 + wc) * 512 + fr * 32 + 8 * fq;
        u32x4 nx = *(const GAS u32x4*)(S + pbase), np = *(const GAS u32x4*)(PP + pbase);
        if (wr == 0) { const int rl = wc * 64 + fr + 16 * fq; float rs, rm; ln_row(st, (size_t)u.pm * BM + rl, rs, rm); *(LAS f32x2*)(xch + rl * 2) = (f32x2){rs, rm}; }
        asm volatile("s_waitcnt lgkmcnt(0)" ::: "memory"); __builtin_amdgcn_s_barrier();
#pragma unroll
        for (int bj = 0; bj < 2; ++bj) {
            f32x4 c_[2], b_[2], g_[2], l_[2];
#pragma unroll
            for (int n = 0; n < 2; ++n) { const int cc = col0 + bj * HALF + 4 * n; c_[n] = *(const GAS f32x4*)(cs + cc); b_[n] = *(const GAS f32x4*)(bw + cc); g_[n] = *(const GAS f32x4*)(lg + cc); l_[n] = *(const GAS f32x4*)(lb + cc); }
#pragma unroll
            for (int r = 0; r < 8; ++r) { const int ai = r >> 2, m = r & 3, step = bj * 8 + r; const size_t off = base + (size_t)(ai * HALF + m * 16) * DM + bj * HALF;
                const u32x4 cx = nx, cp = np;
                if (step < 15) { const int s1 = step + 1; const size_t o1 = base + (size_t)(((s1 >> 2) & 1) * HALF + (s1 & 3) * 16) * DM + (s1 >> 3) * HALF; const size_t b1 = pbase + ((size_t)((((s1 >> 2) & 1) * 8 + (s1 & 3)) * 32 + (s1 >> 3) * 4)) * 512; nx = *(const GAS u32x4*)(S + b1); np = *(const GAS u32x4*)(PP + b1); (void)o1; }
                asm volatile("" ::: "memory");
                const f32x2 rr = *(const LAS f32x2*)(xch + (ai * HALF + wr * 64 + m * 16 + fr) * 2); const float rs = rr[0], rm = rr[1];
                float x[8], p[8]; unpack8(cx, x); unpack8(cp, p);
                f32x4 o[2];
#pragma unroll
                for (int n = 0; n < 2; ++n)
#pragma unroll
                    for (int i = 0; i < 4; ++i) { const float z = sigmoid_f(rs * acc[ai][bj][m][n][i] - rm * c_[n][i] + b_[n][i]); const float gm = g_[n][i];
                        o[n][i] = (x[4 * n + i] * (rs * gm) + (l_[n][i] - rm * gm)) + p[4 * n + i] * z; }
                u32x4 w; w.x = cvt_pk_bf16(o[0][0], o[0][1]); w.y = cvt_pk_bf16(o[0][2], o[0][3]); w.z = cvt_pk_bf16(o[1][0], o[1][1]); w.w = cvt_pk_bf16(o[1][2], o[1][3]);
                if (out32) { *(GAS f32x4*)(out32 + off) = o[0]; *(GAS f32x4*)(out32 + off + 4) = o[1]; }
                else *(GAS u32x4*)(XG + pbase + ((size_t)((ai * 8 + m) * 32 + bj * 4)) * 512) = w;
                asm volatile("" ::: "memory"); } }
    }
};
struct EpiPleB {
    static constexpr bool PERM = true;
    const GAS bf16_t* S; GAS bf16_t* XG; GAS float* out32;
    __device__ __forceinline__ void operator()(const f32x4 (&acc)[2][2][4][2], const Unit& u, int wr, int wc, int fr, int fq) const {
        const int row0 = u.pm * BM + wr * 64 + fr, col0 = u.pn * BM + wc * 32 + 8 * fq;
        G8_ROWLOOP { const size_t off = (size_t)(row0 + ai * HALF + m * 16) * DM + col0;
#pragma unroll
            for (int bj = 0; bj < 2; ++bj) { float x[8], g[8]; unpack8(*(const GAS u32x4*)(S + off + bj * HALF), x); unpack8(*(const GAS u32x4*)(XG + off + bj * HALF), g);
                const f32x4 a0 = acc[ai][bj][m][0], a1 = acc[ai][bj][m][1]; f32x4 o0, o1;
#pragma unroll
                for (int i = 0; i < 4; ++i) { o0[i] = x[i] + a0[i] * g[i]; o1[i] = x[4 + i] + a1[i] * g[4 + i]; }
                u32x4 w; w.x = cvt_pk_bf16(o0[0], o0[1]); w.y = cvt_pk_bf16(o0[2], o0[3]); w.z = cvt_pk_bf16(o1[0], o1[1]); w.w = cvt_pk_bf16(o1[2], o1[3]);
                *(GAS u32x4*)(XG + off + bj * HALF) = w;
                if (out32) { *(GAS f32x4*)(out32 + off + bj * HALF) = o0; *(GAS f32x4*)(out32 + off + bj * HALF + 4) = o1; }
                asm volatile("" ::: "memory"); } }
    }
};
}

struct Frame {
    LAS unsigned char* lds; GAS unsigned* ctl; GAS unsigned char* ws; GAS float* res;
    int wave, vcu, G;
    __device__ __forceinline__ int lane_id() const { int l; asm volatile("v_mbcnt_lo_u32_b32 %0, -1, 0\n\tv_mbcnt_hi_u32_b32 %0, -1, %0" : "=v"(l)); return l; }
    __device__ __forceinline__ int tid_id() const { return wave * 64 + lane_id(); }
};
__device__ __forceinline__ GAS bf16_t* xb_ptr(const Frame& F, int which) { return (GAS bf16_t*)(F.ws + (which ? WS_XB1 : WS_XB0)); }

struct Job { int in_idx, Ns, nkb, n0, nblk, ldd, drow0, dk0, split, item0, ln, cs, vperm; float scale; long long src_off, dst_off; };
constexpr int NJOBS = 58;
struct JobTable { Job j[NJOBS]; int total; int njobs; };
constexpr JobTable make_jobs() {
    JobTable t{}; int n = 0, items = 0;
    auto add = [&](int in_idx, long long src_off, int Ns, int K, int n0, int ncols, long long dst_byte, int ldd, int drow0, int dk0, int split, float scale, int ln = -1, int cs = 0, int vperm = 0) {
        Job& j = t.j[n++]; j.ln = ln; j.cs = cs; j.vperm = vperm; j.in_idx = in_idx; j.src_off = src_off; j.Ns = Ns; j.nkb = K / 64; j.n0 = n0; j.nblk = ncols / 32; j.dst_off = dst_byte; j.ldd = ldd; j.drow0 = drow0; j.dk0 = dk0; j.split = split; j.scale = scale;
        j.item0 = items; items += j.nkb * j.nblk; };
    const long long WD = (long long)WS_WDEAD, WL = (long long)WS_WLIVE;
    const float QS = 0.0625f;
    for (int i = 0; i < 2; ++i) { const long long q = WD + 2 * (long long)(i ? WD_QKV1 : WD_QKV0), o = WD + 2 * (long long)(i ? WD_O1 : WD_O0);
        add(IN_AQKV, (long long)i * 1024 * 3072, 3072, 1024, 0, 1024, q, 1024, 0, 0, 0, QS);
        add(IN_AQKV, (long long)i * 1024 * 3072, 3072, 1024, 1024, 1024, q, 1024, 1024, 0, 0, 1.f);
        add(IN_AQKV, (long long)i * 1024 * 3072, 3072, 1024, 2048, 1024, q, 1024, 2048, 0, 0, 1.f, -1, 0, 1);
        add(IN_AO, (long long)i * 1024 * 1024, 1024, 1024, 0, 1024, o, 1024, 0, 0, 0, 1.f); }
    add(IN_BQ, 0, 1024, 1024, 0, 1024, WL + 2 * (long long)WL_QKV2, 1024, 0, 0, 0, QS);
    add(IN_KVF, 0, 2052, 1024, 0, 1024, WL + 2 * (long long)WL_QKV2, 1024, 1024, 0, 0, 1.f);
    add(IN_KVF, 0, 2052, 1024, 1024, 1024, WL + 2 * (long long)WL_QKV2, 1024, 2048, 0, 0, 1.f, -1, 0, 1);
    add(IN_BQ, (long long)1024 * 1024, 1024, 1024, 0, 1024, WL + 2 * (long long)WL_Q3, 1024, 0, 0, 0, QS);
    add(IN_BO, 0, 1024, 1024, 0, 1024, WL + 2 * (long long)WL_O2, 1024, 0, 0, 0, 1.f);
    add(IN_BO, (long long)1024 * 1024, 1024, 1024, 0, 1024, WL + 2 * (long long)WL_O3, 1024, 0, 0, 0, 1.f);
    for (int i = 0; i < 2; ++i) { const long long gu = i ? WL + 2 * (long long)WL_GU1 : WD + 2 * (long long)WD_GU0, dn = i ? WL + 2 * (long long)WL_DN1 : WD + 2 * (long long)WD_DN0;
        add(IN_FGU, (long long)i * 1024 * 5632, 5632, 1024, 0, 5632, gu, 1024, 0, 0, DFF, 1.f);
        add(IN_FDN, (long long)i * 2816 * 1024, 1024, 2816, 0, 1024, dn, 2816, 0, 0, 0, 1.f); }
    for (int i = 0; i < 2; ++i) for (int e = 0; e < NE; ++e) { const long long gu = i ? WL + 2 * (long long)WL_MGU1 : WD + 2 * (long long)WD_MGU0, dn = i ? WL + 2 * (long long)WL_MDN1 : WD + 2 * (long long)WD_MDN0;
        add(IN_MGU, (long long)(i * NE + e) * 1024 * 1408, 1408, 1024, 0, 1408, gu, 1024, e * 1536, 0, DFE, 1.f);
        add(IN_MDN, (long long)(i * NE + e) * 704 * 1024, 1024, 704, 0, 1024, dn, 5632, 0, e * DFE, 0, 1.f); }
    for (int i = 0; i < 4; ++i) { const long long pp = i == 0 ? WD + 2 * (long long)WD_PP0 : i == 1 ? WD + 2 * (long long)WD_PP1 : i == 2 ? WL + 2 * (long long)WL_PP2 : WL + 2 * (long long)WL_PP3;
        const long long pg = i == 0 ? WD + 2 * (long long)WD_PG0 : i == 1 ? WD + 2 * (long long)WD_PG1 : i == 2 ? WL + 2 * (long long)WL_PG2 : WL + 2 * (long long)WL_PG3;
        add(IN_PP, (long long)i * 256 * 1024, 1024, 256, 0, 1024, pp, 256, 0, 0, 0, 1.f);
        add(IN_PG, (long long)i * 1024 * 1024, 1024, 1024, 0, 1024, pg, 1024, 0, 0, 0, 1.f, 2 * i + 1, CS_PG0 + 1024 * i); }
    t.total = items; t.njobs = n; return t;
}
__device__ const JobTable g_jobs = make_jobs();
static_assert(make_jobs().njobs == NJOBS, "job count");

__device__ __forceinline__ void conv_item(const Frame& F, const Job& J, int it, LAS float* scr) {
    const int lane = F.lane_id(); const int kb = it / J.nblk, nb = it % J.nblk, k0 = 64 * kb, ncol = J.n0 + 32 * nb;
    const GAS float* W = in_sel(J.in_idx) + J.src_off;
    int drow;
    if (J.split) { const int ty = ncol / J.split, jj = ncol % J.split; drow = J.drow0 + 256 * (jj >> 7) + 128 * ty + (jj & 127); } else drow = J.drow0 + (ncol - J.n0);
    GAS float* part = (GAS float*)(F.ws + WS_XB0);
    { f32x4 wv[8];
#pragma unroll
      for (int i = 0; i < 8; ++i) wv[i] = *(const GAS f32x4*)(W + (size_t)(k0 + (lane >> 3) + 8 * i) * J.Ns + ncol + (lane & 7) * 4);
      if (J.ln >= 0) {
          const GAS float* lg = in_sel(IN_LNG) + (size_t)J.ln * DM + k0 + (lane >> 3); const GAS float* lb = in_sel(IN_LNB) + (size_t)J.ln * DM + k0 + (lane >> 3);
          f32x4 bp = (f32x4){0.f, 0.f, 0.f, 0.f};
#pragma unroll
          for (int i = 0; i < 8; ++i) { const float g = lg[8 * i], b = lb[8 * i]; bp += wv[i] * b; wv[i] *= g; }
#pragma unroll
          for (int c = 0; c < 4; ++c) { float v = bp[c]; v += shx(v, 8, lane); v += shx(v, 16, lane); v += shx(v, 32, lane); bp[c] = v; }
          if (lane < 8) *(GAS f32x4*)(part + (size_t)(16 + kb) * CS_TOTAL + J.cs + drow + 4 * lane) = bp; }
#pragma unroll
      for (int i = 0; i < 8; ++i) { LAS float* d = scr + ((lane >> 3) + 8 * i) * 33 + (lane & 7) * 4; d[0] = wv[i][0] * J.scale; d[1] = wv[i][1] * J.scale; d[2] = wv[i][2] * J.scale; d[3] = wv[i][3] * J.scale; } }
    asm volatile("s_waitcnt lgkmcnt(0)" ::: "memory");
    GAS bf16_t* WT = (GAS bf16_t*)(F.ws + J.dst_off);
    const int r = lane >> 2, q = lane & 3;
#pragma unroll
    for (int rb = 0; rb < 2; ++rb) { const int m_ = 8 * (r >> 2) + 4 * rb + (r & 3);
        const int n = J.vperm ? (8 * ((m_ & 15) >> 2) + 4 * (m_ >> 4) + (m_ & 3)) : m_;
        float cv = 0.f;
#pragma unroll
        for (int cb = 0; cb < 2; ++cb) { const LAS float* s = scr + (32 * cb + 8 * q) * 33 + n;
            u32x4 o; o.x = pk2(s[0 * 33], s[1 * 33]); o.y = pk2(s[2 * 33], s[3 * 33]); o.z = pk2(s[4 * 33], s[5 * 33]); o.w = pk2(s[6 * 33], s[7 * 33]);
            const int srow = drow + 16 * rb, kcol = J.dk0 + k0 + 32 * cb;
            *(GAS u32x4*)(WT + ((size_t)(srow >> 4) * (J.ldd >> 5) + (kcol >> 5)) * 512 + lane * 8) = o;
            if (J.ln >= 0) { float x[8]; g8::unpack8(o, x); cv += ((x[0] + x[1]) + (x[2] + x[3])) + ((x[4] + x[5]) + (x[6] + x[7])); } }
        if (J.ln >= 0) {
            cv += shx(cv, 1, lane); cv += shx(cv, 2, lane);
            if (q == 0) part[(size_t)kb * CS_TOTAL + J.cs + drow + n] = cv; } }
    asm volatile("s_waitcnt lgkmcnt(0)" ::: "memory");
}
__device__ __forceinline__ void cs_finalize(Frame& F) {
    const GAS float* part = (const GAS float*)(F.ws + WS_XB0); GAS float* cs = (GAS float*)(F.ws + WS_MISC + MS_CS);
    const int gt = (int)blockIdx.x * NTHREADS + F.tid_id(), gs = F.G * NTHREADS;
    for (int i = gt; i < 2 * 4096; i += gs) { const int a = i >> 12, idx = CS_PG0 + (i & 4095); float v = 0.f;
#pragma unroll
        for (int kb = 0; kb < 16; ++kb) v += part[(size_t)(a * 16 + kb) * CS_TOTAL + idx];
        cs[a * CS_TOTAL + idx] = v; }
}
__device__ __forceinline__ void prologue_phase(Frame& F) {
    LAS float* scr = (LAS float*)(F.lds + F.wave * 16384);
    const int gw = F.vcu * NWAVES + F.wave, NGW = F.G * NWAVES;
    const int total = g_jobs.total;
    for (int it = gw; it < total; it += NGW) {
        int jn = 0;
        for (int k = 1; k < NJOBS; ++k) jn += (it >= g_jobs.j[k].item0) ? 1 : 0;
        jn = __builtin_amdgcn_readfirstlane(jn);
        conv_item(F, g_jobs.j[jn], it - g_jobs.j[jn].item0, scr);
    }
    { const size_t gt = (size_t)blockIdx.x * NTHREADS + F.tid_id(), gs = (size_t)F.G * NTHREADS;
      for (size_t i = gt; i < (size_t)2 * NE * 2 * 64 * 128; i += gs) {
          const int ch = (int)(i & 127), row = (int)((i >> 7) & 63), gu = (int)((i >> 13) & 1), e = (int)((i >> 14) & 7), li = (int)(i >> 17);
          GAS bf16_t* base = (GAS bf16_t*)(F.ws + (li ? WS_WLIVE + 2 * WL_MGU1 : WS_WDEAD + 2 * WD_MGU0));
          { const int prow = e * 1536 + 1280 + 128 * gu + 64 + row, kc = ch * 8;
            *(GAS u32x4*)(base + ((size_t)(prow >> 4) * 32 + (kc >> 5)) * 512 + (prow & 15) * 32 + (kc & 31)) = (u32x4){0u, 0u, 0u, 0u}; } } }
    GAS bf16_t* xb = xb_ptr(F, 1);
    { const int ln = F.lane_id();
      for (int m = gw; m < T; m += 2 * NGW) {
          const GAS f32x4* xa = (const GAS f32x4*)(in_sel(IN_X) + (size_t)m * DM) + 2 * ln; const GAS f32x4* xc = (const GAS f32x4*)(in_sel(IN_X) + (size_t)(m + NGW) * DM) + 2 * ln;
          GAS u32x4* oa = (GAS u32x4*)(xb + sblk(m, 8 * ln)); GAS u32x4* oc = (GAS u32x4*)(xb + sblk(m + NGW, 8 * ln));
          f32x4 va[4], vc[4];
#pragma unroll
          for (int j = 0; j < 2; ++j) { va[2 * j] = xa[128 * j]; va[2 * j + 1] = xa[128 * j + 1]; vc[2 * j] = xc[128 * j]; vc[2 * j + 1] = xc[128 * j + 1]; }
#pragma unroll
          for (int j = 0; j < 2; ++j) { u32x4 o; o.x = cvt_pk_bf16(va[2 * j][0], va[2 * j][1]); o.y = cvt_pk_bf16(va[2 * j][2], va[2 * j][3]); o.z = cvt_pk_bf16(va[2 * j + 1][0], va[2 * j + 1][1]); o.w = cvt_pk_bf16(va[2 * j + 1][2], va[2 * j + 1][3]); oa[1024 * j] = o;
              o.x = cvt_pk_bf16(vc[2 * j][0], vc[2 * j][1]); o.y = cvt_pk_bf16(vc[2 * j][2], vc[2 * j][3]); o.z = cvt_pk_bf16(vc[2 * j + 1][0], vc[2 * j + 1][1]); o.w = cvt_pk_bf16(vc[2 * j + 1][2], vc[2 * j + 1][3]); oc[1024 * j] = o; } } }
}

template <bool ROUTER, bool CVT_P>
__device__ __forceinline__ void ln_phase(Frame& F, int L, int which, GAS bf16_t* S) {
    int tid_ = F.tid_id(); asm volatile("" : "+v"(tid_));
    const int w = __builtin_amdgcn_readfirstlane(tid_ >> 6);
    LAS f32x4* gl = (LAS f32x4*)F.lds; LAS f32x4* bl = gl + 256;
    LAS f32x4* wrl = gl + 512;
    LAS int* hist = (LAS int*)(gl + 512 + 2048);
    __syncthreads();
    if (tid_ < 256) { gl[tid_] = ((const GAS f32x4*)(in_sel(IN_LNG) + (size_t)(L * 2 + which) * DM))[tid_]; bl[tid_] = ((const GAS f32x4*)(in_sel(IN_LNB) + (size_t)(L * 2 + which) * DM))[tid_]; }
    if constexpr (ROUTER) { const GAS f32x4* Wr = (const GAS f32x4*)(in_sel(IN_MR) + (size_t)(L >> 1) * DM * NE);
#pragma unroll
        for (int i = 0; i < 4; ++i) wrl[tid_ + 512 * i] = Wr[tid_ + 512 * i]; }
    __syncthreads();
    for (int ch = blockIdx.x; ch < T / 128; ch += F.G) {
        if constexpr (ROUTER) { __syncthreads(); if (tid_ < 40) hist[tid_] = 0; __syncthreads(); }
        const int r0 = 128 * ch + 16 * w;
        const int lane = F.lane_id(), q = lane & 3;
        GAS u32x4* sp = (GAS u32x4*)(S + (size_t)(r0 >> 4) * 32 * 512) + lane;
        u32x4 d[32];
#pragma unroll
        for (int cb = 0; cb < 32; ++cb) d[cb] = sp[64 * cb];
        if constexpr (CVT_P) {
            const GAS f32x4* pp = (const GAS f32x4*)(in_sel(IN_P) + ((size_t)L * T + r0 + (lane >> 5)) * PLE) + 2 * (lane & 31);
            GAS u32x4* po = (GAS u32x4*)((GAS bf16_t*)(F.ws + WS_PB) + (size_t)(r0 + (lane >> 5)) * PLE) + (lane & 31);
#pragma unroll
            for (int h = 0; h < 2; ++h) { f32x4 pa[4], pb[4];
#pragma unroll
                for (int j = 0; j < 4; ++j) { pa[j] = pp[(size_t)(4 * h + j) * 128]; pb[j] = pp[(size_t)(4 * h + j) * 128 + 1]; }
#pragma unroll
                for (int j = 0; j < 4; ++j) { u32x4 o; o.x = cvt_pk_bf16(pa[j][0], pa[j][1]); o.y = cvt_pk_bf16(pa[j][2], pa[j][3]); o.z = cvt_pk_bf16(pb[j][0], pb[j][1]); o.w = cvt_pk_bf16(pb[j][2], pb[j][3]);
                    po[(size_t)(4 * h + j) * 64] = o; } } }
        float sm = 0.f;
#pragma unroll
        for (int cb = 0; cb < 32; ++cb) { float x[8]; g8::unpack8(d[cb], x); sm += ((x[0] + x[1]) + (x[2] + x[3])) + ((x[4] + x[5]) + (x[6] + x[7])); }
        sm += shx(sm, 1, lane); sm += shx(sm, 2, lane);
        const float mean = sm * (1.f / DM); float s2 = 0.f;
#pragma unroll
        for (int cb = 0; cb < 32; ++cb) asm volatile("" : "+v"(d[cb]));
#pragma unroll
        for (int cb = 0; cb < 32; ++cb) { float x[8]; g8::unpack8(d[cb], x);
#pragma unroll
            for (int i = 0; i < 8; ++i) { const float c = x[i] - mean; s2 += c * c; } }
        s2 += shx(s2, 1, lane); s2 += shx(s2, 2, lane);
        const float rstd = 1.f / sqrtf(s2 * (1.f / DM) + LN_EPS);
#pragma unroll
        for (int cb = 0; cb < 32; ++cb) asm volatile("" : "+v"(d[cb]));
        float lg[NE];
#pragma unroll
        for (int e = 0; e < NE; ++e) lg[e] = 0.f;
#pragma unroll
        for (int cb = 0; cb < 32; ++cb) { float x[8]; g8::unpack8(d[cb], x); const int c0 = 32 * cb + 8 * q;
            const f32x4 ga = gl[c0 >> 2], gb = gl[(c0 >> 2) + 1], ba = bl[c0 >> 2], bb = bl[(c0 >> 2) + 1];
#pragma unroll
            for (int i = 0; i < 4; ++i) { x[i] = (x[i] - mean) * rstd * ga[i] + ba[i]; x[4 + i] = (x[4 + i] - mean) * rstd * gb[i] + bb[i]; }
            if constexpr (ROUTER) {
#pragma unroll
                for (int i = 0; i < 8; ++i) { const f32x4 w0 = wrl[2 * (c0 + i)], w1 = wrl[2 * (c0 + i) + 1];
#pragma unroll
                    for (int e = 0; e < 4; ++e) { lg[e] += x[i] * w0[e]; lg[4 + e] += x[i] * w1[e]; }
                    if ((i & 1) == 1) asm volatile("" ::: "memory"); } }
            u32x4 o; o.x = cvt_pk_bf16(x[0], x[1]); o.y = cvt_pk_bf16(x[2], x[3]); o.z = cvt_pk_bf16(x[4], x[5]); o.w = cvt_pk_bf16(x[6], x[7]);
            sp[64 * cb] = o; asm volatile("" ::: "memory"); }
        if constexpr (ROUTER) {
#pragma unroll
            for (int e = 0; e < NE; ++e) { lg[e] += shx(lg[e], 1, lane); lg[e] += shx(lg[e], 2, lane); }
            int i1 = 0; float v1 = lg[0];
#pragma unroll
            for (int e = 1; e < NE; ++e) if (lg[e] > v1) { v1 = lg[e]; i1 = e; }
            int i2 = -1; float v2 = -3.0e38f;
#pragma unroll
            for (int e = 0; e < NE; ++e) if (e != i1 && lg[e] > v2) { v2 = lg[e]; i2 = e; }
            const float ex = fast_exp(v2 - v1), g1 = __builtin_amdgcn_rcpf(1.f + ex), g2 = 1.f - g1;
            const int ea = i1 < i2 ? i1 : i2, eb = i1 < i2 ? i2 : i1, pid = ea * (15 - ea) / 2 + eb - ea - 1;
            if (q == 0) { const int row = r0 + (lane >> 2); GAS float* gpp = (GAS float*)(F.ws + WS_MISC + MS_GATE);
                *((GAS i32x4*)(F.ws + WS_MISC + MS_REC) + row) = (i32x4){i1 | (i2 << 8) | (pid << 16), 0, 0, row}; gpp[row] = g1; gpp[T + row] = g2;
                __hip_atomic_fetch_add(hist + i1, 1, __ATOMIC_RELAXED, __HIP_MEMORY_SCOPE_WORKGROUP); __hip_atomic_fetch_add(hist + i2, 1, __ATOMIC_RELAXED, __HIP_MEMORY_SCOPE_WORKGROUP);
                __hip_atomic_fetch_add(hist + 8 + pid, 1, __ATOMIC_RELAXED, __HIP_MEMORY_SCOPE_WORKGROUP); }
            __syncthreads(); if (tid_ < 40) ((GAS int*)(F.ws + WS_MISC + MS_HIST))[ch * 40 + tid_] = hist[tid_]; }
    }
}

__device__ __forceinline__ int pad256(int v) { return (v + 255) & ~255; }
__device__ __forceinline__ void moe_lists_phase(Frame& F) {
    LAS int* pre = (LAS int*)F.lds; LAS int* tot = pre + 40; LAS int* eoff = tot + 40; LAS int* poff = eoff + 16; LAS int* recs = poff + 32; LAS int* tabl = recs + 128;
    const GAS int* hist = (const GAS int*)(F.ws + WS_MISC + MS_HIST);
    const GAS i32x4* rec = (const GAS i32x4*)(F.ws + WS_MISC + MS_REC);
    GAS i32x4* elist = (GAS i32x4*)(F.ws + WS_MISC + MS_ELIST); GAS int* plist = (GAS int*)(F.ws + WS_MISC + MS_PLIST);
    int tid_ = F.tid_id(); asm volatile("" : "+v"(tid_));
    const int lane = tid_ & 63, w = F.wave, tid = tid_;
    bool first = true;
    for (int ch = blockIdx.x; ch < T / 128; ch += F.G) {
        __syncthreads();
        { int hv[5][4];
#pragma unroll
          for (int q = 0; q < 5; ++q) { const int col = w + NWAVES * q;
#pragma unroll
              for (int k = 0; k < 4; ++k) hv[q][k] = (col < 36) ? hist[(lane + 64 * k) * 40 + col] : 0; }
#pragma unroll
          for (int q = 0; q < 5; ++q) { const int col = w + NWAVES * q; int sp = 0, st = 0;
#pragma unroll
              for (int k = 0; k < 4; ++k) { const int c2 = lane + 64 * k; st += hv[q][k]; sp += (c2 < ch) ? hv[q][k] : 0; }
#pragma unroll
              for (int o = 1; o < 64; o <<= 1) { sp += shxi(sp, o, lane); st += shxi(st, o, lane); }
              if (lane == 0 && col < 36) { pre[col] = sp; tot[col] = st; } } }
        __syncthreads();
        if (tid == 0) {
            int acc = 0, ucum = 0;
            for (int e = 0; e < NE; ++e) { eoff[e] = acc; tabl[TB_EOFF + e] = acc; tabl[TB_ECUM + e] = ucum; const int p = pad256(tot[e]); acc += p; ucum += 6 * (p >> 8); }
            eoff[NE] = acc; tabl[TB_EOFF + NE] = acc; tabl[TB_ECUM + NE] = ucum;
            int pacc = 0, pid = 0;
            for (int a = 0; a < NE - 1; ++a) for (int b = a + 1; b < NE; ++b) { poff[pid] = pacc; pacc += pad256(tot[8 + pid]); ++pid; }
            poff[NPAIR] = pacc; tabl[TB_NRT] = pacc >> 8;
        }
        __syncthreads();
        if (tid < 192) { const int r8 = tid << 8; int p = 0;
            for (int k = 1; k < NPAIR; ++k) p += (r8 >= poff[k]) ? 1 : 0;
            int a = 0, rem = p; while (rem >= NE - 1 - a) { rem -= NE - 1 - a; ++a; }
            tabl[TB_RT2P + tid] = a | ((a + 1 + rem) << 8); }
        __syncthreads();
        if (ch == 0) { for (int i = tid; i < TB_WORDS; i += NTHREADS) ((GAS int*)(F.ws + WS_MISC + MS_TAB))[i] = tabl[i]; }
        if (tid < 128) recs[tid] = rec[128 * ch + tid].x;
        __syncthreads();
        if (tid < 128) {
            const int token = 128 * ch + tid; const i32x4 r = rec[token]; const int e1 = r.x & 0xff, e2 = (r.x >> 8) & 0xff, pid = (r.x >> 16) & 0xff;
            int r1 = 0, r2 = 0, rp = 0;
            for (int j = 0; j < tid; ++j) { const int o = recs[j]; const int o1 = o & 0xff, o2 = (o >> 8) & 0xff, op = (o >> 16) & 0xff;
                r1 += ((o1 == e1) | (o2 == e1)) ? 1 : 0; r2 += ((o1 == e2) | (o2 == e2)) ? 1 : 0; rp += (op == pid) ? 1 : 0; }
            const int pslot = poff[pid] + pre[8 + pid] + rp; plist[pslot] = token;
            i32x4 en; en.x = token; en.w = 0;
            const GAS float* gp = (const GAS float*)(F.ws + WS_MISC + MS_GATE);
            GAS float* eg = (GAS float*)(F.ws + WS_MISC + MS_EGATE); en.z = 0;
            { const int sl = eoff[e1] + pre[e1] + r1; en.y = pslot * 1408 + (e1 < e2 ? 0 : DFE); elist[sl] = en; eg[sl] = gp[token]; }
            { const int sl = eoff[e2] + pre[e2] + r2; en.y = pslot * 1408 + (e2 < e1 ? 0 : DFE); elist[sl] = en; eg[sl] = gp[T + token]; }
        }
        if (first) {
            first = false; const int gt = blockIdx.x * NTHREADS + tid, gs = F.G * NTHREADS;
            for (int e = 0; e < NE; ++e) for (int i = eoff[e] + tot[e] + gt; i < eoff[e + 1]; i += gs) elist[i] = (i32x4){0, -1, 0, 0};
            for (int p = 0; p < NPAIR; ++p) for (int i = poff[p] + tot[8 + p] + gt; i < poff[p + 1]; i += gs) plist[i] = -1;
        }
    }
    __syncthreads();
}
__device__ __forceinline__ void load_tab(Frame& F) {
    __syncthreads();
    for (int i = F.tid_id(); i < TB_WORDS; i += NTHREADS) ((LAS int*)(F.lds + LDS_TAB))[i] = ((const GAS int*)(F.ws + WS_MISC + MS_TAB))[i];
    __syncthreads();
}

__device__ __forceinline__ void forget_phase(Frame& F, const GAS bf16_t* S) {
    int tid_ = F.tid_id(); asm volatile("" : "+v"(tid_));
    const int lane = tid_ & 63, w = __builtin_amdgcn_readfirstlane(tid_ >> 6);
    const GAS float* Wf = in_sel(IN_KVF);
    f32x4 wf[16];
#pragma unroll
    for (int i = 0; i < 16; ++i) wf[i] = *(const GAS f32x4*)(Wf + (size_t)(16 * lane + i) * 2052 + 2048);
    const f32x4 bias = *(const GAS f32x4*)in_sel(IN_KVFB);
    LAS float* lf = (LAS float*)F.lds;
    GAS float* cl = (GAS float*)(F.ws + WS_MISC + MS_CL); GAS float* tt = (GAS float*)(F.ws + WS_MISC + MS_TOT);
    for (int ch = blockIdx.x; ch < T / 128; ch += F.G) {
        __syncthreads();
#pragma unroll
        for (int h = 0; h < 2; ++h) { u32x4 ra[8], rb[8];
#pragma unroll
          for (int k8 = 0; k8 < 8; ++k8) { const GAS u32x4* xr = (const GAS u32x4*)(S + sblk(128 * ch + 16 * w + 8 * h + k8, 16 * lane)); ra[k8] = xr[0]; rb[k8] = xr[1]; }
#pragma unroll
          for (int k8 = 0; k8 < 8; ++k8) { const int k = 8 * h + k8;
            float x[8]; f32x4 a = (f32x4){0.f, 0.f, 0.f, 0.f};
            g8::unpack8(ra[k8], x);
#pragma unroll
            for (int i = 0; i < 8; ++i) a += wf[i] * x[i];
            g8::unpack8(rb[k8], x);
#pragma unroll
            for (int i = 0; i < 8; ++i) a += wf[8 + i] * x[i];
#pragma unroll
            for (int hh = 0; hh < 4; ++hh) a[hh] = wave_sum_dpp(a[hh]);
            if (lane == 0) { f32x4 o;
#pragma unroll
                for (int hh = 0; hh < 4; ++hh) { const float z = a[hh] + bias[hh]; o[hh] = -(fmaxf(-z, 0.f) + log1pf(__expf(-fabsf(z)))); }
                *(LAS f32x4*)(lf + (16 * w + k) * 4) = o; }
          } }
        __syncthreads();
        { const int tile = w >> 2, hh = w & 3; float x = lf[(tile * 64 + lane) * 4 + hh];
#pragma unroll
          for (int o = 1; o < 64; o <<= 1) { const float y = shup(x, o, lane); if (lane >= o) x += y; }
          const int row = 128 * ch + tile * 64 + lane, b = row / SEQ, s = row % SEQ;
          cl[(size_t)(b * NH + hh) * SEQ + s] = x; if (lane == 63) tt[(b * NH + hh) * 256 + (s >> 6)] = x; }
    }
    __syncthreads();
}
__device__ __forceinline__ void knorm_phase(Frame& F, const GAS bf16_t* KS) {
    const int lane = F.lane_id(), w = F.wave;
    for (int ch = blockIdx.x; ch < T / 128; ch += F.G) {
        float mx = 0.f;
#pragma unroll
        for (int h = 0; h < 2; ++h) { u32x4 ra[8], rb[8];
#pragma unroll
            for (int k = 0; k < 8; ++k) { const int row = 128 * ch + 16 * w + 8 * h + k;
                const GAS u32x4* kr = (const GAS u32x4*)(KS + ((size_t)(row >> 4) * 32 + (lane >> 1)) * 512 + (row & 15) * 32 + 16 * (lane & 1)); ra[k] = kr[0]; rb[k] = kr[1]; }
#pragma unroll
            for (int k = 0; k < 8; ++k) { const unsigned u[8] = {ra[k].x, ra[k].y, ra[k].z, ra[k].w, rb[k].x, rb[k].y, rb[k].z, rb[k].w}; float s = 0.f;
#pragma unroll
                for (int i = 0; i < 8; ++i) { const float lo = __builtin_bit_cast(float, u[i] << 16), hi = __builtin_bit_cast(float, u[i] & 0xffff0000u); s += lo * lo + hi * hi; }
                s += shx(s, 1, lane); s += shx(s, 2, lane); s += shx(s, 4, lane); s += shx(s, 8, lane);
                mx = fmaxf(mx, s); } }
        if ((lane & 15) == 0) { const int b = (128 * ch) / SEQ; (void)__hip_atomic_fetch_max(F.ctl + CW_KN2 + b * NH + (lane >> 4), __builtin_bit_cast(unsigned, mx), RLX_AGENT); }
    }
}

constexpr int AT_KB0 = 0, AT_VB0 = 32768, AT_KB1 = 66048, AT_VB1 = 98816, AT_VPANEL = 2080, AT_CL0 = 132096, AT_CL1 = 132352, AT_TT0 = 132608, AT_TT1 = 132864;
constexpr float SB_STOP = -14.f, FOX_STOP = -20.f;
typedef short s16x4 __attribute__((ext_vector_type(4)));
#define AT_TR4(r0, r1, r2, r3, addr, o0, o1, o2, o3) asm volatile("ds_read_b64_tr_b16 %0, %4 offset:%5\n\tds_read_b64_tr_b16 %1, %4 offset:%6\n\tds_read_b64_tr_b16 %2, %4 offset:%7\n\tds_read_b64_tr_b16 %3, %4 offset:%8" \
    : "=&v"(r0), "=&v"(r1), "=&v"(r2), "=&v"(r3) : "v"(addr), "i"(o0), "i"(o1), "i"(o2), "i"(o3) : "memory")
#define AT_WAIT4(r0, r1, r2, r3) asm volatile("s_waitcnt lgkmcnt(0)" : "+v"(r0), "+v"(r1), "+v"(r2), "+v"(r3) :: "memory")

template <bool FOX>
__device__ __forceinline__ void attn_phase(Frame& F, const GAS bf16_t* Q, const GAS bf16_t* Kb, const GAS bf16_t* Vb, GAS bf16_t* O) {
    LAS unsigned char* lds = F.lds;
    volatile LAS unsigned* flags = (volatile LAS unsigned*)(lds + LDS_FLAGS);
    int tid_ = F.tid_id(); asm volatile("" : "+v"(tid_));
    const int tid = tid_, w = __builtin_amdgcn_readfirstlane(tid >> 6), lane = tid & 63, fr = lane & 15, fq = lane >> 4;
    const unsigned vrd = (unsigned)((4 * fq + ((lane & 15) >> 2)) * 32 + 8 * (lane & 3));
    const GAS float* cl = (const GAS float*)(F.ws + WS_MISC + MS_CL); const GAS float* tt = (const GAS float*)(F.ws + WS_MISC + MS_TOT);
    for (int id = blockIdx.x; id < 8 * 128; id += F.G) {
        const int bh = id & 7, qt = id >> 3, b = bh >> 2, h = bh & 3, t0 = qt * 128;
        const size_t rowbase = (size_t)b * SEQ;
        const int tq = t0 + 16 * w + fr;
        int kt = 2 * qt + 1, it = 0; bool wdone = false;
#ifndef QK_NF
#define QK_NF 8
#endif
#ifndef QK_NF_SB
#define QK_NF_SB 8
#endif
#define AT_DMA(KT, IT) do { const int ln_ = F.lane_id();     \
            const int kb_ = ((IT) & 1) ? AT_KB1 : AT_KB0, vb_ = ((IT) & 1) ? AT_VB1 : AT_VB0; \
            _Pragma("unroll") for (int j = 0; j < 4; ++j) { const int pc_ = w + 8 * j; const int r_ = 2 * pc_ + (ln_ >> 5); \
                __builtin_amdgcn_global_load_lds((const GAS unsigned*)(Kb + ((size_t)((rowbase + (size_t)64 * (KT) + r_) >> 4) * 32 + h * 8 + ((((ln_ & 31) ^ (r_ & 15))) >> 2)) * 512 + (r_ & 15) * 32 + ((((ln_ & 31) ^ (r_ & 15))) & 3) * 8), (LAS unsigned*)(lds + kb_ + pc_ * 1024), 16, 0, 0); } \
            _Pragma("unroll") for (int j = 0; j < 4; ++j) { const int pc_ = w + 8 * j; \
                __builtin_amdgcn_global_load_lds((const GAS unsigned*)(Vb + ((size_t)((rowbase + (size_t)64 * (KT) + 32 * (pc_ & 1) + (ln_ >> 1)) >> 4) * 32 + h * 8 + (pc_ >> 2)) * 512 + ((ln_ >> 1) & 15) * 32 + ((pc_ >> 1) & 1) * 16 + 8 * (ln_ & 1)), (LAS unsigned*)(lds + vb_ + (pc_ >> 1) * AT_VPANEL + (pc_ & 1) * 1024), 16, 0, 0); } \
            if constexpr (FOX) { if (w == 0) __builtin_amdgcn_global_load_lds((const GAS unsigned*)(cl + (size_t)bh * SEQ + 64 * (KT) + ln_), (LAS unsigned*)(lds + (((IT) & 1) ? AT_CL1 : AT_CL0)), 4, 0, 0); \
                                 if (w == 1) __builtin_amdgcn_global_load_lds((const GAS unsigned*)(tt + bh * 256 + ((KT) > 2 * qt ? 2 * qt : (KT))), (LAS unsigned*)(lds + (((IT) & 1) ? AT_TT1 : AT_TT0)), 4, 0, 0); } } while (0)
        AT_DMA(kt, 0);
        bf16x8 qf[8];
        { const GAS bf16_t* qp = Q + ((size_t)((rowbase + t0 + 16 * w) >> 4) * 32 + h * 8) * 512 + fr * 32 + 8 * fq;
#pragma unroll
          for (int s = 0; s < 8; ++s) qf[s] = *(const GAS bf16x8*)(qp + 512 * s); }
        f32x4 o[16];
#pragma unroll
        for (int d = 0; d < 16; ++d) o[d] = (f32x4){0.f, 0.f, 0.f, 0.f};
        float R = 0.f;
        float mrun = -1.0e30f, lsum = 0.f, cq = 0.f, qn = 0.f, KN = 0.f, gacc = 0.f;
        if constexpr (FOX) {
            float s2 = 0.f;
#pragma unroll
            for (int s = 0; s < 8; ++s)
#pragma unroll
                for (int j = 0; j < 8; ++j) { const float x = bf2f((unsigned short)qf[s][j]); s2 += x * x; }
            s2 = xsum32(xsum16(s2)); qn = sqrtf(s2);
            KN = sqrtf(__builtin_bit_cast(float, __hip_atomic_load(F.ctl + CW_KN2 + bh, RLX_AGENT))) * 1.002f;
            cq = cl[(size_t)bh * SEQ + tq] + ((tq >= t0 + 64) ? tt[bh * 256 + 2 * qt] : 0.f);
        }
        asm volatile("s_waitcnt vmcnt(0) lgkmcnt(0)" ::: "memory"); __builtin_amdgcn_s_barrier();
        for (;;) {
            const int kbuf = (it & 1) ? AT_KB1 : AT_KB0, vbuf = (it & 1) ? AT_VB1 : AT_VB0;
            if (it >= 2) { const int par = (it - 1) & 1; const u32x4 f0 = *(const LAS u32x4*)(lds + LDS_FLAGS + par * 32), f1 = *(const LAS u32x4*)(lds + LDS_FLAGS + par * 32 + 16);
                if (((f0.x | f0.y) | (f0.z | f0.w) | (f1.x | f1.y) | (f1.z | f1.w)) == 0u) break; }
            const int kmin = 64 * kt, wmax = t0 + 16 * w + 15, wmin = t0 + 16 * w;
            if (kt > 0) AT_DMA(kt - 1, it + 1);
            const bool part = !wdone && (FOX ? (kmin <= wmax) : (kmin < wmax));
            if (part) {
                const bool need_mask = (kmin + 63 >= wmin);
                f32x4 s[4];
                {
                    constexpr int NF = FOX ? QK_NF : QK_NF_SB;
                    bf16x8 kf[NF];
#pragma unroll
                    for (int blk = 0; blk < 4; ++blk) s[blk] = (f32x4){0.f, 0.f, 0.f, 0.f};
#pragma unroll
                    for (int n = 0; n < NF - 1; ++n) kf[n] = *(const LAS bf16x8*)(lds + kbuf + (16 * (n & 3) + fr) * 512 + (((4 * (n >> 2) + fq) ^ fr) * 16));
                    __builtin_amdgcn_sched_barrier(0);
#pragma unroll
                    for (int n = 0; n < 32; ++n) {
                        if (n + NF - 1 < 32) { const int m = n + NF - 1; kf[m % NF] = *(const LAS bf16x8*)(lds + kbuf + (16 * (m & 3) + fr) * 512 + (((4 * (m >> 2) + fq) ^ fr) * 16)); }
                        s[n & 3] = __builtin_amdgcn_mfma_f32_16x16x32_bf16(kf[n % NF], qf[n >> 2], s[n & 3], 0, 0, 0);
                        __builtin_amdgcn_sched_barrier(0);
                    }
                }
                f32x4 ckv[4]; float ttv = 0.f;
                if constexpr (FOX) { const int cb_ = (it & 1) ? AT_CL1 : AT_CL0;
#pragma unroll
                    for (int blk = 0; blk < 4; ++blk) ckv[blk] = *(const LAS f32x4*)(lds + cb_ + (16 * blk + 4 * fq) * 4);
                    ttv = *(const LAS float*)(lds + ((it & 1) ? AT_TT1 : AT_TT0)); }
                float pv[4][4];
                if constexpr (!FOX) {
                    float lm[4][4], w4[4], Tt[4], Ex[4];
#pragma unroll
                    for (int blk = 0; blk < 4; ++blk) { w4[blk] = 0.f;
#pragma unroll
                        for (int i = 0; i < 4; ++i) { const float z = s[blk][i]; const float sp = softplus_f(z); const bool valid = !need_mask || (kmin + 16 * blk + 4 * fq + i < tq);
                            lm[blk][i] = valid ? -sp : 0.f; pv[blk][i] = valid ? (z - sp) : -1.0e30f; w4[blk] += lm[blk][i]; } }
#pragma unroll
                    for (int blk = 0; blk < 4; ++blk) { const float a = xget16(w4[blk], fq), bq = xget32(w4[blk], fq), c = xget32(a, fq);
                        Tt[blk] = (w4[blk] + a) + (bq + c); Ex[blk] = (fq == 0) ? (a + bq + c) : (fq == 1) ? (bq + c) : (fq == 2) ? a : 0.f; }
                    float bs = 0.f;
#pragma unroll
                    for (int blk = 3; blk >= 0; --blk) { float tail = R + bs + Ex[blk];
#pragma unroll
                        for (int i = 3; i >= 0; --i) { const float e = pv[blk][i] + tail; pv[blk][i] = (e > -80.f) ? fast_exp(e) : 0.f; tail += lm[blk][i]; }
                        bs += Tt[blk]; }
                    R += bs;
                } else {
                    float base;
                    if (kt == 2 * qt + 1) base = ttv; else if (kt == 2 * qt) base = 0.f; else { gacc += ttv; base = -gacc; }
                    float mx = -1.0e30f;
#pragma unroll
                    for (int blk = 0; blk < 4; ++blk) { const f32x4 ck = ckv[blk];
#pragma unroll
                        for (int i = 0; i < 4; ++i) { const bool valid = !need_mask || (kmin + 16 * blk + 4 * fq + i <= tq); const float lg = valid ? (s[blk][i] + cq - (ck[i] + base)) : -1.0e30f; pv[blk][i] = lg; mx = fmaxf(mx, lg); } }
                    mx = xmax32(xmax16(mx));
                    const float mnew = fmaxf(mrun, mx), al = fast_exp(mrun - mnew); float ps = 0.f;
#pragma unroll
                    for (int blk = 0; blk < 4; ++blk)
#pragma unroll
                        for (int i = 0; i < 4; ++i) { const float e = pv[blk][i] - mnew; const float p = (e > -80.f) ? fast_exp(e) : 0.f; pv[blk][i] = p; ps += p; }
                    lsum = lsum * al + ps;
                    if (__any(mnew > mrun)) {
#pragma unroll
                        for (int d = 0; d < 16; ++d) o[d] = o[d] * al; }
                    mrun = mnew;
                }
                bf16x8 pf[2];
#pragma unroll
                for (int c = 0; c < 2; ++c) { u32x4 pw; pw.x = cvt_pk_bf16(pv[2 * c][0], pv[2 * c][1]); pw.y = cvt_pk_bf16(pv[2 * c][2], pv[2 * c][3]); pw.z = cvt_pk_bf16(pv[2 * c + 1][0], pv[2 * c + 1][1]); pw.w = cvt_pk_bf16(pv[2 * c + 1][2], pv[2 * c + 1][3]);
                    pf[c] = __builtin_bit_cast(bf16x8, pw); }
                const unsigned va = (unsigned)(size_t)(lds + vbuf) + vrd;
                s16x4 x0, x1, x2, x3, y0, y1, y2, y3, z0, z1, z2, z3;
                AT_TR4(x0, x1, x2, x3, va, 0, 512, 1024, 1536);
                AT_TR4(y0, y1, y2, y3, va, AT_VPANEL, AT_VPANEL + 512, AT_VPANEL + 1024, AT_VPANEL + 1536);
                z0 = x0; z1 = x1; z2 = x2; z3 = x3;
#define AT_PV(db, A0, A1, A2, A3, F0, F1, F2, F3) do { \
                    if ((db) < 15) asm volatile("s_waitcnt lgkmcnt(4)" : "+v"(A0), "+v"(A1), "+v"(A2), "+v"(A3) :: "memory"); else asm volatile("s_waitcnt lgkmcnt(0)" : "+v"(A0), "+v"(A1), "+v"(A2), "+v"(A3) :: "memory"); \
                    if ((db) < 14) { AT_TR4(F0, F1, F2, F3, va, ((db) + 2) * AT_VPANEL, ((db) + 2) * AT_VPANEL + 512, ((db) + 2) * AT_VPANEL + 1024, ((db) + 2) * AT_VPANEL + 1536); } \
                    { const bf16x8 v0 = __builtin_shufflevector(A0, A1, 0, 1, 2, 3, 4, 5, 6, 7), v1 = __builtin_shufflevector(A2, A3, 0, 1, 2, 3, 4, 5, 6, 7); \
                      o[db] = __builtin_amdgcn_mfma_f32_16x16x32_bf16(v0, pf[0], o[db], 0, 0, 0); o[db] = __builtin_amdgcn_mfma_f32_16x16x32_bf16(v1, pf[1], o[db], 0, 0, 0); } } while (0)
#define AT_PVX(db) AT_PV(db, x0, x1, x2, x3, z0, z1, z2, z3)
#define AT_PVY(db) AT_PV(db, y0, y1, y2, y3, x0, x1, x2, x3)
#define AT_PVZ(db) AT_PV(db, z0, z1, z2, z3, y0, y1, y2, y3)
                AT_PVX(0); AT_PVY(1); AT_PVZ(2); AT_PVX(3); AT_PVY(4); AT_PVZ(5); AT_PVX(6); AT_PVY(7); AT_PVZ(8); AT_PVX(9); AT_PVY(10); AT_PVZ(11); AT_PVX(12); AT_PVY(13); AT_PVZ(14); AT_PVX(15);
#undef AT_PVX
#undef AT_PVY
#undef AT_PVZ
#undef AT_PV
            } else { if constexpr (FOX) { if (kt < 2 * qt) gacc += *(const LAS float*)(lds + ((it & 1) ? AT_TT1 : AT_TT0)); } }
            { bool cont;
              if constexpr (!FOX) cont = (R >= SB_STOP);
              else cont = (qn * KN + cq + ((kt <= 2 * qt) ? gacc : 0.f) - mrun >= FOX_STOP) || (kt > 2 * qt);
              const bool anyc = !wdone && __any(cont); wdone = !anyc;
              if (lane == 0) flags[(it & 1) * 8 + w] = anyc ? 1u : 0u; }
            asm volatile("s_waitcnt vmcnt(0) lgkmcnt(0)" ::: "memory"); __builtin_amdgcn_s_barrier();
            if (kt == 0) break;
            --kt; ++it;
        }
#undef AT_DMA
        float inv = 1.f;
        if constexpr (FOX) { const float lt = xsum32(xsum16(lsum)); inv = 1.f / lt; }
        { GAS bf16_t* op = O + ((size_t)((rowbase + t0 + 16 * w) >> 4) * 32 + h * 8) * 512 + fr * 32 + 8 * fq;
#pragma unroll
          for (int k2 = 0; k2 < 8; ++k2) { u32x4 ow;
              ow.x = cvt_pk_bf16(o[2 * k2][0] * inv, o[2 * k2][1] * inv); ow.y = cvt_pk_bf16(o[2 * k2][2] * inv, o[2 * k2][3] * inv); ow.z = cvt_pk_bf16(o[2 * k2 + 1][0] * inv, o[2 * k2 + 1][1] * inv); ow.w = cvt_pk_bf16(o[2 * k2 + 1][2] * inv, o[2 * k2 + 1][3] * inv);
              *(GAS u32x4*)(op + 512 * k2) = ow; } }
    }
}

constexpr int NPH = 41;
__host__ __device__ inline bool phase_nonempty(int k) { if (k == 0) return true; const int L = (k - 1) / 10, s = (k - 1) % 10; if (s == 1) return L == 2; if (s == 5) return (L & 1) != 0; if (s == 8) return false; return true; }
struct Args { const float* in[N_IN]; float* out; unsigned char* ws; int ph_lo, ph_hi, sub, pad; };

__global__ void __launch_bounds__(NTHREADS, 2) mk_fwd(Args args) {
    extern __shared__ __attribute__((aligned(16))) unsigned char lds_raw[];
    Frame F;
    F.lds = (LAS unsigned char*)lds_raw;
    F.wave = __builtin_amdgcn_readfirstlane((int)threadIdx.x >> 6);
    F.G = gridDim.x; { const int bx = blockIdx.x; F.vcu = (F.G % 8 == 0) ? (bx % 8) * (F.G / 8) + bx / 8 : bx; }
    F.ws = (GAS unsigned char*)args.ws; F.ctl = (GAS unsigned*)F.ws; F.res = (GAS float*)args.out;
    for (int u = (int)threadIdx.x; u < (LDS_BYTES - LDS_CTL) / 4; u += NTHREADS) ((LAS unsigned*)(F.lds + LDS_CTL))[u] = 0u;
    __syncthreads();
    const int lo = args.ph_lo, hi = args.ph_hi;
    XcdBarrier bar; bar.bar = F.ctl + CW_BAR; bar.x = 0; bar.st = nullptr;
    if (hi - lo > 1) bar = xcd_barrier_post(F.ctl + CW_BAR, (volatile LAS unsigned*)(F.lds + LDS_CTL) + 8);
#ifndef UNALIGNED_EPI
#define UNALIGNED_EPI 1
#endif
#ifndef DUP_MASK
#define DUP_MASK 0
#endif
#define DUP(n) (1 + ((DUP_MASK >> (n)) & 1))
#ifndef SITE_MASK
#define SITE_MASK 0xFFFFF
#endif
#define SITE(n) ((SITE_MASK >> (n)) & 1)
#define IN(k) (lo <= (k) && (k) < hi)
#define SEAM(k) do { if ((k) + 1 < hi) xcd_barrier(bar); } while (0)
    const int c = (int)blockIdx.x;
#define WSB(name) GAS unsigned char* name = launder_ptr(F.ws)
#define XBP(ws_, which) ((GAS bf16_t*)((ws_) + ((which) ? WS_XB1 : WS_XB0)))

    if (SITE(0) && IN(0)) { for (int rep_ = 0; rep_ < DUP(0); ++rep_) prologue_phase(F); SEAM(0); }

    for (int L = 0; L < DEPTH; ++L) {
        const int pb = 1 + 10 * L;
        {
            F.wave = launder_int(F.wave); F.ws = launder_ptr(F.ws); F.res = launder_ptr(F.res); F.ctl = (GAS unsigned*)F.ws; F.G = launder_int(F.G); }
        for (int repa_ = 0; repa_ < DUP(20); ++repa_) {
        if (SITE(1) && IN(pb + 0)) {
            WSB(ws);
            const GAS bf16_t* Wqkv = (const GAS bf16_t*)(ws + (L < 2 ? WS_WDEAD : WS_WLIVE)) + (L == 0 ? WD_QKV0 : L == 1 ? WD_QKV1 : L == 2 ? WL_QKV2 : WL_Q3);
            g8::ProbPlain P{XBP(ws, (L + 1) & 1), Wqkv, 1024, 1024, 16, T / 256, (L == 3) ? 4 : 12, F.G, c, 1};
            g8::EpiBf16Split E{(GAS bf16_t*)(ws + WS_QA), 1024, (L == 3) ? 0 : 1024, (size_t)(WS_KS - WS_QA) / 2};
            if (L == 0) cs_finalize(F);
            for (int rep_ = 0; rep_ < DUP(1); ++rep_) g8::gemm_phase<g8::ProbPlain, g8::EpiBf16Split, UNALIGNED_EPI == 0>(F.lds, P, E, F.wave);
            if (SITE(2) && L == 2) forget_phase(F, XBP(ws, (L + 1) & 1));
            SEAM(pb + 0);
        }
        if (SITE(3) && IN(pb + 1) && L == 2) { WSB(ws); knorm_phase(F, (const GAS bf16_t*)(ws + WS_KS)); SEAM(pb + 1); }
        if (IN(pb + 2)) {
            WSB(ws); GAS bf16_t* QA = (GAS bf16_t*)(ws + WS_QA); const GAS bf16_t* KS = (const GAS bf16_t*)(ws + WS_KS); const GAS bf16_t* VS = (const GAS bf16_t*)(ws + WS_VS);
            if (L < 2) { if (SITE(4)) attn_phase<false>(F, QA, KS, VS, QA); } else { if (SITE(5)) attn_phase<true>(F, QA, KS, VS, QA); }
            SEAM(pb + 2);
        }
        }
        if (SITE(6) && IN(pb + 3)) {
            WSB(ws);
            const GAS bf16_t* Wo = (const GAS bf16_t*)(ws + (L < 2 ? WS_WDEAD : WS_WLIVE)) + (L == 0 ? WD_O0 : L == 1 ? WD_O1 : L == 2 ? WL_O2 : WL_O3);
            g8::ProbPlain P{(const GAS bf16_t*)(ws + WS_QA), Wo, 1024, 1024, 16, T / 256, 4, F.G, c, 1};
            g8::EpiResidB<false> E{XBP(ws, (L + 1) & 1), (GAS float*)nullptr, (LAS float*)nullptr};
            g8::gemm_phase<g8::ProbPlain, g8::EpiResidB<false>>(F.lds, P, E, F.wave);
            SEAM(pb + 3);
        }
        if (IN(pb + 4)) { WSB(ws); GAS bf16_t* xln1 = XBP(ws, (L + 1) & 1); if (L & 1) { if (SITE(7)) ln_phase<true, true>(F, L, 0, xln1); } else { if (SITE(8)) ln_phase<false, true>(F, L, 0, xln1); } SEAM(pb + 4); }
        if (SITE(9) && IN(pb + 5) && (L & 1)) { moe_lists_phase(F); SEAM(pb + 5); }
        if (IN(pb + 6)) {
            WSB(ws); const GAS bf16_t* xln1 = XBP(ws, (L + 1) & 1);
            if (L & 1) { if (SITE(10)) { load_tab(F);
                const GAS bf16_t* Wmgu = (const GAS bf16_t*)(ws + (L == 1 ? WS_WDEAD : WS_WLIVE)) + (L == 1 ? WD_MGU0 : WL_MGU1); const GAS i32x4* elist = (const GAS i32x4*)(ws + WS_MISC + MS_ELIST);
                g8::ProbMoeGU P{xln1, Wmgu, elist, (const LAS int*)(F.lds + LDS_TAB), 1024, 1024, 16, F.G, c}; g8::EpiMoeGU E{(GAS bf16_t*)(ws + (L == 1 ? WS_QA : WS_WDEAD)), elist, (const GAS float*)(ws + WS_MISC + MS_EGATE), (LAS float*)(F.lds + LDS_XCH)};
                for (int rep_ = 0; rep_ < DUP(10); ++rep_) g8::gemm_phase<g8::ProbMoeGU, g8::EpiMoeGU, UNALIGNED_EPI == 0>(F.lds, P, E, F.wave);
                if (SITE(17)) {
                    const int rem = ((const LAS int*)(F.lds + LDS_TAB))[TB_ECUM + NE] % F.G;
                    if (c >= rem) { const GAS bf16_t* Wpp = (const GAS bf16_t*)(ws + (L == 1 ? WS_WDEAD : WS_WLIVE)) + (L == 1 ? WD_PP1 : WL_PP3);
                        g8::ProbPlain P2{(const GAS bf16_t*)(ws + WS_PB), Wpp, PLE, PLE, launder_int(4), T / 256, 4, F.G - rem, c - rem}; g8::EpiStoreB E2{(GAS bf16_t*)(ws + WS_VS)};
                        g8::gemm_phase<g8::ProbPlain, g8::EpiStoreB, UNALIGNED_EPI == 0>(F.lds, P2, E2, F.wave); } } } }
            else if (SITE(11)) { const GAS bf16_t* Wgu = (const GAS bf16_t*)(ws + (L == 0 ? WS_WDEAD : WS_WLIVE)) + (L == 0 ? WD_GU0 : WL_GU1);
                g8::ProbPlain P{xln1, Wgu, 1024, 1024, 16, T / 256, 22, F.G, c, 1}; g8::EpiSwiglu E{(GAS bf16_t*)(ws + (L == 0 ? WS_QA : WS_XB0)), DFF};
                for (int rep_ = 0; rep_ < DUP(11); ++rep_) g8::gemm_phase<g8::ProbPlain, g8::EpiSwiglu, UNALIGNED_EPI == 0>(F.lds, P, E, F.wave); }
            SEAM(pb + 6);
        }
        if (IN(pb + 7)) {
            WSB(ws);
            if (L & 1) { if (SITE(12)) { load_tab(F);
                const GAS bf16_t* Wmdn = (const GAS bf16_t*)(ws + (L == 1 ? WS_WDEAD : WS_WLIVE)) + (L == 1 ? WD_MDN0 : WL_MDN1);
                g8::ProbMoeDown P{(const GAS bf16_t*)(ws + (L == 1 ? WS_QA : WS_WDEAD)), Wmdn, (const LAS int*)(F.lds + LDS_TAB), 1408, 5632, 22, F.G, c}; g8::EpiMoeDownB E{XBP(ws, (L + 1) & 1), (const GAS int*)(ws + WS_MISC + MS_PLIST), (GAS float*)(ws + WS_MISC + MS_ST2), (LAS float*)(F.lds + LDS_XCH)};
                g8::gemm_phase<g8::ProbMoeDown, g8::EpiMoeDownB>(F.lds, P, E, F.wave); } }
            else if (SITE(13)) { const GAS bf16_t* Wdn = (const GAS bf16_t*)(ws + (L == 0 ? WS_WDEAD : WS_WLIVE)) + (L == 0 ? WD_DN0 : WL_DN1);
                g8::ProbPlain P{(const GAS bf16_t*)(ws + (L == 0 ? WS_QA : WS_XB0)), Wdn, DFF, DFF, 44, T / 256, 4, F.G, c, 1}; g8::EpiResidB<true> E{XBP(ws, (L + 1) & 1), (GAS float*)(ws + WS_MISC + MS_ST2), (LAS float*)(F.lds + LDS_XCH)};
                g8::gemm_phase<g8::ProbPlain, g8::EpiResidB<true>>(F.lds, P, E, F.wave); }
            SEAM(pb + 7);
        }
        if (IN(pb + 9)) {
            if (SITE(16) && !(L & 1)) { WSB(ws); const GAS bf16_t* Wpp = (const GAS bf16_t*)(ws + (L < 2 ? WS_WDEAD : WS_WLIVE)) + (L == 0 ? WD_PP0 : WL_PP2);
                g8::ProbPlain P{(const GAS bf16_t*)(ws + WS_PB), Wpp, PLE, PLE, launder_int(4), T / 256, 4, F.G, c}; g8::EpiStoreB E{(GAS bf16_t*)(ws + WS_QA)};
                g8::gemm_phase<g8::ProbPlain, g8::EpiStoreB, UNALIGNED_EPI == 0>(F.lds, P, E, F.wave); }
            if (SITE(15)) { WSB(ws); const GAS bf16_t* Wpg = (const GAS bf16_t*)(ws + (L < 2 ? WS_WDEAD : WS_WLIVE)) + (L == 0 ? WD_PG0 : L == 1 ? WD_PG1 : L == 2 ? WL_PG2 : WL_PG3);
                g8::ProbPlain P{XBP(ws, (L + 1) & 1), Wpg, 1024, 1024, 16, T / 256, 4, F.G, c, 1};
                g8::EpiGatePleLN E{XBP(ws, (L + 1) & 1), XBP(ws, L & 1), L == DEPTH - 1 ? F.res : (GAS float*)nullptr, (const GAS float*)(ws + WS_MISC + MS_ST2), (const GAS float*)(ws + WS_MISC + MS_CS) + CS_PG0 + 1024 * L, (const GAS float*)(ws + WS_MISC + MS_CS) + CS_TOTAL + CS_PG0 + 1024 * L, in_sel(IN_LNG) + (size_t)(2 * L + 1) * DM, in_sel(IN_LNB) + (size_t)(2 * L + 1) * DM, (LAS float*)(F.lds + LDS_XCH), (const GAS bf16_t*)(ws + ((L & 1) ? WS_VS : WS_QA))};
                for (int rep_ = 0; rep_ < DUP(15); ++rep_) g8::gemm_phase<g8::ProbPlain, g8::EpiGatePleLN>(F.lds, P, E, F.wave); }
            if (pb + 9 < NPH - 1) SEAM(pb + 9);
        }
    }
#undef WSB
#undef XBP
#undef IN
#undef SEAM
}

extern "C" void kernel_launch(void* const* d_in, const int* in_sizes, int n_in, void* d_out, int out_size, void* d_ws, size_t ws_size, hipStream_t stream) {
    static int grid = 0;
    if (grid == 0) {
        if (n_in != N_IN || out_size != T * DM || ws_size < WS_END) { fprintf(stderr, "kernel_launch: unexpected problem (n_in %d, out %d, ws %zu < %zu)\n", n_in, out_size, ws_size, (size_t)WS_END); grid = -1; return; }
        int dev = 0, cus = 0, per_cu = 0;
        if (hipGetDevice(&dev) != hipSuccess || hipDeviceGetAttribute(&cus, hipDeviceAttributeMultiprocessorCount, dev) != hipSuccess) { grid = -1; return; }
        if (hipFuncSetAttribute((const void*)mk_fwd, hipFuncAttributeMaxDynamicSharedMemorySize, LDS_BYTES) != hipSuccess) { fprintf(stderr, "kernel_launch: hipFuncSetAttribute failed\n"); grid = -1; return; }
        if (hipOccupancyMaxActiveBlocksPerMultiprocessor(&per_cu, (const void*)mk_fwd, NTHREADS, LDS_BYTES) != hipSuccess || per_cu < 1) { fprintf(stderr, "kernel_launch: occupancy query says %d blocks per CU\n", per_cu); }
        (void)hipGetLastError();
        grid = cus;
    }
    if (grid < 0) return;
    (void)hipMemsetAsync((char*)d_ws + WS_CTL, 0, CTL_ZERO_BYTES, stream);
    Args a{};
    for (int i = 0; i < N_IN; ++i) a.in[i] = (const float*)d_in[i];
    a.out = (float*)d_out; a.ws = (unsigned char*)d_ws;
    a.ph_lo = 0; a.ph_hi = NPH; a.sub = 0; a.pad = 0;
    hipLaunchKernelGGL(mk_fwd, dim3(grid), dim3(NTHREADS), LDS_BYTES, stream, a);
}
```
